# Optimizing an MI355X kernel written in HIP

```python
import math
import jax, jax.numpy as jnp
from jax import lax
import numpy as np

D_MODEL = 1024
BATCH = 4
SEQ = 4096
DEPTH = 2

BRANCH_WIDTH = D_MODEL // 2
N_BRANCHES = 3
EPS = 1e-6

A_HEADS = 4
A_DK = BRANCH_WIDTH // A_HEADS
A_DV = BRANCH_WIDTH // A_HEADS
A_CHUNK = 64

B_HEADS = 4
B_DK = BRANCH_WIDTH // B_HEADS
B_DV = BRANCH_WIDTH // B_HEADS
B_CONV = 4
B_CONV_CH = B_HEADS * (2 * B_DK + B_DV)
B_CHUNK = 64

C_Q_HEADS = 8
C_KV_HEADS = 2
C_GROUP = C_Q_HEADS // C_KV_HEADS
C_HEAD_DIM = BRANCH_WIDTH // C_Q_HEADS
WINDOW = 128
C_BLOCK = 128
N_BUCKETS = 32
MAX_DISTANCE = 128

IN_WIDTHS = (
    A_HEADS * A_DK, A_HEADS * A_DK, A_HEADS * A_DV, A_HEADS * A_DV,
    B_CONV_CH, B_HEADS * B_DV, B_HEADS, B_HEADS,
    C_Q_HEADS * C_HEAD_DIM, C_KV_HEADS * C_HEAD_DIM,
    C_KV_HEADS * C_HEAD_DIM, C_Q_HEADS * C_HEAD_DIM,
    N_BRANCHES * D_MODEL,
)
N_IN = sum(IN_WIDTHS)

kernel_name = 'hybrid_hgrn2_gdn_swa_sink_gated_merge'

F32 = jnp.float32


def _rmsnorm(x, w):
    x32 = x.astype(F32)
    y = x32 * lax.rsqrt(jnp.mean(x32 * x32, axis=-1, keepdims=True) + EPS)
    return (y * w.astype(F32)).astype(x.dtype)


def _gated_rmsnorm(o, gate, w):
    y = o * lax.rsqrt(jnp.mean(o * o, axis=-1, keepdims=True) + EPS) * w.astype(F32)
    return y * jax.nn.silu(gate)


def _l2norm(t):
    return t * lax.rsqrt(jnp.sum(t * t, axis=-1, keepdims=True) + EPS)


def _causal_conv(x, w):
    return lax.conv_general_dilated(
        x, w[:, None, :].astype(x.dtype), window_strides=(1,), padding=[(B_CONV - 1, 0)],
        dimension_numbers=('NWC', 'WIO', 'NWC'), feature_group_count=x.shape[-1])


def _t5_bucket(dist):
    max_exact = N_BUCKETS // 2
    d_f = jnp.maximum(dist, 1).astype(F32)
    large = max_exact + (jnp.log(d_f / max_exact) / math.log(MAX_DISTANCE / max_exact)
                         * (N_BUCKETS - max_exact)).astype(jnp.int32)
    large = jnp.minimum(large, N_BUCKETS - 1)
    return jnp.where(dist < max_exact, dist, large)


def _band_dist():
    i = jnp.arange(C_BLOCK)[:, None]
    j = jnp.arange(2 * C_BLOCK)[None, :]
    return i + C_BLOCK - j


def _band_bias(rel_bias):
    bucket = _t5_bucket(jnp.maximum(_band_dist(), 0))
    bias = rel_bias.astype(F32)[bucket]
    return bias.transpose(2, 0, 1).reshape(C_KV_HEADS, C_GROUP, C_BLOCK, 2 * C_BLOCK)


def _hgrn2_branch(q, f, i, g, lb, norm_w):
    Bn, S, _ = q.shape
    n = S // A_CHUNK
    q = jax.nn.silu(q.astype(F32))
    z = f.astype(F32)
    log_f = jnp.logaddexp(jnp.log(lb), jnp.log1p(-lb) + jax.nn.log_sigmoid(z))
    k = (1.0 - lb) * jax.nn.sigmoid(-z)

    def chunks(t, d):
        return t.reshape(Bn, n, A_CHUNK, A_HEADS, d).transpose(1, 0, 3, 2, 4)

    qc, kc, gc = chunks(q, A_DK), chunks(k, A_DK), chunks(log_f, A_DK)
    vc = chunks(i.astype(F32), A_DV)
    causal = jnp.tril(jnp.ones((A_CHUNK, A_CHUNK), dtype=bool))[:, :, None]

    def step(state, inp):
        qb, kb, vb, gb = inp
        b = jnp.cumsum(gb, axis=2)
        diff = b[:, :, :, None, :] - b[:, :, None, :, :]
        decay = jnp.exp(jnp.where(causal, diff, -jnp.inf))
        scores = jnp.einsum('bhtk,bhsk,bhtsk->bhts', qb, kb, decay)
        o = (jnp.einsum('bhts,bhsv->bhtv', scores, vb)
             + jnp.einsum('bhtk,bhkv->bhtv', qb * jnp.exp(b), state))
        b_end = b[:, :, -1:, :]
        state = (state * jnp.exp(b_end[:, :, 0, :, None])
                 + jnp.einsum('bhsk,bhsv->bhkv', kb * jnp.exp(b_end - b), vb))
        return state, o

    state0 = jnp.zeros((Bn, A_HEADS, A_DK, A_DV), F32)
    _, o = lax.scan(step, state0, (qc, kc, vc, gc))
    o = o.transpose(1, 0, 3, 2, 4).reshape(Bn, S, A_HEADS, A_DV)
    gate = g.astype(F32).reshape(Bn, S, A_HEADS, A_DV)
    return _gated_rmsnorm(o, gate, norm_w).reshape(Bn, S, A_HEADS * A_DV)


def _gated_deltanet_branch(qkv, z, beta_logit, a_logit, conv_w, a_log, dt_bias, norm_w):
    Bn, S, _ = qkv.shape
    n = S // B_CHUNK
    C = B_CHUNK
    qkv = jax.nn.silu(_causal_conv(qkv, conv_w)).astype(F32)
    q, k, v = jnp.split(qkv, [B_HEADS * B_DK, 2 * B_HEADS * B_DK], axis=-1)
    q = _l2norm(q.reshape(Bn, S, B_HEADS, B_DK)) * (B_DK ** -0.5)
    k = _l2norm(k.reshape(Bn, S, B_HEADS, B_DK))
    v = v.reshape(Bn, S, B_HEADS, B_DV)
    beta = jax.nn.sigmoid(beta_logit.astype(F32))
    g = -jnp.exp(a_log.astype(F32)) * jax.nn.softplus(a_logit.astype(F32) + dt_bias.astype(F32))

    def chunks4(t):
        return t.reshape(Bn, n, C, B_HEADS, t.shape[-1]).transpose(1, 0, 3, 2, 4)

    def chunks3(t):
        return t.reshape(Bn, n, C, B_HEADS).transpose(1, 0, 3, 2)

    qc, kc, vc = chunks4(q), chunks4(k), chunks4(v)
    bc, gcum = chunks3(beta), jnp.cumsum(chunks3(g), axis=-1)
    incl = jnp.tril(jnp.ones((C, C), dtype=bool))
    strict = jnp.tril(jnp.ones((C, C), dtype=bool), k=-1)
    L = jnp.exp(jnp.where(incl, gcum[..., :, None] - gcum[..., None, :], -jnp.inf))
    kb = kc * bc[..., None]
    A = jnp.where(strict, jnp.einsum('nbhtd,nbhsd->nbhts', kb, kc) * L, 0.0)
    eye = jnp.eye(C, dtype=F32)
    T = lax.linalg.triangular_solve(eye + A, jnp.broadcast_to(eye, A.shape),
                                    left_side=True, lower=True, unit_diagonal=True)
    u = T @ (vc * bc[..., None])
    w = T @ (kb * jnp.exp(gcum)[..., None])
    qk = jnp.where(incl, jnp.einsum('nbhtd,nbhsd->nbhts', qc, kc) * L, 0.0)
    q_dec = qc * jnp.exp(gcum)[..., None]
    k_dec = kc * jnp.exp(gcum[..., -1:] - gcum)[..., None]
    g_end = jnp.exp(gcum[..., -1])

    def step(state, inp):
        qk_c, u_c, w_c, qd_c, kd_c, ge_c = inp
        v_new = u_c - jnp.einsum('bhtk,bhkv->bhtv', w_c, state)
        o = (jnp.einsum('bhtk,bhkv->bhtv', qd_c, state)
             + jnp.einsum('bhts,bhsv->bhtv', qk_c, v_new))
        state = state * ge_c[..., None, None] + jnp.einsum('bhsk,bhsv->bhkv', kd_c, v_new)
        return state, o

    state0 = jnp.zeros((Bn, B_HEADS, B_DK, B_DV), F32)
    _, o = lax.scan(step, state0, (qk, u, w, q_dec, k_dec, g_end))
    o = o.transpose(1, 0, 3, 2, 4).reshape(Bn, S, B_HEADS, B_DV)
    gate = z.astype(F32).reshape(Bn, S, B_HEADS, B_DV)
    return _gated_rmsnorm(o, gate, norm_w).reshape(Bn, S, B_HEADS * B_DV)


def _swa_sink_branch(q, k, v, g, sinks, bias_blk):
    Bn, S, _ = q.shape
    nb = S // C_BLOCK
    qb = q.astype(F32).reshape(Bn, nb, C_BLOCK, C_KV_HEADS, C_GROUP, C_HEAD_DIM)

    def band(t):
        t = t.astype(F32).reshape(Bn, S, C_KV_HEADS, C_HEAD_DIM)
        t = jnp.pad(t, ((0, 0), (C_BLOCK, 0), (0, 0), (0, 0)))
        t = t.reshape(Bn, nb + 1, C_BLOCK, C_KV_HEADS, C_HEAD_DIM)
        return jnp.concatenate([t[:, :-1], t[:, 1:]], axis=2)

    kb, vb = band(k), band(v)
    logits = jnp.einsum('bnqhgd,bnkhd->bnhgqk', qb, kb) * (C_HEAD_DIM ** -0.5) + bias_blk
    dist = _band_dist()
    key_pos = jnp.arange(nb)[:, None] * C_BLOCK + jnp.arange(2 * C_BLOCK)[None, :] - C_BLOCK
    mask = ((dist >= 0) & (dist < WINDOW))[None, :, :] & (key_pos >= 0)[:, None, :]
    logits = jnp.where(mask[None, :, None, None], logits, -jnp.inf)
    sink = jnp.broadcast_to(sinks.astype(F32).reshape(C_KV_HEADS, C_GROUP)[:, :, None, None],
                            logits.shape[:-1] + (1,))
    probs = jax.nn.softmax(jnp.concatenate([logits, sink], axis=-1), axis=-1)[..., :-1]
    o = jnp.einsum('bnhgqk,bnkhd->bnqhgd', probs, vb).reshape(Bn, S, C_Q_HEADS * C_HEAD_DIM)
    return o * jax.nn.silu(g.astype(F32))


def setup_inputs(seed: int = 0) -> dict:
    key = jax.random.key(seed)
    ks = jax.random.split(key, 15)
    nrm = jax.random.normal
    x = nrm(ks[0], (BATCH, SEQ, D_MODEL), F32)
    norm_w = 1.0 + 0.02 * nrm(ks[1], (DEPTH, D_MODEL), F32)
    w_in = nrm(ks[2], (DEPTH, D_MODEL, N_IN), F32) * (D_MODEL ** -0.5)
    conv_w = nrm(ks[3], (DEPTH, B_CONV, B_CONV_CH), F32) * (B_CONV ** -0.5)
    a_log = jnp.log(jax.random.uniform(ks[4], (DEPTH, B_HEADS), F32, 1.0, 16.0))
    dt = jnp.exp(jax.random.uniform(ks[5], (DEPTH, B_HEADS), F32, math.log(1e-3), math.log(0.1)))
    dt_bias = dt + jnp.log(-jnp.expm1(-dt))
    lb_param = 0.1 * nrm(ks[6], (DEPTH, A_HEADS * A_DK), F32)
    norm_a = 1.0 + 0.02 * nrm(ks[7], (DEPTH, A_DV), F32)
    norm_b = 1.0 + 0.02 * nrm(ks[8], (DEPTH, B_DV), F32)
    sinks = 0.5 * nrm(ks[9], (DEPTH, C_Q_HEADS), F32)
    rel_bias = 0.5 * nrm(ks[10], (N_BUCKETS, C_Q_HEADS), F32)
    w_branch = nrm(ks[11], (DEPTH, N_BRANCHES, BRANCH_WIDTH, D_MODEL), F32) * (BRANCH_WIDTH ** -0.5)
    w_out = nrm(ks[12], (DEPTH, D_MODEL, D_MODEL), F32) * (D_MODEL ** -0.5)
    final_norm = 1.0 + 0.02 * nrm(ks[13], (D_MODEL,), F32)
    return {'x': x, 'norm_w': norm_w, 'w_in': w_in, 'conv_w': conv_w, 'a_log': a_log,
            'dt_bias': dt_bias, 'lb_param': lb_param, 'norm_a': norm_a, 'norm_b': norm_b,
            'sinks': sinks, 'rel_bias': rel_bias, 'w_branch': w_branch, 'w_out': w_out,
            'final_norm': final_norm}


def reference(x, norm_w, w_in, conv_w, a_log, dt_bias, lb_param, norm_a, norm_b,
              sinks, rel_bias, w_branch, w_out, final_norm):
    Bn, S, _ = x.shape
    split_points = np.cumsum(IN_WIDTHS)[:-1].tolist()
    lb_all = jnp.cumsum(jax.nn.softmax(lb_param.astype(F32), axis=0), axis=0)
    lb_all = lb_all - lb_all[0:1]
    bias_blk = _band_bias(rel_bias)
    for l in range(DEPTH):
        h = _rmsnorm(x, norm_w[l])
        proj = h @ w_in[l]
        (a_q, a_f, a_i, a_g, b_qkv, b_z, b_beta, b_a,
         c_q, c_k, c_v, c_g, gate_logits) = jnp.split(proj, split_points, axis=-1)
        y_a = _hgrn2_branch(a_q, a_f, a_i, a_g, lb_all[l], norm_a[l])
        y_b = _gated_deltanet_branch(b_qkv, b_z, b_beta, b_a, conv_w[l], a_log[l],
                                     dt_bias[l], norm_b[l])
        y_c = _swa_sink_branch(c_q, c_k, c_v, c_g, sinks[l], bias_blk)
        ys = jnp.stack([y_a, y_b, y_c], axis=2).astype(x.dtype)
        lifted = jnp.einsum('bsnc,ncd->bsnd', ys, w_branch[l])
        gates = jax.nn.sigmoid(gate_logits.reshape(Bn, S, N_BRANCHES, D_MODEL))
        merged = jnp.sum(gates * lifted, axis=2)
        x = x + merged @ w_out[l]
    return _rmsnorm(x, final_norm)
```

```cpp
#include <hip/hip_runtime.h>
#include <hip/hip_cooperative_groups.h>
#include <cstdio>
#include <cstdint>
namespace cg = cooperative_groups;

typedef unsigned short bf16_t;
typedef short bf16x8 __attribute__((ext_vector_type(8)));
typedef float f32x4 __attribute__((ext_vector_type(4)));
typedef float f32x2 __attribute__((ext_vector_type(2)));
typedef unsigned u32x4 __attribute__((ext_vector_type(4)));
typedef unsigned u32x2 __attribute__((ext_vector_type(2)));
typedef __bf16 bf16x2v __attribute__((ext_vector_type(2)));

constexpr int BATCH = 4, SEQ = 4096, M = BATCH * SEQ, D = 1024, DEPTH = 2;
constexpr int NORIG = 8456;
constexpr int NMIX = 5376;
constexpr int NGATE = 3072;
constexpr int NALL = NMIX + NGATE;
constexpr int LDP = NMIX;
constexpr int PC_AQ = 0, PC_AI = 1024, PC_AG = 1536, PC_BQKV = 2048, PC_BZ = 3584, PC_CQ = 4096, PC_CK = 4608, PC_CV = 4736, PC_CG = 4864;
constexpr float EPS = 1e-6f;
constexpr int NTHREADS = 512;
constexpr int LDS_BYTES = 98304;
#define DIAG_ZERO_C 0
#define DIAG_NAIVE_C 1

constexpr size_t WS_P = 0;
constexpr size_t WS_AF = WS_P + (size_t)M * LDP * 2;
constexpr size_t WS_HB = WS_AF + (size_t)M * 512 * 4;
constexpr size_t WS_WIN = WS_HB + (size_t)M * D * 2;
constexpr size_t WS_WB = WS_WIN + (size_t)NALL * D * 2;
constexpr size_t WS_WO = WS_WB + (size_t)D * 1536 * 2;
constexpr size_t WS_SM = WS_WO + (size_t)D * D * 2;
constexpr size_t WS_END = WS_SM + (size_t)M * 8 * 4;

__device__ const unsigned char kBucket[128] = {0, 1, 2, 3, 4, 5, 6, 7, 8, 9, 10, 11, 12, 13, 14, 15, 16, 16, 16, 17, 17, 18, 18, 18, 19, 19, 19, 20, 20, 20, 20, 21, 21, 21, 21, 22, 22, 22, 22, 22, 23, 23, 23, 23, 23, 23, 24, 24, 24, 24, 24, 24, 25, 25, 25, 25, 25, 25, 25, 26, 26, 26, 26, 26, 26, 26, 26, 27, 27, 27, 27, 27, 27, 27, 27, 27, 27, 28, 28, 28, 28, 28, 28, 28, 28, 28, 28, 29, 29, 29, 29, 29, 29, 29, 29, 29, 29, 29, 29, 30, 30, 30, 30, 30, 30, 30, 30, 30, 30, 30, 30, 30, 30, 31, 31, 31, 31, 31, 31, 31, 31, 31, 31, 31, 31, 31, 31, 31};

struct Params {
    const float* x; const float* norm_w; const float* w_in; const float* conv_w; const float* a_log; const float* dt_bias;
    const float* lb_param; const float* norm_a; const float* norm_b; const float* sinks; const float* rel_bias;
    const float* w_branch; const float* w_out; const float* final_norm;
    float* out; unsigned char* ws;
};

__device__ __forceinline__ unsigned f2bf(float f) { unsigned u = __builtin_bit_cast(unsigned, f); return (u + 0x7fffu + ((u >> 16) & 1u)) >> 16; }
__device__ __forceinline__ unsigned pk2(float lo, float hi) { return f2bf(lo) | (f2bf(hi) << 16); }
__device__ __forceinline__ float bf_lo(unsigned u) { return __builtin_bit_cast(float, u << 16); }
__device__ __forceinline__ float bf_hi(unsigned u) { return __builtin_bit_cast(float, u & 0xffff0000u); }
__device__ __forceinline__ float bf2f(bf16_t b) { return __builtin_bit_cast(float, (unsigned)b << 16); }
__device__ __forceinline__ int tid_() { int t = threadIdx.x; asm volatile("" : "+v"(t)); return t; }
__device__ __forceinline__ int bid_() { int b = blockIdx.x; asm volatile("" : "+s"(b)); return b; }
__device__ __forceinline__ float sigmoidf_(float x) { return 1.0f / (1.0f + __expf(-x)); }
__device__ __forceinline__ float siluf_(float x) { return x / (1.0f + __expf(-x)); }
template <int CTRL> __device__ __forceinline__ float dpp_mov(float x) { return __builtin_bit_cast(float, __builtin_amdgcn_mov_dpp(__builtin_bit_cast(int, x), CTRL, 0xf, 0xf, true)); }
__device__ __forceinline__ float row16_sum(float x) { x += dpp_mov<0xB1>(x); x += dpp_mov<0x4E>(x); x += dpp_mov<0x141>(x); x += dpp_mov<0x128>(x); return x; }
__device__ __forceinline__ float xor16_sum(float x) { auto s = __builtin_amdgcn_permlane16_swap(__float_as_uint(x), __float_as_uint(x), false, false); return __uint_as_float(s[0]) + __uint_as_float(s[1]); }
__device__ __forceinline__ float xor32_sum(float x) { auto s = __builtin_amdgcn_permlane32_swap(__float_as_uint(x), __float_as_uint(x), false, false); return __uint_as_float(s[0]) + __uint_as_float(s[1]); }
__device__ __forceinline__ float wave_sum(float x) { return xor32_sum(xor16_sum(row16_sum(x))); }

__device__ __forceinline__ void transpose_item(const float* W, int ldsrc, int k0, int nsrc0, bf16_t* WT, int ldd, int ndst0, int kdst0, float* scr, int lane) {
#pragma unroll 8
    for (int i = 0; i < 32; ++i) { const int kk = 2 * i + (lane >> 5); scr[kk * 33 + (lane & 31)] = W[(size_t)(k0 + kk) * ldsrc + nsrc0 + (lane & 31)]; }
    __builtin_amdgcn_wave_barrier();
    asm volatile("s_waitcnt lgkmcnt(0)" ::: "memory");
    const int c = lane & 7;
#pragma unroll
    for (int j = 0; j < 4; ++j) { const int n = (lane >> 3) + 8 * j; const float* s = scr + (8 * c) * 33 + n;
        u32x4 o; o.x = pk2(s[0 * 33], s[1 * 33]); o.y = pk2(s[2 * 33], s[3 * 33]); o.z = pk2(s[4 * 33], s[5 * 33]); o.w = pk2(s[6 * 33], s[7 * 33]);
        *(u32x4*)(WT + (size_t)(ndst0 + n) * ldd + kdst0 + k0 + 8 * c) = o; }
    asm volatile("s_waitcnt lgkmcnt(0)" ::: "memory");
    __builtin_amdgcn_wave_barrier();
}
__device__ __forceinline__ void phase_convert_weights(const Params& p, int l, unsigned char* lds) {
    const int tid = tid_(), lane = tid & 63, wave = tid >> 6;
    float* scr = (float*)(lds) + wave * (64 * 33);
    bf16_t* WinT = (bf16_t*)(p.ws + WS_WIN); bf16_t* WbT = (bf16_t*)(p.ws + WS_WB); bf16_t* WoT = (bf16_t*)(p.ws + WS_WO);
    const float* win = p.w_in + (size_t)l * D * NORIG; const float* wbr = p.w_branch + (size_t)l * 3 * 512 * D; const float* wo = p.w_out + (size_t)l * D * D;
    constexpr int I_IN = (D / 64) * (NALL / 32), I_B = (512 / 64) * (D / 32), I_O = (D / 64) * (D / 32);
    constexpr int NITEMS = I_IN + 3 * I_B + I_O;
    const int gw = bid_() * 8 + wave, NGW = gridDim.x * 8;
    for (int it = gw; it < NITEMS; it += NGW) {
        int r = it;
        if (r < I_IN) { const int nb = r % (NALL / 32), kb = r / (NALL / 32); const int n0 = nb * 32; const int ns = n0 < 4096 ? n0 : n0 + 8;
            transpose_item(win, NORIG, kb * 64, ns, WinT, D, n0, 0, scr, lane); continue; }
        r -= I_IN;
        if (r < 3 * I_B) { const int br = r / I_B; const int q = r % I_B; const int nb = q % (D / 32), kb = q / (D / 32);
            transpose_item(wbr + (size_t)br * 512 * D, D, kb * 64, nb * 32, WbT, 1536, nb * 32, br * 512, scr, lane); continue; }
        r -= 3 * I_B;
        { const int nb = r % (D / 32), kb = r / (D / 32); transpose_item(wo, D, kb * 64, nb * 32, WoT, D, nb * 32, 0, scr, lane); }
    }
}

template <int MODE>
__device__ __forceinline__ void phase_rowpass(const Params& p, const float* xin, const float* nw, int l, unsigned char* lds) {
    const int tid = tid_(), lane = tid & 63, wave = tid >> 6;
    float* wsm = (float*)lds;
    if (MODE == 0) {
        const float* win = p.w_in + (size_t)l * D * NORIG;
        for (int i = tid; i < 8 * D; i += NTHREADS) { const int k = i >> 3, e = i & 7; wsm[e * D + k] = win[(size_t)k * NORIG + 4096 + e]; }
        __syncthreads();
    }
    bf16_t* hb = (bf16_t*)(p.ws + WS_HB); float* sm8 = (float*)(p.ws + WS_SM);
    const int gw = bid_() * 8 + wave, NGW = gridDim.x * 8;
    f32x4 wv[4];
#pragma unroll
    for (int j = 0; j < 4; ++j) wv[j] = *(const f32x4*)(nw + 256 * j + 4 * lane);
    for (int m = gw; m < M; m += NGW) {
        const float* xr = xin + (size_t)m * D;
        f32x4 v[4]; float s = 0.f;
#pragma unroll
        for (int j = 0; j < 4; ++j) { v[j] = *(const f32x4*)(xr + 256 * j + 4 * lane); s += (v[j].x * v[j].x + v[j].y * v[j].y) + (v[j].z * v[j].z + v[j].w * v[j].w); }
        const float rstd = 1.0f / sqrtf(wave_sum(s) * (1.0f / D) + EPS);
#pragma unroll
        for (int j = 0; j < 4; ++j) v[j] = v[j] * rstd * wv[j];
        if (MODE == 1) {
            float* orow = p.out + (size_t)m * D;
#pragma unroll
            for (int j = 0; j < 4; ++j) *(f32x4*)(orow + 256 * j + 4 * lane) = v[j];
        } else {
            bf16_t* hr = hb + (size_t)m * D;
#pragma unroll
            for (int j = 0; j < 4; ++j) { u32x2 o; o.x = pk2(v[j].x, v[j].y); o.y = pk2(v[j].z, v[j].w); *(u32x2*)(hr + 256 * j + 4 * lane) = o; }
            float acc8[8];
#pragma unroll
            for (int e = 0; e < 8; ++e) { float a = 0.f;
#pragma unroll
                for (int j = 0; j < 4; ++j) { const f32x4 w4 = *(const f32x4*)(wsm + e * D + 256 * j + 4 * lane); a += (v[j].x * w4.x + v[j].y * w4.y) + (v[j].z * w4.z + v[j].w * w4.w); }
                acc8[e] = wave_sum(a); }
            if (lane == 0) { *(f32x4*)(sm8 + (size_t)m * 8) = (f32x4){acc8[0], acc8[1], acc8[2], acc8[3]}; *(f32x4*)(sm8 + (size_t)m * 8 + 4) = (f32x4){acc8[4], acc8[5], acc8[6], acc8[7]}; }
        }
    }
}

constexpr int G_LDT = 72;
constexpr int G_TILE_BYTES = 128 * G_LDT * 2;
__device__ __forceinline__ void gemm_tile_acc(const bf16_t* A, int lda, const bf16_t* Bt, int ldb, int K, f32x4 (&acc)[2][4], unsigned char* lds) {
    const int tid = tid_(), lane = tid & 63, wave = tid >> 6, wm = wave >> 1, wn = wave & 1, fr = lane & 15, fq = lane >> 4;
    bf16_t* sA = (bf16_t*)lds; bf16_t* sB = (bf16_t*)(lds + G_TILE_BYTES);
    const int r0 = tid >> 3, c0 = (tid & 7) * 8;
    u32x4 ra[2], rb[2];
    const bf16_t* ga = A + (size_t)r0 * lda + c0; const bf16_t* gb = Bt + (size_t)r0 * ldb + c0;
    ra[0] = *(const u32x4*)(ga); ra[1] = *(const u32x4*)(ga + (size_t)64 * lda);
    rb[0] = *(const u32x4*)(gb); rb[1] = *(const u32x4*)(gb + (size_t)64 * ldb);
    const int nk = K / 64;
    for (int kt = 0; kt < nk; ++kt) {
        __syncthreads();
        *(u32x4*)(sA + r0 * G_LDT + c0) = ra[0]; *(u32x4*)(sA + (r0 + 64) * G_LDT + c0) = ra[1];
        *(u32x4*)(sB + r0 * G_LDT + c0) = rb[0]; *(u32x4*)(sB + (r0 + 64) * G_LDT + c0) = rb[1];
        __syncthreads();
        if (kt + 1 < nk) { const int ko = (kt + 1) * 64;
            ra[0] = *(const u32x4*)(ga + ko); ra[1] = *(const u32x4*)(ga + (size_t)64 * lda + ko);
            rb[0] = *(const u32x4*)(gb + ko); rb[1] = *(const u32x4*)(gb + (size_t)64 * ldb + ko); }
#pragma unroll
        for (int ks = 0; ks < 2; ++ks) {
            bf16x8 af[2], bfr[4];
#pragma unroll
            for (int m = 0; m < 2; ++m) af[m] = *(const bf16x8*)(sA + (wm * 32 + m * 16 + fr) * G_LDT + ks * 32 + fq * 8);
#pragma unroll
            for (int n = 0; n < 4; ++n) bfr[n] = *(const bf16x8*)(sB + (wn * 64 + n * 16 + fr) * G_LDT + ks * 32 + fq * 8);
#pragma unroll
            for (int m = 0; m < 2; ++m)
#pragma unroll
                for (int n = 0; n < 4; ++n) acc[m][n] = __builtin_amdgcn_mfma_f32_16x16x32_bf16(bfr[n], af[m], acc[m][n], 0, 0, 0);
        }
    }
}
#define ACC_ZERO(acc) do { _Pragma("unroll") for (int m_ = 0; m_ < 2; ++m_) _Pragma("unroll") for (int n_ = 0; n_ < 4; ++n_) acc[m_][n_] = (f32x4){0.f, 0.f, 0.f, 0.f}; } while (0)
#define ACC_ROW(m) (wm * 32 + (m) * 16 + fr)
#define ACC_COL(n) (wn * 64 + (n) * 16 + 4 * fq)

__device__ __forceinline__ void phase_inproj(const Params& p, int l, unsigned char* lds) {
    const int tid = tid_(), lane = tid & 63, wave = tid >> 6, wm = wave >> 1, wn = wave & 1, fr = lane & 15, fq = lane >> 4;
    const bf16_t* hb = (const bf16_t*)(p.ws + WS_HB); const bf16_t* WinT = (const bf16_t*)(p.ws + WS_WIN);
    bf16_t* P = (bf16_t*)(p.ws + WS_P); float* AF = (float*)(p.ws + WS_AF);
    constexpr int NTN = NMIX / 128, NTM = M / 128;
    for (int u = bid_(); u < NTN * NTM; u += gridDim.x) {
        const int pn = u % NTN, pm = u / NTN;
        f32x4 acc[2][4]; ACC_ZERO(acc);
        gemm_tile_acc(hb + (size_t)pm * 128 * D, D, WinT + (size_t)pn * 128 * D, D, D, acc, lds);
        const int colt = pn * 128;
#pragma unroll
        for (int m = 0; m < 2; ++m)
#pragma unroll
            for (int n = 0; n < 4; ++n) {
                const int row = pm * 128 + ACC_ROW(m), col = colt + ACC_COL(n); f32x4 v = acc[m][n];
                if (colt >= 512 && colt < 1024) {
                    f32x4 o;
#pragma unroll
                    for (int e = 0; e < 4; ++e) { float lb = 0.f; if (l == 1) { const float p0 = p.lb_param[col - 512 + e], p1 = p.lb_param[512 + col - 512 + e]; lb = 1.0f / (1.0f + __expf(p0 - p1)); }
                        o[e] = lb + (1.0f - lb) * sigmoidf_(v[e]); }
                    *(f32x4*)(AF + (size_t)row * 512 + (col - 512)) = o;
                } else {
                    if (colt < 512) { v[0] = siluf_(v[0]); v[1] = siluf_(v[1]); v[2] = siluf_(v[2]); v[3] = siluf_(v[3]); }
                    else if (colt >= PC_CQ && colt < PC_CK) { v = v * 0.125f; }
                    u32x2 o; o.x = pk2(v[0], v[1]); o.y = pk2(v[2], v[3]);
                    *(u32x2*)(P + (size_t)row * LDP + col) = o;
                }
            }
    }
}
__device__ __forceinline__ bf16_t* gate_ptr(unsigned char* ws, int br, size_t row, int d) {
    if (br == 0) return (bf16_t*)(ws + WS_P) + row * LDP + d;
    if (br == 1) return (bf16_t*)(ws + WS_P) + row * LDP + 2048 + d;
    return (bf16_t*)(ws + WS_AF) + row * 1024 + d;
}
__device__ __forceinline__ void phase_gates(const Params& p, unsigned char* lds) {
    const int tid = tid_(), lane = tid & 63, wave = tid >> 6, wm = wave >> 1, wn = wave & 1, fr = lane & 15, fq = lane >> 4;
    const bf16_t* hb = (const bf16_t*)(p.ws + WS_HB); const bf16_t* WgT = (const bf16_t*)(p.ws + WS_WIN) + (size_t)NMIX * D;
    bf16_t* P = (bf16_t*)(p.ws + WS_P);
    constexpr int NTN = NGATE / 128, NTM = M / 128;
    for (int u = bid_(); u < NTN * NTM; u += gridDim.x) {
        const int pn = u % NTN, pm = u / NTN;
        f32x4 acc[2][4]; ACC_ZERO(acc);
        gemm_tile_acc(hb + (size_t)pm * 128 * D, D, WgT + (size_t)pn * 128 * D, D, D, acc, lds);
#pragma unroll
        for (int m = 0; m < 2; ++m)
#pragma unroll
            for (int n = 0; n < 4; ++n) {
                const int row = pm * 128 + ACC_ROW(m), j = pn * 128 + ACC_COL(n); const f32x4 v = acc[m][n];
                u32x2 o; o.x = pk2(sigmoidf_(v[0]), sigmoidf_(v[1])); o.y = pk2(sigmoidf_(v[2]), sigmoidf_(v[3]));
                *(u32x2*)gate_ptr(p.ws, j >> 10, (size_t)row, j & 1023) = o;
            }
    }
}
__device__ __forceinline__ void phase_lift(const Params& p, unsigned char* lds) {
    const int tid = tid_(), lane = tid & 63, wave = tid >> 6, wm = wave >> 1, wn = wave & 1, fr = lane & 15, fq = lane >> 4;
    const bf16_t* P = (const bf16_t*)(p.ws + WS_P); const bf16_t* WbT = (const bf16_t*)(p.ws + WS_WB); bf16_t* MG = (bf16_t*)(p.ws + WS_HB);
    constexpr int NTN = D / 128, NTM = M / 128;
    for (int u = bid_(); u < NTN * NTM; u += gridDim.x) {
        const int pn = u % NTN, pm = u / NTN;
        f32x4 macc[2][4]; ACC_ZERO(macc);
#pragma unroll 1
        for (int br = 0; br < 3; ++br) {
            const int ycol = br == 0 ? PC_AG : (br == 1 ? PC_BZ : PC_CG);
            f32x4 acc[2][4]; ACC_ZERO(acc);
            gemm_tile_acc(P + (size_t)pm * 128 * LDP + ycol, LDP, WbT + (size_t)pn * 128 * 1536 + br * 512, 1536, 512, acc, lds);
#pragma unroll
            for (int m = 0; m < 2; ++m)
#pragma unroll
                for (int n = 0; n < 4; ++n) {
                    const int row = pm * 128 + ACC_ROW(m);
                    const u32x2 g = *(const u32x2*)gate_ptr(p.ws, br, (size_t)row, pn * 128 + ACC_COL(n));
                    macc[m][n][0] += bf_lo(g.x) * acc[m][n][0]; macc[m][n][1] += bf_hi(g.x) * acc[m][n][1];
                    macc[m][n][2] += bf_lo(g.y) * acc[m][n][2]; macc[m][n][3] += bf_hi(g.y) * acc[m][n][3];
                }
        }
#pragma unroll
        for (int m = 0; m < 2; ++m)
#pragma unroll
            for (int n = 0; n < 4; ++n) { const int row = pm * 128 + ACC_ROW(m), col = pn * 128 + ACC_COL(n);
                u32x2 o; o.x = pk2(macc[m][n][0], macc[m][n][1]); o.y = pk2(macc[m][n][2], macc[m][n][3]);
                *(u32x2*)(MG + (size_t)row * D + col) = o; }
    }
}
__device__ __forceinline__ void phase_outproj(const Params& p, const float* xin, unsigned char* lds) {
    const int tid = tid_(), lane = tid & 63, wave = tid >> 6, wm = wave >> 1, wn = wave & 1, fr = lane & 15, fq = lane >> 4;
    const bf16_t* MG = (const bf16_t*)(p.ws + WS_HB); const bf16_t* WoT = (const bf16_t*)(p.ws + WS_WO);
    constexpr int NTN = D / 128, NTM = M / 128;
    for (int u = bid_(); u < NTN * NTM; u += gridDim.x) {
        const int pn = u % NTN, pm = u / NTN;
        f32x4 acc[2][4]; ACC_ZERO(acc);
        gemm_tile_acc(MG + (size_t)pm * 128 * D, D, WoT + (size_t)pn * 128 * D, D, D, acc, lds);
#pragma unroll
        for (int m = 0; m < 2; ++m)
#pragma unroll
            for (int n = 0; n < 4; ++n) { const size_t off = (size_t)(pm * 128 + ACC_ROW(m)) * D + pn * 128 + ACC_COL(n);
                const f32x4 xv = *(const f32x4*)(xin + off); *(f32x4*)(p.out + off) = xv + acc[m][n]; }
    }
}

constexpr int A_TB = 16;
__device__ __forceinline__ void mixer_a(const Params& p, int bh, int vs, unsigned char* lds) {
    const int tid = tid_(), lane = tid & 63, wave = tid >> 6, r = lane >> 4, i = lane & 15;
    const int b = bh >> 2, h = bh & 3;
    bf16_t* P = (bf16_t*)(p.ws + WS_P); const float* AF = (const float*)(p.ws + WS_AF);
    constexpr int BUF = 8192 + 8192 + 2048;
    float* obuf = (float*)(lds + 2 * BUF);
    const size_t row0 = (size_t)b * SEQ;
    const int fr_row = tid >> 5, fr_c4 = (tid & 31) * 4;
    const int q_row = tid >> 5, q_c4 = (tid & 31) * 4;
    const int i_row = (tid >> 3) & 15, i_c4 = (tid & 7) * 4;
    f32x4 pf; u32x2 pq; u32x2 pi;
    auto gload = [&](int t0) {
        pf = *(const f32x4*)(AF + (row0 + t0 + fr_row) * 512 + h * 128 + fr_c4);
        pq = *(const u32x2*)(P + (row0 + t0 + q_row) * LDP + PC_AQ + h * 128 + q_c4);
        if (tid < 128) pi = *(const u32x2*)(P + (row0 + t0 + i_row) * LDP + PC_AI + h * 128 + vs * 32 + i_c4);
    };
    auto lstore = [&](int bufi) {
        float* fb = (float*)(lds + bufi * BUF); float* qb = fb + 2048; float* ib = qb + 2048;
        *(f32x4*)(fb + fr_row * 128 + fr_c4) = pf;
        *(f32x4*)(qb + q_row * 128 + q_c4) = (f32x4){bf_lo(pq.x), bf_hi(pq.x), bf_lo(pq.y), bf_hi(pq.y)};
        if (tid < 128) *(f32x4*)(ib + i_row * 32 + i_c4) = (f32x4){bf_lo(pi.x), bf_hi(pi.x), bf_lo(pi.y), bf_hi(pi.y)};
    };
    float S[8];
#pragma unroll
    for (int j = 0; j < 8; ++j) S[j] = 0.f;
    gload(0); lstore(0); __syncthreads();
    constexpr int NB = SEQ / A_TB;
    for (int bt = 0; bt < NB; ++bt) {
        const int cur = bt & 1;
        if (bt + 1 < NB) gload((bt + 1) * A_TB);
        const float* fb = (const float*)(lds + cur * BUF); const float* qb = fb + 2048; const float* ib = qb + 2048;
#pragma unroll 4
        for (int t = 0; t < A_TB; ++t) {
            const f32x4 f0 = *(const f32x4*)(fb + t * 128 + 8 * i), f1 = *(const f32x4*)(fb + t * 128 + 8 * i + 4);
            const f32x4 q0 = *(const f32x4*)(qb + t * 128 + 8 * i), q1 = *(const f32x4*)(qb + t * 128 + 8 * i + 4);
            const float iv = ib[t * 32 + wave * 4 + r];
            float pa = 0.f, pb = 0.f;
            S[0] = iv + f0[0] * (S[0] - iv); pa += q0[0] * S[0];
            S[1] = iv + f0[1] * (S[1] - iv); pb += q0[1] * S[1];
            S[2] = iv + f0[2] * (S[2] - iv); pa += q0[2] * S[2];
            S[3] = iv + f0[3] * (S[3] - iv); pb += q0[3] * S[3];
            S[4] = iv + f1[0] * (S[4] - iv); pa += q1[0] * S[4];
            S[5] = iv + f1[1] * (S[5] - iv); pb += q1[1] * S[5];
            S[6] = iv + f1[2] * (S[6] - iv); pa += q1[2] * S[6];
            S[7] = iv + f1[3] * (S[7] - iv); pb += q1[3] * S[7];
            const float o = row16_sum(pa + pb);
            if (i == 0) obuf[t * 32 + wave * 4 + r] = o;
        }
        __syncthreads();
        { const int t = tid >> 5, v = tid & 31; P[(row0 + bt * A_TB + t) * LDP + PC_AI + h * 128 + vs * 32 + v] = (bf16_t)f2bf(obuf[t * 32 + v]); }
        if (bt + 1 < NB) lstore(cur ^ 1);
        __syncthreads();
    }
}

constexpr int B_TB = 16;
__device__ __forceinline__ void mixer_b(const Params& p, int l, int bh, int vs, unsigned char* lds) {
    const int tid = tid_(), lane = tid & 63, wave = tid >> 6, r = lane >> 5, i = lane & 31;
    const int b = bh >> 2, h = bh & 3;
    bf16_t* P = (bf16_t*)(p.ws + WS_P); const float* sm8 = (const float*)(p.ws + WS_SM);
    const float* cw = p.conv_w + (size_t)l * 4 * 1536;
    constexpr int RAWC = 272;
    float* raw = (float*)lds;
    float* qk = (float*)(lds + 20736);
    float* vv = (float*)(lds + 20736 + 16384);
    float* sc = (float*)(lds + 20736 + 16384 + 1024);
    float* obuf = (float*)(lds + 20736 + 16384 + 1024 + 256);
    const size_t row0 = (size_t)b * SEQ;
    const float a_coef = -__expf(p.a_log[l * 4 + h]); const float dtb = p.dt_bias[l * 4 + h];
    const int cqk = tid & 255; const int chq = cqk < 128 ? h * 128 + cqk : 512 + h * 128 + (cqk - 128);
    float wq[4]; float wvv[4];
#pragma unroll
    for (int j = 0; j < 4; ++j) { wq[j] = cw[j * 1536 + chq]; wvv[j] = cw[j * 1536 + 1024 + h * 128 + vs * 16 + (tid & 15)]; }
    for (int e = tid; e < 3 * RAWC; e += NTHREADS) raw[e] = 0.f;
    float S[4] = {0.f, 0.f, 0.f, 0.f};
    u32x4 st0, st1;
    auto chunk_addr = [&](int t0, int ck) -> const bf16_t* {
        const int row = ck / 34, c8 = ck % 34; const int ch = c8 < 16 ? h * 128 + c8 * 8 : (c8 < 32 ? 512 + h * 128 + (c8 - 16) * 8 : 1024 + h * 128 + vs * 16 + (c8 - 32) * 8);
        return P + (row0 + t0 + row) * LDP + PC_BQKV + ch; };
    auto gload = [&](int t0) { st0 = *(const u32x4*)chunk_addr(t0, tid); if (tid < 32) st1 = *(const u32x4*)chunk_addr(t0, 512 + tid); };
    auto rstore = [&]() {
        { const int row = tid / 34, c8 = tid % 34; float* d = raw + (3 + row) * RAWC + c8 * 8;
          *(f32x4*)d = (f32x4){bf_lo(st0.x), bf_hi(st0.x), bf_lo(st0.y), bf_hi(st0.y)}; *(f32x4*)(d + 4) = (f32x4){bf_lo(st0.z), bf_hi(st0.z), bf_lo(st0.w), bf_hi(st0.w)}; }
        if (tid < 32) { const int ck = 512 + tid; const int row = ck / 34, c8 = ck % 34; float* d = raw + (3 + row) * RAWC + c8 * 8;
          *(f32x4*)d = (f32x4){bf_lo(st1.x), bf_hi(st1.x), bf_lo(st1.y), bf_hi(st1.y)}; *(f32x4*)(d + 4) = (f32x4){bf_lo(st1.z), bf_hi(st1.z), bf_lo(st1.w), bf_hi(st1.w)}; }
    };
    gload(0);
    constexpr int NB = SEQ / B_TB;
    for (int bt = 0; bt < NB; ++bt) {
        const int t0 = bt * B_TB;
        __syncthreads();
        rstore();
        if (bt + 1 < NB) gload(t0 + B_TB);
        __syncthreads();
        {
            const int tb = (tid >> 8) * 8;
#pragma unroll
            for (int tt = 0; tt < 8; ++tt) { const int t = tb + tt;
                const float x = raw[(t + 0) * RAWC + cqk] * wq[0] + raw[(t + 1) * RAWC + cqk] * wq[1] + raw[(t + 2) * RAWC + cqk] * wq[2] + raw[(t + 3) * RAWC + cqk] * wq[3];
                qk[t * 256 + cqk] = siluf_(x); }
            if (tid < 256) { const int t = tid >> 4, c = tid & 15;
                const float x = raw[(t + 0) * RAWC + 256 + c] * wvv[0] + raw[(t + 1) * RAWC + 256 + c] * wvv[1] + raw[(t + 2) * RAWC + 256 + c] * wvv[2] + raw[(t + 3) * RAWC + 256 + c] * wvv[3];
                vv[t * 16 + c] = siluf_(x); }
            if (tid < 16) { const f32x4 lo = *(const f32x4*)(sm8 + (row0 + t0 + tid) * 8), hi = *(const f32x4*)(sm8 + (row0 + t0 + tid) * 8 + 4);
                const float bl = lo[h], al = hi[h]; const float xx = al + dtb; const float sp = xx > 20.f ? xx : log1pf(__expf(xx));
                sc[tid * 4 + 0] = __expf(a_coef * sp); sc[tid * 4 + 1] = sigmoidf_(bl); }
        }
        __syncthreads();
        {
            const int vec = tid >> 4, sub = tid & 15; const int t = vec >> 1, which = vec & 1;
            float* src = qk + t * 256 + which * 128 + sub * 8;
            f32x4 a0 = *(f32x4*)src, a1 = *(f32x4*)(src + 4);
            float ss = (a0[0] * a0[0] + a0[1] * a0[1]) + (a0[2] * a0[2] + a0[3] * a0[3]) + (a1[0] * a1[0] + a1[1] * a1[1]) + (a1[2] * a1[2] + a1[3] * a1[3]);
            ss = row16_sum(ss);
            float sc_ = 1.0f / sqrtf(ss + EPS); if (which == 0) sc_ *= 0.08838834764831845f;
            a0 = a0 * sc_; a1 = a1 * sc_;
            *(f32x4*)src = a0; *(f32x4*)(src + 4) = a1;
        }
        __syncthreads();
        if (tid < 256) { const int t = tid >> 4, sub = tid & 15; const float* qs = qk + t * 256 + sub * 8; const float* ks = qs + 128;
            float d = 0.f;
#pragma unroll
            for (int e = 0; e < 8; ++e) d += qs[e] * ks[e];
            d = row16_sum(d); if (sub == 0) sc[t * 4 + 2] = d; }
        __syncthreads();
#pragma unroll 2
        for (int t = 0; t < B_TB; ++t) {
            const f32x4 q4 = *(const f32x4*)(qk + t * 256 + 4 * i), k4 = *(const f32x4*)(qk + t * 256 + 128 + 4 * i);
            const f32x4 s4 = *(const f32x4*)(sc + t * 4); const float vt = vv[t * 16 + wave * 2 + r];
            const float alpha = s4[0], beta = s4[1], qkd = s4[2];
            float rk = (S[0] * k4[0] + S[1] * k4[1]) + (S[2] * k4[2] + S[3] * k4[3]);
            float rq = (S[0] * q4[0] + S[1] * q4[1]) + (S[2] * q4[2] + S[3] * q4[3]);
            rk = xor16_sum(row16_sum(rk)); rq = xor16_sum(row16_sum(rq));
            const float vn = beta * (vt - alpha * rk);
            const float o = alpha * rq + qkd * vn;
            S[0] = alpha * S[0] + k4[0] * vn; S[1] = alpha * S[1] + k4[1] * vn; S[2] = alpha * S[2] + k4[2] * vn; S[3] = alpha * S[3] + k4[3] * vn;
            if (i == 0) obuf[t * 16 + wave * 2 + r] = o;
        }
        __syncthreads();
        if (tid < 256) { const int t = tid >> 4, c = tid & 15; P[(row0 + t0 + t) * LDP + PC_BQKV + 1024 + h * 128 + vs * 16 + c] = (bf16_t)f2bf(obuf[t * 16 + c]); }
        float hv0 = 0.f, hv1 = 0.f; const int e0 = tid, e1 = tid + 512;
        if (e0 < 3 * RAWC) hv0 = raw[16 * RAWC + e0];
        if (e1 < 3 * RAWC) hv1 = raw[16 * RAWC + e1];
        __syncthreads();
        if (e0 < 3 * RAWC) raw[e0] = hv0;
        if (e1 < 3 * RAWC) raw[e1] = hv1;
    }
}

__device__ __forceinline__ void mixer_c(const Params& p, int l, int unit, unsigned char* lds) {
    const int tid = tid_(), wave = tid >> 6;
    const int kvh = unit & 1, nb = (unit >> 1) & 31, b = unit >> 6;
    bf16_t* P = (bf16_t*)(p.ws + WS_P);
    bf16_t* sK = (bf16_t*)lds;
    bf16_t* sVT = (bf16_t*)(lds + 32768);
    float* sBias = (float*)(lds + 32768 + 64 * 264 * 2);
    constexpr int VTP = 264;
    const size_t rowq0 = (size_t)b * SEQ + (size_t)nb * 128;
    __syncthreads();
    for (int c = tid; c < 256 * 8; c += NTHREADS) {
        const int j = c >> 3, d8 = (c & 7) * 8; u32x4 kv = (u32x4){0u, 0u, 0u, 0u}, vv = (u32x4){0u, 0u, 0u, 0u};
        if (nb > 0 || j >= 128) { const size_t row = rowq0 - 128 + j; kv = *(const u32x4*)(P + row * LDP + PC_CK + kvh * 64 + d8); vv = *(const u32x4*)(P + row * LDP + PC_CV + kvh * 64 + d8); }
        *(u32x4*)(sK + j * 64 + d8) = kv;
        sVT[(d8 + 0) * VTP + j] = (bf16_t)(vv.x & 0xffff); sVT[(d8 + 1) * VTP + j] = (bf16_t)(vv.x >> 16);
        sVT[(d8 + 2) * VTP + j] = (bf16_t)(vv.y & 0xffff); sVT[(d8 + 3) * VTP + j] = (bf16_t)(vv.y >> 16);
        sVT[(d8 + 4) * VTP + j] = (bf16_t)(vv.z & 0xffff); sVT[(d8 + 5) * VTP + j] = (bf16_t)(vv.z >> 16);
        sVT[(d8 + 6) * VTP + j] = (bf16_t)(vv.w & 0xffff); sVT[(d8 + 7) * VTP + j] = (bf16_t)(vv.w >> 16);
    }
    { const int g = tid >> 7, dist = tid & 127; sBias[g * 128 + dist] = p.rel_bias[(int)kBucket[dist] * 8 + kvh * 4 + g]; }
    __syncthreads();
    const int g = tid >> 7, i = tid & 127, hq = kvh * 4 + g;
    const size_t rowq = rowq0 + i;
    unsigned qp[32];
#pragma unroll
    for (int c = 0; c < 8; ++c) { const u32x4 t = *(const u32x4*)(P + rowq * LDP + PC_CQ + hq * 64 + c * 8); qp[4 * c] = t.x; qp[4 * c + 1] = t.y; qp[4 * c + 2] = t.z; qp[4 * c + 3] = t.w; }
    float o[64];
#pragma unroll
    for (int d = 0; d < 64; ++d) o[d] = 0.f;
    const float sink = p.sinks[l * 8 + hq];
    float mrun = sink, lrun = 1.0f;
    const int jlo = 64 * (wave & 1);
    const bool first = (nb == 0);
    for (int jg = 0; jg < 24; ++jg) {
        const int j0 = jlo + jg * 8;
        float s[8];
#pragma unroll
        for (int u = 0; u < 8; ++u) {
            const int j = j0 + u; const bf16_t* kr = sK + j * 64; float a = 0.f;
#pragma unroll
            for (int c = 0; c < 8; ++c) { const u32x4 kk = *(const u32x4*)(kr + c * 8);
                a = __builtin_amdgcn_fdot2_f32_bf16(__builtin_bit_cast(bf16x2v, kk.x), __builtin_bit_cast(bf16x2v, qp[4 * c]), a, false);
                a = __builtin_amdgcn_fdot2_f32_bf16(__builtin_bit_cast(bf16x2v, kk.y), __builtin_bit_cast(bf16x2v, qp[4 * c + 1]), a, false);
                a = __builtin_amdgcn_fdot2_f32_bf16(__builtin_bit_cast(bf16x2v, kk.z), __builtin_bit_cast(bf16x2v, qp[4 * c + 2]), a, false);
                a = __builtin_amdgcn_fdot2_f32_bf16(__builtin_bit_cast(bf16x2v, kk.w), __builtin_bit_cast(bf16x2v, qp[4 * c + 3]), a, false); }
            const int dist = i + 128 - j; const bool ok = (dist >= 0) && (dist < 128) && !(first && j < 128);
            s[u] = ok ? a + sBias[g * 128 + (dist & 127)] : -1e30f;
        }
        float gm = fmaxf(fmaxf(fmaxf(s[0], s[1]), fmaxf(s[2], s[3])), fmaxf(fmaxf(s[4], s[5]), fmaxf(s[6], s[7])));
        const float mnew = fmaxf(mrun, gm); const float corr = __expf(mrun - mnew); mrun = mnew;
        float ps = 0.f; unsigned pp[4];
        float pe[8];
#pragma unroll
        for (int u = 0; u < 8; ++u) { pe[u] = __expf(s[u] - mnew); }
#pragma unroll
        for (int u = 0; u < 4; ++u) { pp[u] = pk2(pe[2 * u], pe[2 * u + 1]); ps += bf_lo(pp[u]) + bf_hi(pp[u]); }
        lrun = lrun * corr + ps;
#pragma unroll
        for (int d = 0; d < 64; ++d) {
            const u32x4 vt = *(const u32x4*)(sVT + d * VTP + j0);
            float a = o[d] * corr;
            a = __builtin_amdgcn_fdot2_f32_bf16(__builtin_bit_cast(bf16x2v, vt.x), __builtin_bit_cast(bf16x2v, pp[0]), a, false);
            a = __builtin_amdgcn_fdot2_f32_bf16(__builtin_bit_cast(bf16x2v, vt.y), __builtin_bit_cast(bf16x2v, pp[1]), a, false);
            a = __builtin_amdgcn_fdot2_f32_bf16(__builtin_bit_cast(bf16x2v, vt.z), __builtin_bit_cast(bf16x2v, pp[2]), a, false);
            a = __builtin_amdgcn_fdot2_f32_bf16(__builtin_bit_cast(bf16x2v, vt.w), __builtin_bit_cast(bf16x2v, pp[3]), a, false);
            o[d] = a;
        }
    }
    float inv = 1.0f / lrun;
#if DIAG_ZERO_C
    inv = 0.f;
#endif
    bf16_t* gp = P + rowq * LDP + PC_CG + hq * 64;
#pragma unroll
    for (int c = 0; c < 8; ++c) {
        const u32x4 gv = *(const u32x4*)(gp + c * 8); u32x4 ov;
        ov.x = pk2(o[8 * c + 0] * inv * siluf_(bf_lo(gv.x)), o[8 * c + 1] * inv * siluf_(bf_hi(gv.x)));
        ov.y = pk2(o[8 * c + 2] * inv * siluf_(bf_lo(gv.y)), o[8 * c + 3] * inv * siluf_(bf_hi(gv.y)));
        ov.z = pk2(o[8 * c + 4] * inv * siluf_(bf_lo(gv.z)), o[8 * c + 5] * inv * siluf_(bf_hi(gv.z)));
        ov.w = pk2(o[8 * c + 6] * inv * siluf_(bf_lo(gv.w)), o[8 * c + 7] * inv * siluf_(bf_hi(gv.w)));
        *(u32x4*)(gp + c * 8) = ov;
    }
}


#if DIAG_NAIVE_C
__device__ __forceinline__ void mixer_c_naive(const Params& p, int l, int unit) {
    const int tid = tid_();
    const int kvh = unit & 1, nb = (unit >> 1) & 31, b = unit >> 6;
    bf16_t* P = (bf16_t*)(p.ws + WS_P);
    const int g = tid >> 7, i = tid & 127, hq = kvh * 4 + g;
    const size_t rowq = (size_t)b * SEQ + (size_t)nb * 128 + i;
    float q[64], o[64];
#pragma unroll
    for (int d = 0; d < 64; ++d) { q[d] = bf2f(P[rowq * LDP + PC_CQ + hq * 64 + d]); o[d] = 0.f; }
    float m = p.sinks[l * 8 + hq], lsum = 1.0f;
    const int tpos = nb * 128 + i;
    for (int kp = tpos - 127; kp <= tpos; ++kp) {
        if (kp < 0) continue;
        const size_t rowk = (size_t)b * SEQ + kp;
        float s = 0.f;
#pragma unroll
        for (int d = 0; d < 64; ++d) s += q[d] * bf2f(P[rowk * LDP + PC_CK + kvh * 64 + d]);
        s += p.rel_bias[(int)kBucket[tpos - kp] * 8 + hq];
        const float mn = fmaxf(m, s); const float corr = __expf(m - mn); const float pe = __expf(s - mn); m = mn;
        lsum = lsum * corr + pe;
#pragma unroll
        for (int d = 0; d < 64; ++d) o[d] = o[d] * corr + pe * bf2f(P[rowk * LDP + PC_CV + kvh * 64 + d]);
    }
    const float inv = 1.0f / lsum;
#pragma unroll
    for (int d = 0; d < 64; ++d) { const size_t a = rowq * LDP + PC_CG + hq * 64 + d; P[a] = (bf16_t)f2bf(o[d] * inv * siluf_(bf2f(P[a]))); }
}
#endif
__device__ __forceinline__ void phase_mixers(const Params& p, int l, unsigned char* lds) {
    const int vb = bid_();
    if (vb < 128) { mixer_b(p, l, vb >> 3, vb & 7, lds); }
    else if (vb < 192) { const int a = vb - 128; mixer_a(p, a >> 2, a & 3, lds); }
    else if (vb < 256) { const int c0 = vb - 192;
#pragma unroll 1
        for (int k = 0; k < 4; ++k) {
#if DIAG_NAIVE_C
            mixer_c_naive(p, l, c0 * 4 + k);
#else
            mixer_c(p, l, c0 * 4 + k, lds);
#endif
        } }
}
__device__ __forceinline__ void phase_finalize(const Params& p, int l) {
    const int tid = tid_(), lane = tid & 63, wave = tid >> 6;
    bf16_t* P = (bf16_t*)(p.ws + WS_P);
    const int hh = lane >> 4, v8 = (lane & 15) * 8;
    float wa[8], wb[8];
#pragma unroll
    for (int e = 0; e < 8; ++e) { wa[e] = p.norm_a[l * 128 + v8 + e]; wb[e] = p.norm_b[l * 128 + v8 + e]; }
    const int gw = bid_() * 8 + wave, NGW = gridDim.x * 8;
    for (int m = gw; m < M; m += NGW) {
        bf16_t* pr = P + (size_t)m * LDP;
#pragma unroll
        for (int br = 0; br < 2; ++br) {
            const int ocol = br == 0 ? PC_AI + hh * 128 + v8 : PC_BQKV + 1024 + hh * 128 + v8;
            const int gcol = br == 0 ? PC_AG + hh * 128 + v8 : PC_BZ + hh * 128 + v8;
            const u32x4 ov = *(const u32x4*)(pr + ocol); const u32x4 gv = *(const u32x4*)(pr + gcol);
            float o[8] = {bf_lo(ov.x), bf_hi(ov.x), bf_lo(ov.y), bf_hi(ov.y), bf_lo(ov.z), bf_hi(ov.z), bf_lo(ov.w), bf_hi(ov.w)};
            float gt[8] = {bf_lo(gv.x), bf_hi(gv.x), bf_lo(gv.y), bf_hi(gv.y), bf_lo(gv.z), bf_hi(gv.z), bf_lo(gv.w), bf_hi(gv.w)};
            float ss = 0.f;
#pragma unroll
            for (int e = 0; e < 8; ++e) ss += o[e] * o[e];
            ss = row16_sum(ss);
            const float rs = 1.0f / sqrtf(ss * (1.0f / 128.0f) + EPS);
            float y[8];
#pragma unroll
            for (int e = 0; e < 8; ++e) y[e] = o[e] * rs * (br == 0 ? wa[e] : wb[e]) * siluf_(gt[e]);
            u32x4 yo; yo.x = pk2(y[0], y[1]); yo.y = pk2(y[2], y[3]); yo.z = pk2(y[4], y[5]); yo.w = pk2(y[6], y[7]);
            *(u32x4*)(pr + gcol) = yo;
        }
    }
}

__device__ __forceinline__ int launder_i(int v) { asm volatile("" : "+s"(v)); return v; }
__device__ __forceinline__ Params launder(Params p) {
    asm volatile("" : "+s"(p.x), "+s"(p.norm_w), "+s"(p.w_in), "+s"(p.conv_w), "+s"(p.a_log), "+s"(p.dt_bias), "+s"(p.lb_param), "+s"(p.norm_a));
    asm volatile("" : "+s"(p.norm_b), "+s"(p.sinks), "+s"(p.rel_bias), "+s"(p.w_branch), "+s"(p.w_out), "+s"(p.final_norm), "+s"(p.out), "+s"(p.ws));
    return p;
}
__global__ void __launch_bounds__(NTHREADS, 2) fwd_megakernel(Params p) {
    extern __shared__ __attribute__((aligned(16))) unsigned char lds[];
    cg::grid_group grid = cg::this_grid();
#pragma unroll 1
    for (int l0 = 0; l0 < DEPTH; ++l0) {
        { const Params q = launder(p); const int l = launder_i(l0); phase_convert_weights(q, l, lds); }
        __syncthreads();
        { const Params q = launder(p); const int l = launder_i(l0); phase_rowpass<0>(q, (l == 0) ? q.x : q.out, q.norm_w + (size_t)l * D, l, lds); }
        grid.sync();
        { const Params q = launder(p); const int l = launder_i(l0); phase_inproj(q, l, lds); }
        grid.sync();
        { const Params q = launder(p); const int l = launder_i(l0); phase_mixers(q, l, lds); }
        grid.sync();
        { const Params q = launder(p); const int l = launder_i(l0); phase_finalize(q, l); }
        { const Params q = launder(p); phase_gates(q, lds); }
        grid.sync();
        { const Params q = launder(p); phase_lift(q, lds); }
        grid.sync();
        { const Params q = launder(p); const int l = launder_i(l0); phase_outproj(q, (l == 0) ? q.x : q.out, lds); }
        grid.sync();
    }
    { const Params q = launder(p); phase_rowpass<1>(q, q.out, q.final_norm, 0, lds); }
}

extern "C" void kernel_launch(void* const* d_in, const int* in_sizes, int n_in, void* d_out, int out_size, void* d_ws, size_t ws_size, hipStream_t stream) {
    static int grid_blocks = 0;
    if (grid_blocks == 0) {
        if (n_in != 14 || in_sizes[0] != M * D || out_size != M * D || ws_size < WS_END) {
            fprintf(stderr, "kernel_launch: unexpected shapes n_in=%d in0=%d out=%d ws=%zu (need %zu)\n", n_in, n_in > 0 ? in_sizes[0] : -1, out_size, ws_size, (size_t)WS_END); grid_blocks = -1; return; }
        int dev = 0, cus = 0, per_cu = 0;
        hipGetDevice(&dev);
        hipDeviceGetAttribute(&cus, hipDeviceAttributeMultiprocessorCount, dev);
        hipFuncSetAttribute((const void*)fwd_megakernel, hipFuncAttributeMaxDynamicSharedMemorySize, LDS_BYTES);
        hipOccupancyMaxActiveBlocksPerMultiprocessor(&per_cu, (const void*)fwd_megakernel, NTHREADS, LDS_BYTES);
        if (per_cu < 1) { fprintf(stderr, "kernel_launch: occupancy query says %d blocks/CU\n", per_cu); per_cu = 1; }
        if (per_cu > 1) per_cu = 1;
        grid_blocks = cus * per_cu;
        if (grid_blocks < 256) { fprintf(stderr, "kernel_launch: needs >= 256 resident blocks, got %d\n", grid_blocks); grid_blocks = -1; return; }
    }
    if (grid_blocks < 0) return;
    Params p{};
    p.x = (const float*)d_in[0]; p.norm_w = (const float*)d_in[1]; p.w_in = (const float*)d_in[2]; p.conv_w = (const float*)d_in[3];
    p.a_log = (const float*)d_in[4]; p.dt_bias = (const float*)d_in[5]; p.lb_param = (const float*)d_in[6]; p.norm_a = (const float*)d_in[7];
    p.norm_b = (const float*)d_in[8]; p.sinks = (const float*)d_in[9]; p.rel_bias = (const float*)d_in[10]; p.w_branch = (const float*)d_in[11];
    p.w_out = (const float*)d_in[12]; p.final_norm = (const float*)d_in[13];
    p.out = (float*)d_out; p.ws = (unsigned char*)d_ws;
    void* args[] = {&p};
    hipError_t e = hipLaunchCooperativeKernel((const void*)fwd_megakernel, dim3(grid_blocks), dim3(NTHREADS), args, LDS_BYTES, stream);
    if (e != hipSuccess) fprintf(stderr, "cooperative launch failed: %s (grid %d)\n", hipGetErrorString(e), grid_blocks);
}
```

```cpp
#include <hip/hip_runtime.h>
#include <hip/hip_cooperative_groups.h>
#include <cstdio>
#include <cstdint>
namespace cg = cooperative_groups;

typedef unsigned short bf16_t;
typedef short bf16x8 __attribute__((ext_vector_type(8)));
typedef float f32x4 __attribute__((ext_vector_type(4)));
typedef float f32x2 __attribute__((ext_vector_type(2)));
typedef unsigned u32x4 __attribute__((ext_vector_type(4)));
typedef unsigned u32x2 __attribute__((ext_vector_type(2)));
typedef __bf16 bf16x2v __attribute__((ext_vector_type(2)));

constexpr int BATCH = 4, SEQ = 4096, M = BATCH * SEQ, D = 1024, DEPTH = 2;
constexpr int NORIG = 8456;
constexpr int NMIX = 5376;
constexpr int NGATE = 3072;
constexpr int NALL = NMIX + NGATE;
constexpr int LDP = NMIX;
constexpr int PC_AQ = 0, PC_AI = 1024, PC_AG = 1536, PC_BQKV = 2048, PC_BZ = 3584, PC_CQ = 4096, PC_CK = 4608, PC_CV = 4736, PC_CG = 4864;
constexpr float EPS = 1e-6f;
constexpr int NTHREADS = 512;
constexpr int LDS_BYTES = 98304;
#define DIAG_ZERO_C 0
#define DIAG_NAIVE_C 0

constexpr size_t WS_P = 0;
constexpr size_t WS_AF = WS_P + (size_t)M * LDP * 2;
constexpr size_t WS_HB = WS_AF + (size_t)M * 512 * 4;
constexpr size_t WS_WIN = WS_HB + (size_t)M * D * 2;
constexpr size_t WS_WB = WS_WIN + (size_t)NALL * D * 2;
constexpr size_t WS_WO = WS_WB + (size_t)D * 1536 * 2;
constexpr size_t WS_SM = WS_WO + (size_t)D * D * 2;
constexpr size_t WS_END = WS_SM + (size_t)M * 8 * 4;

__device__ const unsigned char kBucket[128] = {0, 1, 2, 3, 4, 5, 6, 7, 8, 9, 10, 11, 12, 13, 14, 15, 16, 16, 16, 17, 17, 18, 18, 18, 19, 19, 19, 20, 20, 20, 20, 21, 21, 21, 21, 22, 22, 22, 22, 22, 23, 23, 23, 23, 23, 23, 24, 24, 24, 24, 24, 24, 25, 25, 25, 25, 25, 25, 25, 26, 26, 26, 26, 26, 26, 26, 26, 27, 27, 27, 27, 27, 27, 27, 27, 27, 27, 28, 28, 28, 28, 28, 28, 28, 28, 28, 28, 29, 29, 29, 29, 29, 29, 29, 29, 29, 29, 29, 29, 30, 30, 30, 30, 30, 30, 30, 30, 30, 30, 30, 30, 30, 30, 31, 31, 31, 31, 31, 31, 31, 31, 31, 31, 31, 31, 31, 31, 31};

struct Params {
    const float* x; const float* norm_w; const float* w_in; const float* conv_w; const float* a_log; const float* dt_bias;
    const float* lb_param; const float* norm_a; const float* norm_b; const float* sinks; const float* rel_bias;
    const float* w_branch; const float* w_out; const float* final_norm;
    float* out; unsigned char* ws;
};

__device__ __forceinline__ unsigned f2bf(float f) { unsigned u = __builtin_bit_cast(unsigned, f); return (u + 0x7fffu + ((u >> 16) & 1u)) >> 16; }
__device__ __forceinline__ unsigned pk2(float lo, float hi) { return f2bf(lo) | (f2bf(hi) << 16); }
__device__ __forceinline__ float bf_lo(unsigned u) { return __builtin_bit_cast(float, u << 16); }
__device__ __forceinline__ float bf_hi(unsigned u) { return __builtin_bit_cast(float, u & 0xffff0000u); }
__device__ __forceinline__ float bf2f(bf16_t b) { return __builtin_bit_cast(float, (unsigned)b << 16); }
__device__ __forceinline__ int tid_() { int t = threadIdx.x; asm volatile("" : "+v"(t)); return t; }
__device__ __forceinline__ int bid_() { int b = blockIdx.x; asm volatile("" : "+s"(b)); return b; }
__device__ __forceinline__ float dot2u(unsigned k, unsigned q, float acc) { return __builtin_amdgcn_fdot2_f32_bf16(__builtin_bit_cast(bf16x2v, k), __builtin_bit_cast(bf16x2v, q), acc, false); }
__device__ __forceinline__ float sigmoidf_(float x) { return 1.0f / (1.0f + __expf(-x)); }
__device__ __forceinline__ float siluf_(float x) { return x / (1.0f + __expf(-x)); }
template <int CTRL> __device__ __forceinline__ float dpp_mov(float x) { return __builtin_bit_cast(float, __builtin_amdgcn_mov_dpp(__builtin_bit_cast(int, x), CTRL, 0xf, 0xf, true)); }
__device__ __forceinline__ float row16_sum(float x) { x += dpp_mov<0xB1>(x); x += dpp_mov<0x4E>(x); x += dpp_mov<0x141>(x); x += dpp_mov<0x128>(x); return x; }
__device__ __forceinline__ float xor16_sum(float x) { auto s = __builtin_amdgcn_permlane16_swap(__float_as_uint(x), __float_as_uint(x), false, false); return __uint_as_float(s[0]) + __uint_as_float(s[1]); }
__device__ __forceinline__ float xor32_sum(float x) { auto s = __builtin_amdgcn_permlane32_swap(__float_as_uint(x), __float_as_uint(x), false, false); return __uint_as_float(s[0]) + __uint_as_float(s[1]); }
__device__ __forceinline__ float wave_sum(float x) { return xor32_sum(xor16_sum(row16_sum(x))); }

__device__ __forceinline__ void transpose_item(const float* W, int ldsrc, int k0, int nsrc0, bf16_t* WT, int ldd, int ndst0, int kdst0, float* scr, int lane) {
#pragma unroll 8
    for (int i = 0; i < 32; ++i) { const int kk = 2 * i + (lane >> 5); scr[kk * 33 + (lane & 31)] = W[(size_t)(k0 + kk) * ldsrc + nsrc0 + (lane & 31)]; }
    __builtin_amdgcn_wave_barrier();
    asm volatile("s_waitcnt lgkmcnt(0)" ::: "memory");
    const int c = lane & 7;
#pragma unroll
    for (int j = 0; j < 4; ++j) { const int n = (lane >> 3) + 8 * j; const float* s = scr + (8 * c) * 33 + n;
        u32x4 o; o.x = pk2(s[0 * 33], s[1 * 33]); o.y = pk2(s[2 * 33], s[3 * 33]); o.z = pk2(s[4 * 33], s[5 * 33]); o.w = pk2(s[6 * 33], s[7 * 33]);
        *(u32x4*)(WT + (size_t)(ndst0 + n) * ldd + kdst0 + k0 + 8 * c) = o; }
    asm volatile("s_waitcnt lgkmcnt(0)" ::: "memory");
    __builtin_amdgcn_wave_barrier();
}
__device__ __forceinline__ void phase_convert_weights(const Params& p, int l, unsigned char* lds) {
    const int tid = tid_(), lane = tid & 63, wave = tid >> 6;
    float* scr = (float*)(lds) + wave * (64 * 33);
    bf16_t* WinT = (bf16_t*)(p.ws + WS_WIN); bf16_t* WbT = (bf16_t*)(p.ws + WS_WB); bf16_t* WoT = (bf16_t*)(p.ws + WS_WO);
    const float* win = p.w_in + (size_t)l * D * NORIG; const float* wbr = p.w_branch + (size_t)l * 3 * 512 * D; const float* wo = p.w_out + (size_t)l * D * D;
    constexpr int I_IN = (D / 64) * (NALL / 32), I_B = (512 / 64) * (D / 32), I_O = (D / 64) * (D / 32);
    constexpr int NITEMS = I_IN + 3 * I_B + I_O;
    const int gw = bid_() * 8 + wave, NGW = gridDim.x * 8;
    for (int it = gw; it < NITEMS; it += NGW) {
        int r = it;
        if (r < I_IN) { const int nb = r % (NALL / 32), kb = r / (NALL / 32); const int n0 = nb * 32; const int ns = n0 < 4096 ? n0 : n0 + 8;
            transpose_item(win, NORIG, kb * 64, ns, WinT, D, n0, 0, scr, lane); continue; }
        r -= I_IN;
        if (r < 3 * I_B) { const int br = r / I_B; const int q = r % I_B; const int nb = q % (D / 32), kb = q / (D / 32);
            transpose_item(wbr + (size_t)br * 512 * D, D, kb * 64, nb * 32, WbT, 1536, nb * 32, br * 512, scr, lane); continue; }
        r -= 3 * I_B;
        { const int nb = r % (D / 32), kb = r / (D / 32); transpose_item(wo, D, kb * 64, nb * 32, WoT, D, nb * 32, 0, scr, lane); }
    }
}

template <int MODE>
__device__ __forceinline__ void phase_rowpass(const Params& p, const float* xin, const float* nw, int l, unsigned char* lds) {
    const int tid = tid_(), lane = tid & 63, wave = tid >> 6;
    float* wsm = (float*)lds;
    if (MODE == 0) {
        const float* win = p.w_in + (size_t)l * D * NORIG;
        for (int i = tid; i < 8 * D; i += NTHREADS) { const int k = i >> 3, e = i & 7; wsm[e * D + k] = win[(size_t)k * NORIG + 4096 + e]; }
        __syncthreads();
    }
    bf16_t* hb = (bf16_t*)(p.ws + WS_HB); float* sm8 = (float*)(p.ws + WS_SM);
    const int gw = bid_() * 8 + wave, NGW = gridDim.x * 8;
    f32x4 wv[4];
#pragma unroll
    for (int j = 0; j < 4; ++j) wv[j] = *(const f32x4*)(nw + 256 * j + 4 * lane);
    for (int m = gw; m < M; m += NGW) {
        const float* xr = xin + (size_t)m * D;
        f32x4 v[4]; float s = 0.f;
#pragma unroll
        for (int j = 0; j < 4; ++j) { v[j] = *(const f32x4*)(xr + 256 * j + 4 * lane); s += (v[j].x * v[j].x + v[j].y * v[j].y) + (v[j].z * v[j].z + v[j].w * v[j].w); }
        const float rstd = 1.0f / sqrtf(wave_sum(s) * (1.0f / D) + EPS);
#pragma unroll
        for (int j = 0; j < 4; ++j) v[j] = v[j] * rstd * wv[j];
        if (MODE == 1) {
            float* orow = p.out + (size_t)m * D;
#pragma unroll
            for (int j = 0; j < 4; ++j) *(f32x4*)(orow + 256 * j + 4 * lane) = v[j];
        } else {
            bf16_t* hr = hb + (size_t)m * D;
#pragma unroll
            for (int j = 0; j < 4; ++j) { u32x2 o; o.x = pk2(v[j].x, v[j].y); o.y = pk2(v[j].z, v[j].w); *(u32x2*)(hr + 256 * j + 4 * lane) = o; }
            float acc8[8];
#pragma unroll
            for (int e = 0; e < 8; ++e) { float a = 0.f;
#pragma unroll
                for (int j = 0; j < 4; ++j) { const f32x4 w4 = *(const f32x4*)(wsm + e * D + 256 * j + 4 * lane); a += (v[j].x * w4.x + v[j].y * w4.y) + (v[j].z * w4.z + v[j].w * w4.w); }
                acc8[e] = wave_sum(a); }
            if (lane == 0) { *(f32x4*)(sm8 + (size_t)m * 8) = (f32x4){acc8[0], acc8[1], acc8[2], acc8[3]}; *(f32x4*)(sm8 + (size_t)m * 8 + 4) = (f32x4){acc8[4], acc8[5], acc8[6], acc8[7]}; }
        }
    }
}

constexpr int G_LDT = 72;
constexpr int G_TILE_BYTES = 128 * G_LDT * 2;
__device__ __forceinline__ void gemm_tile_acc(const bf16_t* A, int lda, const bf16_t* Bt, int ldb, int K, f32x4 (&acc)[2][4], unsigned char* lds) {
    const int tid = tid_(), lane = tid & 63, wave = tid >> 6, wm = wave >> 1, wn = wave & 1, fr = lane & 15, fq = lane >> 4;
    bf16_t* sA = (bf16_t*)lds; bf16_t* sB = (bf16_t*)(lds + G_TILE_BYTES);
    const int r0 = tid >> 3, c0 = (tid & 7) * 8;
    u32x4 ra[2], rb[2];
    const bf16_t* ga = A + (size_t)r0 * lda + c0; const bf16_t* gb = Bt + (size_t)r0 * ldb + c0;
    ra[0] = *(const u32x4*)(ga); ra[1] = *(const u32x4*)(ga + (size_t)64 * lda);
    rb[0] = *(const u32x4*)(gb); rb[1] = *(const u32x4*)(gb + (size_t)64 * ldb);
    const int nk = K / 64;
    for (int kt = 0; kt < nk; ++kt) {
        __syncthreads();
        *(u32x4*)(sA + r0 * G_LDT + c0) = ra[0]; *(u32x4*)(sA + (r0 + 64) * G_LDT + c0) = ra[1];
        *(u32x4*)(sB + r0 * G_LDT + c0) = rb[0]; *(u32x4*)(sB + (r0 + 64) * G_LDT + c0) = rb[1];
        __syncthreads();
        if (kt + 1 < nk) { const int ko = (kt + 1) * 64;
            ra[0] = *(const u32x4*)(ga + ko); ra[1] = *(const u32x4*)(ga + (size_t)64 * lda + ko);
            rb[0] = *(const u32x4*)(gb + ko); rb[1] = *(const u32x4*)(gb + (size_t)64 * ldb + ko); }
#pragma unroll
        for (int ks = 0; ks < 2; ++ks) {
            bf16x8 af[2], bfr[4];
#pragma unroll
            for (int m = 0; m < 2; ++m) af[m] = *(const bf16x8*)(sA + (wm * 32 + m * 16 + fr) * G_LDT + ks * 32 + fq * 8);
#pragma unroll
            for (int n = 0; n < 4; ++n) bfr[n] = *(const bf16x8*)(sB + (wn * 64 + n * 16 + fr) * G_LDT + ks * 32 + fq * 8);
#pragma unroll
            for (int m = 0; m < 2; ++m)
#pragma unroll
                for (int n = 0; n < 4; ++n) acc[m][n] = __builtin_amdgcn_mfma_f32_16x16x32_bf16(bfr[n], af[m], acc[m][n], 0, 0, 0);
        }
    }
}
#define ACC_ZERO(acc) do { _Pragma("unroll") for (int m_ = 0; m_ < 2; ++m_) _Pragma("unroll") for (int n_ = 0; n_ < 4; ++n_) acc[m_][n_] = (f32x4){0.f, 0.f, 0.f, 0.f}; } while (0)
#define ACC_ROW(m) (wm * 32 + (m) * 16 + fr)
#define ACC_COL(n) (wn * 64 + (n) * 16 + 4 * fq)

__device__ __forceinline__ void phase_inproj(const Params& p, int l, unsigned char* lds) {
    const int tid = tid_(), lane = tid & 63, wave = tid >> 6, wm = wave >> 1, wn = wave & 1, fr = lane & 15, fq = lane >> 4;
    const bf16_t* hb = (const bf16_t*)(p.ws + WS_HB); const bf16_t* WinT = (const bf16_t*)(p.ws + WS_WIN);
    bf16_t* P = (bf16_t*)(p.ws + WS_P); float* AF = (float*)(p.ws + WS_AF);
    constexpr int NTN = NMIX / 128, NTM = M / 128;
    for (int u = bid_(); u < NTN * NTM; u += gridDim.x) {
        const int pn = u % NTN, pm = u / NTN;
        f32x4 acc[2][4]; ACC_ZERO(acc);
        gemm_tile_acc(hb + (size_t)pm * 128 * D, D, WinT + (size_t)pn * 128 * D, D, D, acc, lds);
        const int colt = pn * 128;
#pragma unroll
        for (int m = 0; m < 2; ++m)
#pragma unroll
            for (int n = 0; n < 4; ++n) {
                const int row = pm * 128 + ACC_ROW(m), col = colt + ACC_COL(n); f32x4 v = acc[m][n];
                if (colt >= 512 && colt < 1024) {
                    f32x4 o;
#pragma unroll
                    for (int e = 0; e < 4; ++e) { float lb = 0.f; if (l == 1) { const float p0 = p.lb_param[col - 512 + e], p1 = p.lb_param[512 + col - 512 + e]; lb = 1.0f / (1.0f + __expf(p0 - p1)); }
                        o[e] = lb + (1.0f - lb) * sigmoidf_(v[e]); }
                    *(f32x4*)(AF + (size_t)row * 512 + (col - 512)) = o;
                } else {
                    if (colt < 512) { v[0] = siluf_(v[0]); v[1] = siluf_(v[1]); v[2] = siluf_(v[2]); v[3] = siluf_(v[3]); }
                    else if (colt >= PC_CQ && colt < PC_CK) { v = v * 0.125f; }
                    u32x2 o; o.x = pk2(v[0], v[1]); o.y = pk2(v[2], v[3]);
                    *(u32x2*)(P + (size_t)row * LDP + col) = o;
                }
            }
    }
}
__device__ __forceinline__ bf16_t* gate_ptr(unsigned char* ws, int br, size_t row, int d) {
    if (br == 0) return (bf16_t*)(ws + WS_P) + row * LDP + d;
    if (br == 1) return (bf16_t*)(ws + WS_P) + row * LDP + 2048 + d;
    return (bf16_t*)(ws + WS_AF) + row * 1024 + d;
}
__device__ __forceinline__ void phase_gates(const Params& p, unsigned char* lds) {
    const int tid = tid_(), lane = tid & 63, wave = tid >> 6, wm = wave >> 1, wn = wave & 1, fr = lane & 15, fq = lane >> 4;
    const bf16_t* hb = (const bf16_t*)(p.ws + WS_HB); const bf16_t* WgT = (const bf16_t*)(p.ws + WS_WIN) + (size_t)NMIX * D;
    bf16_t* P = (bf16_t*)(p.ws + WS_P);
    constexpr int NTN = NGATE / 128, NTM = M / 128;
    for (int u = bid_(); u < NTN * NTM; u += gridDim.x) {
        const int pn = u % NTN, pm = u / NTN;
        f32x4 acc[2][4]; ACC_ZERO(acc);
        gemm_tile_acc(hb + (size_t)pm * 128 * D, D, WgT + (size_t)pn * 128 * D, D, D, acc, lds);
#pragma unroll
        for (int m = 0; m < 2; ++m)
#pragma unroll
            for (int n = 0; n < 4; ++n) {
                const int row = pm * 128 + ACC_ROW(m), j = pn * 128 + ACC_COL(n); const f32x4 v = acc[m][n];
                u32x2 o; o.x = pk2(sigmoidf_(v[0]), sigmoidf_(v[1])); o.y = pk2(sigmoidf_(v[2]), sigmoidf_(v[3]));
                *(u32x2*)gate_ptr(p.ws, j >> 10, (size_t)row, j & 1023) = o;
            }
    }
}
__device__ __forceinline__ void phase_lift(const Params& p, unsigned char* lds) {
    const int tid = tid_(), lane = tid & 63, wave = tid >> 6, wm = wave >> 1, wn = wave & 1, fr = lane & 15, fq = lane >> 4;
    const bf16_t* P = (const bf16_t*)(p.ws + WS_P); const bf16_t* WbT = (const bf16_t*)(p.ws + WS_WB); bf16_t* MG = (bf16_t*)(p.ws + WS_HB);
    constexpr int NTN = D / 128, NTM = M / 128;
    for (int u = bid_(); u < NTN * NTM; u += gridDim.x) {
        const int pn = u % NTN, pm = u / NTN;
        f32x4 macc[2][4]; ACC_ZERO(macc);
#pragma unroll 1
        for (int br = 0; br < 3; ++br) {
            const int ycol = br == 0 ? PC_AG : (br == 1 ? PC_BZ : PC_CG);
            f32x4 acc[2][4]; ACC_ZERO(acc);
            gemm_tile_acc(P + (size_t)pm * 128 * LDP + ycol, LDP, WbT + (size_t)pn * 128 * 1536 + br * 512, 1536, 512, acc, lds);
#pragma unroll
            for (int m = 0; m < 2; ++m)
#pragma unroll
                for (int n = 0; n < 4; ++n) {
                    const int row = pm * 128 + ACC_ROW(m);
                    const u32x2 g = *(const u32x2*)gate_ptr(p.ws, br, (size_t)row, pn * 128 + ACC_COL(n));
                    macc[m][n][0] += bf_lo(g.x) * acc[m][n][0]; macc[m][n][1] += bf_hi(g.x) * acc[m][n][1];
                    macc[m][n][2] += bf_lo(g.y) * acc[m][n][2]; macc[m][n][3] += bf_hi(g.y) * acc[m][n][3];
                }
        }
#pragma unroll
        for (int m = 0; m < 2; ++m)
#pragma unroll
            for (int n = 0; n < 4; ++n) { const int row = pm * 128 + ACC_ROW(m), col = pn * 128 + ACC_COL(n);
                u32x2 o; o.x = pk2(macc[m][n][0], macc[m][n][1]); o.y = pk2(macc[m][n][2], macc[m][n][3]);
                *(u32x2*)(MG + (size_t)row * D + col) = o; }
    }
}
__device__ __forceinline__ void phase_outproj(const Params& p, const float* xin, unsigned char* lds) {
    const int tid = tid_(), lane = tid & 63, wave = tid >> 6, wm = wave >> 1, wn = wave & 1, fr = lane & 15, fq = lane >> 4;
    const bf16_t* MG = (const bf16_t*)(p.ws + WS_HB); const bf16_t* WoT = (const bf16_t*)(p.ws + WS_WO);
    constexpr int NTN = D / 128, NTM = M / 128;
    for (int u = bid_(); u < NTN * NTM; u += gridDim.x) {
        const int pn = u % NTN, pm = u / NTN;
        f32x4 acc[2][4]; ACC_ZERO(acc);
        gemm_tile_acc(MG + (size_t)pm * 128 * D, D, WoT + (size_t)pn * 128 * D, D, D, acc, lds);
#pragma unroll
        for (int m = 0; m < 2; ++m)
#pragma unroll
            for (int n = 0; n < 4; ++n) { const size_t off = (size_t)(pm * 128 + ACC_ROW(m)) * D + pn * 128 + ACC_COL(n);
                const f32x4 xv = *(const f32x4*)(xin + off); *(f32x4*)(p.out + off) = xv + acc[m][n]; }
    }
}

constexpr int A_TB = 16;
__device__ __forceinline__ void mixer_a(const Params& p, int bh, int vs, unsigned char* lds) {
    const int tid = tid_(), lane = tid & 63, wave = tid >> 6, r = lane >> 4, i = lane & 15;
    const int b = bh >> 2, h = bh & 3;
    bf16_t* P = (bf16_t*)(p.ws + WS_P); const float* AF = (const float*)(p.ws + WS_AF);
    constexpr int BUF = 8192 + 8192 + 2048;
    float* obuf = (float*)(lds + 2 * BUF);
    const size_t row0 = (size_t)b * SEQ;
    const int fr_row = tid >> 5, fr_c4 = (tid & 31) * 4;
    const int q_row = tid >> 5, q_c4 = (tid & 31) * 4;
    const int i_row = (tid >> 3) & 15, i_c4 = (tid & 7) * 4;
    f32x4 pf; u32x2 pq; u32x2 pi;
    auto gload = [&](int t0) {
        pf = *(const f32x4*)(AF + (row0 + t0 + fr_row) * 512 + h * 128 + fr_c4);
        pq = *(const u32x2*)(P + (row0 + t0 + q_row) * LDP + PC_AQ + h * 128 + q_c4);
        if (tid < 128) pi = *(const u32x2*)(P + (row0 + t0 + i_row) * LDP + PC_AI + h * 128 + vs * 32 + i_c4);
    };
    auto lstore = [&](int bufi) {
        float* fb = (float*)(lds + bufi * BUF); float* qb = fb + 2048; float* ib = qb + 2048;
        *(f32x4*)(fb + fr_row * 128 + fr_c4) = pf;
        *(f32x4*)(qb + q_row * 128 + q_c4) = (f32x4){bf_lo(pq.x), bf_hi(pq.x), bf_lo(pq.y), bf_hi(pq.y)};
        if (tid < 128) *(f32x4*)(ib + i_row * 32 + i_c4) = (f32x4){bf_lo(pi.x), bf_hi(pi.x), bf_lo(pi.y), bf_hi(pi.y)};
    };
    float S[8];
#pragma unroll
    for (int j = 0; j < 8; ++j) S[j] = 0.f;
    gload(0); lstore(0); __syncthreads();
    constexpr int NB = SEQ / A_TB;
    for (int bt = 0; bt < NB; ++bt) {
        const int cur = bt & 1;
        if (bt + 1 < NB) gload((bt + 1) * A_TB);
        const float* fb = (const float*)(lds + cur * BUF); const float* qb = fb + 2048; const float* ib = qb + 2048;
#pragma unroll 4
        for (int t = 0; t < A_TB; ++t) {
            const f32x4 f0 = *(const f32x4*)(fb + t * 128 + 8 * i), f1 = *(const f32x4*)(fb + t * 128 + 8 * i + 4);
            const f32x4 q0 = *(const f32x4*)(qb + t * 128 + 8 * i), q1 = *(const f32x4*)(qb + t * 128 + 8 * i + 4);
            const float iv = ib[t * 32 + wave * 4 + r];
            float pa = 0.f, pb = 0.f;
            S[0] = iv + f0[0] * (S[0] - iv); pa += q0[0] * S[0];
            S[1] = iv + f0[1] * (S[1] - iv); pb += q0[1] * S[1];
            S[2] = iv + f0[2] * (S[2] - iv); pa += q0[2] * S[2];
            S[3] = iv + f0[3] * (S[3] - iv); pb += q0[3] * S[3];
            S[4] = iv + f1[0] * (S[4] - iv); pa += q1[0] * S[4];
            S[5] = iv + f1[1] * (S[5] - iv); pb += q1[1] * S[5];
            S[6] = iv + f1[2] * (S[6] - iv); pa += q1[2] * S[6];
            S[7] = iv + f1[3] * (S[7] - iv); pb += q1[3] * S[7];
            const float o = row16_sum(pa + pb);
            if (i == 0) obuf[t * 32 + wave * 4 + r] = o;
        }
        __syncthreads();
        { const int t = tid >> 5, v = tid & 31; P[(row0 + bt * A_TB + t) * LDP + PC_AI + h * 128 + vs * 32 + v] = (bf16_t)f2bf(obuf[t * 32 + v]); }
        if (bt + 1 < NB) lstore(cur ^ 1);
        __syncthreads();
    }
}

constexpr int B_TB = 16;
__device__ __forceinline__ void mixer_b(const Params& p, int l, int bh, int vs, unsigned char* lds) {
    const int tid = tid_(), lane = tid & 63, wave = tid >> 6, r = lane >> 5, i = lane & 31;
    const int b = bh >> 2, h = bh & 3;
    bf16_t* P = (bf16_t*)(p.ws + WS_P); const float* sm8 = (const float*)(p.ws + WS_SM);
    const float* cw = p.conv_w + (size_t)l * 4 * 1536;
    constexpr int RAWC = 272;
    float* raw = (float*)lds;
    float* qk = (float*)(lds + 20736);
    float* vv = (float*)(lds + 20736 + 16384);
    float* sc = (float*)(lds + 20736 + 16384 + 1024);
    float* obuf = (float*)(lds + 20736 + 16384 + 1024 + 256);
    const size_t row0 = (size_t)b * SEQ;
    const float a_coef = -__expf(p.a_log[l * 4 + h]); const float dtb = p.dt_bias[l * 4 + h];
    const int cqk = tid & 255; const int chq = cqk < 128 ? h * 128 + cqk : 512 + h * 128 + (cqk - 128);
    float wq[4]; float wvv[4];
#pragma unroll
    for (int j = 0; j < 4; ++j) { wq[j] = cw[j * 1536 + chq]; wvv[j] = cw[j * 1536 + 1024 + h * 128 + vs * 16 + (tid & 15)]; }
    for (int e = tid; e < 3 * RAWC; e += NTHREADS) raw[e] = 0.f;
    float S[4] = {0.f, 0.f, 0.f, 0.f};
    u32x4 st0, st1;
    auto chunk_addr = [&](int t0, int ck) -> const bf16_t* {
        const int row = ck / 34, c8 = ck % 34; const int ch = c8 < 16 ? h * 128 + c8 * 8 : (c8 < 32 ? 512 + h * 128 + (c8 - 16) * 8 : 1024 + h * 128 + vs * 16 + (c8 - 32) * 8);
        return P + (row0 + t0 + row) * LDP + PC_BQKV + ch; };
    auto gload = [&](int t0) { st0 = *(const u32x4*)chunk_addr(t0, tid); if (tid < 32) st1 = *(const u32x4*)chunk_addr(t0, 512 + tid); };
    auto rstore = [&]() {
        { const int row = tid / 34, c8 = tid % 34; float* d = raw + (3 + row) * RAWC + c8 * 8;
          *(f32x4*)d = (f32x4){bf_lo(st0.x), bf_hi(st0.x), bf_lo(st0.y), bf_hi(st0.y)}; *(f32x4*)(d + 4) = (f32x4){bf_lo(st0.z), bf_hi(st0.z), bf_lo(st0.w), bf_hi(st0.w)}; }
        if (tid < 32) { const int ck = 512 + tid; const int row = ck / 34, c8 = ck % 34; float* d = raw + (3 + row) * RAWC + c8 * 8;
          *(f32x4*)d = (f32x4){bf_lo(st1.x), bf_hi(st1.x), bf_lo(st1.y), bf_hi(st1.y)}; *(f32x4*)(d + 4) = (f32x4){bf_lo(st1.z), bf_hi(st1.z), bf_lo(st1.w), bf_hi(st1.w)}; }
    };
    gload(0);
    constexpr int NB = SEQ / B_TB;
    for (int bt = 0; bt < NB; ++bt) {
        const int t0 = bt * B_TB;
        __syncthreads();
        rstore();
        if (bt + 1 < NB) gload(t0 + B_TB);
        __syncthreads();
        {
            const int tb = (tid >> 8) * 8;
#pragma unroll
            for (int tt = 0; tt < 8; ++tt) { const int t = tb + tt;
                const float x = raw[(t + 0) * RAWC + cqk] * wq[0] + raw[(t + 1) * RAWC + cqk] * wq[1] + raw[(t + 2) * RAWC + cqk] * wq[2] + raw[(t + 3) * RAWC + cqk] * wq[3];
                qk[t * 256 + cqk] = siluf_(x); }
            if (tid < 256) { const int t = tid >> 4, c = tid & 15;
                const float x = raw[(t + 0) * RAWC + 256 + c] * wvv[0] + raw[(t + 1) * RAWC + 256 + c] * wvv[1] + raw[(t + 2) * RAWC + 256 + c] * wvv[2] + raw[(t + 3) * RAWC + 256 + c] * wvv[3];
                vv[t * 16 + c] = siluf_(x); }
            if (tid < 16) { const f32x4 lo = *(const f32x4*)(sm8 + (row0 + t0 + tid) * 8), hi = *(const f32x4*)(sm8 + (row0 + t0 + tid) * 8 + 4);
                const float bl = lo[h], al = hi[h]; const float xx = al + dtb; const float sp = xx > 20.f ? xx : log1pf(__expf(xx));
                sc[tid * 4 + 0] = __expf(a_coef * sp); sc[tid * 4 + 1] = sigmoidf_(bl); }
        }
        __syncthreads();
        {
            const int vec = tid >> 4, sub = tid & 15; const int t = vec >> 1, which = vec & 1;
            float* src = qk + t * 256 + which * 128 + sub * 8;
            f32x4 a0 = *(f32x4*)src, a1 = *(f32x4*)(src + 4);
            float ss = (a0[0] * a0[0] + a0[1] * a0[1]) + (a0[2] * a0[2] + a0[3] * a0[3]) + (a1[0] * a1[0] + a1[1] * a1[1]) + (a1[2] * a1[2] + a1[3] * a1[3]);
            ss = row16_sum(ss);
            float sc_ = 1.0f / sqrtf(ss + EPS); if (which == 0) sc_ *= 0.08838834764831845f;
            a0 = a0 * sc_; a1 = a1 * sc_;
            *(f32x4*)src = a0; *(f32x4*)(src + 4) = a1;
        }
        __syncthreads();
        if (tid < 256) { const int t = tid >> 4, sub = tid & 15; const float* qs = qk + t * 256 + sub * 8; const float* ks = qs + 128;
            float d = 0.f;
#pragma unroll
            for (int e = 0; e < 8; ++e) d += qs[e] * ks[e];
            d = row16_sum(d); if (sub == 0) sc[t * 4 + 2] = d; }
        __syncthreads();
#pragma unroll 2
        for (int t = 0; t < B_TB; ++t) {
            const f32x4 q4 = *(const f32x4*)(qk + t * 256 + 4 * i), k4 = *(const f32x4*)(qk + t * 256 + 128 + 4 * i);
            const f32x4 s4 = *(const f32x4*)(sc + t * 4); const float vt = vv[t * 16 + wave * 2 + r];
            const float alpha = s4[0], beta = s4[1], qkd = s4[2];
            float rk = (S[0] * k4[0] + S[1] * k4[1]) + (S[2] * k4[2] + S[3] * k4[3]);
            float rq = (S[0] * q4[0] + S[1] * q4[1]) + (S[2] * q4[2] + S[3] * q4[3]);
            rk = xor16_sum(row16_sum(rk)); rq = xor16_sum(row16_sum(rq));
            const float vn = beta * (vt - alpha * rk);
            const float o = alpha * rq + qkd * vn;
            S[0] = alpha * S[0] + k4[0] * vn; S[1] = alpha * S[1] + k4[1] * vn; S[2] = alpha * S[2] + k4[2] * vn; S[3] = alpha * S[3] + k4[3] * vn;
            if (i == 0) obuf[t * 16 + wave * 2 + r] = o;
        }
        __syncthreads();
        if (tid < 256) { const int t = tid >> 4, c = tid & 15; P[(row0 + t0 + t) * LDP + PC_BQKV + 1024 + h * 128 + vs * 16 + c] = (bf16_t)f2bf(obuf[t * 16 + c]); }
        float hv0 = 0.f, hv1 = 0.f; const int e0 = tid, e1 = tid + 512;
        if (e0 < 3 * RAWC) hv0 = raw[16 * RAWC + e0];
        if (e1 < 3 * RAWC) hv1 = raw[16 * RAWC + e1];
        __syncthreads();
        if (e0 < 3 * RAWC) raw[e0] = hv0;
        if (e1 < 3 * RAWC) raw[e1] = hv1;
    }
}

__device__ __forceinline__ void mixer_c(const Params& p, int l, int unit, unsigned char* lds) {
    const int tid = tid_(), wave = tid >> 6;
    const int kvh = unit & 1, nb = (unit >> 1) & 31, b = unit >> 6;
    bf16_t* P = (bf16_t*)(p.ws + WS_P);
    bf16_t* sK = (bf16_t*)lds;
    bf16_t* sVT = (bf16_t*)(lds + 32768);
    float* sBias = (float*)(lds + 32768 + 64 * 264 * 2);
    constexpr int VTP = 264;
    const size_t rowq0 = (size_t)b * SEQ + (size_t)nb * 128;
    __syncthreads();
    for (int c = tid; c < 256 * 8; c += NTHREADS) {
        const int j = c >> 3, d8 = (c & 7) * 8; u32x4 kv = (u32x4){0u, 0u, 0u, 0u}, vv = (u32x4){0u, 0u, 0u, 0u};
        if (nb > 0 || j >= 128) { const size_t row = rowq0 - 128 + j; kv = *(const u32x4*)(P + row * LDP + PC_CK + kvh * 64 + d8); vv = *(const u32x4*)(P + row * LDP + PC_CV + kvh * 64 + d8); }
        *(u32x4*)(sK + j * 64 + d8) = kv;
        sVT[(d8 + 0) * VTP + j] = (bf16_t)(vv.x & 0xffff); sVT[(d8 + 1) * VTP + j] = (bf16_t)(vv.x >> 16);
        sVT[(d8 + 2) * VTP + j] = (bf16_t)(vv.y & 0xffff); sVT[(d8 + 3) * VTP + j] = (bf16_t)(vv.y >> 16);
        sVT[(d8 + 4) * VTP + j] = (bf16_t)(vv.z & 0xffff); sVT[(d8 + 5) * VTP + j] = (bf16_t)(vv.z >> 16);
        sVT[(d8 + 6) * VTP + j] = (bf16_t)(vv.w & 0xffff); sVT[(d8 + 7) * VTP + j] = (bf16_t)(vv.w >> 16);
    }
    { const int g = tid >> 7, dist = tid & 127; sBias[g * 128 + dist] = p.rel_bias[(int)kBucket[dist] * 8 + kvh * 4 + g]; }
    __syncthreads();
    const int g = tid >> 7, i = tid & 127, hq = kvh * 4 + g;
    const size_t rowq = rowq0 + i;
    unsigned qp[32];
#pragma unroll
    for (int c = 0; c < 8; ++c) { const u32x4 t = *(const u32x4*)(P + rowq * LDP + PC_CQ + hq * 64 + c * 8); qp[4 * c] = t.x; qp[4 * c + 1] = t.y; qp[4 * c + 2] = t.z; qp[4 * c + 3] = t.w; }
    float o[64];
#pragma unroll
    for (int d = 0; d < 64; ++d) o[d] = 0.f;
    const float sink = p.sinks[l * 8 + hq];
    float mrun = sink, lrun = 1.0f;
    const int jlo = 64 * (wave & 1);
    const bool first = (nb == 0);
    for (int jg = 0; jg < 24; ++jg) {
        const int j0 = jlo + jg * 8;
        float s[8];
#pragma unroll
        for (int u = 0; u < 8; ++u) {
            const int j = j0 + u; const bf16_t* kr = sK + j * 64; float a = 0.f;
#pragma unroll
            for (int c = 0; c < 8; ++c) { const u32x4 kk = *(const u32x4*)(kr + c * 8);
                a = dot2u(kk.x, qp[4 * c], a);
                a = dot2u(kk.y, qp[4 * c + 1], a);
                a = dot2u(kk.z, qp[4 * c + 2], a);
                a = dot2u(kk.w, qp[4 * c + 3], a); }
            const int dist = i + 128 - j; const bool ok = (dist >= 0) && (dist < 128) && !(first && j < 128);
            s[u] = ok ? a + sBias[g * 128 + (dist & 127)] : -1e30f;
        }
        float gm = fmaxf(fmaxf(fmaxf(s[0], s[1]), fmaxf(s[2], s[3])), fmaxf(fmaxf(s[4], s[5]), fmaxf(s[6], s[7])));
        const float mnew = fmaxf(mrun, gm); const float corr = __expf(mrun - mnew); mrun = mnew;
        float ps = 0.f; unsigned pp[4];
        float pe[8];
#pragma unroll
        for (int u = 0; u < 8; ++u) { pe[u] = __expf(s[u] - mnew); }
#pragma unroll
        for (int u = 0; u < 4; ++u) { pp[u] = pk2(pe[2 * u], pe[2 * u + 1]); ps += bf_lo(pp[u]) + bf_hi(pp[u]); }
        lrun = lrun * corr + ps;
#pragma unroll
        for (int d = 0; d < 64; ++d) {
            const u32x4 vt = *(const u32x4*)(sVT + d * VTP + j0);
            float a = o[d] * corr;
            a = dot2u(vt.x, pp[0], a);
            a = dot2u(vt.y, pp[1], a);
            a = dot2u(vt.z, pp[2], a);
            a = dot2u(vt.w, pp[3], a);
            o[d] = a;
        }
    }
    float inv = 1.0f / lrun;
#if DIAG_ZERO_C
    inv = 0.f;
#endif
    bf16_t* gp = P + rowq * LDP + PC_CG + hq * 64;
#pragma unroll
    for (int c = 0; c < 8; ++c) {
        const u32x4 gv = *(const u32x4*)(gp + c * 8); u32x4 ov;
        ov.x = pk2(o[8 * c + 0] * inv * siluf_(bf_lo(gv.x)), o[8 * c + 1] * inv * siluf_(bf_hi(gv.x)));
        ov.y = pk2(o[8 * c + 2] * inv * siluf_(bf_lo(gv.y)), o[8 * c + 3] * inv * siluf_(bf_hi(gv.y)));
        ov.z = pk2(o[8 * c + 4] * inv * siluf_(bf_lo(gv.z)), o[8 * c + 5] * inv * siluf_(bf_hi(gv.z)));
        ov.w = pk2(o[8 * c + 6] * inv * siluf_(bf_lo(gv.w)), o[8 * c + 7] * inv * siluf_(bf_hi(gv.w)));
        *(u32x4*)(gp + c * 8) = ov;
    }
}


#if DIAG_NAIVE_C
__device__ __forceinline__ void mixer_c_naive(const Params& p, int l, int unit) {
    const int tid = tid_();
    const int kvh = unit & 1, nb = (unit >> 1) & 31, b = unit >> 6;
    bf16_t* P = (bf16_t*)(p.ws + WS_P);
    const int g = tid >> 7, i = tid & 127, hq = kvh * 4 + g;
    const size_t rowq = (size_t)b * SEQ + (size_t)nb * 128 + i;
    float q[64], o[64];
#pragma unroll
    for (int d = 0; d < 64; ++d) { q[d] = bf2f(P[rowq * LDP + PC_CQ + hq * 64 + d]); o[d] = 0.f; }
    float m = p.sinks[l * 8 + hq], lsum = 1.0f;
    const int tpos = nb * 128 + i;
    for (int kp = tpos - 127; kp <= tpos; ++kp) {
        if (kp < 0) continue;
        const size_t rowk = (size_t)b * SEQ + kp;
        float s = 0.f;
#pragma unroll
        for (int d = 0; d < 64; ++d) s += q[d] * bf2f(P[rowk * LDP + PC_CK + kvh * 64 + d]);
        s += p.rel_bias[(int)kBucket[tpos - kp] * 8 + hq];
        const float mn = fmaxf(m, s); const float corr = __expf(m - mn); const float pe = __expf(s - mn); m = mn;
        lsum = lsum * corr + pe;
#pragma unroll
        for (int d = 0; d < 64; ++d) o[d] = o[d] * corr + pe * bf2f(P[rowk * LDP + PC_CV + kvh * 64 + d]);
    }
    const float inv = 1.0f / lsum;
#pragma unroll
    for (int d = 0; d < 64; ++d) { const size_t a = rowq * LDP + PC_CG + hq * 64 + d; P[a] = (bf16_t)f2bf(o[d] * inv * siluf_(bf2f(P[a]))); }
}
#endif
__device__ __forceinline__ void phase_mixers(const Params& p, int l, unsigned char* lds) {
    const int vb = bid_();
    if (vb < 128) { mixer_b(p, l, vb >> 3, vb & 7, lds); }
    else if (vb < 192) { const int a = vb - 128; mixer_a(p, a >> 2, a & 3, lds); }
    else if (vb < 256) { const int c0 = vb - 192;
#pragma unroll 1
        for (int k = 0; k < 4; ++k) {
#if DIAG_NAIVE_C
            mixer_c_naive(p, l, c0 * 4 + k);
#else
            mixer_c(p, l, c0 * 4 + k, lds);
#endif
        } }
}
__device__ __forceinline__ void phase_finalize(const Params& p, int l) {
    const int tid = tid_(), lane = tid & 63, wave = tid >> 6;
    bf16_t* P = (bf16_t*)(p.ws + WS_P);
    const int hh = lane >> 4, v8 = (lane & 15) * 8;
    float wa[8], wb[8];
#pragma unroll
    for (int e = 0; e < 8; ++e) { wa[e] = p.norm_a[l * 128 + v8 + e]; wb[e] = p.norm_b[l * 128 + v8 + e]; }
    const int gw = bid_() * 8 + wave, NGW = gridDim.x * 8;
    for (int m = gw; m < M; m += NGW) {
        bf16_t* pr = P + (size_t)m * LDP;
#pragma unroll
        for (int br = 0; br < 2; ++br) {
            const int ocol = br == 0 ? PC_AI + hh * 128 + v8 : PC_BQKV + 1024 + hh * 128 + v8;
            const int gcol = br == 0 ? PC_AG + hh * 128 + v8 : PC_BZ + hh * 128 + v8;
            const u32x4 ov = *(const u32x4*)(pr + ocol); const u32x4 gv = *(const u32x4*)(pr + gcol);
            float o[8] = {bf_lo(ov.x), bf_hi(ov.x), bf_lo(ov.y), bf_hi(ov.y), bf_lo(ov.z), bf_hi(ov.z), bf_lo(ov.w), bf_hi(ov.w)};
            float gt[8] = {bf_lo(gv.x), bf_hi(gv.x), bf_lo(gv.y), bf_hi(gv.y), bf_lo(gv.z), bf_hi(gv.z), bf_lo(gv.w), bf_hi(gv.w)};
            float ss = 0.f;
#pragma unroll
            for (int e = 0; e < 8; ++e) ss += o[e] * o[e];
            ss = row16_sum(ss);
            const float rs = 1.0f / sqrtf(ss * (1.0f / 128.0f) + EPS);
            float y[8];
#pragma unroll
            for (int e = 0; e < 8; ++e) y[e] = o[e] * rs * (br == 0 ? wa[e] : wb[e]) * siluf_(gt[e]);
            u32x4 yo; yo.x = pk2(y[0], y[1]); yo.y = pk2(y[2], y[3]); yo.z = pk2(y[4], y[5]); yo.w = pk2(y[6], y[7]);
            *(u32x4*)(pr + gcol) = yo;
        }
    }
}

__device__ __forceinline__ int launder_i(int v) { asm volatile("" : "+s"(v)); return v; }
__device__ __forceinline__ Params launder(Params p) {
    asm volatile("" : "+s"(p.x), "+s"(p.norm_w), "+s"(p.w_in), "+s"(p.conv_w), "+s"(p.a_log), "+s"(p.dt_bias), "+s"(p.lb_param), "+s"(p.norm_a));
    asm volatile("" : "+s"(p.norm_b), "+s"(p.sinks), "+s"(p.rel_bias), "+s"(p.w_branch), "+s"(p.w_out), "+s"(p.final_norm), "+s"(p.out), "+s"(p.ws));
    return p;
}
__global__ void __launch_bounds__(NTHREADS, 2) fwd_megakernel(Params p) {
    extern __shared__ __attribute__((aligned(16))) unsigned char lds[];
    cg::grid_group grid = cg::this_grid();
#pragma unroll 1
    for (int l0 = 0; l0 < DEPTH; ++l0) {
        { const Params q = launder(p); const int l = launder_i(l0); phase_convert_weights(q, l, lds); }
        __syncthreads();
        { const Params q = launder(p); const int l = launder_i(l0); phase_rowpass<0>(q, (l == 0) ? q.x : q.out, q.norm_w + (size_t)l * D, l, lds); }
        grid.sync();
        { const Params q = launder(p); const int l = launder_i(l0); phase_inproj(q, l, lds); }
        grid.sync();
        { const Params q = launder(p); const int l = launder_i(l0); phase_mixers(q, l, lds); }
        grid.sync();
        { const Params q = launder(p); const int l = launder_i(l0); phase_finalize(q, l); }
        { const Params q = launder(p); phase_gates(q, lds); }
        grid.sync();
        { const Params q = launder(p); phase_lift(q, lds); }
        grid.sync();
        { const Params q = launder(p); const int l = launder_i(l0); phase_outproj(q, (l == 0) ? q.x : q.out, lds); }
        grid.sync();
    }
    { const Params q = launder(p); phase_rowpass<1>(q, q.out, q.final_norm, 0, lds); }
}

extern "C" void kernel_launch(void* const* d_in, const int* in_sizes, int n_in, void* d_out, int out_size, void* d_ws, size_t ws_size, hipStream_t stream) {
    static int grid_blocks = 0;
    if (grid_blocks == 0) {
        if (n_in != 14 || in_sizes[0] != M * D || out_size != M * D || ws_size < WS_END) {
            fprintf(stderr, "kernel_launch: unexpected shapes n_in=%d in0=%d out=%d ws=%zu (need %zu)\n", n_in, n_in > 0 ? in_sizes[0] : -1, out_size, ws_size, (size_t)WS_END); grid_blocks = -1; return; }
        int dev = 0, cus = 0, per_cu = 0;
        hipGetDevice(&dev);
        hipDeviceGetAttribute(&cus, hipDeviceAttributeMultiprocessorCount, dev);
        hipFuncSetAttribute((const void*)fwd_megakernel, hipFuncAttributeMaxDynamicSharedMemorySize, LDS_BYTES);
        hipOccupancyMaxActiveBlocksPerMultiprocessor(&per_cu, (const void*)fwd_megakernel, NTHREADS, LDS_BYTES);
        if (per_cu < 1) { fprintf(stderr, "kernel_launch: occupancy query says %d blocks/CU\n", per_cu); per_cu = 1; }
        if (per_cu > 1) per_cu = 1;
        grid_blocks = cus * per_cu;
        if (grid_blocks < 256) { fprintf(stderr, "kernel_launch: needs >= 256 resident blocks, got %d\n", grid_blocks); grid_blocks = -1; return; }
    }
    if (grid_blocks < 0) return;
    Params p{};
    p.x = (const float*)d_in[0]; p.norm_w = (const float*)d_in[1]; p.w_in = (const float*)d_in[2]; p.conv_w = (const float*)d_in[3];
    p.a_log = (const float*)d_in[4]; p.dt_bias = (const float*)d_in[5]; p.lb_param = (const float*)d_in[6]; p.norm_a = (const float*)d_in[7];
    p.norm_b = (const float*)d_in[8]; p.sinks = (const float*)d_in[9]; p.rel_bias = (const float*)d_in[10]; p.w_branch = (const float*)d_in[11];
    p.w_out = (const float*)d_in[12]; p.final_norm = (const float*)d_in[13];
    p.out = (float*)d_out; p.ws = (unsigned char*)d_ws;
    void* args[] = {&p};
    hipError_t e = hipLaunchCooperativeKernel((const void*)fwd_megakernel, dim3(grid_blocks), dim3(NTHREADS), args, LDS_BYTES, stream);
    if (e != hipSuccess) fprintf(stderr, "cooperative launch failed: %s (grid %d)\n", hipGetErrorString(e), grid_blocks);
}
```

```cpp
#include <hip/hip_runtime.h>
#include <hip/hip_cooperative_groups.h>
#include <cstdio>
#include <cstdint>
namespace cg = cooperative_groups;

typedef unsigned short bf16_t;
typedef short bf16x8 __attribute__((ext_vector_type(8)));
typedef float f32x4 __attribute__((ext_vector_type(4)));
typedef float f32x2 __attribute__((ext_vector_type(2)));
typedef unsigned u32x4 __attribute__((ext_vector_type(4)));
typedef unsigned u32x2 __attribute__((ext_vector_type(2)));
typedef __bf16 bf16x2v __attribute__((ext_vector_type(2)));

constexpr int BATCH = 4, SEQ = 4096, M = BATCH * SEQ, D = 1024, DEPTH = 2;
constexpr int NORIG = 8456;
constexpr int NMIX = 5376;
constexpr int NGATE = 3072;
constexpr int NALL = NMIX + NGATE;
constexpr int LDP = NMIX;
constexpr int PC_AQ = 0, PC_AI = 1024, PC_AG = 1536, PC_BQKV = 2048, PC_BZ = 3584, PC_CQ = 4096, PC_CK = 4608, PC_CV = 4736, PC_CG = 4864;
constexpr float EPS = 1e-6f;
constexpr int NTHREADS = 512;
constexpr int LDS_BYTES = 147456;
#define DIAG_ZERO_C 0
#define DIAG_NAIVE_C 0

constexpr size_t WS_P = 0;
constexpr size_t WS_AF = WS_P + (size_t)M * LDP * 2;
constexpr size_t WS_HB = WS_AF + (size_t)M * 512 * 4;
constexpr size_t WS_WIN = WS_HB + (size_t)M * D * 2;
constexpr size_t WS_WB = WS_WIN + (size_t)NALL * D * 2;
constexpr size_t WS_WO = WS_WB + (size_t)D * 1536 * 2;
constexpr size_t WS_SM = WS_WO + (size_t)D * D * 2;
constexpr size_t WS_END = WS_SM + (size_t)M * 8 * 4;

__device__ const unsigned char kBucket[128] = {0, 1, 2, 3, 4, 5, 6, 7, 8, 9, 10, 11, 12, 13, 14, 15, 16, 16, 16, 17, 17, 18, 18, 18, 19, 19, 19, 20, 20, 20, 20, 21, 21, 21, 21, 22, 22, 22, 22, 22, 23, 23, 23, 23, 23, 23, 24, 24, 24, 24, 24, 24, 25, 25, 25, 25, 25, 25, 25, 26, 26, 26, 26, 26, 26, 26, 26, 27, 27, 27, 27, 27, 27, 27, 27, 27, 27, 28, 28, 28, 28, 28, 28, 28, 28, 28, 28, 29, 29, 29, 29, 29, 29, 29, 29, 29, 29, 29, 29, 30, 30, 30, 30, 30, 30, 30, 30, 30, 30, 30, 30, 30, 30, 31, 31, 31, 31, 31, 31, 31, 31, 31, 31, 31, 31, 31, 31, 31};

struct Params {
    const float* x; const float* norm_w; const float* w_in; const float* conv_w; const float* a_log; const float* dt_bias;
    const float* lb_param; const float* norm_a; const float* norm_b; const float* sinks; const float* rel_bias;
    const float* w_branch; const float* w_out; const float* final_norm;
    float* out; unsigned char* ws;
};

__device__ __forceinline__ unsigned f2bf(float f) { unsigned u = __builtin_bit_cast(unsigned, f); return (u + 0x7fffu + ((u >> 16) & 1u)) >> 16; }
__device__ __forceinline__ unsigned pk2(float lo, float hi) { return f2bf(lo) | (f2bf(hi) << 16); }
__device__ __forceinline__ float bf_lo(unsigned u) { return __builtin_bit_cast(float, u << 16); }
__device__ __forceinline__ float bf_hi(unsigned u) { return __builtin_bit_cast(float, u & 0xffff0000u); }
__device__ __forceinline__ float bf2f(bf16_t b) { return __builtin_bit_cast(float, (unsigned)b << 16); }
__device__ __forceinline__ int tid_() { int t = threadIdx.x; asm volatile("" : "+v"(t)); return t; }
__device__ __forceinline__ int bid_() { int b = blockIdx.x; asm volatile("" : "+s"(b)); return b; }
__device__ __forceinline__ float dot2u(unsigned k, unsigned q, float acc) { return __builtin_amdgcn_fdot2_f32_bf16(__builtin_bit_cast(bf16x2v, k), __builtin_bit_cast(bf16x2v, q), acc, false); }
__device__ __forceinline__ float sigmoidf_(float x) { return 1.0f / (1.0f + __expf(-x)); }
__device__ __forceinline__ float siluf_(float x) { return x / (1.0f + __expf(-x)); }
template <int CTRL> __device__ __forceinline__ float dpp_mov(float x) { return __builtin_bit_cast(float, __builtin_amdgcn_mov_dpp(__builtin_bit_cast(int, x), CTRL, 0xf, 0xf, true)); }
__device__ __forceinline__ float row16_sum(float x) { x += dpp_mov<0xB1>(x); x += dpp_mov<0x4E>(x); x += dpp_mov<0x141>(x); x += dpp_mov<0x128>(x); return x; }
__device__ __forceinline__ float xor16_sum(float x) { auto s = __builtin_amdgcn_permlane16_swap(__float_as_uint(x), __float_as_uint(x), false, false); return __uint_as_float(s[0]) + __uint_as_float(s[1]); }
__device__ __forceinline__ float xor32_sum(float x) { auto s = __builtin_amdgcn_permlane32_swap(__float_as_uint(x), __float_as_uint(x), false, false); return __uint_as_float(s[0]) + __uint_as_float(s[1]); }
__device__ __forceinline__ float wave_sum(float x) { return xor32_sum(xor16_sum(row16_sum(x))); }

__device__ __forceinline__ void transpose_item(const float* W, int ldsrc, int k0, int nsrc0, bf16_t* WT, int ldd, int ndst0, int kdst0, float* scr, int lane) {
#pragma unroll 8
    for (int i = 0; i < 32; ++i) { const int kk = 2 * i + (lane >> 5); scr[kk * 33 + (lane & 31)] = W[(size_t)(k0 + kk) * ldsrc + nsrc0 + (lane & 31)]; }
    __builtin_amdgcn_wave_barrier();
    asm volatile("s_waitcnt lgkmcnt(0)" ::: "memory");
    const int c = lane & 7;
#pragma unroll
    for (int j = 0; j < 4; ++j) { const int n = (lane >> 3) + 8 * j; const float* s = scr + (8 * c) * 33 + n;
        u32x4 o; o.x = pk2(s[0 * 33], s[1 * 33]); o.y = pk2(s[2 * 33], s[3 * 33]); o.z = pk2(s[4 * 33], s[5 * 33]); o.w = pk2(s[6 * 33], s[7 * 33]);
        *(u32x4*)(WT + (size_t)(ndst0 + n) * ldd + kdst0 + k0 + 8 * c) = o; }
    asm volatile("s_waitcnt lgkmcnt(0)" ::: "memory");
    __builtin_amdgcn_wave_barrier();
}
__device__ __forceinline__ void phase_convert_weights(const Params& p, int l, unsigned char* lds) {
    const int tid = tid_(), lane = tid & 63, wave = tid >> 6;
    float* scr = (float*)(lds) + wave * (64 * 33);
    bf16_t* WinT = (bf16_t*)(p.ws + WS_WIN); bf16_t* WbT = (bf16_t*)(p.ws + WS_WB); bf16_t* WoT = (bf16_t*)(p.ws + WS_WO);
    const float* win = p.w_in + (size_t)l * D * NORIG; const float* wbr = p.w_branch + (size_t)l * 3 * 512 * D; const float* wo = p.w_out + (size_t)l * D * D;
    constexpr int I_IN = (D / 64) * (NALL / 32), I_B = (512 / 64) * (D / 32), I_O = (D / 64) * (D / 32);
    constexpr int NITEMS = I_IN + 3 * I_B + I_O;
    const int gw = bid_() * 8 + wave, NGW = gridDim.x * 8;
    for (int it = gw; it < NITEMS; it += NGW) {
        int r = it;
        if (r < I_IN) { const int nb = r % (NALL / 32), kb = r / (NALL / 32); const int n0 = nb * 32; const int ns = n0 < 4096 ? n0 : n0 + 8;
            transpose_item(win, NORIG, kb * 64, ns, WinT, D, n0, 0, scr, lane); continue; }
        r -= I_IN;
        if (r < 3 * I_B) { const int br = r / I_B; const int q = r % I_B; const int nb = q % (D / 32), kb = q / (D / 32);
            transpose_item(wbr + (size_t)br * 512 * D, D, kb * 64, nb * 32, WbT, 1536, nb * 32, br * 512, scr, lane); continue; }
        r -= 3 * I_B;
        { const int nb = r % (D / 32), kb = r / (D / 32); transpose_item(wo, D, kb * 64, nb * 32, WoT, D, nb * 32, 0, scr, lane); }
    }
}

template <int MODE>
__device__ __forceinline__ void phase_rowpass(const Params& p, const float* xin, const float* nw, int l, unsigned char* lds) {
    const int tid = tid_(), lane = tid & 63, wave = tid >> 6;
    float* wsm = (float*)lds;
    if (MODE == 0) {
        const float* win = p.w_in + (size_t)l * D * NORIG;
        for (int i = tid; i < 8 * D; i += NTHREADS) { const int k = i >> 3, e = i & 7; wsm[e * D + k] = win[(size_t)k * NORIG + 4096 + e]; }
        __syncthreads();
    }
    bf16_t* hb = (bf16_t*)(p.ws + WS_HB); float* sm8 = (float*)(p.ws + WS_SM);
    const int gw = bid_() * 8 + wave, NGW = gridDim.x * 8;
    f32x4 wv[4];
#pragma unroll
    for (int j = 0; j < 4; ++j) wv[j] = *(const f32x4*)(nw + 256 * j + 4 * lane);
    for (int m = gw; m < M; m += NGW) {
        const float* xr = xin + (size_t)m * D;
        f32x4 v[4]; float s = 0.f;
#pragma unroll
        for (int j = 0; j < 4; ++j) { v[j] = *(const f32x4*)(xr + 256 * j + 4 * lane); s += (v[j].x * v[j].x + v[j].y * v[j].y) + (v[j].z * v[j].z + v[j].w * v[j].w); }
        const float rstd = 1.0f / sqrtf(wave_sum(s) * (1.0f / D) + EPS);
#pragma unroll
        for (int j = 0; j < 4; ++j) v[j] = v[j] * rstd * wv[j];
        if (MODE == 1) {
            float* orow = p.out + (size_t)m * D;
#pragma unroll
            for (int j = 0; j < 4; ++j) *(f32x4*)(orow + 256 * j + 4 * lane) = v[j];
        } else {
            bf16_t* hr = hb + (size_t)m * D;
#pragma unroll
            for (int j = 0; j < 4; ++j) { u32x2 o; o.x = pk2(v[j].x, v[j].y); o.y = pk2(v[j].z, v[j].w); *(u32x2*)(hr + 256 * j + 4 * lane) = o; }
            float acc8[8];
#pragma unroll
            for (int e = 0; e < 8; ++e) { float a = 0.f;
#pragma unroll
                for (int j = 0; j < 4; ++j) { const f32x4 w4 = *(const f32x4*)(wsm + e * D + 256 * j + 4 * lane); a += (v[j].x * w4.x + v[j].y * w4.y) + (v[j].z * w4.z + v[j].w * w4.w); }
                acc8[e] = wave_sum(a); }
            if (lane == 0) { *(f32x4*)(sm8 + (size_t)m * 8) = (f32x4){acc8[0], acc8[1], acc8[2], acc8[3]}; *(f32x4*)(sm8 + (size_t)m * 8 + 4) = (f32x4){acc8[4], acc8[5], acc8[6], acc8[7]}; }
        }
    }
}

namespace pg8 {
#define PG8_LAS __attribute__((address_space(3)))
constexpr int BM = 256, BK = 64, HALF = 128, HTB = HALF * BK * 2  , STAGE_BYTES = 8 * HTB, NXCD = 8, WGM = 8;

__host__ __device__ __forceinline__ int lds_byte(int r, int c) { const int st = (r >> 4) * 2 + (c >> 5), rr = r & 15, cc = c & 31, ob = rr * 64 + cc * 2; return st * 1024 + (ob ^ (((ob >> 9) & 1) << 5)); }
__host__ __device__ __forceinline__ void stage_rc(int b, int& R, int& C) { const int st = b / 1024, sb = b % 1024, swz = sb ^ (((sb >> 9) & 1) << 5); R = (st >> 1) * 16 + swz / 64; C = (st & 1) * 32 + (swz % 64) / 2; }
__host__ __device__ __forceinline__ int perm32(int rho) { const int n = rho >> 4, i = rho & 15; return 8 * (i >> 2) + 4 * n + (i & 3); }

struct Unit { int pm, pn, kb; };
struct Gemm { const bf16_t* A; const bf16_t* Bt; int lda, ldb, K; };
struct SegNone { static __device__ __forceinline__ int a(int) { return 0; } static __device__ __forceinline__ int b(int) { return 0; } };
struct StaticOrder {
    int nM, nN, nwg, G, c, nseg;
    __device__ void init(int M_, int N_, int G_, int c_, int nseg_) { nM = M_ / BM; nN = N_ / BM; nwg = nM * nN; G = G_; c = c_; nseg = nseg_; }
    __device__ bool next(int i, Unit& u) const {
        const int it = i / nseg; u.kb = i - it * nseg;
        const long L = (long)it * G + c; if (L >= nwg) return false;
        int wgid = (int)L; { const int q = nwg / NXCD, r = nwg % NXCD, xcd = wgid % NXCD, off = wgid / NXCD; wgid = (xcd < r ? xcd * (q + 1) : r * (q + 1) + (xcd - r) * q) + off; }
        const int nig = WGM * nN, gid = wgid / nig, fm = gid * WGM, gsz = (nM - fm) < WGM ? (nM - fm) : WGM;
        u.pm = fm + ((wgid % nig) % gsz); u.pn = (wgid % nig) / gsz; return true;
    }
};
__device__ __forceinline__ unsigned cvt_pk_bf16(float lo, float hi) { unsigned r; asm volatile("v_cvt_pk_bf16_f32 %0, %1, %2" : "=v"(r) : "v"(lo), "v"(hi)); return r; }
template <class Epi, class Sched, class Seg, bool ALIGN_EPI = false, bool SP2 = false>
__device__ __forceinline__ void gemm_phase(PG8_LAS unsigned char* lds, const Gemm g, const Sched& S, const Epi& E) {
    const int tid = tid_(), wid = __builtin_amdgcn_readfirstlane(tid >> 6), lane = tid & 63, wr = wid >> 2, wc = wid & 3, fr = lane & 15, fq = lane >> 4;
    const int K = g.K, nt = K / BK;
    unsigned voffA[2], voffB[2];
#pragma unroll
    for (int i = 0; i < 2; ++i) { int R, C; stage_rc(tid * 16 + i * 8192, R, C); const int Rb = Epi::PERM ? ((R & ~31) + perm32(R & 31)) : R;
        voffA[i] = (unsigned)(R * g.lda + C) * 2u; voffB[i] = (unsigned)(Rb * g.ldb + C) * 2u; }
    const size_t kstep = (size_t)(BK * 2);
    const size_t hstepA = (size_t)HALF * g.lda * 2, hstepB = (size_t)HALF * g.ldb * 2;
    const size_t tstepA = 2 * hstepA, tstepB = 2 * hstepB;
    const unsigned ldsw = (unsigned)wid * 1024u;
    const int aoff = lds_byte(wr * 64 + fr, fq * 8), boff = lds_byte(wc * 32 + fr, fq * 8);
#define PG8_SA(b, h) (((b) * 2 + (h)) * HTB)
#define PG8_SB(b, h) ((4 + (b) * 2 + (h)) * HTB)
#define PG8_STAGE(bufoff, gbase, voff) do { _Pragma("unroll") for (int _i = 0; _i < 2; ++_i) \
        __builtin_amdgcn_global_load_lds((const unsigned*)((const char*)(gbase) + (voff)[_i]), (PG8_LAS unsigned*)(lds + (bufoff) + ldsw + _i * 8192), 16, 0, 0); } while (0)
#define PG8_LDA(dst, b, h) do { _Pragma("unroll") for (int m = 0; m < 4; ++m) _Pragma("unroll") for (int k = 0; k < 2; ++k) dst[m][k] = *(const PG8_LAS bf16x8*)(lds + PG8_SA(b, h) + aoff + m * 2048 + k * 1024); } while (0)
#define PG8_LDB(dst, b, h) do { _Pragma("unroll") for (int n = 0; n < 2; ++n) _Pragma("unroll") for (int k = 0; k < 2; ++k) dst[n][k] = *(const PG8_LAS bf16x8*)(lds + PG8_SB(b, h) + boff + n * 2048 + k * 1024); } while (0)
#define PG8_MMA(ai, bj, At, Bt) do { __builtin_amdgcn_s_setprio(1); _Pragma("unroll") for (int m = 0; m < 4; ++m) _Pragma("unroll") for (int n = 0; n < 2; ++n) _Pragma("unroll") for (int k = 0; k < 2; ++k) \
        acc[ai][bj][m][n] = __builtin_amdgcn_mfma_f32_16x16x32_bf16(Bt[n][k], At[m][k], acc[ai][bj][m][n], 0, 0, 0); __builtin_amdgcn_s_setprio(0); } while (0)
#define PG8_WAIT_V(n) asm volatile("s_waitcnt vmcnt(" #n ")" ::: "memory")
#define PG8_WAIT_L(n) asm volatile("s_waitcnt lgkmcnt(" #n ")" ::: "memory")
#define PG8_BAR __builtin_amdgcn_s_barrier()
#define PG8_SCHED __builtin_amdgcn_sched_barrier(0)
    Unit cur, nxt; int ui = 0;
    if (!S.next(0, cur)) return;
    f32x4 acc[2][2][4][2];
#pragma unroll
    for (int a = 0; a < 2; ++a)
#pragma unroll
        for (int b = 0; b < 2; ++b)
#pragma unroll
            for (int m = 0; m < 4; ++m)
#pragma unroll
                for (int n = 0; n < 2; ++n) acc[a][b][m][n] = (f32x4){0.f, 0.f, 0.f, 0.f};
    bf16x8 At[4][2], B0[2][2], B1[2][2];
    const char* cA = (const char*)g.A + (size_t)cur.pm * tstepA + (size_t)Seg::a(cur.kb) * 2; const char* cB = (const char*)g.Bt + (size_t)cur.pn * tstepB + (size_t)Seg::b(cur.kb) * 2;

    if constexpr (SP2) {
        PG8_STAGE(PG8_SB(0, 0), cB, voffB); PG8_STAGE(PG8_SB(0, 1), cB + hstepB, voffB); PG8_STAGE(PG8_SA(0, 0), cA, voffA); PG8_STAGE(PG8_SA(0, 1), cA + hstepA, voffA);
        if (wr == 1) PG8_BAR;
        PG8_WAIT_V(2); PG8_BAR;
        PG8_STAGE(PG8_SB(1, 0), cB + kstep, voffB); PG8_STAGE(PG8_SA(1, 0), cA + kstep, voffA); PG8_STAGE(PG8_SB(1, 1), cB + hstepB + kstep, voffB);
        PG8_WAIT_V(6); PG8_BAR;
    } else {
        PG8_STAGE(PG8_SB(0, 0), cB, voffB); PG8_STAGE(PG8_SA(0, 0), cA, voffA); PG8_STAGE(PG8_SB(0, 1), cB + hstepB, voffB); PG8_STAGE(PG8_SA(0, 1), cA + hstepA, voffA);
        if (wr == 1) PG8_BAR;
        PG8_WAIT_V(4); PG8_BAR;
        PG8_STAGE(PG8_SB(1, 0), cB + kstep, voffB); PG8_STAGE(PG8_SA(1, 0), cA + kstep, voffA); PG8_STAGE(PG8_SB(1, 1), cB + hstepB + kstep, voffB);
        PG8_WAIT_V(6); PG8_BAR;
    }
    for (;;) {
        const bool has_next = S.next(ui + 1, nxt);
        const char* nA = has_next ? (const char*)g.A + (size_t)nxt.pm * tstepA + (size_t)Seg::a(nxt.kb) * 2 : cA; const char* nB = has_next ? (const char*)g.Bt + (size_t)nxt.pn * tstepB + (size_t)Seg::b(nxt.kb) * 2 : cB;
        for (int t = 0; t < nt; t += 2) {
            const bool last = (t == nt - 2);
            const char* a1 = cA + (size_t)(t + 1) * kstep;
            const char* a2 = last ? nA : cA + (size_t)(t + 2) * kstep; const char* b2 = last ? nB : cB + (size_t)(t + 2) * kstep;
            const char* a3 = a2 + kstep; const char* b3 = b2 + kstep;

            if constexpr (SP2) {
            PG8_LDB(B0, 0, 0); PG8_LDB(B1, 0, 1); PG8_SCHED; PG8_LDA(At, 0, 0); PG8_STAGE(PG8_SA(1, 1), a1 + hstepA, voffA);
            PG8_WAIT_V(8); PG8_WAIT_L(0); PG8_BAR; PG8_MMA(0, 0, At, B0); PG8_MMA(0, 1, At, B1); PG8_BAR; PG8_SCHED;
            PG8_LDA(At, 0, 1); PG8_STAGE(PG8_SB(0, 0), b2, voffB); PG8_STAGE(PG8_SB(0, 1), b2 + hstepB, voffB); PG8_STAGE(PG8_SA(0, 0), a2, voffA);
            PG8_WAIT_V(8); PG8_WAIT_L(0); PG8_BAR; PG8_MMA(1, 0, At, B0); PG8_MMA(1, 1, At, B1); PG8_BAR; PG8_SCHED;
            PG8_LDB(B0, 1, 0); PG8_LDB(B1, 1, 1); PG8_SCHED; PG8_LDA(At, 1, 0); PG8_STAGE(PG8_SA(0, 1), a2 + hstepA, voffA);
            PG8_WAIT_V(8); PG8_WAIT_L(0); PG8_BAR; PG8_MMA(0, 0, At, B0); PG8_MMA(0, 1, At, B1); PG8_BAR; PG8_SCHED;
            PG8_LDA(At, 1, 1); PG8_STAGE(PG8_SB(1, 0), b3, voffB); PG8_STAGE(PG8_SB(1, 1), b3 + hstepB, voffB); PG8_STAGE(PG8_SA(1, 0), a3, voffA);
            PG8_WAIT_V(8); PG8_WAIT_L(0); PG8_BAR; PG8_MMA(1, 0, At, B0); PG8_MMA(1, 1, At, B1); PG8_BAR; PG8_SCHED;
            } else {
            PG8_LDB(B0, 0, 0); PG8_SCHED; PG8_LDA(At, 0, 0); PG8_STAGE(PG8_SA(1, 1), a1 + hstepA, voffA);
            PG8_WAIT_L(8); PG8_BAR; PG8_WAIT_L(0); PG8_MMA(0, 0, At, B0); PG8_BAR; PG8_SCHED;
            PG8_LDB(B1, 0, 1); PG8_STAGE(PG8_SB(0, 0), b2, voffB);
            PG8_BAR; PG8_WAIT_L(0); PG8_MMA(0, 1, At, B1); PG8_BAR;
            PG8_LDA(At, 0, 1); PG8_STAGE(PG8_SA(0, 0), a2, voffA);
            PG8_BAR; PG8_WAIT_L(0); PG8_MMA(1, 0, At, B0); PG8_BAR; PG8_SCHED;
            PG8_STAGE(PG8_SB(0, 1), b2 + hstepB, voffB);
            PG8_WAIT_V(6); PG8_BAR; PG8_MMA(1, 1, At, B1); PG8_BAR;
            PG8_LDB(B0, 1, 0); PG8_SCHED; PG8_LDA(At, 1, 0); PG8_STAGE(PG8_SA(0, 1), a2 + hstepA, voffA);
            PG8_WAIT_L(8); PG8_BAR; PG8_WAIT_L(0); PG8_MMA(0, 0, At, B0); PG8_BAR; PG8_SCHED;
            PG8_LDB(B1, 1, 1); PG8_STAGE(PG8_SB(1, 0), b3, voffB);
            PG8_BAR; PG8_WAIT_L(0); PG8_MMA(0, 1, At, B1); PG8_BAR;
            PG8_LDA(At, 1, 1); PG8_STAGE(PG8_SA(1, 0), a3, voffA);
            PG8_BAR; PG8_WAIT_L(0); PG8_MMA(1, 0, At, B0); PG8_BAR; PG8_SCHED;
            PG8_STAGE(PG8_SB(1, 1), b3 + hstepB, voffB);
            PG8_WAIT_V(6); PG8_BAR; PG8_MMA(1, 1, At, B1); PG8_BAR;
            }
        }
        if constexpr (ALIGN_EPI) { if (wr == 0) PG8_BAR; }
        const bool keep_acc = E(acc, cur, wr, wc, fr, fq);
        if (!has_next) break;
        if (!keep_acc) {
#pragma unroll
        for (int a = 0; a < 2; ++a)
#pragma unroll
            for (int b = 0; b < 2; ++b)
#pragma unroll
                for (int m = 0; m < 4; ++m)
#pragma unroll
                    for (int n = 0; n < 2; ++n) acc[a][b][m][n] = (f32x4){0.f, 0.f, 0.f, 0.f};
        }
        cur = nxt; cA = nA; cB = nB; ++ui;
        if constexpr (ALIGN_EPI) { if (wr == 1) PG8_BAR; }
    }
    PG8_WAIT_V(0);
    if constexpr (!ALIGN_EPI) { if (wr == 0) PG8_BAR; }
    PG8_BAR;
#undef PG8_SA
#undef PG8_SB
#undef PG8_STAGE
#undef PG8_LDA
#undef PG8_LDB
#undef PG8_MMA
#undef PG8_WAIT_V
#undef PG8_WAIT_L
#undef PG8_BAR
#undef PG8_SCHED
}
}

__device__ __forceinline__ bf16_t* gate_ptr(unsigned char* ws, int br, size_t row, int d) {
    if (br == 0) return (bf16_t*)(ws + WS_P) + row * LDP + d;
    if (br == 1) return (bf16_t*)(ws + WS_P) + row * LDP + 2048 + d;
    return (bf16_t*)(ws + WS_AF) + row * 1024 + d;
}
typedef f32x4 acc_t[2][2][4][2];
struct EpiInproj {
    static constexpr bool PERM = true;
    unsigned char* ws; const float* lb_param; int l;
    __device__ __forceinline__ bool operator()(acc_t& acc, const pg8::Unit& u, int wr, int wc, int fr, int fq) const {
        bf16_t* P = (bf16_t*)(ws + WS_P); float* AF = (float*)(ws + WS_AF);
        const int row0 = u.pm * 256 + wr * 64 + fr, col0 = u.pn * 256 + wc * 32 + 8 * fq;
        const int pn = u.pn;
        if (pn == 2 || pn == 3) {
            float lb[2][8];
#pragma unroll
            for (int bj = 0; bj < 2; ++bj)
#pragma unroll
                for (int e = 0; e < 8; ++e) { float v = 0.f; if (l == 1) { const int k = col0 + bj * 128 - 512 + e; v = 1.0f / (1.0f + __expf(lb_param[k] - lb_param[512 + k])); } lb[bj][e] = v; }
#pragma unroll
            for (int ai = 0; ai < 2; ++ai)
#pragma unroll
                for (int m = 0; m < 4; ++m) { float* rowp = AF + (size_t)(row0 + ai * 128 + m * 16) * 512 + (col0 - 512);
#pragma unroll
                    for (int bj = 0; bj < 2; ++bj) { const f32x4 v0 = acc[ai][bj][m][0], v1 = acc[ai][bj][m][1]; f32x4 o0, o1;
#pragma unroll
                        for (int e = 0; e < 4; ++e) { o0[e] = lb[bj][e] + (1.0f - lb[bj][e]) * sigmoidf_(v0[e]); o1[e] = lb[bj][4 + e] + (1.0f - lb[bj][4 + e]) * sigmoidf_(v1[e]); }
                        *(f32x4*)(rowp + bj * 128) = o0; *(f32x4*)(rowp + bj * 128 + 4) = o1; } }
        } else {
            const int act = pn < 2 ? 1 : ((pn == 16 || pn == 17) ? 2 : 0);
#pragma unroll
            for (int ai = 0; ai < 2; ++ai)
#pragma unroll
                for (int m = 0; m < 4; ++m) { bf16_t* rowp = P + (size_t)(row0 + ai * 128 + m * 16) * LDP + col0;
#pragma unroll
                    for (int bj = 0; bj < 2; ++bj) { f32x4 v0 = acc[ai][bj][m][0], v1 = acc[ai][bj][m][1];
                        if (act == 1) {
#pragma unroll
                            for (int e = 0; e < 4; ++e) { v0[e] = siluf_(v0[e]); v1[e] = siluf_(v1[e]); } }
                        else if (act == 2) { v0 = v0 * 0.125f; v1 = v1 * 0.125f; }
                        u32x4 w; w.x = pk2(v0[0], v0[1]); w.y = pk2(v0[2], v0[3]); w.z = pk2(v1[0], v1[1]); w.w = pk2(v1[2], v1[3]);
                        *(u32x4*)(rowp + bj * 128) = w; } }
        }
        return false;
    }
};
struct EpiGates {
    static constexpr bool PERM = true;
    unsigned char* ws;
    __device__ __forceinline__ bool operator()(acc_t& acc, const pg8::Unit& u, int wr, int wc, int fr, int fq) const {
        const int row0 = u.pm * 256 + wr * 64 + fr, br = u.pn >> 2, d0 = (u.pn & 3) * 256 + wc * 32 + 8 * fq;
#pragma unroll
        for (int ai = 0; ai < 2; ++ai)
#pragma unroll
            for (int m = 0; m < 4; ++m) { bf16_t* rowp = gate_ptr(ws, br, (size_t)(row0 + ai * 128 + m * 16), d0);
#pragma unroll
                for (int bj = 0; bj < 2; ++bj) { const f32x4 v0 = acc[ai][bj][m][0], v1 = acc[ai][bj][m][1];
                    u32x4 w; w.x = pk2(sigmoidf_(v0[0]), sigmoidf_(v0[1])); w.y = pk2(sigmoidf_(v0[2]), sigmoidf_(v0[3])); w.z = pk2(sigmoidf_(v1[0]), sigmoidf_(v1[1])); w.w = pk2(sigmoidf_(v1[2]), sigmoidf_(v1[3]));
                    *(u32x4*)(rowp + bj * 128) = w; } }
        return false;
    }
};
struct EpiLift {
    static constexpr bool PERM = true;
    unsigned char* ws;
    __device__ __forceinline__ bool operator()(acc_t& acc, const pg8::Unit& u, int wr, int wc, int fr, int fq) const {
        bf16_t* MG = (bf16_t*)(ws + WS_HB);
        const int row0 = u.pm * 256 + wr * 64 + fr, d0 = u.pn * 256 + wc * 32 + 8 * fq, s = u.kb;
#pragma unroll
        for (int ai = 0; ai < 2; ++ai)
#pragma unroll
            for (int m = 0; m < 4; ++m) { const size_t row = (size_t)(row0 + ai * 128 + m * 16);
#pragma unroll
                for (int bj = 0; bj < 2; ++bj) {
                    const u32x4 ga = *(const u32x4*)gate_ptr(ws, s, row, d0 + bj * 128);
                    f32x4 fa = (f32x4){bf_lo(ga.x), bf_hi(ga.x), bf_lo(ga.y), bf_hi(ga.y)}, fb = (f32x4){bf_lo(ga.z), bf_hi(ga.z), bf_lo(ga.w), bf_hi(ga.w)};
                    if (s < 2) { const u32x4 gb = *(const u32x4*)gate_ptr(ws, s + 1, row, d0 + bj * 128);
                        fa[0] *= __builtin_amdgcn_rcpf(fmaxf(bf_lo(gb.x), 1e-30f)); fa[1] *= __builtin_amdgcn_rcpf(fmaxf(bf_hi(gb.x), 1e-30f));
                        fa[2] *= __builtin_amdgcn_rcpf(fmaxf(bf_lo(gb.y), 1e-30f)); fa[3] *= __builtin_amdgcn_rcpf(fmaxf(bf_hi(gb.y), 1e-30f));
                        fb[0] *= __builtin_amdgcn_rcpf(fmaxf(bf_lo(gb.z), 1e-30f)); fb[1] *= __builtin_amdgcn_rcpf(fmaxf(bf_hi(gb.z), 1e-30f));
                        fb[2] *= __builtin_amdgcn_rcpf(fmaxf(bf_lo(gb.w), 1e-30f)); fb[3] *= __builtin_amdgcn_rcpf(fmaxf(bf_hi(gb.w), 1e-30f)); }
                    const f32x4 v0 = acc[ai][bj][m][0] * fa, v1 = acc[ai][bj][m][1] * fb;
                    acc[ai][bj][m][0] = v0; acc[ai][bj][m][1] = v1;
                    if (s == 2) { u32x4 w; w.x = pk2(v0[0], v0[1]); w.y = pk2(v0[2], v0[3]); w.z = pk2(v1[0], v1[1]); w.w = pk2(v1[2], v1[3]);
                        *(u32x4*)(MG + row * D + d0 + bj * 128) = w; }
                }
                asm volatile("" ::: "memory");
            }
        return s < 2;
    }
};
struct EpiOut {
    static constexpr bool PERM = false;
    const float* xin; float* out;
    __device__ __forceinline__ bool operator()(acc_t& acc, const pg8::Unit& u, int wr, int wc, int fr, int fq) const {
        const int row0 = u.pm * 256 + wr * 64 + fr, col0 = u.pn * 256 + wc * 32 + 4 * fq;
#pragma unroll
        for (int ai = 0; ai < 2; ++ai)
#pragma unroll
            for (int m = 0; m < 4; ++m) { const size_t off = (size_t)(row0 + ai * 128 + m * 16) * D + col0;
#pragma unroll
                for (int bj = 0; bj < 2; ++bj)
#pragma unroll
                    for (int n = 0; n < 2; ++n) { const f32x4 xv = *(const f32x4*)(xin + off + bj * 128 + n * 16); *(f32x4*)(out + off + bj * 128 + n * 16) = xv + acc[ai][bj][m][n]; }
                asm volatile("" ::: "memory"); }
        return false;
    }
};
struct SegLift { static __device__ __forceinline__ int a(int s) { return PC_AG + (s >= 1 ? PC_BZ - PC_AG : 0) + (s >= 2 ? PC_CG - PC_BZ : 0); } static __device__ __forceinline__ int b(int s) { return s * 512; } };
__device__ __forceinline__ void phase_inproj(const Params& p, int l, unsigned char* lds) {
    pg8::Gemm g{(const bf16_t*)(p.ws + WS_HB), (const bf16_t*)(p.ws + WS_WIN), D, D, D};
    pg8::StaticOrder S; S.init(M, NMIX, (int)gridDim.x, bid_(), 1);
    EpiInproj E{p.ws, p.lb_param, l};
    pg8::gemm_phase<EpiInproj, pg8::StaticOrder, pg8::SegNone, true, true>((PG8_LAS unsigned char*)lds, g, S, E);
}
__device__ __forceinline__ void phase_gates(const Params& p, unsigned char* lds) {
    pg8::Gemm g{(const bf16_t*)(p.ws + WS_HB), (const bf16_t*)(p.ws + WS_WIN) + (size_t)NMIX * D, D, D, D};
    pg8::StaticOrder S; S.init(M, NGATE, (int)gridDim.x, bid_(), 1);
    EpiGates E{p.ws};
    pg8::gemm_phase<EpiGates, pg8::StaticOrder, pg8::SegNone, true, true>((PG8_LAS unsigned char*)lds, g, S, E);
}
__device__ __forceinline__ void phase_lift(const Params& p, unsigned char* lds) {
    pg8::Gemm g{(const bf16_t*)(p.ws + WS_P), (const bf16_t*)(p.ws + WS_WB), LDP, 1536, 512};
    pg8::StaticOrder S; S.init(M, D, (int)gridDim.x, bid_(), 3);
    EpiLift E{p.ws};
    pg8::gemm_phase<EpiLift, pg8::StaticOrder, SegLift, false, true>((PG8_LAS unsigned char*)lds, g, S, E);
}
__device__ __forceinline__ void phase_outproj(const Params& p, const float* xin, unsigned char* lds) {
    pg8::Gemm g{(const bf16_t*)(p.ws + WS_HB), (const bf16_t*)(p.ws + WS_WO), D, D, D};
    pg8::StaticOrder S; S.init(M, D, (int)gridDim.x, bid_(), 1);
    EpiOut E{xin, p.out};
    pg8::gemm_phase<EpiOut, pg8::StaticOrder, pg8::SegNone, false, true>((PG8_LAS unsigned char*)lds, g, S, E);
}

constexpr int A_TB = 16;
__device__ __forceinline__ void mixer_a(const Params& p, int bh, int vs, unsigned char* lds) {
    const int tid = tid_(), lane = tid & 63, wave = tid >> 6, r = lane >> 4, i = lane & 15;
    const int b = bh >> 2, h = bh & 3;
    bf16_t* P = (bf16_t*)(p.ws + WS_P); const float* AF = (const float*)(p.ws + WS_AF);
    constexpr int BUF = 8192 + 8192 + 2048;
    float* obuf = (float*)(lds + 2 * BUF);
    const size_t row0 = (size_t)b * SEQ;
    const int fr_row = tid >> 5, fr_c4 = (tid & 31) * 4;
    const int q_row = tid >> 5, q_c4 = (tid & 31) * 4;
    const int i_row = (tid >> 3) & 15, i_c4 = (tid & 7) * 4;
    f32x4 pf; u32x2 pq; u32x2 pi;
    auto gload = [&](int t0) {
        pf = *(const f32x4*)(AF + (row0 + t0 + fr_row) * 512 + h * 128 + fr_c4);
        pq = *(const u32x2*)(P + (row0 + t0 + q_row) * LDP + PC_AQ + h * 128 + q_c4);
        if (tid < 128) pi = *(const u32x2*)(P + (row0 + t0 + i_row) * LDP + PC_AI + h * 128 + vs * 32 + i_c4);
    };
    auto lstore = [&](int bufi) {
        float* fb = (float*)(lds + bufi * BUF); float* qb = fb + 2048; float* ib = qb + 2048;
        *(f32x4*)(fb + fr_row * 128 + fr_c4) = pf;
        *(f32x4*)(qb + q_row * 128 + q_c4) = (f32x4){bf_lo(pq.x), bf_hi(pq.x), bf_lo(pq.y), bf_hi(pq.y)};
        if (tid < 128) *(f32x4*)(ib + i_row * 32 + i_c4) = (f32x4){bf_lo(pi.x), bf_hi(pi.x), bf_lo(pi.y), bf_hi(pi.y)};
    };
    float S[8];
#pragma unroll
    for (int j = 0; j < 8; ++j) S[j] = 0.f;
    gload(0); lstore(0); __syncthreads();
    constexpr int NB = SEQ / A_TB;
    for (int bt = 0; bt < NB; ++bt) {
        const int cur = bt & 1;
        if (bt + 1 < NB) gload((bt + 1) * A_TB);
        const float* fb = (const float*)(lds + cur * BUF); const float* qb = fb + 2048; const float* ib = qb + 2048;
#pragma unroll 4
        for (int t = 0; t < A_TB; ++t) {
            const f32x4 f0 = *(const f32x4*)(fb + t * 128 + 8 * i), f1 = *(const f32x4*)(fb + t * 128 + 8 * i + 4);
            const f32x4 q0 = *(const f32x4*)(qb + t * 128 + 8 * i), q1 = *(const f32x4*)(qb + t * 128 + 8 * i + 4);
            const float iv = ib[t * 32 + wave * 4 + r];
            float pa = 0.f, pb = 0.f;
            S[0] = iv + f0[0] * (S[0] - iv); pa += q0[0] * S[0];
            S[1] = iv + f0[1] * (S[1] - iv); pb += q0[1] * S[1];
            S[2] = iv + f0[2] * (S[2] - iv); pa += q0[2] * S[2];
            S[3] = iv + f0[3] * (S[3] - iv); pb += q0[3] * S[3];
            S[4] = iv + f1[0] * (S[4] - iv); pa += q1[0] * S[4];
            S[5] = iv + f1[1] * (S[5] - iv); pb += q1[1] * S[5];
            S[6] = iv + f1[2] * (S[6] - iv); pa += q1[2] * S[6];
            S[7] = iv + f1[3] * (S[7] - iv); pb += q1[3] * S[7];
            const float o = row16_sum(pa + pb);
            if (i == 0) obuf[t * 32 + wave * 4 + r] = o;
        }
        __syncthreads();
        { const int t = tid >> 5, v = tid & 31; P[(row0 + bt * A_TB + t) * LDP + PC_AI + h * 128 + vs * 32 + v] = (bf16_t)f2bf(obuf[t * 32 + v]); }
        if (bt + 1 < NB) lstore(cur ^ 1);
        __syncthreads();
    }
}

constexpr int B_TB = 16;
__device__ __forceinline__ void mixer_b(const Params& p, int l, int bh, int vs, unsigned char* lds) {
    const int tid = tid_(), lane = tid & 63, wave = tid >> 6, r = lane >> 5, i = lane & 31;
    const int b = bh >> 2, h = bh & 3;
    bf16_t* P = (bf16_t*)(p.ws + WS_P); const float* sm8 = (const float*)(p.ws + WS_SM);
    const float* cw = p.conv_w + (size_t)l * 4 * 1536;
    constexpr int RAWC = 272;
    float* raw = (float*)lds;
    float* qk = (float*)(lds + 20736);
    float* vv = (float*)(lds + 20736 + 16384);
    float* sc = (float*)(lds + 20736 + 16384 + 1024);
    float* obuf = (float*)(lds + 20736 + 16384 + 1024 + 256);
    const size_t row0 = (size_t)b * SEQ;
    const float a_coef = -__expf(p.a_log[l * 4 + h]); const float dtb = p.dt_bias[l * 4 + h];
    const int cqk = tid & 255; const int chq = cqk < 128 ? h * 128 + cqk : 512 + h * 128 + (cqk - 128);
    float wq[4]; float wvv[4];
#pragma unroll
    for (int j = 0; j < 4; ++j) { wq[j] = cw[j * 1536 + chq]; wvv[j] = cw[j * 1536 + 1024 + h * 128 + vs * 16 + (tid & 15)]; }
    for (int e = tid; e < 3 * RAWC; e += NTHREADS) raw[e] = 0.f;
    float S[4] = {0.f, 0.f, 0.f, 0.f};
    u32x4 st0, st1;
    auto chunk_addr = [&](int t0, int ck) -> const bf16_t* {
        const int row = ck / 34, c8 = ck % 34; const int ch = c8 < 16 ? h * 128 + c8 * 8 : (c8 < 32 ? 512 + h * 128 + (c8 - 16) * 8 : 1024 + h * 128 + vs * 16 + (c8 - 32) * 8);
        return P + (row0 + t0 + row) * LDP + PC_BQKV + ch; };
    auto gload = [&](int t0) { st0 = *(const u32x4*)chunk_addr(t0, tid); if (tid < 32) st1 = *(const u32x4*)chunk_addr(t0, 512 + tid); };
    auto rstore = [&]() {
        { const int row = tid / 34, c8 = tid % 34; float* d = raw + (3 + row) * RAWC + c8 * 8;
          *(f32x4*)d = (f32x4){bf_lo(st0.x), bf_hi(st0.x), bf_lo(st0.y), bf_hi(st0.y)}; *(f32x4*)(d + 4) = (f32x4){bf_lo(st0.z), bf_hi(st0.z), bf_lo(st0.w), bf_hi(st0.w)}; }
        if (tid < 32) { const int ck = 512 + tid; const int row = ck / 34, c8 = ck % 34; float* d = raw + (3 + row) * RAWC + c8 * 8;
          *(f32x4*)d = (f32x4){bf_lo(st1.x), bf_hi(st1.x), bf_lo(st1.y), bf_hi(st1.y)}; *(f32x4*)(d + 4) = (f32x4){bf_lo(st1.z), bf_hi(st1.z), bf_lo(st1.w), bf_hi(st1.w)}; }
    };
    gload(0);
    constexpr int NB = SEQ / B_TB;
    for (int bt = 0; bt < NB; ++bt) {
        const int t0 = bt * B_TB;
        __syncthreads();
        rstore();
        if (bt + 1 < NB) gload(t0 + B_TB);
        __syncthreads();
        {
            const int tb = (tid >> 8) * 8;
#pragma unroll
            for (int tt = 0; tt < 8; ++tt) { const int t = tb + tt;
                const float x = raw[(t + 0) * RAWC + cqk] * wq[0] + raw[(t + 1) * RAWC + cqk] * wq[1] + raw[(t + 2) * RAWC + cqk] * wq[2] + raw[(t + 3) * RAWC + cqk] * wq[3];
                qk[t * 256 + cqk] = siluf_(x); }
            if (tid < 256) { const int t = tid >> 4, c = tid & 15;
                const float x = raw[(t + 0) * RAWC + 256 + c] * wvv[0] + raw[(t + 1) * RAWC + 256 + c] * wvv[1] + raw[(t + 2) * RAWC + 256 + c] * wvv[2] + raw[(t + 3) * RAWC + 256 + c] * wvv[3];
                vv[t * 16 + c] = siluf_(x); }
            if (tid < 16) { const f32x4 lo = *(const f32x4*)(sm8 + (row0 + t0 + tid) * 8), hi = *(const f32x4*)(sm8 + (row0 + t0 + tid) * 8 + 4);
                const float bl = lo[h], al = hi[h]; const float xx = al + dtb; const float sp = xx > 20.f ? xx : log1pf(__expf(xx));
                sc[tid * 4 + 0] = __expf(a_coef * sp); sc[tid * 4 + 1] = sigmoidf_(bl); }
        }
        __syncthreads();
        {
            const int vec = tid >> 4, sub = tid & 15; const int t = vec >> 1, which = vec & 1;
            float* src = qk + t * 256 + which * 128 + sub * 8;
            f32x4 a0 = *(f32x4*)src, a1 = *(f32x4*)(src + 4);
            float ss = (a0[0] * a0[0] + a0[1] * a0[1]) + (a0[2] * a0[2] + a0[3] * a0[3]) + (a1[0] * a1[0] + a1[1] * a1[1]) + (a1[2] * a1[2] + a1[3] * a1[3]);
            ss = row16_sum(ss);
            float sc_ = 1.0f / sqrtf(ss + EPS); if (which == 0) sc_ *= 0.08838834764831845f;
            a0 = a0 * sc_; a1 = a1 * sc_;
            *(f32x4*)src = a0; *(f32x4*)(src + 4) = a1;
        }
        __syncthreads();
        if (tid < 256) { const int t = tid >> 4, sub = tid & 15; const float* qs = qk + t * 256 + sub * 8; const float* ks = qs + 128;
            float d = 0.f;
#pragma unroll
            for (int e = 0; e < 8; ++e) d += qs[e] * ks[e];
            d = row16_sum(d); if (sub == 0) sc[t * 4 + 2] = d; }
        __syncthreads();
#pragma unroll 2
        for (int t = 0; t < B_TB; ++t) {
            const f32x4 q4 = *(const f32x4*)(qk + t * 256 + 4 * i), k4 = *(const f32x4*)(qk + t * 256 + 128 + 4 * i);
            const f32x4 s4 = *(const f32x4*)(sc + t * 4); const float vt = vv[t * 16 + wave * 2 + r];
            const float alpha = s4[0], beta = s4[1], qkd = s4[2];
            float rk = (S[0] * k4[0] + S[1] * k4[1]) + (S[2] * k4[2] + S[3] * k4[3]);
            float rq = (S[0] * q4[0] + S[1] * q4[1]) + (S[2] * q4[2] + S[3] * q4[3]);
            rk = xor16_sum(row16_sum(rk)); rq = xor16_sum(row16_sum(rq));
            const float vn = beta * (vt - alpha * rk);
            const float o = alpha * rq + qkd * vn;
            S[0] = alpha * S[0] + k4[0] * vn; S[1] = alpha * S[1] + k4[1] * vn; S[2] = alpha * S[2] + k4[2] * vn; S[3] = alpha * S[3] + k4[3] * vn;
            if (i == 0) obuf[t * 16 + wave * 2 + r] = o;
        }
        __syncthreads();
        if (tid < 256) { const int t = tid >> 4, c = tid & 15; P[(row0 + t0 + t) * LDP + PC_BQKV + 1024 + h * 128 + vs * 16 + c] = (bf16_t)f2bf(obuf[t * 16 + c]); }
        float hv0 = 0.f, hv1 = 0.f; const int e0 = tid, e1 = tid + 512;
        if (e0 < 3 * RAWC) hv0 = raw[16 * RAWC + e0];
        if (e1 < 3 * RAWC) hv1 = raw[16 * RAWC + e1];
        __syncthreads();
        if (e0 < 3 * RAWC) raw[e0] = hv0;
        if (e1 < 3 * RAWC) raw[e1] = hv1;
    }
}

__device__ __forceinline__ void mixer_c(const Params& p, int l, int unit, unsigned char* lds) {
    const int tid = tid_(), wave = tid >> 6;
    const int kvh = unit & 1, nb = (unit >> 1) & 31, b = unit >> 6;
    bf16_t* P = (bf16_t*)(p.ws + WS_P);
    bf16_t* sK = (bf16_t*)lds;
    bf16_t* sVT = (bf16_t*)(lds + 32768);
    float* sBias = (float*)(lds + 32768 + 64 * 264 * 2);
    constexpr int VTP = 264;
    const size_t rowq0 = (size_t)b * SEQ + (size_t)nb * 128;
    __syncthreads();
    for (int c = tid; c < 256 * 8; c += NTHREADS) {
        const int j = c >> 3, d8 = (c & 7) * 8; u32x4 kv = (u32x4){0u, 0u, 0u, 0u}, vv = (u32x4){0u, 0u, 0u, 0u};
        if (nb > 0 || j >= 128) { const size_t row = rowq0 - 128 + j; kv = *(const u32x4*)(P + row * LDP + PC_CK + kvh * 64 + d8); vv = *(const u32x4*)(P + row * LDP + PC_CV + kvh * 64 + d8); }
        *(u32x4*)(sK + j * 64 + d8) = kv;
        sVT[(d8 + 0) * VTP + j] = (bf16_t)(vv.x & 0xffff); sVT[(d8 + 1) * VTP + j] = (bf16_t)(vv.x >> 16);
        sVT[(d8 + 2) * VTP + j] = (bf16_t)(vv.y & 0xffff); sVT[(d8 + 3) * VTP + j] = (bf16_t)(vv.y >> 16);
        sVT[(d8 + 4) * VTP + j] = (bf16_t)(vv.z & 0xffff); sVT[(d8 + 5) * VTP + j] = (bf16_t)(vv.z >> 16);
        sVT[(d8 + 6) * VTP + j] = (bf16_t)(vv.w & 0xffff); sVT[(d8 + 7) * VTP + j] = (bf16_t)(vv.w >> 16);
    }
    { const int g = tid >> 7, dist = tid & 127; sBias[g * 128 + dist] = p.rel_bias[(int)kBucket[dist] * 8 + kvh * 4 + g]; }
    __syncthreads();
    const int g = tid >> 7, i = tid & 127, hq = kvh * 4 + g;
    const size_t rowq = rowq0 + i;
    unsigned qp[32];
#pragma unroll
    for (int c = 0; c < 8; ++c) { const u32x4 t = *(const u32x4*)(P + rowq * LDP + PC_CQ + hq * 64 + c * 8); qp[4 * c] = t.x; qp[4 * c + 1] = t.y; qp[4 * c + 2] = t.z; qp[4 * c + 3] = t.w; }
    float o[64];
#pragma unroll
    for (int d = 0; d < 64; ++d) o[d] = 0.f;
    const float sink = p.sinks[l * 8 + hq];
    float mrun = sink, lrun = 1.0f;
    const int jlo = 64 * (wave & 1);
    const bool first = (nb == 0);
    for (int jg = 0; jg < 24; ++jg) {
        const int j0 = jlo + jg * 8;
        float s[8];
#pragma unroll
        for (int u = 0; u < 8; ++u) {
            const int j = j0 + u; const bf16_t* kr = sK + j * 64; float a = 0.f;
#pragma unroll
            for (int c = 0; c < 8; ++c) { const u32x4 kk = *(const u32x4*)(kr + c * 8);
                a = dot2u(kk.x, qp[4 * c], a);
                a = dot2u(kk.y, qp[4 * c + 1], a);
                a = dot2u(kk.z, qp[4 * c + 2], a);
                a = dot2u(kk.w, qp[4 * c + 3], a); }
            const int dist = i + 128 - j; const bool ok = (dist >= 0) && (dist < 128) && !(first && j < 128);
            s[u] = ok ? a + sBias[g * 128 + (dist & 127)] : -1e30f;
        }
        float gm = fmaxf(fmaxf(fmaxf(s[0], s[1]), fmaxf(s[2], s[3])), fmaxf(fmaxf(s[4], s[5]), fmaxf(s[6], s[7])));
        const float mnew = fmaxf(mrun, gm); const float corr = __expf(mrun - mnew); mrun = mnew;
        float ps = 0.f; unsigned pp[4];
        float pe[8];
#pragma unroll
        for (int u = 0; u < 8; ++u) { pe[u] = __expf(s[u] - mnew); }
#pragma unroll
        for (int u = 0; u < 4; ++u) { pp[u] = pk2(pe[2 * u], pe[2 * u + 1]); ps += bf_lo(pp[u]) + bf_hi(pp[u]); }
        lrun = lrun * corr + ps;
#pragma unroll
        for (int d = 0; d < 64; ++d) {
            const u32x4 vt = *(const u32x4*)(sVT + d * VTP + j0);
            float a = o[d] * corr;
            a = dot2u(vt.x, pp[0], a);
            a = dot2u(vt.y, pp[1], a);
            a = dot2u(vt.z, pp[2], a);
            a = dot2u(vt.w, pp[3], a);
            o[d] = a;
        }
    }
    float inv = 1.0f / lrun;
#if DIAG_ZERO_C
    inv = 0.f;
#endif
    bf16_t* gp = P + rowq * LDP + PC_CG + hq * 64;
#pragma unroll
    for (int c = 0; c < 8; ++c) {
        const u32x4 gv = *(const u32x4*)(gp + c * 8); u32x4 ov;
        ov.x = pk2(o[8 * c + 0] * inv * siluf_(bf_lo(gv.x)), o[8 * c + 1] * inv * siluf_(bf_hi(gv.x)));
        ov.y = pk2(o[8 * c + 2] * inv * siluf_(bf_lo(gv.y)), o[8 * c + 3] * inv * siluf_(bf_hi(gv.y)));
        ov.z = pk2(o[8 * c + 4] * inv * siluf_(bf_lo(gv.z)), o[8 * c + 5] * inv * siluf_(bf_hi(gv.z)));
        ov.w = pk2(o[8 * c + 6] * inv * siluf_(bf_lo(gv.w)), o[8 * c + 7] * inv * siluf_(bf_hi(gv.w)));
        *(u32x4*)(gp + c * 8) = ov;
    }
}


#if DIAG_NAIVE_C
__device__ __forceinline__ void mixer_c_naive(const Params& p, int l, int unit) {
    const int tid = tid_();
    const int kvh = unit & 1, nb = (unit >> 1) & 31, b = unit >> 6;
    bf16_t* P = (bf16_t*)(p.ws + WS_P);
    const int g = tid >> 7, i = tid & 127, hq = kvh * 4 + g;
    const size_t rowq = (size_t)b * SEQ + (size_t)nb * 128 + i;
    float q[64], o[64];
#pragma unroll
    for (int d = 0; d < 64; ++d) { q[d] = bf2f(P[rowq * LDP + PC_CQ + hq * 64 + d]); o[d] = 0.f; }
    float m = p.sinks[l * 8 + hq], lsum = 1.0f;
    const int tpos = nb * 128 + i;
    for (int kp = tpos - 127; kp <= tpos; ++kp) {
        if (kp < 0) continue;
        const size_t rowk = (size_t)b * SEQ + kp;
        float s = 0.f;
#pragma unroll
        for (int d = 0; d < 64; ++d) s += q[d] * bf2f(P[rowk * LDP + PC_CK + kvh * 64 + d]);
        s += p.rel_bias[(int)kBucket[tpos - kp] * 8 + hq];
        const float mn = fmaxf(m, s); const float corr = __expf(m - mn); const float pe = __expf(s - mn); m = mn;
        lsum = lsum * corr + pe;
#pragma unroll
        for (int d = 0; d < 64; ++d) o[d] = o[d] * corr + pe * bf2f(P[rowk * LDP + PC_CV + kvh * 64 + d]);
    }
    const float inv = 1.0f / lsum;
#pragma unroll
    for (int d = 0; d < 64; ++d) { const size_t a = rowq * LDP + PC_CG + hq * 64 + d; P[a] = (bf16_t)f2bf(o[d] * inv * siluf_(bf2f(P[a]))); }
}
#endif
__device__ __forceinline__ void phase_mixers(const Params& p, int l, unsigned char* lds) {
    const int vb = bid_();
    if (vb < 128) { mixer_b(p, l, vb >> 3, vb & 7, lds); }
    else if (vb < 192) { const int a = vb - 128; mixer_a(p, a >> 2, a & 3, lds); }
    else if (vb < 256) { const int c0 = vb - 192;
#pragma unroll 1
        for (int k = 0; k < 4; ++k) {
#if DIAG_NAIVE_C
            mixer_c_naive(p, l, c0 * 4 + k);
#else
            mixer_c(p, l, c0 * 4 + k, lds);
#endif
        } }
}
__device__ __forceinline__ void phase_finalize(const Params& p, int l) {
    const int tid = tid_(), lane = tid & 63, wave = tid >> 6;
    bf16_t* P = (bf16_t*)(p.ws + WS_P);
    const int hh = lane >> 4, v8 = (lane & 15) * 8;
    float wa[8], wb[8];
#pragma unroll
    for (int e = 0; e < 8; ++e) { wa[e] = p.norm_a[l * 128 + v8 + e]; wb[e] = p.norm_b[l * 128 + v8 + e]; }
    const int gw = bid_() * 8 + wave, NGW = gridDim.x * 8;
    for (int m = gw; m < M; m += NGW) {
        bf16_t* pr = P + (size_t)m * LDP;
#pragma unroll
        for (int br = 0; br < 2; ++br) {
            const int ocol = br == 0 ? PC_AI + hh * 128 + v8 : PC_BQKV + 1024 + hh * 128 + v8;
            const int gcol = br == 0 ? PC_AG + hh * 128 + v8 : PC_BZ + hh * 128 + v8;
            const u32x4 ov = *(const u32x4*)(pr + ocol); const u32x4 gv = *(const u32x4*)(pr + gcol);
            float o[8] = {bf_lo(ov.x), bf_hi(ov.x), bf_lo(ov.y), bf_hi(ov.y), bf_lo(ov.z), bf_hi(ov.z), bf_lo(ov.w), bf_hi(ov.w)};
            float gt[8] = {bf_lo(gv.x), bf_hi(gv.x), bf_lo(gv.y), bf_hi(gv.y), bf_lo(gv.z), bf_hi(gv.z), bf_lo(gv.w), bf_hi(gv.w)};
            float ss = 0.f;
#pragma unroll
            for (int e = 0; e < 8; ++e) ss += o[e] * o[e];
            ss = row16_sum(ss);
            const float rs = 1.0f / sqrtf(ss * (1.0f / 128.0f) + EPS);
            float y[8];
#pragma unroll
            for (int e = 0; e < 8; ++e) y[e] = o[e] * rs * (br == 0 ? wa[e] : wb[e]) * siluf_(gt[e]);
            u32x4 yo; yo.x = pk2(y[0], y[1]); yo.y = pk2(y[2], y[3]); yo.z = pk2(y[4], y[5]); yo.w = pk2(y[6], y[7]);
            *(u32x4*)(pr + gcol) = yo;
        }
    }
}

__device__ __forceinline__ int launder_i(int v) { asm volatile("" : "+s"(v)); return v; }
__device__ __forceinline__ Params launder(Params p) {
    asm volatile("" : "+s"(p.x), "+s"(p.norm_w), "+s"(p.w_in), "+s"(p.conv_w), "+s"(p.a_log), "+s"(p.dt_bias), "+s"(p.lb_param), "+s"(p.norm_a));
    asm volatile("" : "+s"(p.norm_b), "+s"(p.sinks), "+s"(p.rel_bias), "+s"(p.w_branch), "+s"(p.w_out), "+s"(p.final_norm), "+s"(p.out), "+s"(p.ws));
    return p;
}
__global__ void __launch_bounds__(NTHREADS, 2) fwd_megakernel(Params p) {
    extern __shared__ __attribute__((aligned(16))) unsigned char lds[];
    cg::grid_group grid = cg::this_grid();
#pragma unroll 1
    for (int l0 = 0; l0 < DEPTH; ++l0) {
        { const Params q = launder(p); const int l = launder_i(l0); phase_convert_weights(q, l, lds); }
        __syncthreads();
        { const Params q = launder(p); const int l = launder_i(l0); phase_rowpass<0>(q, (l == 0) ? q.x : q.out, q.norm_w + (size_t)l * D, l, lds); }
        grid.sync();
        { const Params q = launder(p); const int l = launder_i(l0); phase_inproj(q, l, lds); }
        grid.sync();
        { const Params q = launder(p); const int l = launder_i(l0); phase_mixers(q, l, lds); }
        grid.sync();
        { const Params q = launder(p); const int l = launder_i(l0); phase_finalize(q, l); }
        { const Params q = launder(p); phase_gates(q, lds); }
        grid.sync();
        { const Params q = launder(p); phase_lift(q, lds); }
        grid.sync();
        { const Params q = launder(p); const int l = launder_i(l0); phase_outproj(q, (l == 0) ? q.x : q.out, lds); }
        grid.sync();
    }
    { const Params q = launder(p); phase_rowpass<1>(q, q.out, q.final_norm, 0, lds); }
}

extern "C" void kernel_launch(void* const* d_in, const int* in_sizes, int n_in, void* d_out, int out_size, void* d_ws, size_t ws_size, hipStream_t stream) {
    static int grid_blocks = 0;
    if (grid_blocks == 0) {
        if (n_in != 14 || in_sizes[0] != M * D || out_size != M * D || ws_size < WS_END) {
            fprintf(stderr, "kernel_launch: unexpected shapes n_in=%d in0=%d out=%d ws=%zu (need %zu)\n", n_in, n_in > 0 ? in_sizes[0] : -1, out_size, ws_size, (size_t)WS_END); grid_blocks = -1; return; }
        int dev = 0, cus = 0, per_cu = 0;
        hipGetDevice(&dev);
        hipDeviceGetAttribute(&cus, hipDeviceAttributeMultiprocessorCount, dev);
        hipFuncSetAttribute((const void*)fwd_megakernel, hipFuncAttributeMaxDynamicSharedMemorySize, LDS_BYTES);
        hipOccupancyMaxActiveBlocksPerMultiprocessor(&per_cu, (const void*)fwd_megakernel, NTHREADS, LDS_BYTES);
        if (per_cu < 1) { fprintf(stderr, "kernel_launch: occupancy query says %d blocks/CU\n", per_cu); per_cu = 1; }
        if (per_cu > 1) per_cu = 1;
        grid_blocks = cus * per_cu;
        if (grid_blocks < 256) { fprintf(stderr, "kernel_launch: needs >= 256 resident blocks, got %d\n", grid_blocks); grid_blocks = -1; return; }
    }
    if (grid_blocks < 0) return;
    Params p{};
    p.x = (const float*)d_in[0]; p.norm_w = (const float*)d_in[1]; p.w_in = (const float*)d_in[2]; p.conv_w = (const float*)d_in[3];
    p.a_log = (const float*)d_in[4]; p.dt_bias = (const float*)d_in[5]; p.lb_param = (const float*)d_in[6]; p.norm_a = (const float*)d_in[7];
    p.norm_b = (const float*)d_in[8]; p.sinks = (const float*)d_in[9]; p.rel_bias = (const float*)d_in[10]; p.w_branch = (const float*)d_in[11];
    p.w_out = (const float*)d_in[12]; p.final_norm = (const float*)d_in[13];
    p.out = (float*)d_out; p.ws = (unsigned char*)d_ws;
    void* args[] = {&p};
    hipError_t e = hipLaunchCooperativeKernel((const void*)fwd_megakernel, dim3(grid_blocks), dim3(NTHREADS), args, LDS_BYTES, stream);
    if (e != hipSuccess) fprintf(stderr, "cooperative launch failed: %s (grid %d)\n", hipGetErrorString(e), grid_blocks);
}
```

```cpp
#include <hip/hip_runtime.h>
#include <hip/hip_cooperative_groups.h>
#include <cstdio>
#include <cstdint>
namespace cg = cooperative_groups;

typedef unsigned short bf16_t;
typedef short bf16x8 __attribute__((ext_vector_type(8)));
typedef float f32x4 __attribute__((ext_vector_type(4)));
typedef float f32x2 __attribute__((ext_vector_type(2)));
typedef unsigned u32x4 __attribute__((ext_vector_type(4)));
typedef unsigned u32x2 __attribute__((ext_vector_type(2)));
typedef __bf16 bf16x2v __attribute__((ext_vector_type(2)));

constexpr int BATCH = 4, SEQ = 4096, M = BATCH * SEQ, D = 1024, DEPTH = 2;
constexpr int NORIG = 8456;
constexpr int NMIX = 5376;
constexpr int NGATE = 3072;
constexpr int NALL = NMIX + NGATE;
constexpr int LDP = NMIX;
constexpr int PC_AQ = 0, PC_AI = 1024, PC_AG = 1536, PC_BQKV = 2048, PC_BZ = 3584, PC_CQ = 4096, PC_CK = 4608, PC_CV = 4736, PC_CG = 4864;
constexpr float EPS = 1e-6f;
constexpr int NTHREADS = 512;
constexpr int LDS_BYTES = 155648;
#define DIAG_ZERO_C 0
#define DIAG_NAIVE_C 0
#define DIAG_DRYMODE 5
#define DIAG_DRY 1

constexpr size_t WS_P = 0;
constexpr size_t WS_AF = WS_P + (size_t)M * LDP * 2;
constexpr size_t WS_HB = WS_AF + (size_t)M * 512 * 4;
constexpr size_t WS_WIN = WS_HB + (size_t)M * D * 2;
constexpr size_t WS_WB = WS_WIN + (size_t)NALL * D * 2;
constexpr size_t WS_WO = WS_WB + (size_t)D * 1536 * 2;
constexpr size_t WS_SM = WS_WO + (size_t)D * D * 2;
constexpr size_t WS_HALO = WS_SM + (size_t)M * 8 * 4;
constexpr size_t WS_GC = WS_HALO + (size_t)256 * 3 * 1536 * 2;
constexpr size_t WS_DEC = WS_GC + (size_t)M * 4 * 4;
constexpr size_t WS_END = WS_DEC + (size_t)1024 * 128 * 4;

__device__ const unsigned char kBucket[128] = {0, 1, 2, 3, 4, 5, 6, 7, 8, 9, 10, 11, 12, 13, 14, 15, 16, 16, 16, 17, 17, 18, 18, 18, 19, 19, 19, 20, 20, 20, 20, 21, 21, 21, 21, 22, 22, 22, 22, 22, 23, 23, 23, 23, 23, 23, 24, 24, 24, 24, 24, 24, 25, 25, 25, 25, 25, 25, 25, 26, 26, 26, 26, 26, 26, 26, 26, 27, 27, 27, 27, 27, 27, 27, 27, 27, 27, 28, 28, 28, 28, 28, 28, 28, 28, 28, 28, 29, 29, 29, 29, 29, 29, 29, 29, 29, 29, 29, 29, 30, 30, 30, 30, 30, 30, 30, 30, 30, 30, 30, 30, 30, 30, 31, 31, 31, 31, 31, 31, 31, 31, 31, 31, 31, 31, 31, 31, 31};

struct Params {
    const float* x; const float* norm_w; const float* w_in; const float* conv_w; const float* a_log; const float* dt_bias;
    const float* lb_param; const float* norm_a; const float* norm_b; const float* sinks; const float* rel_bias;
    const float* w_branch; const float* w_out; const float* final_norm;
    float* out; unsigned char* ws;
};

__device__ __forceinline__ unsigned f2bf(float f) { unsigned u = __builtin_bit_cast(unsigned, f); return (u + 0x7fffu + ((u >> 16) & 1u)) >> 16; }
__device__ __forceinline__ unsigned pk2(float lo, float hi) { const f32x2 v = {lo, hi}; const bf16x2v b = __builtin_convertvector(v, bf16x2v); return __builtin_bit_cast(unsigned, b); }
__device__ __forceinline__ float bf_lo(unsigned u) { return __builtin_bit_cast(float, u << 16); }
__device__ __forceinline__ float bf_hi(unsigned u) { return __builtin_bit_cast(float, u & 0xffff0000u); }
__device__ __forceinline__ float bf2f(bf16_t b) { return __builtin_bit_cast(float, (unsigned)b << 16); }
__device__ __forceinline__ int tid_() { int t = threadIdx.x; asm volatile("" : "+v"(t)); return t; }
__device__ __forceinline__ int bid_() { int b = blockIdx.x; asm volatile("" : "+s"(b)); return b; }
__device__ __forceinline__ float dot2u(unsigned k, unsigned q, float acc) { return __builtin_amdgcn_fdot2_f32_bf16(__builtin_bit_cast(bf16x2v, k), __builtin_bit_cast(bf16x2v, q), acc, false); }
__device__ __forceinline__ float sigmoidf_(float x) { return __builtin_amdgcn_rcpf(1.0f + __expf(-x)); }
__device__ __forceinline__ float siluf_(float x) { return x * __builtin_amdgcn_rcpf(1.0f + __expf(-x)); }
template <int CTRL> __device__ __forceinline__ float dpp_mov(float x) { return __builtin_bit_cast(float, __builtin_amdgcn_mov_dpp(__builtin_bit_cast(int, x), CTRL, 0xf, 0xf, true)); }
__device__ __forceinline__ float row16_sum(float x) { x += dpp_mov<0xB1>(x); x += dpp_mov<0x4E>(x); x += dpp_mov<0x141>(x); x += dpp_mov<0x128>(x); return x; }
__device__ __forceinline__ float xor16_sum(float x) { auto s = __builtin_amdgcn_permlane16_swap(__float_as_uint(x), __float_as_uint(x), false, false); return __uint_as_float(s[0]) + __uint_as_float(s[1]); }
__device__ __forceinline__ float xor32_sum(float x) { auto s = __builtin_amdgcn_permlane32_swap(__float_as_uint(x), __float_as_uint(x), false, false); return __uint_as_float(s[0]) + __uint_as_float(s[1]); }
__device__ __forceinline__ float wave_sum(float x) { return xor32_sum(xor16_sum(row16_sum(x))); }

__device__ __forceinline__ void transpose_item(const float* W, int ldsrc, int k0, int nsrc0, bf16_t* WT, int ldd, int ndst0, int kdst0, float* scr, int lane) {
#pragma unroll 8
    for (int i = 0; i < 32; ++i) { const int kk = 2 * i + (lane >> 5); scr[kk * 33 + (lane & 31)] = W[(size_t)(k0 + kk) * ldsrc + nsrc0 + (lane & 31)]; }
    __builtin_amdgcn_wave_barrier();
    asm volatile("s_waitcnt lgkmcnt(0)" ::: "memory");
    const int c = lane & 7;
#pragma unroll
    for (int j = 0; j < 4; ++j) { const int n = (lane >> 3) + 8 * j; const float* s = scr + (8 * c) * 33 + n;
        u32x4 o; o.x = pk2(s[0 * 33], s[1 * 33]); o.y = pk2(s[2 * 33], s[3 * 33]); o.z = pk2(s[4 * 33], s[5 * 33]); o.w = pk2(s[6 * 33], s[7 * 33]);
        *(u32x4*)(WT + (size_t)(ndst0 + n) * ldd + kdst0 + k0 + 8 * c) = o; }
    asm volatile("s_waitcnt lgkmcnt(0)" ::: "memory");
    __builtin_amdgcn_wave_barrier();
}
__device__ __forceinline__ void phase_convert_weights(const Params& p, int l, unsigned char* lds) {
    const int tid = tid_(), lane = tid & 63, wave = tid >> 6;
    float* scr = (float*)(lds) + wave * (64 * 33);
    bf16_t* WinT = (bf16_t*)(p.ws + WS_WIN); bf16_t* WbT = (bf16_t*)(p.ws + WS_WB); bf16_t* WoT = (bf16_t*)(p.ws + WS_WO);
    const float* win = p.w_in + (size_t)l * D * NORIG; const float* wbr = p.w_branch + (size_t)l * 3 * 512 * D; const float* wo = p.w_out + (size_t)l * D * D;
    constexpr int I_IN = (D / 64) * (NALL / 32), I_B = (512 / 64) * (D / 32), I_O = (D / 64) * (D / 32);
    constexpr int NITEMS = I_IN + 3 * I_B + I_O;
    const int gw = bid_() * 8 + wave, NGW = gridDim.x * 8;
    for (int it = gw; it < NITEMS; it += NGW) {
        int r = it;
        if (r < I_IN) { const int nb = r % (NALL / 32), kb = r / (NALL / 32); const int n0 = nb * 32; const int ns = n0 < 4096 ? n0 : n0 + 8;
            transpose_item(win, NORIG, kb * 64, ns, WinT, D, n0, 0, scr, lane); continue; }
        r -= I_IN;
        if (r < 3 * I_B) { const int br = r / I_B; const int q = r % I_B; const int nb = q % (D / 32), kb = q / (D / 32);
            transpose_item(wbr + (size_t)br * 512 * D, D, kb * 64, nb * 32, WbT, 1536, nb * 32, br * 512, scr, lane); continue; }
        r -= 3 * I_B;
        { const int nb = r % (D / 32), kb = r / (D / 32); transpose_item(wo, D, kb * 64, nb * 32, WoT, D, nb * 32, 0, scr, lane); }
    }
}

template <int MODE>
__device__ __forceinline__ void phase_rowpass(const Params& p, const float* xin, const float* nw, int l, unsigned char* lds) {
    const int tid = tid_(), lane = tid & 63, wave = tid >> 6;
    float* wsm = (float*)lds;
    if (MODE == 0) {
        const float* win = p.w_in + (size_t)l * D * NORIG;
        for (int i = tid; i < 8 * D; i += NTHREADS) { const int k = i >> 3, e = i & 7; wsm[e * D + k] = win[(size_t)k * NORIG + 4096 + e]; }
        __syncthreads();
    }
    bf16_t* hb = (bf16_t*)(p.ws + WS_HB); float* sm8 = (float*)(p.ws + WS_SM);
    const int gw = bid_() * 8 + wave, NGW = gridDim.x * 8;
    f32x4 wv[4];
#pragma unroll
    for (int j = 0; j < 4; ++j) wv[j] = *(const f32x4*)(nw + 256 * j + 4 * lane);
    for (int m = gw; m < M; m += NGW) {
        const float* xr = xin + (size_t)m * D;
        f32x4 v[4]; float s = 0.f;
#pragma unroll
        for (int j = 0; j < 4; ++j) { v[j] = *(const f32x4*)(xr + 256 * j + 4 * lane); s += (v[j].x * v[j].x + v[j].y * v[j].y) + (v[j].z * v[j].z + v[j].w * v[j].w); }
        const float rstd = 1.0f / sqrtf(wave_sum(s) * (1.0f / D) + EPS);
#pragma unroll
        for (int j = 0; j < 4; ++j) v[j] = v[j] * rstd * wv[j];
        if (MODE == 1) {
            float* orow = p.out + (size_t)m * D;
#pragma unroll
            for (int j = 0; j < 4; ++j) *(f32x4*)(orow + 256 * j + 4 * lane) = v[j];
        } else {
            bf16_t* hr = hb + (size_t)m * D;
#pragma unroll
            for (int j = 0; j < 4; ++j) { u32x2 o; o.x = pk2(v[j].x, v[j].y); o.y = pk2(v[j].z, v[j].w); *(u32x2*)(hr + 256 * j + 4 * lane) = o; }
            float acc8[8];
#pragma unroll
            for (int e = 0; e < 8; ++e) { float a = 0.f;
#pragma unroll
                for (int j = 0; j < 4; ++j) { const f32x4 w4 = *(const f32x4*)(wsm + e * D + 256 * j + 4 * lane); a += (v[j].x * w4.x + v[j].y * w4.y) + (v[j].z * w4.z + v[j].w * w4.w); }
                acc8[e] = wave_sum(a); }
            if (lane == 0) { *(f32x4*)(sm8 + (size_t)m * 8) = (f32x4){acc8[0], acc8[1], acc8[2], acc8[3]}; *(f32x4*)(sm8 + (size_t)m * 8 + 4) = (f32x4){acc8[4], acc8[5], acc8[6], acc8[7]}; }
        }
    }
}

namespace pg8 {
#define PG8_LAS __attribute__((address_space(3)))
constexpr int BM = 256, BK = 64, HALF = 128, HTB = HALF * BK * 2  , STAGE_BYTES = 8 * HTB, NXCD = 8, WGM = 8;

__host__ __device__ __forceinline__ int lds_byte(int r, int c) { const int st = (r >> 4) * 2 + (c >> 5), rr = r & 15, cc = c & 31, ob = rr * 64 + cc * 2; return st * 1024 + (ob ^ (((ob >> 9) & 1) << 5)); }
__host__ __device__ __forceinline__ void stage_rc(int b, int& R, int& C) { const int st = b / 1024, sb = b % 1024, swz = sb ^ (((sb >> 9) & 1) << 5); R = (st >> 1) * 16 + swz / 64; C = (st & 1) * 32 + (swz % 64) / 2; }
__host__ __device__ __forceinline__ int perm32(int rho) { const int n = rho >> 4, i = rho & 15; return 8 * (i >> 2) + 4 * n + (i & 3); }

struct Unit { int pm, pn, kb; };
struct Gemm { const bf16_t* A; const bf16_t* Bt; int lda, ldb, K; };
struct SegNone { static __device__ __forceinline__ int a(int) { return 0; } static __device__ __forceinline__ int b(int) { return 0; } };
struct StaticOrder {
    int nM, nN, nwg, G, c, nseg;
    __device__ void init(int M_, int N_, int G_, int c_, int nseg_) { nM = M_ / BM; nN = N_ / BM; nwg = nM * nN; G = G_; c = c_; nseg = nseg_; }
    __device__ bool next(int i, Unit& u) const {
        const int it = i / nseg; u.kb = i - it * nseg;
        const long L = (long)it * G + c; if (L >= nwg) return false;
        int wgid = (int)L; { const int q = nwg / NXCD, r = nwg % NXCD, xcd = wgid % NXCD, off = wgid / NXCD; wgid = (xcd < r ? xcd * (q + 1) : r * (q + 1) + (xcd - r) * q) + off; }
        const int nig = WGM * nN, gid = wgid / nig, fm = gid * WGM, gsz = (nM - fm) < WGM ? (nM - fm) : WGM;
        u.pm = fm + ((wgid % nig) % gsz); u.pn = (wgid % nig) / gsz; return true;
    }
};
__device__ __forceinline__ unsigned cvt_pk_bf16(float lo, float hi) { unsigned r; asm volatile("v_cvt_pk_bf16_f32 %0, %1, %2" : "=v"(r) : "v"(lo), "v"(hi)); return r; }
template <class Epi, class Sched, class Seg, bool ALIGN_EPI = false, bool SP2 = false>
__device__ __forceinline__ void gemm_phase(PG8_LAS unsigned char* lds, const Gemm g, const Sched& S, const Epi& E) {
    const int tid = tid_(), wid = __builtin_amdgcn_readfirstlane(tid >> 6), lane = tid & 63, wr = wid >> 2, wc = wid & 3, fr = lane & 15, fq = lane >> 4;
    const int K = g.K, nt = K / BK;
    unsigned voffA[2], voffB[2];
#pragma unroll
    for (int i = 0; i < 2; ++i) { int R, C; stage_rc(tid * 16 + i * 8192, R, C); const int Rb = Epi::PERM ? ((R & ~31) + perm32(R & 31)) : R;
        voffA[i] = (unsigned)(R * g.lda + C) * 2u; voffB[i] = (unsigned)(Rb * g.ldb + C) * 2u; }
    const size_t kstep = (size_t)(BK * 2);
    const size_t hstepA = (size_t)HALF * g.lda * 2, hstepB = (size_t)HALF * g.ldb * 2;
    const size_t tstepA = 2 * hstepA, tstepB = 2 * hstepB;
    const unsigned ldsw = (unsigned)wid * 1024u;
    const int aoff = lds_byte(wr * 64 + fr, fq * 8), boff = lds_byte(wc * 32 + fr, fq * 8);
#define PG8_SA(b, h) (((b) * 2 + (h)) * HTB)
#define PG8_SB(b, h) ((4 + (b) * 2 + (h)) * HTB)
#define PG8_STAGE(bufoff, gbase, voff) do { _Pragma("unroll") for (int _i = 0; _i < 2; ++_i) \
        __builtin_amdgcn_global_load_lds((const unsigned*)((const char*)(gbase) + (voff)[_i]), (PG8_LAS unsigned*)(lds + (bufoff) + ldsw + _i * 8192), 16, 0, 0); } while (0)
#define PG8_LDA(dst, b, h) do { _Pragma("unroll") for (int m = 0; m < 4; ++m) _Pragma("unroll") for (int k = 0; k < 2; ++k) dst[m][k] = *(const PG8_LAS bf16x8*)(lds + PG8_SA(b, h) + aoff + m * 2048 + k * 1024); } while (0)
#define PG8_LDB(dst, b, h) do { _Pragma("unroll") for (int n = 0; n < 2; ++n) _Pragma("unroll") for (int k = 0; k < 2; ++k) dst[n][k] = *(const PG8_LAS bf16x8*)(lds + PG8_SB(b, h) + boff + n * 2048 + k * 1024); } while (0)
#define PG8_MMA(ai, bj, At, Bt) do { __builtin_amdgcn_s_setprio(1); _Pragma("unroll") for (int m = 0; m < 4; ++m) _Pragma("unroll") for (int n = 0; n < 2; ++n) _Pragma("unroll") for (int k = 0; k < 2; ++k) \
        acc[ai][bj][m][n] = __builtin_amdgcn_mfma_f32_16x16x32_bf16(Bt[n][k], At[m][k], acc[ai][bj][m][n], 0, 0, 0); __builtin_amdgcn_s_setprio(0); } while (0)
#define PG8_WAIT_V(n) asm volatile("s_waitcnt vmcnt(" #n ")" ::: "memory")
#define PG8_WAIT_L(n) asm volatile("s_waitcnt lgkmcnt(" #n ")" ::: "memory")
#define PG8_BAR __builtin_amdgcn_s_barrier()
#define PG8_SCHED __builtin_amdgcn_sched_barrier(0)
    Unit cur, nxt; int ui = 0;
    if (!S.next(0, cur)) return;
    f32x4 acc[2][2][4][2];
#pragma unroll
    for (int a = 0; a < 2; ++a)
#pragma unroll
        for (int b = 0; b < 2; ++b)
#pragma unroll
            for (int m = 0; m < 4; ++m)
#pragma unroll
                for (int n = 0; n < 2; ++n) acc[a][b][m][n] = (f32x4){0.f, 0.f, 0.f, 0.f};
    bf16x8 At[4][2], B0[2][2], B1[2][2];
    const char* cA = (const char*)g.A + (size_t)cur.pm * tstepA + (size_t)Seg::a(cur.kb) * 2; const char* cB = (const char*)g.Bt + (size_t)cur.pn * tstepB + (size_t)Seg::b(cur.kb) * 2;

    if constexpr (SP2) {
        PG8_STAGE(PG8_SB(0, 0), cB, voffB); PG8_STAGE(PG8_SB(0, 1), cB + hstepB, voffB); PG8_STAGE(PG8_SA(0, 0), cA, voffA); PG8_STAGE(PG8_SA(0, 1), cA + hstepA, voffA);
        if (wr == 1) PG8_BAR;
        PG8_WAIT_V(2); PG8_BAR;
        PG8_STAGE(PG8_SB(1, 0), cB + kstep, voffB); PG8_STAGE(PG8_SA(1, 0), cA + kstep, voffA); PG8_STAGE(PG8_SB(1, 1), cB + hstepB + kstep, voffB);
        PG8_WAIT_V(6); PG8_BAR;
    } else {
        PG8_STAGE(PG8_SB(0, 0), cB, voffB); PG8_STAGE(PG8_SA(0, 0), cA, voffA); PG8_STAGE(PG8_SB(0, 1), cB + hstepB, voffB); PG8_STAGE(PG8_SA(0, 1), cA + hstepA, voffA);
        if (wr == 1) PG8_BAR;
        PG8_WAIT_V(4); PG8_BAR;
        PG8_STAGE(PG8_SB(1, 0), cB + kstep, voffB); PG8_STAGE(PG8_SA(1, 0), cA + kstep, voffA); PG8_STAGE(PG8_SB(1, 1), cB + hstepB + kstep, voffB);
        PG8_WAIT_V(6); PG8_BAR;
    }
    for (;;) {
        const bool has_next = S.next(ui + 1, nxt);
        const char* nA = has_next ? (const char*)g.A + (size_t)nxt.pm * tstepA + (size_t)Seg::a(nxt.kb) * 2 : cA; const char* nB = has_next ? (const char*)g.Bt + (size_t)nxt.pn * tstepB + (size_t)Seg::b(nxt.kb) * 2 : cB;
        for (int t = 0; t < nt; t += 2) {
            const bool last = (t == nt - 2);
            const char* a1 = cA + (size_t)(t + 1) * kstep;
            const char* a2 = last ? nA : cA + (size_t)(t + 2) * kstep; const char* b2 = last ? nB : cB + (size_t)(t + 2) * kstep;
            const char* a3 = a2 + kstep; const char* b3 = b2 + kstep;

            if constexpr (SP2) {
            PG8_LDB(B0, 0, 0); PG8_LDB(B1, 0, 1); PG8_SCHED; PG8_LDA(At, 0, 0); PG8_STAGE(PG8_SA(1, 1), a1 + hstepA, voffA);
            PG8_WAIT_V(8); PG8_WAIT_L(0); PG8_BAR; PG8_MMA(0, 0, At, B0); PG8_MMA(0, 1, At, B1); PG8_BAR; PG8_SCHED;
            PG8_LDA(At, 0, 1); PG8_STAGE(PG8_SB(0, 0), b2, voffB); PG8_STAGE(PG8_SB(0, 1), b2 + hstepB, voffB); PG8_STAGE(PG8_SA(0, 0), a2, voffA);
            PG8_WAIT_V(8); PG8_WAIT_L(0); PG8_BAR; PG8_MMA(1, 0, At, B0); PG8_MMA(1, 1, At, B1); PG8_BAR; PG8_SCHED;
            PG8_LDB(B0, 1, 0); PG8_LDB(B1, 1, 1); PG8_SCHED; PG8_LDA(At, 1, 0); PG8_STAGE(PG8_SA(0, 1), a2 + hstepA, voffA);
            PG8_WAIT_V(8); PG8_WAIT_L(0); PG8_BAR; PG8_MMA(0, 0, At, B0); PG8_MMA(0, 1, At, B1); PG8_BAR; PG8_SCHED;
            PG8_LDA(At, 1, 1); PG8_STAGE(PG8_SB(1, 0), b3, voffB); PG8_STAGE(PG8_SB(1, 1), b3 + hstepB, voffB); PG8_STAGE(PG8_SA(1, 0), a3, voffA);
            PG8_WAIT_V(8); PG8_WAIT_L(0); PG8_BAR; PG8_MMA(1, 0, At, B0); PG8_MMA(1, 1, At, B1); PG8_BAR; PG8_SCHED;
            } else {
            PG8_LDB(B0, 0, 0); PG8_SCHED; PG8_LDA(At, 0, 0); PG8_STAGE(PG8_SA(1, 1), a1 + hstepA, voffA);
            PG8_WAIT_L(8); PG8_BAR; PG8_WAIT_L(0); PG8_MMA(0, 0, At, B0); PG8_BAR; PG8_SCHED;
            PG8_LDB(B1, 0, 1); PG8_STAGE(PG8_SB(0, 0), b2, voffB);
            PG8_BAR; PG8_WAIT_L(0); PG8_MMA(0, 1, At, B1); PG8_BAR;
            PG8_LDA(At, 0, 1); PG8_STAGE(PG8_SA(0, 0), a2, voffA);
            PG8_BAR; PG8_WAIT_L(0); PG8_MMA(1, 0, At, B0); PG8_BAR; PG8_SCHED;
            PG8_STAGE(PG8_SB(0, 1), b2 + hstepB, voffB);
            PG8_WAIT_V(6); PG8_BAR; PG8_MMA(1, 1, At, B1); PG8_BAR;
            PG8_LDB(B0, 1, 0); PG8_SCHED; PG8_LDA(At, 1, 0); PG8_STAGE(PG8_SA(0, 1), a2 + hstepA, voffA);
            PG8_WAIT_L(8); PG8_BAR; PG8_WAIT_L(0); PG8_MMA(0, 0, At, B0); PG8_BAR; PG8_SCHED;
            PG8_LDB(B1, 1, 1); PG8_STAGE(PG8_SB(1, 0), b3, voffB);
            PG8_BAR; PG8_WAIT_L(0); PG8_MMA(0, 1, At, B1); PG8_BAR;
            PG8_LDA(At, 1, 1); PG8_STAGE(PG8_SA(1, 0), a3, voffA);
            PG8_BAR; PG8_WAIT_L(0); PG8_MMA(1, 0, At, B0); PG8_BAR; PG8_SCHED;
            PG8_STAGE(PG8_SB(1, 1), b3 + hstepB, voffB);
            PG8_WAIT_V(6); PG8_BAR; PG8_MMA(1, 1, At, B1); PG8_BAR;
            }
        }
        if constexpr (ALIGN_EPI) { if (wr == 0) PG8_BAR; }
        const bool keep_acc = E(acc, cur, wr, wc, fr, fq);
        if (!has_next) break;
        if (!keep_acc) {
#pragma unroll
        for (int a = 0; a < 2; ++a)
#pragma unroll
            for (int b = 0; b < 2; ++b)
#pragma unroll
                for (int m = 0; m < 4; ++m)
#pragma unroll
                    for (int n = 0; n < 2; ++n) acc[a][b][m][n] = (f32x4){0.f, 0.f, 0.f, 0.f};
        }
        cur = nxt; cA = nA; cB = nB; ++ui;
        if constexpr (ALIGN_EPI) { if (wr == 1) PG8_BAR; }
    }
    PG8_WAIT_V(0);
    if constexpr (!ALIGN_EPI) { if (wr == 0) PG8_BAR; }
    PG8_BAR;
#undef PG8_SA
#undef PG8_SB
#undef PG8_STAGE
#undef PG8_LDA
#undef PG8_LDB
#undef PG8_MMA
#undef PG8_WAIT_V
#undef PG8_WAIT_L
#undef PG8_BAR
#undef PG8_SCHED
}
}

__device__ __forceinline__ bf16_t* gate_ptr(unsigned char* ws, int br, size_t row, int d) {
    if (br == 0) return (bf16_t*)(ws + WS_P) + row * LDP + d;
    if (br == 1) return (bf16_t*)(ws + WS_P) + row * LDP + 2048 + d;
    return (bf16_t*)(ws + WS_AF) + row * 1024 + d;
}
typedef f32x4 acc_t[2][2][4][2];
struct EpiInproj {
    static constexpr bool PERM = true;
    unsigned char* ws; const float* lb_param; int l;
    __device__ __forceinline__ bool operator()(acc_t& acc, const pg8::Unit& u, int wr, int wc, int fr, int fq) const {
        bf16_t* P = (bf16_t*)(ws + WS_P); float* AF = (float*)(ws + WS_AF);
        const int row0 = u.pm * 256 + wr * 64 + fr, col0 = u.pn * 256 + wc * 32 + 8 * fq;
        const int pn = u.pn;
        if (pn == 2 || pn == 3) {
            float lb[2][8];
#pragma unroll
            for (int bj = 0; bj < 2; ++bj)
#pragma unroll
                for (int e = 0; e < 8; ++e) { float v = 0.f; if (l == 1) { const int k = col0 + bj * 128 - 512 + e; v = 1.0f / (1.0f + __expf(lb_param[k] - lb_param[512 + k])); } lb[bj][e] = v; }
#pragma unroll
            for (int ai = 0; ai < 2; ++ai)
#pragma unroll
                for (int m = 0; m < 4; ++m) { float* rowp = AF + (size_t)(row0 + ai * 128 + m * 16) * 512 + (col0 - 512);
#pragma unroll
                    for (int bj = 0; bj < 2; ++bj) { const f32x4 v0 = acc[ai][bj][m][0], v1 = acc[ai][bj][m][1]; f32x4 o0, o1;
#pragma unroll
                        for (int e = 0; e < 4; ++e) { o0[e] = lb[bj][e] + (1.0f - lb[bj][e]) * sigmoidf_(v0[e]); o1[e] = lb[bj][4 + e] + (1.0f - lb[bj][4 + e]) * sigmoidf_(v1[e]); }
                        *(f32x4*)(rowp + bj * 128) = o0; *(f32x4*)(rowp + bj * 128 + 4) = o1; } }
        } else {
            const int act = pn < 2 ? 1 : ((pn == 16 || pn == 17) ? 2 : 0);
#pragma unroll
            for (int ai = 0; ai < 2; ++ai)
#pragma unroll
                for (int m = 0; m < 4; ++m) { bf16_t* rowp = P + (size_t)(row0 + ai * 128 + m * 16) * LDP + col0;
#pragma unroll
                    for (int bj = 0; bj < 2; ++bj) { f32x4 v0 = acc[ai][bj][m][0], v1 = acc[ai][bj][m][1];
                        if (act == 1) {
#pragma unroll
                            for (int e = 0; e < 4; ++e) { v0[e] = siluf_(v0[e]); v1[e] = siluf_(v1[e]); } }
                        else if (act == 2) { v0 = v0 * 0.125f; v1 = v1 * 0.125f; }
                        u32x4 w; w.x = pk2(v0[0], v0[1]); w.y = pk2(v0[2], v0[3]); w.z = pk2(v1[0], v1[1]); w.w = pk2(v1[2], v1[3]);
                        *(u32x4*)(rowp + bj * 128) = w;
                        if (pn >= 8 && pn < 14) { const int row = row0 + ai * 128 + m * 16, tc = row & 63;
                            if (tc >= 61) *(u32x4*)((bf16_t*)(ws + WS_HALO) + ((size_t)(row >> 6) * 3 + (tc - 61)) * 1536 + (col0 + bj * 128 - PC_BQKV)) = w; } } }
        }
        return false;
    }
};
struct EpiGates {
    static constexpr bool PERM = true;
    unsigned char* ws;
    __device__ __forceinline__ bool operator()(acc_t& acc, const pg8::Unit& u, int wr, int wc, int fr, int fq) const {
        const int row0 = u.pm * 256 + wr * 64 + fr, br = u.pn >> 2, d0 = (u.pn & 3) * 256 + wc * 32 + 8 * fq;
#pragma unroll
        for (int ai = 0; ai < 2; ++ai)
#pragma unroll
            for (int m = 0; m < 4; ++m) { bf16_t* rowp = gate_ptr(ws, br, (size_t)(row0 + ai * 128 + m * 16), d0);
#pragma unroll
                for (int bj = 0; bj < 2; ++bj) { const f32x4 v0 = acc[ai][bj][m][0], v1 = acc[ai][bj][m][1];
                    u32x4 w; w.x = pk2(sigmoidf_(v0[0]), sigmoidf_(v0[1])); w.y = pk2(sigmoidf_(v0[2]), sigmoidf_(v0[3])); w.z = pk2(sigmoidf_(v1[0]), sigmoidf_(v1[1])); w.w = pk2(sigmoidf_(v1[2]), sigmoidf_(v1[3]));
                    *(u32x4*)(rowp + bj * 128) = w; } }
        return false;
    }
};
struct EpiLift {
    static constexpr bool PERM = true;
    unsigned char* ws;
    __device__ __forceinline__ bool operator()(acc_t& acc, const pg8::Unit& u, int wr, int wc, int fr, int fq) const {
        bf16_t* MG = (bf16_t*)(ws + WS_HB);
        const int row0 = u.pm * 256 + wr * 64 + fr, d0 = u.pn * 256 + wc * 32 + 8 * fq, s = u.kb;
#pragma unroll
        for (int ai = 0; ai < 2; ++ai)
#pragma unroll
            for (int m = 0; m < 4; ++m) { const size_t row = (size_t)(row0 + ai * 128 + m * 16);
#pragma unroll
                for (int bj = 0; bj < 2; ++bj) {
                    const u32x4 ga = *(const u32x4*)gate_ptr(ws, s, row, d0 + bj * 128);
                    f32x4 fa = (f32x4){bf_lo(ga.x), bf_hi(ga.x), bf_lo(ga.y), bf_hi(ga.y)}, fb = (f32x4){bf_lo(ga.z), bf_hi(ga.z), bf_lo(ga.w), bf_hi(ga.w)};
                    if (s < 2) { const u32x4 gb = *(const u32x4*)gate_ptr(ws, s + 1, row, d0 + bj * 128);
                        fa[0] *= __builtin_amdgcn_rcpf(fmaxf(bf_lo(gb.x), 1e-30f)); fa[1] *= __builtin_amdgcn_rcpf(fmaxf(bf_hi(gb.x), 1e-30f));
                        fa[2] *= __builtin_amdgcn_rcpf(fmaxf(bf_lo(gb.y), 1e-30f)); fa[3] *= __builtin_amdgcn_rcpf(fmaxf(bf_hi(gb.y), 1e-30f));
                        fb[0] *= __builtin_amdgcn_rcpf(fmaxf(bf_lo(gb.z), 1e-30f)); fb[1] *= __builtin_amdgcn_rcpf(fmaxf(bf_hi(gb.z), 1e-30f));
                        fb[2] *= __builtin_amdgcn_rcpf(fmaxf(bf_lo(gb.w), 1e-30f)); fb[3] *= __builtin_amdgcn_rcpf(fmaxf(bf_hi(gb.w), 1e-30f)); }
                    const f32x4 v0 = acc[ai][bj][m][0] * fa, v1 = acc[ai][bj][m][1] * fb;
                    acc[ai][bj][m][0] = v0; acc[ai][bj][m][1] = v1;
                    if (s == 2) { u32x4 w; w.x = pk2(v0[0], v0[1]); w.y = pk2(v0[2], v0[3]); w.z = pk2(v1[0], v1[1]); w.w = pk2(v1[2], v1[3]);
                        *(u32x4*)(MG + row * D + d0 + bj * 128) = w; }
                }
                asm volatile("" ::: "memory");
            }
        return s < 2;
    }
};
struct EpiOut {
    static constexpr bool PERM = false;
    const float* xin; float* out;
    __device__ __forceinline__ bool operator()(acc_t& acc, const pg8::Unit& u, int wr, int wc, int fr, int fq) const {
        const int row0 = u.pm * 256 + wr * 64 + fr, col0 = u.pn * 256 + wc * 32 + 4 * fq;
#pragma unroll
        for (int ai = 0; ai < 2; ++ai)
#pragma unroll
            for (int m = 0; m < 4; ++m) { const size_t off = (size_t)(row0 + ai * 128 + m * 16) * D + col0;
#pragma unroll
                for (int bj = 0; bj < 2; ++bj)
#pragma unroll
                    for (int n = 0; n < 2; ++n) { const f32x4 xv = *(const f32x4*)(xin + off + bj * 128 + n * 16); *(f32x4*)(out + off + bj * 128 + n * 16) = xv + acc[ai][bj][m][n]; }
                asm volatile("" ::: "memory"); }
        return false;
    }
};
struct SegLift { static __device__ __forceinline__ int a(int s) { return PC_AG + (s >= 1 ? PC_BZ - PC_AG : 0) + (s >= 2 ? PC_CG - PC_BZ : 0); } static __device__ __forceinline__ int b(int s) { return s * 512; } };
__device__ __forceinline__ void phase_inproj(const Params& p, int l, unsigned char* lds) {
    pg8::Gemm g{(const bf16_t*)(p.ws + WS_HB), (const bf16_t*)(p.ws + WS_WIN), D, D, D};
    pg8::StaticOrder S; S.init(M, NMIX, (int)gridDim.x, bid_(), 1);
    EpiInproj E{p.ws, p.lb_param, l};
    pg8::gemm_phase<EpiInproj, pg8::StaticOrder, pg8::SegNone, true, true>((PG8_LAS unsigned char*)lds, g, S, E);
}
__device__ __forceinline__ void phase_gates(const Params& p, unsigned char* lds) {
    pg8::Gemm g{(const bf16_t*)(p.ws + WS_HB), (const bf16_t*)(p.ws + WS_WIN) + (size_t)NMIX * D, D, D, D};
    pg8::StaticOrder S; S.init(M, NGATE, (int)gridDim.x, bid_(), 1);
    EpiGates E{p.ws};
    pg8::gemm_phase<EpiGates, pg8::StaticOrder, pg8::SegNone, true, true>((PG8_LAS unsigned char*)lds, g, S, E);
}
__device__ __forceinline__ void phase_lift(const Params& p, unsigned char* lds) {
    pg8::Gemm g{(const bf16_t*)(p.ws + WS_P), (const bf16_t*)(p.ws + WS_WB), LDP, 1536, 512};
    pg8::StaticOrder S; S.init(M, D, (int)gridDim.x, bid_(), 3);
    EpiLift E{p.ws};
    pg8::gemm_phase<EpiLift, pg8::StaticOrder, SegLift, false, true>((PG8_LAS unsigned char*)lds, g, S, E);
}
__device__ __forceinline__ void phase_outproj(const Params& p, const float* xin, unsigned char* lds) {
    pg8::Gemm g{(const bf16_t*)(p.ws + WS_HB), (const bf16_t*)(p.ws + WS_WO), D, D, D};
    pg8::StaticOrder S; S.init(M, D, (int)gridDim.x, bid_(), 1);
    EpiOut E{xin, p.out};
    pg8::gemm_phase<EpiOut, pg8::StaticOrder, pg8::SegNone, false, true>((PG8_LAS unsigned char*)lds, g, S, E);
}

constexpr int A_TB = 16;
__device__ __forceinline__ void mixer_a(const Params& p, int bh, int vs, unsigned char* lds, int dry) {
    const int tid = tid_(), lane = tid & 63, wave = tid >> 6, r = lane >> 4, i = lane & 15;
    const int b = bh >> 2, h = bh & 3;
    bf16_t* P = (bf16_t*)(p.ws + WS_P); const float* AF = (const float*)(p.ws + WS_AF);
    constexpr int BUF = 8192 + 8192 + 2048;
    float* obuf = (float*)(lds + 2 * BUF);
    const size_t row0 = (size_t)b * SEQ;
    const int fr_row = tid >> 5, fr_c4 = (tid & 31) * 4;
    const int q_row = tid >> 5, q_c4 = (tid & 31) * 4;
    const int i_row = (tid >> 3) & 15, i_c4 = (tid & 7) * 4;
    f32x4 pf; u32x2 pq; u32x2 pi;
    auto gload = [&](int t0) {
        pf = *(const f32x4*)(AF + (row0 + t0 + fr_row) * 512 + h * 128 + fr_c4);
        pq = *(const u32x2*)(P + (row0 + t0 + q_row) * LDP + PC_AQ + h * 128 + q_c4);
        if (tid < 128) pi = *(const u32x2*)(P + (row0 + t0 + i_row) * LDP + PC_AI + h * 128 + vs * 32 + i_c4);
    };
    auto lstore = [&](int bufi) {
        float* fb = (float*)(lds + bufi * BUF); float* qb = fb + 2048; float* ib = qb + 2048;
        *(f32x4*)(fb + fr_row * 128 + fr_c4) = pf;
        *(f32x4*)(qb + q_row * 128 + q_c4) = (f32x4){bf_lo(pq.x), bf_hi(pq.x), bf_lo(pq.y), bf_hi(pq.y)};
        if (tid < 128) *(f32x4*)(ib + i_row * 32 + i_c4) = (f32x4){bf_lo(pi.x), bf_hi(pi.x), bf_lo(pi.y), bf_hi(pi.y)};
    };
    float S[8];
#pragma unroll
    for (int j = 0; j < 8; ++j) S[j] = 0.f;
    gload(0); lstore(0); __syncthreads();
    constexpr int NB = SEQ / A_TB;
    for (int bt = 0; bt < NB; ++bt) {
        const int cur = bt & 1;
        if (bt + 1 < NB) gload((bt + 1) * A_TB);
        const float* fb = (const float*)(lds + cur * BUF); const float* qb = fb + 2048; const float* ib = qb + 2048;
#pragma unroll 4
        for (int t = 0; t < A_TB; ++t) {
            const f32x4 f0 = *(const f32x4*)(fb + t * 128 + 8 * i), f1 = *(const f32x4*)(fb + t * 128 + 8 * i + 4);
            const f32x4 q0 = *(const f32x4*)(qb + t * 128 + 8 * i), q1 = *(const f32x4*)(qb + t * 128 + 8 * i + 4);
            const float iv = ib[t * 32 + wave * 4 + r];
            float pa = 0.f, pb = 0.f;
            S[0] = iv + f0[0] * (S[0] - iv); pa += q0[0] * S[0];
            S[1] = iv + f0[1] * (S[1] - iv); pb += q0[1] * S[1];
            S[2] = iv + f0[2] * (S[2] - iv); pa += q0[2] * S[2];
            S[3] = iv + f0[3] * (S[3] - iv); pb += q0[3] * S[3];
            S[4] = iv + f1[0] * (S[4] - iv); pa += q1[0] * S[4];
            S[5] = iv + f1[1] * (S[5] - iv); pb += q1[1] * S[5];
            S[6] = iv + f1[2] * (S[6] - iv); pa += q1[2] * S[6];
            S[7] = iv + f1[3] * (S[7] - iv); pb += q1[3] * S[7];
            const float o = row16_sum(pa + pb);
            if (i == 0) obuf[t * 32 + wave * 4 + r] = o;
        }
        __syncthreads();
        if (!dry) { const int t = tid >> 5, v = tid & 31; P[(row0 + bt * A_TB + t) * LDP + PC_AI + h * 128 + vs * 32 + v] = (bf16_t)f2bf(obuf[t * 32 + v]); }
        if (bt + 1 < NB) lstore(cur ^ 1);
        __syncthreads();
    }
}

constexpr int B_TB = 16;
__device__ __forceinline__ void mixer_b(const Params& p, int l, int bh, int vs, unsigned char* lds, int dry) {
    const int tid = tid_(), lane = tid & 63, wave = tid >> 6, r = lane >> 5, i = lane & 31;
    const int b = bh >> 2, h = bh & 3;
    bf16_t* P = (bf16_t*)(p.ws + WS_P); const float* sm8 = (const float*)(p.ws + WS_SM);
    const float* cw = p.conv_w + (size_t)l * 4 * 1536;
    constexpr int RAWC = 272;
    float* raw = (float*)lds;
    float* qk = (float*)(lds + 20736);
    float* vv = (float*)(lds + 20736 + 16384);
    float* sc = (float*)(lds + 20736 + 16384 + 1024);
    float* obuf = (float*)(lds + 20736 + 16384 + 1024 + 256);
    const size_t row0 = (size_t)b * SEQ;
    const float a_coef = -__expf(p.a_log[l * 4 + h]); const float dtb = p.dt_bias[l * 4 + h];
    const int cqk = tid & 255; const int chq = cqk < 128 ? h * 128 + cqk : 512 + h * 128 + (cqk - 128);
    float wq[4]; float wvv[4];
#pragma unroll
    for (int j = 0; j < 4; ++j) { wq[j] = cw[j * 1536 + chq]; wvv[j] = cw[j * 1536 + 1024 + h * 128 + vs * 16 + (tid & 15)]; }
    for (int e = tid; e < 3 * RAWC; e += NTHREADS) raw[e] = 0.f;
    float S[4] = {0.f, 0.f, 0.f, 0.f};
    u32x4 st0, st1;
    auto chunk_addr = [&](int t0, int ck) -> const bf16_t* {
        const int row = ck / 34, c8 = ck % 34; const int ch = c8 < 16 ? h * 128 + c8 * 8 : (c8 < 32 ? 512 + h * 128 + (c8 - 16) * 8 : 1024 + h * 128 + vs * 16 + (c8 - 32) * 8);
        return P + (row0 + t0 + row) * LDP + PC_BQKV + ch; };
    auto gload = [&](int t0) { st0 = *(const u32x4*)chunk_addr(t0, tid); if (tid < 32) st1 = *(const u32x4*)chunk_addr(t0, 512 + tid); };
    auto rstore = [&]() {
        { const int row = tid / 34, c8 = tid % 34; float* d = raw + (3 + row) * RAWC + c8 * 8;
          *(f32x4*)d = (f32x4){bf_lo(st0.x), bf_hi(st0.x), bf_lo(st0.y), bf_hi(st0.y)}; *(f32x4*)(d + 4) = (f32x4){bf_lo(st0.z), bf_hi(st0.z), bf_lo(st0.w), bf_hi(st0.w)}; }
        if (tid < 32) { const int ck = 512 + tid; const int row = ck / 34, c8 = ck % 34; float* d = raw + (3 + row) * RAWC + c8 * 8;
          *(f32x4*)d = (f32x4){bf_lo(st1.x), bf_hi(st1.x), bf_lo(st1.y), bf_hi(st1.y)}; *(f32x4*)(d + 4) = (f32x4){bf_lo(st1.z), bf_hi(st1.z), bf_lo(st1.w), bf_hi(st1.w)}; }
    };
    gload(0);
    constexpr int NB = SEQ / B_TB;
    for (int bt = 0; bt < NB; ++bt) {
        const int t0 = bt * B_TB;
        __syncthreads();
        rstore();
        if (bt + 1 < NB) gload(t0 + B_TB);
        __syncthreads();
        {
            const int tb = (tid >> 8) * 8;
#pragma unroll
            for (int tt = 0; tt < 8; ++tt) { const int t = tb + tt;
                const float x = raw[(t + 0) * RAWC + cqk] * wq[0] + raw[(t + 1) * RAWC + cqk] * wq[1] + raw[(t + 2) * RAWC + cqk] * wq[2] + raw[(t + 3) * RAWC + cqk] * wq[3];
                qk[t * 256 + cqk] = siluf_(x); }
            if (tid < 256) { const int t = tid >> 4, c = tid & 15;
                const float x = raw[(t + 0) * RAWC + 256 + c] * wvv[0] + raw[(t + 1) * RAWC + 256 + c] * wvv[1] + raw[(t + 2) * RAWC + 256 + c] * wvv[2] + raw[(t + 3) * RAWC + 256 + c] * wvv[3];
                vv[t * 16 + c] = siluf_(x); }
            if (tid < 16) { const f32x4 lo = *(const f32x4*)(sm8 + (row0 + t0 + tid) * 8), hi = *(const f32x4*)(sm8 + (row0 + t0 + tid) * 8 + 4);
                const float bl = lo[h], al = hi[h]; const float xx = al + dtb; const float sp = xx > 20.f ? xx : log1pf(__expf(xx));
                sc[tid * 4 + 0] = __expf(a_coef * sp); sc[tid * 4 + 1] = sigmoidf_(bl); }
        }
        __syncthreads();
        {
            const int vec = tid >> 4, sub = tid & 15; const int t = vec >> 1, which = vec & 1;
            float* src = qk + t * 256 + which * 128 + sub * 8;
            f32x4 a0 = *(f32x4*)src, a1 = *(f32x4*)(src + 4);
            float ss = (a0[0] * a0[0] + a0[1] * a0[1]) + (a0[2] * a0[2] + a0[3] * a0[3]) + (a1[0] * a1[0] + a1[1] * a1[1]) + (a1[2] * a1[2] + a1[3] * a1[3]);
            ss = row16_sum(ss);
            float sc_ = 1.0f / sqrtf(ss + EPS); if (which == 0) sc_ *= 0.08838834764831845f;
            a0 = a0 * sc_; a1 = a1 * sc_;
            *(f32x4*)src = a0; *(f32x4*)(src + 4) = a1;
        }
        __syncthreads();
        if (tid < 256) { const int t = tid >> 4, sub = tid & 15; const float* qs = qk + t * 256 + sub * 8; const float* ks = qs + 128;
            float d = 0.f;
#pragma unroll
            for (int e = 0; e < 8; ++e) d += qs[e] * ks[e];
            d = row16_sum(d); if (sub == 0) sc[t * 4 + 2] = d; }
        __syncthreads();
#pragma unroll 2
        for (int t = 0; t < B_TB; ++t) {
            const f32x4 q4 = *(const f32x4*)(qk + t * 256 + 4 * i), k4 = *(const f32x4*)(qk + t * 256 + 128 + 4 * i);
            const f32x4 s4 = *(const f32x4*)(sc + t * 4); const float vt = vv[t * 16 + wave * 2 + r];
            const float alpha = s4[0], beta = s4[1], qkd = s4[2];
            float rk = (S[0] * k4[0] + S[1] * k4[1]) + (S[2] * k4[2] + S[3] * k4[3]);
            float rq = (S[0] * q4[0] + S[1] * q4[1]) + (S[2] * q4[2] + S[3] * q4[3]);
            rk = xor16_sum(row16_sum(rk)); rq = xor16_sum(row16_sum(rq));
            const float vn = beta * (vt - alpha * rk);
            const float o = alpha * rq + qkd * vn;
            S[0] = alpha * S[0] + k4[0] * vn; S[1] = alpha * S[1] + k4[1] * vn; S[2] = alpha * S[2] + k4[2] * vn; S[3] = alpha * S[3] + k4[3] * vn;
            if (i == 0) obuf[t * 16 + wave * 2 + r] = o;
        }
        __syncthreads();
        if (tid < 256 && !dry) { const int t = tid >> 4, c = tid & 15; P[(row0 + t0 + t) * LDP + PC_BQKV + 1024 + h * 128 + vs * 16 + c] = (bf16_t)f2bf(obuf[t * 16 + c]); }
        float hv0 = 0.f, hv1 = 0.f; const int e0 = tid, e1 = tid + 512;
        if (e0 < 3 * RAWC) hv0 = raw[16 * RAWC + e0];
        if (e1 < 3 * RAWC) hv1 = raw[16 * RAWC + e1];
        __syncthreads();
        if (e0 < 3 * RAWC) raw[e0] = hv0;
        if (e1 < 3 * RAWC) raw[e1] = hv1;
    }
}


#define LDS_BARRIER() do { asm volatile("s_waitcnt lgkmcnt(0)" ::: "memory"); __builtin_amdgcn_s_barrier(); asm volatile("" ::: "memory"); } while (0)
template <int KS> __device__ __forceinline__ f32x4 mma_tile(const bf16_t* a, int lda, const bf16_t* b, int ldb, f32x4 acc, int fr, int fq) {
#pragma unroll
    for (int ks = 0; ks < KS; ++ks) {
        const bf16x8 af = *(const bf16x8*)(a + fr * lda + ks * 32 + fq * 8);
        const bf16x8 bv = *(const bf16x8*)(b + fr * ldb + ks * 32 + fq * 8);
        acc = __builtin_amdgcn_mfma_f32_16x16x32_bf16(bv, af, acc, 0, 0, 0);
    }
    return acc;
}
__device__ __forceinline__ u32x2 pack4(f32x4 v) { u32x2 o; o.x = pk2(v[0], v[1]); o.y = pk2(v[2], v[3]); return o; }
__device__ __forceinline__ f32x4 unpack4(u32x2 u) { return (f32x4){bf_lo(u.x), bf_hi(u.x), bf_lo(u.y), bf_hi(u.y)}; }

__device__ __forceinline__ void bpre_unit(const Params& p, int l, int unit, unsigned char* lds, int dry) {
    const int tid = tid_(), lane = tid & 63, wave = tid >> 6, fr = lane & 15, fq = lane >> 4;
    const int h = unit & 3, c = (unit >> 2) & 63, b = unit >> 8;
    bf16_t* P = (bf16_t*)(p.ws + WS_P); const float* sm8 = (const float*)(p.ws + WS_SM); float* GC = (float*)(p.ws + WS_GC);
    const bf16_t* HALO = (const bf16_t*)(p.ws + WS_HALO);
    const float* cw = p.conv_w + (size_t)l * 4 * 1536;
    constexpr int RAWC = 384;
    float* raw = (float*)lds;
    float* qkf = (float*)(lds + 29184);
    bf16_t* KN = (bf16_t*)(lds + 45568);
    bf16_t* KB = (bf16_t*)(lds + 62976);
    bf16_t* XT = (bf16_t*)(lds + 80384);
    float* AM = (float*)(lds + 117248);
    bf16_t* TM = (bf16_t*)(lds + 133632);
    float* sgc = (float*)(lds + 142848); float* sbeta = sgc + 64; float* sg = sgc + 128;
    const size_t row0 = (size_t)b * SEQ + (size_t)c * 64;
    const float a_coef = -__expf(p.a_log[l * 4 + h]); const float dtb = p.dt_bias[l * 4 + h];
    const int cqk = tid & 255; const int chq = cqk < 128 ? h * 128 + cqk : 512 + h * 128 + (cqk - 128);
    float wq[4], wvv[4];
#pragma unroll
    for (int j = 0; j < 4; ++j) { wq[j] = cw[j * 1536 + chq]; wvv[j] = cw[j * 1536 + 1024 + h * 128 + (tid & 127)]; }
    LDS_BARRIER();
    if (tid < 64) { const float bl = sm8[(row0 + tid) * 8 + h], al = sm8[(row0 + tid) * 8 + 4 + h]; const float xx = al + dtb; const float sp = xx > 20.f ? xx : log1pf(__expf(xx));
        sg[tid] = a_coef * sp; sbeta[tid] = sigmoidf_(bl); }
    for (int e = tid; e < 3 * RAWC; e += NTHREADS) { const int r = e / RAWC, ch = e % RAWC; const int chg = ch < 128 ? h * 128 + ch : (ch < 256 ? 512 + h * 128 + (ch - 128) : 1024 + h * 128 + (ch - 256));
        raw[e] = (c > 0) ? bf2f(HALO[((size_t)(b * 64 + c - 1) * 3 + r) * 1536 + chg]) : 0.f; }
    LDS_BARRIER();
    if (tid < 64) { float s0 = 0.f, s1 = 0.f;
#pragma unroll
        for (int j = 0; j < 64; j += 2) { s0 += (j <= tid) ? sg[j] : 0.f; s1 += (j + 1 <= tid) ? sg[j + 1] : 0.f; }
        const float s = s0 + s1; sgc[tid] = s; if (!dry) GC[(row0 + tid) * 4 + h] = s; }
    LDS_BARRIER();
#pragma unroll 1
    for (int sb = 0; sb < ((dry & 4) ? 1 : 4); ++sb) {
        const int t0 = sb * 16;
        for (int ck = tid; ck < 768; ck += NTHREADS) { const int row = ck / 48, c8 = ck % 48;
            const int chg = c8 < 16 ? h * 128 + c8 * 8 : (c8 < 32 ? 512 + h * 128 + (c8 - 16) * 8 : 1024 + h * 128 + (c8 - 32) * 8);
            const u32x4 v = *(const u32x4*)(P + (row0 + t0 + row) * LDP + PC_BQKV + chg); float* d = raw + (3 + row) * RAWC + c8 * 8;
            *(f32x4*)d = (f32x4){bf_lo(v.x), bf_hi(v.x), bf_lo(v.y), bf_hi(v.y)}; *(f32x4*)(d + 4) = (f32x4){bf_lo(v.z), bf_hi(v.z), bf_lo(v.w), bf_hi(v.w)}; }
        LDS_BARRIER();
        { const int tb = (tid >> 8) * 8;
#pragma unroll
          for (int tt = 0; tt < 8; ++tt) { const int t = tb + tt;
              const float x = raw[(t + 0) * RAWC + cqk] * wq[0] + raw[(t + 1) * RAWC + cqk] * wq[1] + raw[(t + 2) * RAWC + cqk] * wq[2] + raw[(t + 3) * RAWC + cqk] * wq[3];
              qkf[t * 256 + cqk] = siluf_(x); }
          const int cv = tid & 127, tq = (tid >> 7) * 4;
#pragma unroll
          for (int tt = 0; tt < 4; ++tt) { const int t = tq + tt;
              const float x = raw[(t + 0) * RAWC + 256 + cv] * wvv[0] + raw[(t + 1) * RAWC + 256 + cv] * wvv[1] + raw[(t + 2) * RAWC + 256 + cv] * wvv[2] + raw[(t + 3) * RAWC + 256 + cv] * wvv[3];
              XT[cv * 72 + t0 + t] = (bf16_t)f2bf(siluf_(x) * sbeta[t0 + t]); } }
        LDS_BARRIER();
        {
          const int vec = tid >> 4, sub = tid & 15; const int t = vec >> 1, which = vec & 1;
          const float* src = qkf + t * 256 + which * 128 + sub * 8;
          f32x4 a0 = *(const f32x4*)src, a1 = *(const f32x4*)(src + 4);
          float ss = (a0[0] * a0[0] + a0[1] * a0[1]) + (a0[2] * a0[2] + a0[3] * a0[3]) + (a1[0] * a1[0] + a1[1] * a1[1]) + (a1[2] * a1[2] + a1[3] * a1[3]);
          ss = row16_sum(ss);
          float sc_ = 1.0f / sqrtf(ss + EPS); if (which == 0) sc_ *= 0.08838834764831845f;
          a0 = a0 * sc_; a1 = a1 * sc_;
          u32x4 pk; pk.x = pk2(a0[0], a0[1]); pk.y = pk2(a0[2], a0[3]); pk.z = pk2(a1[0], a1[1]); pk.w = pk2(a1[2], a1[3]);
          bf16_t* grow = P + (row0 + t0 + t) * LDP + PC_BQKV + h * 128 + sub * 8;
          if (which == 0) { if (!dry) *(u32x4*)grow = pk; }
          else { if (!dry) *(u32x4*)(grow + 512) = pk; *(u32x4*)(KN + (t0 + t) * 136 + sub * 8) = pk;
              const float bt = sbeta[t0 + t];
              u32x4 pb; pb.x = pk2(a0[0] * bt, a0[1] * bt); pb.y = pk2(a0[2] * bt, a0[3] * bt); pb.z = pk2(a1[0] * bt, a1[1] * bt); pb.w = pk2(a1[2] * bt, a1[3] * bt);
              *(u32x4*)(KB + (t0 + t) * 136 + sub * 8) = pb; } }
        float hv[3];
#pragma unroll
        for (int k2 = 0; k2 < 3; ++k2) { const int e = tid + k2 * 512; hv[k2] = (e < 3 * RAWC) ? raw[16 * RAWC + e] : 0.f; }
        LDS_BARRIER();
#pragma unroll
        for (int k2 = 0; k2 < 3; ++k2) { const int e = tid + k2 * 512; if (e < 3 * RAWC) raw[e] = hv[k2]; }
    }
    LDS_BARRIER();
    {
      const int t = tid & 63, d0 = (tid >> 6) * 16; const float eg = __expf(sgc[t]);
#pragma unroll
      for (int hlf = 0; hlf < 2; ++hlf) { const u32x4 kv = *(const u32x4*)(KB + t * 136 + d0 + hlf * 8); bf16_t* xt = XT + (128 + d0 + hlf * 8) * 72 + t;
          const unsigned k0 = pk2(bf_lo(kv.x) * eg, bf_hi(kv.x) * eg), k1 = pk2(bf_lo(kv.y) * eg, bf_hi(kv.y) * eg), k2 = pk2(bf_lo(kv.z) * eg, bf_hi(kv.z) * eg), k3 = pk2(bf_lo(kv.w) * eg, bf_hi(kv.w) * eg);
          xt[0 * 72] = (bf16_t)(k0 & 0xffffu); xt[1 * 72] = (bf16_t)(k0 >> 16); xt[2 * 72] = (bf16_t)(k1 & 0xffffu); xt[3 * 72] = (bf16_t)(k1 >> 16);
          xt[4 * 72] = (bf16_t)(k2 & 0xffffu); xt[5 * 72] = (bf16_t)(k2 >> 16); xt[6 * 72] = (bf16_t)(k3 & 0xffffu); xt[7 * 72] = (bf16_t)(k3 >> 16); } }
#pragma unroll
    for (int i2 = 0; i2 < 2; ++i2) { const int ti = 2 * wave + i2, tm = ti >> 2, tn = ti & 3;
        if (tn <= tm) { f32x4 acc = mma_tile<4>(KB + tm * 16 * 136, 136, KN + tn * 16 * 136, 136, (f32x4){0.f, 0.f, 0.f, 0.f}, fr, fq);
            const int t = tm * 16 + fr, s0 = tn * 16 + 4 * fq; const float gt = sgc[t]; f32x4 o;
#pragma unroll
            for (int e = 0; e < 4; ++e) o[e] = (s0 + e < t) ? acc[e] * __expf(gt - sgc[s0 + e]) : 0.f;
            *(f32x4*)(AM + t * 64 + s0) = o; } }
    LDS_BARRIER();
    if (wave == 0 && !(dry & 2)) {
        float Tc[64];
        int amo = 0; asm volatile("" : "+v"(amo));
#pragma unroll
        for (int t = 0; t < 64; ++t) { float ac4[4] = {0.f, 0.f, 0.f, 0.f};
#pragma unroll
            for (int s4 = 0; s4 < (t + 3) / 4; ++s4) { const f32x4 a = *(const f32x4*)(AM + amo + t * 64 + 4 * s4);
#pragma unroll
                for (int e = 0; e < 4; ++e) if (4 * s4 + e < t) ac4[e] += a[e] * Tc[4 * s4 + e]; }
            const float acc = (ac4[0] + ac4[1]) + (ac4[2] + ac4[3]);
            int ln = lane; asm volatile("" : "+v"(ln));
            Tc[t] = ((t == ln) ? 1.f : 0.f) - acc;
            TM[t * 72 + ln] = (bf16_t)f2bf(Tc[t]); }
    }
    LDS_BARRIER();
#pragma unroll
    for (int i2 = 0; i2 < 2; ++i2) { const int nt = 2 * wave + i2;
#pragma unroll
        for (int mt = 0; mt < 4; ++mt) { const f32x4 acc = mma_tile<2>(TM + mt * 16 * 72, 72, XT + nt * 16 * 72, 72, (f32x4){0.f, 0.f, 0.f, 0.f}, fr, fq);
            const int t = mt * 16 + fr, n = nt * 16 + 4 * fq;
            bf16_t* dst = (n < 128) ? P + (row0 + t) * LDP + PC_BQKV + 1024 + h * 128 + n : P + (row0 + t) * LDP + 512 + h * 128 + (n - 128);
            if (!dry) *(u32x2*)dst = pack4(acc); } }
}

__device__ __forceinline__ void bscan_block(const Params& p, int bh, unsigned char* lds, int dry) {
    const int tid = tid_(), lane = tid & 63, wave = tid >> 6, fr = lane & 15, fq = lane >> 4;
    const int b = bh >> 2, h = bh & 3;
    bf16_t* P = (bf16_t*)(p.ws + WS_P); const float* GC = (const float*)(p.ws + WS_GC);
    bf16_t* ST = (bf16_t*)lds;
    bf16_t* Wt = (bf16_t*)(lds + 34816);
    bf16_t* QD = (bf16_t*)(lds + 52224);
    bf16_t* QN = (bf16_t*)(lds + 69632);
    bf16_t* KN = (bf16_t*)(lds + 87040);
    bf16_t* KDT = (bf16_t*)(lds + 104448);
    bf16_t* QK = (bf16_t*)(lds + 122880);
    bf16_t* VNT = (bf16_t*)(lds + 132096);
    float* sgc = (float*)(lds + 150528);
    const size_t row0 = (size_t)b * SEQ;
    f32x4 Sacc[8];
#pragma unroll
    for (int kt = 0; kt < 8; ++kt) Sacc[kt] = (f32x4){0.f, 0.f, 0.f, 0.f};
    LDS_BARRIER();
    for (int e = tid; e < 128 * 136 / 2; e += NTHREADS) ((unsigned*)ST)[e] = 0u;
    u32x4 rq[2], rk[2], rw[2], tk[2], tu[2]; float rgc = 0.f;
    auto gload = [&](int c) {
#pragma unroll
        for (int i2 = 0; i2 < 2; ++i2) { const int ck = tid + 512 * i2, row = ck >> 4, c8 = (ck & 15) * 8; const bf16_t* g = P + (row0 + c * 64 + row) * LDP;
            rq[i2] = *(const u32x4*)(g + PC_BQKV + h * 128 + c8); rk[i2] = *(const u32x4*)(g + PC_BQKV + 512 + h * 128 + c8); rw[i2] = *(const u32x4*)(g + 512 + h * 128 + c8);
            const int t = ck & 63, d8 = (ck >> 6) * 8; const bf16_t* g2 = P + (row0 + c * 64 + t) * LDP;
            tk[i2] = *(const u32x4*)(g2 + PC_BQKV + 512 + h * 128 + d8); tu[i2] = *(const u32x4*)(g2 + PC_BQKV + 1024 + h * 128 + d8); }
        if (tid < 64) rgc = GC[(row0 + c * 64 + tid) * 4 + h];
    };
#define LDFRAG(base, row, pitch, ks) (*(const bf16x8*)((base) + (row) * (pitch) + (ks) * 32 + fq * 8))
#define MFMA16(bfrag, afrag, acc) __builtin_amdgcn_mfma_f32_16x16x32_bf16(bfrag, afrag, acc, 0, 0, 0)
    gload(0);
#pragma unroll 1
    for (int c = 0; c < 64; ++c) {
        LDS_BARRIER();
        if (tid < 64) sgc[tid] = rgc;
        LDS_BARRIER();
        const float gce = sgc[63];
#pragma unroll
        for (int i2 = 0; i2 < 2; ++i2) { const int ck = tid + 512 * i2, row = ck >> 4, c8 = (ck & 15) * 8;
            const float er = __expf(sgc[row]);
            *(u32x4*)(QN + row * 136 + c8) = rq[i2]; *(u32x4*)(KN + row * 136 + c8) = rk[i2]; *(u32x4*)(Wt + row * 136 + c8) = rw[i2];
            u32x4 qd; qd.x = pk2(bf_lo(rq[i2].x) * er, bf_hi(rq[i2].x) * er); qd.y = pk2(bf_lo(rq[i2].y) * er, bf_hi(rq[i2].y) * er);
            qd.z = pk2(bf_lo(rq[i2].z) * er, bf_hi(rq[i2].z) * er); qd.w = pk2(bf_lo(rq[i2].w) * er, bf_hi(rq[i2].w) * er);
            *(u32x4*)(QD + row * 136 + c8) = qd;
            const int t = ck & 63, d8 = (ck >> 6) * 8; const float rr = __expf(gce - sgc[t]);
            bf16_t* kd = KDT + d8 * 72 + t; bf16_t* ut = VNT + d8 * 72 + t;
            const unsigned k0 = pk2(bf_lo(tk[i2].x) * rr, bf_hi(tk[i2].x) * rr), k1 = pk2(bf_lo(tk[i2].y) * rr, bf_hi(tk[i2].y) * rr), k2 = pk2(bf_lo(tk[i2].z) * rr, bf_hi(tk[i2].z) * rr), k3 = pk2(bf_lo(tk[i2].w) * rr, bf_hi(tk[i2].w) * rr);
            kd[0 * 72] = (bf16_t)(k0 & 0xffffu); kd[1 * 72] = (bf16_t)(k0 >> 16); kd[2 * 72] = (bf16_t)(k1 & 0xffffu); kd[3 * 72] = (bf16_t)(k1 >> 16);
            kd[4 * 72] = (bf16_t)(k2 & 0xffffu); kd[5 * 72] = (bf16_t)(k2 >> 16); kd[6 * 72] = (bf16_t)(k3 & 0xffffu); kd[7 * 72] = (bf16_t)(k3 >> 16);
            ut[0 * 72] = (bf16_t)(tu[i2].x & 0xffffu); ut[1 * 72] = (bf16_t)(tu[i2].x >> 16); ut[2 * 72] = (bf16_t)(tu[i2].y & 0xffffu); ut[3 * 72] = (bf16_t)(tu[i2].y >> 16);
            ut[4 * 72] = (bf16_t)(tu[i2].z & 0xffffu); ut[5 * 72] = (bf16_t)(tu[i2].z >> 16); ut[6 * 72] = (bf16_t)(tu[i2].w & 0xffffu); ut[7 * 72] = (bf16_t)(tu[i2].w >> 16); }
        if (c + 1 < 64) gload(c + 1);
        LDS_BARRIER();
        const int vrow = 16 * wave + fr;
        bf16x8 sfr[4];
#pragma unroll
        for (int ks = 0; ks < 4; ++ks) sfr[ks] = LDFRAG(ST, vrow, 136, ks);
#pragma unroll
        for (int tt = 0; tt < 4; ++tt) { f32x4 acc = (f32x4){0.f, 0.f, 0.f, 0.f};
#pragma unroll
            for (int ks = 0; ks < 4; ++ks) acc = MFMA16(LDFRAG(Wt, tt * 16 + fr, 136, ks), sfr[ks], acc);
            bf16_t* vp = VNT + vrow * 72 + tt * 16 + 4 * fq; const f32x4 u4 = unpack4(*(const u32x2*)vp);
            *(u32x2*)vp = pack4(u4 - acc); }
#pragma unroll
        for (int i2 = 0; i2 < 2; ++i2) { const int ti = 2 * wave + i2, tm = ti >> 2, tn = ti & 3; const int t = tm * 16 + fr, s0 = tn * 16 + 4 * fq; f32x4 o = (f32x4){0.f, 0.f, 0.f, 0.f};
            if (tn <= tm) { const f32x4 acc = mma_tile<4>(QN + tm * 16 * 136, 136, KN + tn * 16 * 136, 136, (f32x4){0.f, 0.f, 0.f, 0.f}, fr, fq); const float gt = sgc[t];
#pragma unroll
                for (int e = 0; e < 4; ++e) o[e] = (s0 + e <= t) ? acc[e] * __expf(gt - sgc[s0 + e]) : 0.f; }
            *(u32x2*)(QK + t * 72 + s0) = pack4(o); }
        LDS_BARRIER();
        bf16x8 vfr[2];
#pragma unroll
        for (int ks = 0; ks < 2; ++ks) vfr[ks] = LDFRAG(VNT, vrow, 72, ks);
#pragma unroll
        for (int tt = 0; tt < 4; ++tt) { f32x4 acc = (f32x4){0.f, 0.f, 0.f, 0.f};
#pragma unroll
            for (int ks = 0; ks < 4; ++ks) acc = MFMA16(sfr[ks], LDFRAG(QD, tt * 16 + fr, 136, ks), acc);
#pragma unroll
            for (int ks = 0; ks < 2; ++ks) acc = MFMA16(vfr[ks], LDFRAG(QK, tt * 16 + fr, 72, ks), acc);
            if (!dry) *(u32x2*)(P + (row0 + c * 64 + tt * 16 + fr) * LDP + PC_BQKV + 1024 + h * 128 + 16 * wave + 4 * fq) = pack4(acc); }
        { const float ge = __expf(gce);
#pragma unroll
          for (int kt = 0; kt < 8; ++kt) { f32x4 acc = Sacc[kt] * ge;
#pragma unroll
              for (int ks = 0; ks < 2; ++ks) acc = MFMA16(LDFRAG(KDT, kt * 16 + fr, 72, ks), vfr[ks], acc);
              Sacc[kt] = acc;
              *(u32x2*)(ST + vrow * 136 + kt * 16 + 4 * fq) = pack4(acc); } }
    }
#undef LDFRAG
#undef MFMA16
}


__device__ __forceinline__ unsigned char* a_state_row(unsigned char* ws, size_t row0, int h, int v) {
    return ws + WS_AF + (row0 + (size_t)(v >> 1)) * 2048 + (size_t)h * 512 + (size_t)(v & 1) * 256;
}
__device__ __forceinline__ void ax1_unit(const Params& p, int unit, unsigned char* lds) {
    const int tid = tid_(), lane = tid & 63, wave = tid >> 6, fr = lane & 15, fq = lane >> 4;
    const int h = unit & 3, c = (unit >> 2) & 63, b = unit >> 8;
    bf16_t* P = (bf16_t*)(p.ws + WS_P); const float* AF = (const float*)(p.ws + WS_AF); float* DEC = (float*)(p.ws + WS_DEC);
    constexpr int BP = 132;
    float* BF = (float*)lds;
    bf16_t* QM = (bf16_t*)(lds + 33792);
    bf16_t* KM = (bf16_t*)(lds + 51200);
    bf16_t* KET = (bf16_t*)(lds + 68608);
    bf16_t* VT = (bf16_t*)(lds + 87040);
    bf16_t* SC = (bf16_t*)(lds + 105472);
    const size_t row0 = (size_t)b * SEQ + (size_t)c * 64;
    const int rA = tid >> 3, cA = (tid & 7) * 16;
    const int tB = tid & 63, cB = (tid >> 6) * 16;
    LDS_BARRIER();
    f32x4 fA[4];
#pragma unroll
    for (int i = 0; i < 4; ++i) { fA[i] = *(const f32x4*)(AF + (row0 + rA) * 512 + h * 128 + cA + 4 * i);
        *(f32x4*)(BF + rA * BP + cA + 4 * i) = (f32x4){__logf(fA[i][0]), __logf(fA[i][1]), __logf(fA[i][2]), __logf(fA[i][3])}; }
    f32x4 fB[4]; u32x4 vB[2];
#pragma unroll
    for (int i = 0; i < 4; ++i) fB[i] = *(const f32x4*)(AF + (row0 + tB) * 512 + h * 128 + cB + 4 * i);
#pragma unroll
    for (int i = 0; i < 2; ++i) vB[i] = *(const u32x4*)(P + (row0 + tB) * LDP + PC_AI + h * 128 + cB + 8 * i);
    u32x4 qA[2];
#pragma unroll
    for (int i = 0; i < 2; ++i) qA[i] = *(const u32x4*)(P + (row0 + rA) * LDP + PC_AQ + h * 128 + cA + 8 * i);
    LDS_BARRIER();
    if (tid < 128) { float s = 0.f;
#pragma unroll
        for (int t = 0; t < 64; ++t) { s += BF[t * BP + tid]; BF[t * BP + tid] = s; } }
    LDS_BARRIER();
    {
      float qv[16] = {bf_lo(qA[0].x), bf_hi(qA[0].x), bf_lo(qA[0].y), bf_hi(qA[0].y), bf_lo(qA[0].z), bf_hi(qA[0].z), bf_lo(qA[0].w), bf_hi(qA[0].w),
                      bf_lo(qA[1].x), bf_hi(qA[1].x), bf_lo(qA[1].y), bf_hi(qA[1].y), bf_lo(qA[1].z), bf_hi(qA[1].z), bf_lo(qA[1].w), bf_hi(qA[1].w)};
      unsigned wm[8], wk[8], wh[8];
#pragma unroll
      for (int i = 0; i < 4; ++i) { const f32x4 bt = *(const f32x4*)(BF + rA * BP + cA + 4 * i), bm = *(const f32x4*)(BF + 31 * BP + cA + 4 * i);
          float qm[4], km[4], qh[4];
#pragma unroll
          for (int e = 0; e < 4; ++e) { const float q = qv[4 * i + e], kk = 1.0f - fA[i][e]; qm[e] = q * __expf(bt[e] - bm[e]); km[e] = kk * __expf(bm[e] - bt[e]); qh[e] = q * __expf(bt[e]); }
          wm[2 * i] = pk2(qm[0], qm[1]); wm[2 * i + 1] = pk2(qm[2], qm[3]); wk[2 * i] = pk2(km[0], km[1]); wk[2 * i + 1] = pk2(km[2], km[3]); wh[2 * i] = pk2(qh[0], qh[1]); wh[2 * i + 1] = pk2(qh[2], qh[3]); }
      *(u32x4*)(QM + rA * 136 + cA) = (u32x4){wm[0], wm[1], wm[2], wm[3]}; *(u32x4*)(QM + rA * 136 + cA + 8) = (u32x4){wm[4], wm[5], wm[6], wm[7]};
      *(u32x4*)(KM + rA * 136 + cA) = (u32x4){wk[0], wk[1], wk[2], wk[3]}; *(u32x4*)(KM + rA * 136 + cA + 8) = (u32x4){wk[4], wk[5], wk[6], wk[7]};
      bf16_t* qg = P + (row0 + rA) * LDP + PC_AQ + h * 128 + cA;
      *(u32x4*)qg = (u32x4){wh[0], wh[1], wh[2], wh[3]}; *(u32x4*)(qg + 8) = (u32x4){wh[4], wh[5], wh[6], wh[7]}; }
    {
#pragma unroll
      for (int i = 0; i < 4; ++i) { const f32x4 bt = *(const f32x4*)(BF + tB * BP + cB + 4 * i), be = *(const f32x4*)(BF + 63 * BP + cB + 4 * i);
          const unsigned w0 = pk2((1.0f - fB[i][0]) * __expf(be[0] - bt[0]), (1.0f - fB[i][1]) * __expf(be[1] - bt[1])), w1 = pk2((1.0f - fB[i][2]) * __expf(be[2] - bt[2]), (1.0f - fB[i][3]) * __expf(be[3] - bt[3]));
          bf16_t* kt = KET + (cB + 4 * i) * 72 + tB;
          kt[0] = (bf16_t)(w0 & 0xffffu); kt[72] = (bf16_t)(w0 >> 16); kt[144] = (bf16_t)(w1 & 0xffffu); kt[216] = (bf16_t)(w1 >> 16); }
#pragma unroll
      for (int i = 0; i < 2; ++i) { bf16_t* vt = VT + (cB + 8 * i) * 72 + tB;
          vt[0 * 72] = (bf16_t)(vB[i].x & 0xffffu); vt[1 * 72] = (bf16_t)(vB[i].x >> 16); vt[2 * 72] = (bf16_t)(vB[i].y & 0xffffu); vt[3 * 72] = (bf16_t)(vB[i].y >> 16);
          vt[4 * 72] = (bf16_t)(vB[i].z & 0xffffu); vt[5 * 72] = (bf16_t)(vB[i].z >> 16); vt[6 * 72] = (bf16_t)(vB[i].w & 0xffffu); vt[7 * 72] = (bf16_t)(vB[i].w >> 16); } }
    if (tid < 128) DEC[(size_t)unit * 128 + tid] = __expf(BF[63 * BP + tid]);
    LDS_BARRIER();
#pragma unroll
    for (int i2 = 0; i2 < 2; ++i2) { const int ti = 2 * wave + i2, tm = ti >> 2, tn = ti & 3; const int t = tm * 16 + fr, s0 = tn * 16 + 4 * fq; f32x4 o = (f32x4){0.f, 0.f, 0.f, 0.f};
        if (tn <= tm) { const f32x4 acc = mma_tile<4>(QM + tm * 16 * 136, 136, KM + tn * 16 * 136, 136, (f32x4){0.f, 0.f, 0.f, 0.f}, fr, fq);
#pragma unroll
            for (int e = 0; e < 4; ++e) o[e] = (s0 + e <= t) ? acc[e] : 0.f; }
        *(u32x2*)(SC + t * 72 + s0) = pack4(o); }
    LDS_BARRIER();
    { const int vrow = 16 * wave + fr;
      bf16x8 vfr[2];
#pragma unroll
      for (int ks = 0; ks < 2; ++ks) vfr[ks] = *(const bf16x8*)(VT + vrow * 72 + ks * 32 + fq * 8);
#pragma unroll
      for (int tt = 0; tt < 4; ++tt) { f32x4 acc = (f32x4){0.f, 0.f, 0.f, 0.f};
#pragma unroll
          for (int ks = 0; ks < 2; ++ks) acc = __builtin_amdgcn_mfma_f32_16x16x32_bf16(vfr[ks], *(const bf16x8*)(SC + (tt * 16 + fr) * 72 + ks * 32 + fq * 8), acc, 0, 0, 0);
          *(u32x2*)(P + (row0 + tt * 16 + fr) * LDP + PC_AI + h * 128 + 16 * wave + 4 * fq) = pack4(acc); }
      unsigned char* srow = a_state_row(p.ws, row0, h, vrow);
#pragma unroll
      for (int kt = 0; kt < 8; ++kt) { f32x4 acc = (f32x4){0.f, 0.f, 0.f, 0.f};
#pragma unroll
          for (int ks = 0; ks < 2; ++ks) acc = __builtin_amdgcn_mfma_f32_16x16x32_bf16(*(const bf16x8*)(KET + (kt * 16 + fr) * 72 + ks * 32 + fq * 8), vfr[ks], acc, 0, 0, 0);
          *(u32x2*)(srow + (kt * 16 + 4 * fq) * 2) = pack4(acc); } }
}
__device__ __forceinline__ void ax2_scan(const Params& p, int first_block, int nblocks) {
    const int tid = tid_(); const float* DEC = (const float*)(p.ws + WS_DEC);
    for (int gid = (bid_() - first_block) * NTHREADS + tid; gid < 16 * 8192; gid += nblocks * NTHREADS) {
        const int bh = gid >> 13, e2 = gid & 8191, v = e2 >> 6, kp = (e2 & 63) * 2, b = bh >> 2, h = bh & 3;
        float s0 = 0.f, s1 = 0.f;
#pragma unroll 1
        for (int c0 = 0; c0 < 64; c0 += 8) {
            unsigned x[8]; f32x2 d[8];
#pragma unroll
            for (int j = 0; j < 8; ++j) { const int c = c0 + j; x[j] = *(const unsigned*)(a_state_row(p.ws, (size_t)b * SEQ + (size_t)c * 64, h, v) + kp * 2); d[j] = *(const f32x2*)(DEC + ((size_t)(b * 256 + c * 4 + h)) * 128 + kp); }
#pragma unroll
            for (int j = 0; j < 8; ++j) { const int c = c0 + j; *(unsigned*)(a_state_row(p.ws, (size_t)b * SEQ + (size_t)c * 64, h, v) + kp * 2) = pk2(s0, s1);
                s0 = d[j].x * s0 + bf_lo(x[j]); s1 = d[j].y * s1 + bf_hi(x[j]); }
        }
    }
}
__device__ __forceinline__ void ax3_unit(const Params& p, int l, int unit, unsigned char* lds) {
    const int tid = tid_(), lane = tid & 63, wave = tid >> 6, fr = lane & 15, fq = lane >> 4;
    const int h = unit & 3, c = (unit >> 2) & 63, b = unit >> 8;
    bf16_t* P = (bf16_t*)(p.ws + WS_P);
    bf16_t* QH = (bf16_t*)lds;
    bf16_t* SI = (bf16_t*)(lds + 17408);
    float* OL = (float*)(lds + 52224);
    const size_t row0 = (size_t)b * SEQ + (size_t)c * 64;
    LDS_BARRIER();
#pragma unroll
    for (int i2 = 0; i2 < 2; ++i2) { const int ck = tid + 512 * i2, row = ck >> 4, c8 = (ck & 15) * 8;
        *(u32x4*)(QH + row * 136 + c8) = *(const u32x4*)(P + (row0 + row) * LDP + PC_AQ + h * 128 + c8); }
#pragma unroll
    for (int i2 = 0; i2 < 4; ++i2) { const int ck = tid + 512 * i2, v = ck >> 4, c8 = (ck & 15) * 8;
        *(u32x4*)(SI + v * 136 + c8) = *(const u32x4*)(a_state_row(p.ws, row0, h, v) + c8 * 2); }
    LDS_BARRIER();
    { const int vrow = 16 * wave + fr;
      bf16x8 sfr[4];
#pragma unroll
      for (int ks = 0; ks < 4; ++ks) sfr[ks] = *(const bf16x8*)(SI + vrow * 136 + ks * 32 + fq * 8);
#pragma unroll
      for (int tt = 0; tt < 4; ++tt) { const int t = tt * 16 + fr;
          f32x4 acc = unpack4(*(const u32x2*)(P + (row0 + t) * LDP + PC_AI + h * 128 + 16 * wave + 4 * fq));
#pragma unroll
          for (int ks = 0; ks < 4; ++ks) acc = __builtin_amdgcn_mfma_f32_16x16x32_bf16(sfr[ks], *(const bf16x8*)(QH + t * 136 + ks * 32 + fq * 8), acc, 0, 0, 0);
          *(f32x4*)(OL + t * 132 + 16 * wave + 4 * fq) = acc; } }
    LDS_BARRIER();
    { const int t = tid >> 3, v0 = (tid & 7) * 16;
      f32x4 o[4]; float ss = 0.f;
#pragma unroll
      for (int i = 0; i < 4; ++i) { o[i] = *(const f32x4*)(OL + t * 132 + v0 + 4 * i); ss += (o[i][0] * o[i][0] + o[i][1] * o[i][1]) + (o[i][2] * o[i][2] + o[i][3] * o[i][3]); }
      ss += dpp_mov<0xB1>(ss); ss += dpp_mov<0x4E>(ss); ss += dpp_mov<0x141>(ss);
      const float rs = __builtin_amdgcn_rsqf(ss * (1.0f / 128.0f) + EPS);
      bf16_t* gp = P + (row0 + t) * LDP + PC_AG + h * 128 + v0;
      const u32x4 g0 = *(const u32x4*)gp, g1 = *(const u32x4*)(gp + 8);
      const float gt[16] = {bf_lo(g0.x), bf_hi(g0.x), bf_lo(g0.y), bf_hi(g0.y), bf_lo(g0.z), bf_hi(g0.z), bf_lo(g0.w), bf_hi(g0.w), bf_lo(g1.x), bf_hi(g1.x), bf_lo(g1.y), bf_hi(g1.y), bf_lo(g1.z), bf_hi(g1.z), bf_lo(g1.w), bf_hi(g1.w)};
      unsigned w[8];
#pragma unroll
      for (int i = 0; i < 4; ++i) { const f32x4 nw = *(const f32x4*)(p.norm_a + l * 128 + v0 + 4 * i);
          const float y0 = o[i][0] * rs * nw[0] * siluf_(gt[4 * i]), y1 = o[i][1] * rs * nw[1] * siluf_(gt[4 * i + 1]), y2 = o[i][2] * rs * nw[2] * siluf_(gt[4 * i + 2]), y3 = o[i][3] * rs * nw[3] * siluf_(gt[4 * i + 3]);
          w[2 * i] = pk2(y0, y1); w[2 * i + 1] = pk2(y2, y3); }
      *(u32x4*)gp = (u32x4){w[0], w[1], w[2], w[3]}; *(u32x4*)(gp + 8) = (u32x4){w[4], w[5], w[6], w[7]}; }
}

__device__ __forceinline__ void cmma_unit(const Params& p, int l, int unit, unsigned char* lds) {
    const int tid = tid_(), lane = tid & 63, wave = tid >> 6, fr = lane & 15, fq = lane >> 4;
    const int kvh = unit & 1, nb = (unit >> 1) & 31, b = unit >> 6;
    bf16_t* P = (bf16_t*)(p.ws + WS_P);
    bf16_t* sK = (bf16_t*)lds;
    bf16_t* sVT = (bf16_t*)(lds + 36864);
    float* sBias = (float*)(lds + 70656);
    bf16_t* sP = (bf16_t*)(lds + 72704) + wave * (16 * 168);
    const size_t rowq0 = (size_t)b * SEQ + (size_t)nb * 128;
    const bool first = (nb == 0);
    LDS_BARRIER();
#pragma unroll
    for (int i2 = 0; i2 < 4; ++i2) { const int ck = tid + 512 * i2, j = ck >> 3, d8 = (ck & 7) * 8; u32x4 kv = (u32x4){0u, 0u, 0u, 0u};
        if (!first || j >= 128) kv = *(const u32x4*)(P + (rowq0 - 128 + j) * LDP + PC_CK + kvh * 64 + d8);
        *(u32x4*)(sK + j * 72 + d8) = kv; }
    { const int j = tid & 255, dh = (tid >> 8) * 32;
#pragma unroll
      for (int i = 0; i < 4; ++i) { u32x4 vv = (u32x4){0u, 0u, 0u, 0u};
          if (!first || j >= 128) vv = *(const u32x4*)(P + (rowq0 - 128 + j) * LDP + PC_CV + kvh * 64 + dh + 8 * i);
          bf16_t* vt = sVT + (dh + 8 * i) * 264 + j;
          vt[0 * 264] = (bf16_t)(vv.x & 0xffffu); vt[1 * 264] = (bf16_t)(vv.x >> 16); vt[2 * 264] = (bf16_t)(vv.y & 0xffffu); vt[3 * 264] = (bf16_t)(vv.y >> 16);
          vt[4 * 264] = (bf16_t)(vv.z & 0xffffu); vt[5 * 264] = (bf16_t)(vv.z >> 16); vt[6 * 264] = (bf16_t)(vv.w & 0xffffu); vt[7 * 264] = (bf16_t)(vv.w >> 16); } }
    { const int g = tid >> 7, dist = tid & 127; sBias[g * 128 + dist] = p.rel_bias[(int)kBucket[dist] * 8 + kvh * 4 + g]; }
    LDS_BARRIER();
    const int a = wave, kb0 = 32 * (a >> 1), qi = 16 * a + fr;
#pragma unroll 1
    for (int g = 0; g < 4; ++g) {
        const int hq = kvh * 4 + g; const size_t rowq = rowq0 + qi;
        bf16x8 qf[2];
#pragma unroll
        for (int ks = 0; ks < 2; ++ks) qf[ks] = *(const bf16x8*)(P + rowq * LDP + PC_CQ + hq * 64 + ks * 32 + fq * 8);
        f32x4 s[10];
#pragma unroll
        for (int kt = 0; kt < 10; ++kt) { f32x4 acc = (f32x4){0.f, 0.f, 0.f, 0.f};
#pragma unroll
            for (int ks = 0; ks < 2; ++ks) acc = __builtin_amdgcn_mfma_f32_16x16x32_bf16(*(const bf16x8*)(sK + (kb0 + kt * 16 + fr) * 72 + ks * 32 + fq * 8), qf[ks], acc, 0, 0, 0);
            s[kt] = acc; }
        const float sink = p.sinks[l * 8 + hq];
        float mx = sink;
#pragma unroll
        for (int kt = 0; kt < 10; ++kt)
#pragma unroll
            for (int e = 0; e < 4; ++e) { const int j = kb0 + kt * 16 + 4 * fq + e; const int dist = qi + 128 - j; const bool ok = (dist >= 0) && (dist < 128) && !(first && j < 128);
                const float v = ok ? s[kt][e] + sBias[g * 128 + (dist & 127)] : -1e30f; s[kt][e] = v; mx = fmaxf(mx, v); }
        { auto r16 = __builtin_amdgcn_permlane16_swap(__float_as_uint(mx), __float_as_uint(mx), false, false); mx = fmaxf(__uint_as_float(r16[0]), __uint_as_float(r16[1]));
          auto r32 = __builtin_amdgcn_permlane32_swap(__float_as_uint(mx), __float_as_uint(mx), false, false); mx = fmaxf(__uint_as_float(r32[0]), __uint_as_float(r32[1])); }
        float ls = 0.f;
#pragma unroll
        for (int kt = 0; kt < 10; ++kt) { f32x4 pe;
#pragma unroll
            for (int e = 0; e < 4; ++e) pe[e] = __expf(s[kt][e] - mx);
            const u32x2 pk = pack4(pe); ls += (bf_lo(pk.x) + bf_hi(pk.x)) + (bf_lo(pk.y) + bf_hi(pk.y));
            *(u32x2*)(sP + fr * 168 + kt * 16 + 4 * fq) = pk; }
        ls = xor32_sum(xor16_sum(ls)) + __expf(sink - mx);
        const float inv = __builtin_amdgcn_rcpf(ls);
        asm volatile("s_waitcnt lgkmcnt(0)" ::: "memory");
        bf16x8 pf[5];
#pragma unroll
        for (int ks = 0; ks < 5; ++ks) pf[ks] = *(const bf16x8*)(sP + fr * 168 + ks * 32 + fq * 8);
        bf16_t* gp = P + rowq * LDP + PC_CG + hq * 64;
#pragma unroll
        for (int dt = 0; dt < 4; ++dt) { f32x4 acc = (f32x4){0.f, 0.f, 0.f, 0.f};
#pragma unroll
            for (int ks = 0; ks < 5; ++ks) acc = __builtin_amdgcn_mfma_f32_16x16x32_bf16(*(const bf16x8*)(sVT + (dt * 16 + fr) * 264 + kb0 + ks * 32 + fq * 8), pf[ks], acc, 0, 0, 0);
            const f32x4 gt = unpack4(*(const u32x2*)(gp + dt * 16 + 4 * fq));
            f32x4 y;
#pragma unroll
            for (int e = 0; e < 4; ++e) y[e] = acc[e] * inv * siluf_(gt[e]);
            *(u32x2*)(gp + dt * 16 + 4 * fq) = pack4(y); }
        asm volatile("s_waitcnt lgkmcnt(0)" ::: "memory");
    }
}
__device__ __forceinline__ void mixer_c(const Params& p, int l, int unit, unsigned char* lds, int dry) {
    const int tid = tid_(), wave = tid >> 6;
    const int kvh = unit & 1, nb = (unit >> 1) & 31, b = unit >> 6;
    bf16_t* P = (bf16_t*)(p.ws + WS_P);
    bf16_t* sK = (bf16_t*)lds;
    bf16_t* sVT = (bf16_t*)(lds + 32768);
    float* sBias = (float*)(lds + 32768 + 64 * 264 * 2);
    constexpr int VTP = 264;
    const size_t rowq0 = (size_t)b * SEQ + (size_t)nb * 128;
    __syncthreads();
    for (int c = tid; c < 256 * 8; c += NTHREADS) {
        const int j = c >> 3, d8 = (c & 7) * 8; u32x4 kv = (u32x4){0u, 0u, 0u, 0u}, vv = (u32x4){0u, 0u, 0u, 0u};
        if (nb > 0 || j >= 128) { const size_t row = rowq0 - 128 + j; kv = *(const u32x4*)(P + row * LDP + PC_CK + kvh * 64 + d8); vv = *(const u32x4*)(P + row * LDP + PC_CV + kvh * 64 + d8); }
        *(u32x4*)(sK + j * 64 + d8) = kv;
        sVT[(d8 + 0) * VTP + j] = (bf16_t)(vv.x & 0xffff); sVT[(d8 + 1) * VTP + j] = (bf16_t)(vv.x >> 16);
        sVT[(d8 + 2) * VTP + j] = (bf16_t)(vv.y & 0xffff); sVT[(d8 + 3) * VTP + j] = (bf16_t)(vv.y >> 16);
        sVT[(d8 + 4) * VTP + j] = (bf16_t)(vv.z & 0xffff); sVT[(d8 + 5) * VTP + j] = (bf16_t)(vv.z >> 16);
        sVT[(d8 + 6) * VTP + j] = (bf16_t)(vv.w & 0xffff); sVT[(d8 + 7) * VTP + j] = (bf16_t)(vv.w >> 16);
    }
    { const int g = tid >> 7, dist = tid & 127; sBias[g * 128 + dist] = p.rel_bias[(int)kBucket[dist] * 8 + kvh * 4 + g]; }
    __syncthreads();
    const int g = tid >> 7, i = tid & 127, hq = kvh * 4 + g;
    const size_t rowq = rowq0 + i;
    unsigned qp[32];
#pragma unroll
    for (int c = 0; c < 8; ++c) { const u32x4 t = *(const u32x4*)(P + rowq * LDP + PC_CQ + hq * 64 + c * 8); qp[4 * c] = t.x; qp[4 * c + 1] = t.y; qp[4 * c + 2] = t.z; qp[4 * c + 3] = t.w; }
    float o[64];
#pragma unroll
    for (int d = 0; d < 64; ++d) o[d] = 0.f;
    const float sink = p.sinks[l * 8 + hq];
    float mrun = sink, lrun = 1.0f;
    const int jlo = 64 * (wave & 1);
    const bool first = (nb == 0);
    for (int jg = 0; jg < 24; ++jg) {
        const int j0 = jlo + jg * 8;
        float s[8];
#pragma unroll
        for (int u = 0; u < 8; ++u) {
            const int j = j0 + u; const bf16_t* kr = sK + j * 64; float a = 0.f;
#pragma unroll
            for (int c = 0; c < 8; ++c) { const u32x4 kk = *(const u32x4*)(kr + c * 8);
                a = dot2u(kk.x, qp[4 * c], a);
                a = dot2u(kk.y, qp[4 * c + 1], a);
                a = dot2u(kk.z, qp[4 * c + 2], a);
                a = dot2u(kk.w, qp[4 * c + 3], a); }
            const int dist = i + 128 - j; const bool ok = (dist >= 0) && (dist < 128) && !(first && j < 128);
            s[u] = ok ? a + sBias[g * 128 + (dist & 127)] : -1e30f;
        }
        float gm = fmaxf(fmaxf(fmaxf(s[0], s[1]), fmaxf(s[2], s[3])), fmaxf(fmaxf(s[4], s[5]), fmaxf(s[6], s[7])));
        const float mnew = fmaxf(mrun, gm); const float corr = __expf(mrun - mnew); mrun = mnew;
        float ps = 0.f; unsigned pp[4];
        float pe[8];
#pragma unroll
        for (int u = 0; u < 8; ++u) { pe[u] = __expf(s[u] - mnew); }
#pragma unroll
        for (int u = 0; u < 4; ++u) { pp[u] = pk2(pe[2 * u], pe[2 * u + 1]); ps += bf_lo(pp[u]) + bf_hi(pp[u]); }
        lrun = lrun * corr + ps;
#pragma unroll
        for (int d = 0; d < 64; ++d) {
            const u32x4 vt = *(const u32x4*)(sVT + d * VTP + j0);
            float a = o[d] * corr;
            a = dot2u(vt.x, pp[0], a);
            a = dot2u(vt.y, pp[1], a);
            a = dot2u(vt.z, pp[2], a);
            a = dot2u(vt.w, pp[3], a);
            o[d] = a;
        }
    }
    float inv = 1.0f / lrun;
#if DIAG_ZERO_C
    inv = 0.f;
#endif
    bf16_t* gp = P + rowq * LDP + PC_CG + hq * 64;
#pragma unroll
    for (int c = 0; c < 8; ++c) {
        const u32x4 gv = *(const u32x4*)(gp + c * 8); u32x4 ov;
        ov.x = pk2(o[8 * c + 0] * inv * siluf_(bf_lo(gv.x)), o[8 * c + 1] * inv * siluf_(bf_hi(gv.x)));
        ov.y = pk2(o[8 * c + 2] * inv * siluf_(bf_lo(gv.y)), o[8 * c + 3] * inv * siluf_(bf_hi(gv.y)));
        ov.z = pk2(o[8 * c + 4] * inv * siluf_(bf_lo(gv.z)), o[8 * c + 5] * inv * siluf_(bf_hi(gv.z)));
        ov.w = pk2(o[8 * c + 6] * inv * siluf_(bf_lo(gv.w)), o[8 * c + 7] * inv * siluf_(bf_hi(gv.w)));
        if (!dry) *(u32x4*)(gp + c * 8) = ov;
    }
}


#if DIAG_NAIVE_C
__device__ __forceinline__ void mixer_c_naive(const Params& p, int l, int unit) {
    const int tid = tid_();
    const int kvh = unit & 1, nb = (unit >> 1) & 31, b = unit >> 6;
    bf16_t* P = (bf16_t*)(p.ws + WS_P);
    const int g = tid >> 7, i = tid & 127, hq = kvh * 4 + g;
    const size_t rowq = (size_t)b * SEQ + (size_t)nb * 128 + i;
    float q[64], o[64];
#pragma unroll
    for (int d = 0; d < 64; ++d) { q[d] = bf2f(P[rowq * LDP + PC_CQ + hq * 64 + d]); o[d] = 0.f; }
    float m = p.sinks[l * 8 + hq], lsum = 1.0f;
    const int tpos = nb * 128 + i;
    for (int kp = tpos - 127; kp <= tpos; ++kp) {
        if (kp < 0) continue;
        const size_t rowk = (size_t)b * SEQ + kp;
        float s = 0.f;
#pragma unroll
        for (int d = 0; d < 64; ++d) s += q[d] * bf2f(P[rowk * LDP + PC_CK + kvh * 64 + d]);
        s += p.rel_bias[(int)kBucket[tpos - kp] * 8 + hq];
        const float mn = fmaxf(m, s); const float corr = __expf(m - mn); const float pe = __expf(s - mn); m = mn;
        lsum = lsum * corr + pe;
#pragma unroll
        for (int d = 0; d < 64; ++d) o[d] = o[d] * corr + pe * bf2f(P[rowk * LDP + PC_CV + kvh * 64 + d]);
    }
    const float inv = 1.0f / lsum;
#pragma unroll
    for (int d = 0; d < 64; ++d) { const size_t a = rowq * LDP + PC_CG + hq * 64 + d; P[a] = (bf16_t)f2bf(o[d] * inv * siluf_(bf2f(P[a]))); }
}
#endif
__device__ __forceinline__ void phase_mixers(const Params& p, int l, unsigned char* lds) {
    const int vb = bid_(), G = gridDim.x;
#pragma unroll 1
    for (int u = vb; u < 1024; u += G) { bpre_unit(p, l, u, lds, 0); ax1_unit(p, u, lds); }
#pragma unroll 1
    for (int u = vb; u < 256; u += G) cmma_unit(p, l, u, lds);
}
__device__ __forceinline__ void phase_scan(const Params& p, int l, unsigned char* lds) {
    const int vb = bid_();
    if (vb < 16) bscan_block(p, vb, lds, 0);
    else if (vb < 256) ax2_scan(p, 16, 240);
}
__device__ __forceinline__ void phase_ax3(const Params& p, int l, unsigned char* lds) {
#pragma unroll 1
    for (int u = bid_(); u < 1024; u += gridDim.x) ax3_unit(p, l, u, lds);
}
__device__ __forceinline__ void phase_finalize(const Params& p, int l) {
    const int tid = tid_(), lane = tid & 63, wave = tid >> 6;
    bf16_t* P = (bf16_t*)(p.ws + WS_P);
    const int hh = lane >> 4, v8 = (lane & 15) * 8;
    float wa[8], wb[8];
#pragma unroll
    for (int e = 0; e < 8; ++e) { wa[e] = p.norm_a[l * 128 + v8 + e]; wb[e] = p.norm_b[l * 128 + v8 + e]; }
    const int gw = bid_() * 8 + wave, NGW = gridDim.x * 8;
    for (int m = gw; m < M; m += NGW) {
        bf16_t* pr = P + (size_t)m * LDP;
#pragma unroll
        for (int br = 1; br < 2; ++br) {
            const int ocol = br == 0 ? PC_AI + hh * 128 + v8 : PC_BQKV + 1024 + hh * 128 + v8;
            const int gcol = br == 0 ? PC_AG + hh * 128 + v8 : PC_BZ + hh * 128 + v8;
            const u32x4 ov = *(const u32x4*)(pr + ocol); const u32x4 gv = *(const u32x4*)(pr + gcol);
            float o[8] = {bf_lo(ov.x), bf_hi(ov.x), bf_lo(ov.y), bf_hi(ov.y), bf_lo(ov.z), bf_hi(ov.z), bf_lo(ov.w), bf_hi(ov.w)};
            float gt[8] = {bf_lo(gv.x), bf_hi(gv.x), bf_lo(gv.y), bf_hi(gv.y), bf_lo(gv.z), bf_hi(gv.z), bf_lo(gv.w), bf_hi(gv.w)};
            float ss = 0.f;
#pragma unroll
            for (int e = 0; e < 8; ++e) ss += o[e] * o[e];
            ss = row16_sum(ss);
            const float rs = 1.0f / sqrtf(ss * (1.0f / 128.0f) + EPS);
            float y[8];
#pragma unroll
            for (int e = 0; e < 8; ++e) y[e] = o[e] * rs * (br == 0 ? wa[e] : wb[e]) * siluf_(gt[e]);
            u32x4 yo; yo.x = pk2(y[0], y[1]); yo.y = pk2(y[2], y[3]); yo.z = pk2(y[4], y[5]); yo.w = pk2(y[6], y[7]);
            *(u32x4*)(pr + gcol) = yo;
        }
    }
}

__device__ __forceinline__ int launder_i(int v) { asm volatile("" : "+s"(v)); return v; }
__device__ __forceinline__ Params launder(Params p) {
    asm volatile("" : "+s"(p.x), "+s"(p.norm_w), "+s"(p.w_in), "+s"(p.conv_w), "+s"(p.a_log), "+s"(p.dt_bias), "+s"(p.lb_param), "+s"(p.norm_a));
    asm volatile("" : "+s"(p.norm_b), "+s"(p.sinks), "+s"(p.rel_bias), "+s"(p.w_branch), "+s"(p.w_out), "+s"(p.final_norm), "+s"(p.out), "+s"(p.ws));
    return p;
}
__global__ void __launch_bounds__(NTHREADS, 2) fwd_megakernel(Params p) {
    extern __shared__ __attribute__((aligned(16))) unsigned char lds[];
    cg::grid_group grid = cg::this_grid();
#pragma unroll 1
    for (int l0 = 0; l0 < DEPTH; ++l0) {
        { const Params q = launder(p); const int l = launder_i(l0); phase_convert_weights(q, l, lds); }
        __syncthreads();
        { const Params q = launder(p); const int l = launder_i(l0); phase_rowpass<0>(q, (l == 0) ? q.x : q.out, q.norm_w + (size_t)l * D, l, lds); }
        grid.sync();
        { const Params q = launder(p); const int l = launder_i(l0); phase_inproj(q, l, lds); }
        grid.sync();
        { const Params q = launder(p); const int l = launder_i(l0); phase_mixers(q, l, lds); }
        grid.sync();
        { const Params q = launder(p); const int l = launder_i(l0); phase_scan(q, l, lds); }
        grid.sync();
        { const Params q = launder(p); const int l = launder_i(l0); phase_ax3(q, l, lds); }
        { const Params q = launder(p); const int l = launder_i(l0); phase_finalize(q, l); }
        grid.sync();
        { const Params q = launder(p); phase_gates(q, lds); }
        grid.sync();
        { const Params q = launder(p); phase_lift(q, lds); }
        grid.sync();
        { const Params q = launder(p); const int l = launder_i(l0); phase_outproj(q, (l == 0) ? q.x : q.out, lds); }
        grid.sync();
    }
    { const Params q = launder(p); phase_rowpass<1>(q, q.out, q.final_norm, 0, lds); }
}

extern "C" void kernel_launch(void* const* d_in, const int* in_sizes, int n_in, void* d_out, int out_size, void* d_ws, size_t ws_size, hipStream_t stream) {
    static int grid_blocks = 0;
    if (grid_blocks == 0) {
        if (n_in != 14 || in_sizes[0] != M * D || out_size != M * D || ws_size < WS_END) {
            fprintf(stderr, "kernel_launch: unexpected shapes n_in=%d in0=%d out=%d ws=%zu (need %zu)\n", n_in, n_in > 0 ? in_sizes[0] : -1, out_size, ws_size, (size_t)WS_END); grid_blocks = -1; return; }
        int dev = 0, cus = 0, per_cu = 0;
        hipGetDevice(&dev);
        hipDeviceGetAttribute(&cus, hipDeviceAttributeMultiprocessorCount, dev);
        hipFuncSetAttribute((const void*)fwd_megakernel, hipFuncAttributeMaxDynamicSharedMemorySize, LDS_BYTES);
        hipOccupancyMaxActiveBlocksPerMultiprocessor(&per_cu, (const void*)fwd_megakernel, NTHREADS, LDS_BYTES);
        if (per_cu < 1) { fprintf(stderr, "kernel_launch: occupancy query says %d blocks/CU\n", per_cu); per_cu = 1; }
        if (per_cu > 1) per_cu = 1;
        grid_blocks = cus * per_cu;
        if (grid_blocks < 256) { fprintf(stderr, "kernel_launch: needs >= 256 resident blocks, got %d\n", grid_blocks); grid_blocks = -1; return; }
    }
    if (grid_blocks < 0) return;
    Params p{};
    p.x = (const float*)d_in[0]; p.norm_w = (const float*)d_in[1]; p.w_in = (const float*)d_in[2]; p.conv_w = (const float*)d_in[3];
    p.a_log = (const float*)d_in[4]; p.dt_bias = (const float*)d_in[5]; p.lb_param = (const float*)d_in[6]; p.norm_a = (const float*)d_in[7];
    p.norm_b = (const float*)d_in[8]; p.sinks = (const float*)d_in[9]; p.rel_bias = (const float*)d_in[10]; p.w_branch = (const float*)d_in[11];
    p.w_out = (const float*)d_in[12]; p.final_norm = (const float*)d_in[13];
    p.out = (float*)d_out; p.ws = (unsigned char*)d_ws;
    void* args[] = {&p};
    hipError_t e = hipLaunchCooperativeKernel((const void*)fwd_megakernel, dim3(grid_blocks), dim3(NTHREADS), args, LDS_BYTES, stream);
    if (e != hipSuccess) fprintf(stderr, "cooperative launch failed: %s (grid %d)\n", hipGetErrorString(e), grid_blocks);
}
```

```cpp
#include <hip/hip_runtime.h>
#include <hip/hip_cooperative_groups.h>
#include <cstdio>
#include <cstdint>
namespace cg = cooperative_groups;

typedef unsigned short bf16_t;
typedef short bf16x8 __attribute__((ext_vector_type(8)));
typedef float f32x4 __attribute__((ext_vector_type(4)));
typedef float f32x2 __attribute__((ext_vector_type(2)));
typedef unsigned u32x4 __attribute__((ext_vector_type(4)));
typedef unsigned u32x2 __attribute__((ext_vector_type(2)));
typedef __bf16 bf16x2v __attribute__((ext_vector_type(2)));

constexpr int BATCH = 4, SEQ = 4096, M = BATCH * SEQ, D = 1024, DEPTH = 2;
constexpr int NORIG = 8456;
constexpr int NMIX = 5376;
constexpr int NGATE = 3072;
constexpr int NALL = NMIX + NGATE;
constexpr int LDP = NMIX;
constexpr int PC_AQ = 0, PC_AI = 1024, PC_AG = 1536, PC_BQKV = 2048, PC_BZ = 3584, PC_CQ = 4096, PC_CK = 4608, PC_CV = 4736, PC_CG = 4864;
constexpr float EPS = 1e-6f;
constexpr int NTHREADS = 512;
constexpr int LDS_BYTES = 155648;
#define DIAG_ZERO_C 0
#define DIAG_NAIVE_C 0
#define DIAG_DUP 0
#define DIAG_DRYMODE 1
#define DIAG_DRY 1

constexpr size_t WS_P = 0;
constexpr size_t WS_AF = WS_P + (size_t)M * LDP * 2;
constexpr size_t WS_HB = WS_AF + (size_t)M * 512 * 4;
constexpr size_t WS_WIN = WS_HB + (size_t)M * D * 2;
constexpr size_t WS_WB = WS_WIN + (size_t)NALL * D * 2;
constexpr size_t WS_WO = WS_WB + (size_t)D * 1536 * 2;
constexpr size_t WS_SM = WS_WO + (size_t)D * D * 2;
constexpr size_t WS_HALO = WS_SM + (size_t)M * 8 * 4;
constexpr size_t WS_GC = WS_HALO + (size_t)256 * 3 * 1536 * 2;
constexpr size_t WS_DEC = WS_GC + (size_t)M * 4 * 4;
constexpr size_t WS_BAR = WS_DEC + (size_t)1024 * 128 * 4;
constexpr size_t WS_QK = WS_BAR + 16384;
constexpr size_t WS_END = WS_QK + (size_t)1024 * 2560 * 2;

__device__ const unsigned char kBucket[128] = {0, 1, 2, 3, 4, 5, 6, 7, 8, 9, 10, 11, 12, 13, 14, 15, 16, 16, 16, 17, 17, 18, 18, 18, 19, 19, 19, 20, 20, 20, 20, 21, 21, 21, 21, 22, 22, 22, 22, 22, 23, 23, 23, 23, 23, 23, 24, 24, 24, 24, 24, 24, 25, 25, 25, 25, 25, 25, 25, 26, 26, 26, 26, 26, 26, 26, 26, 27, 27, 27, 27, 27, 27, 27, 27, 27, 27, 28, 28, 28, 28, 28, 28, 28, 28, 28, 28, 29, 29, 29, 29, 29, 29, 29, 29, 29, 29, 29, 29, 30, 30, 30, 30, 30, 30, 30, 30, 30, 30, 30, 30, 30, 30, 31, 31, 31, 31, 31, 31, 31, 31, 31, 31, 31, 31, 31, 31, 31};

struct Params {
    const float* x; const float* norm_w; const float* w_in; const float* conv_w; const float* a_log; const float* dt_bias;
    const float* lb_param; const float* norm_a; const float* norm_b; const float* sinks; const float* rel_bias;
    const float* w_branch; const float* w_out; const float* final_norm;
    float* out; unsigned char* ws;
};

__device__ __forceinline__ unsigned f2bf(float f) { unsigned u = __builtin_bit_cast(unsigned, f); return (u + 0x7fffu + ((u >> 16) & 1u)) >> 16; }
__device__ __forceinline__ unsigned pk2(float lo, float hi) { const f32x2 v = {lo, hi}; const bf16x2v b = __builtin_convertvector(v, bf16x2v); return __builtin_bit_cast(unsigned, b); }
__device__ __forceinline__ float bf_lo(unsigned u) { return __builtin_bit_cast(float, u << 16); }
__device__ __forceinline__ float bf_hi(unsigned u) { return __builtin_bit_cast(float, u & 0xffff0000u); }
__device__ __forceinline__ float bf2f(bf16_t b) { return __builtin_bit_cast(float, (unsigned)b << 16); }
__device__ __forceinline__ int tid_() { int t = threadIdx.x; asm volatile("" : "+v"(t)); return t; }
__device__ __forceinline__ int bid_() { int b = blockIdx.x; asm volatile("" : "+s"(b)); return b; }
__device__ __forceinline__ float dot2u(unsigned k, unsigned q, float acc) { return __builtin_amdgcn_fdot2_f32_bf16(__builtin_bit_cast(bf16x2v, k), __builtin_bit_cast(bf16x2v, q), acc, false); }
__device__ __forceinline__ float sigmoidf_(float x) { return __builtin_amdgcn_rcpf(1.0f + __expf(-x)); }
__device__ __forceinline__ float siluf_(float x) { return x * __builtin_amdgcn_rcpf(1.0f + __expf(-x)); }
template <int CTRL> __device__ __forceinline__ float dpp_mov(float x) { return __builtin_bit_cast(float, __builtin_amdgcn_mov_dpp(__builtin_bit_cast(int, x), CTRL, 0xf, 0xf, true)); }
__device__ __forceinline__ float row16_sum(float x) { x += dpp_mov<0xB1>(x); x += dpp_mov<0x4E>(x); x += dpp_mov<0x141>(x); x += dpp_mov<0x128>(x); return x; }
__device__ __forceinline__ float xor16_sum(float x) { auto s = __builtin_amdgcn_permlane16_swap(__float_as_uint(x), __float_as_uint(x), false, false); return __uint_as_float(s[0]) + __uint_as_float(s[1]); }
__device__ __forceinline__ float xor32_sum(float x) { auto s = __builtin_amdgcn_permlane32_swap(__float_as_uint(x), __float_as_uint(x), false, false); return __uint_as_float(s[0]) + __uint_as_float(s[1]); }
__device__ __forceinline__ float wave_sum(float x) { return xor32_sum(xor16_sum(row16_sum(x))); }

__device__ __forceinline__ void transpose_item(const float* W, int ldsrc, int k0, int nsrc0, bf16_t* WT, int ldd, int ndst0, int kdst0, float* scr, int lane) {
#pragma unroll 8
    for (int i = 0; i < 32; ++i) { const int kk = 2 * i + (lane >> 5); scr[kk * 33 + (lane & 31)] = W[(size_t)(k0 + kk) * ldsrc + nsrc0 + (lane & 31)]; }
    __builtin_amdgcn_wave_barrier();
    asm volatile("s_waitcnt lgkmcnt(0)" ::: "memory");
    const int c = lane & 7;
#pragma unroll
    for (int j = 0; j < 4; ++j) { const int n = (lane >> 3) + 8 * j; const float* s = scr + (8 * c) * 33 + n;
        u32x4 o; o.x = pk2(s[0 * 33], s[1 * 33]); o.y = pk2(s[2 * 33], s[3 * 33]); o.z = pk2(s[4 * 33], s[5 * 33]); o.w = pk2(s[6 * 33], s[7 * 33]);
        *(u32x4*)(WT + (size_t)(ndst0 + n) * ldd + kdst0 + k0 + 8 * c) = o; }
    asm volatile("s_waitcnt lgkmcnt(0)" ::: "memory");
    __builtin_amdgcn_wave_barrier();
}
__device__ __forceinline__ void phase_convert_weights(const Params& p, int l, unsigned char* lds) {
    const int tid = tid_(), lane = tid & 63, wave = tid >> 6;
    float* scr = (float*)(lds) + wave * (64 * 33);
    bf16_t* WinT = (bf16_t*)(p.ws + WS_WIN); bf16_t* WbT = (bf16_t*)(p.ws + WS_WB); bf16_t* WoT = (bf16_t*)(p.ws + WS_WO);
    const float* win = p.w_in + (size_t)l * D * NORIG; const float* wbr = p.w_branch + (size_t)l * 3 * 512 * D; const float* wo = p.w_out + (size_t)l * D * D;
    constexpr int I_IN = (D / 64) * (NALL / 32), I_B = (512 / 64) * (D / 32), I_O = (D / 64) * (D / 32);
    constexpr int NITEMS = I_IN + 3 * I_B + I_O;
    const int gw = bid_() * 8 + wave, NGW = gridDim.x * 8;
    for (int it = gw; it < NITEMS; it += NGW) {
        int r = it;
        if (r < I_IN) { const int nb = r % (NALL / 32), kb = r / (NALL / 32); const int n0 = nb * 32; const int ns = n0 < 4096 ? n0 : n0 + 8;
            transpose_item(win, NORIG, kb * 64, ns, WinT, D, n0, 0, scr, lane); continue; }
        r -= I_IN;
        if (r < 3 * I_B) { const int br = r / I_B; const int q = r % I_B; const int nb = q % (D / 32), kb = q / (D / 32);
            transpose_item(wbr + (size_t)br * 512 * D, D, kb * 64, nb * 32, WbT, 1536, nb * 32, br * 512, scr, lane); continue; }
        r -= 3 * I_B;
        { const int nb = r % (D / 32), kb = r / (D / 32); transpose_item(wo, D, kb * 64, nb * 32, WoT, D, nb * 32, 0, scr, lane); }
    }
}

template <int MODE>
__device__ __forceinline__ void phase_rowpass(const Params& p, const float* xin, const float* nw, int l, unsigned char* lds) {
    const int tid = tid_(), lane = tid & 63, wave = tid >> 6;
    float* wsm = (float*)lds;
    if (MODE == 0) {
        const float* win = p.w_in + (size_t)l * D * NORIG;
        for (int i = tid; i < 8 * D; i += NTHREADS) { const int k = i >> 3, e = i & 7; wsm[e * D + k] = win[(size_t)k * NORIG + 4096 + e]; }
        __syncthreads();
    }
    bf16_t* hb = (bf16_t*)(p.ws + WS_HB); float* sm8 = (float*)(p.ws + WS_SM);
    const int gw = bid_() * 8 + wave, NGW = gridDim.x * 8;
    f32x4 wv[4];
#pragma unroll
    for (int j = 0; j < 4; ++j) wv[j] = *(const f32x4*)(nw + 256 * j + 4 * lane);
    for (int m = gw; m < M; m += NGW) {
        const float* xr = xin + (size_t)m * D;
        f32x4 v[4]; float s = 0.f;
#pragma unroll
        for (int j = 0; j < 4; ++j) { v[j] = *(const f32x4*)(xr + 256 * j + 4 * lane); s += (v[j].x * v[j].x + v[j].y * v[j].y) + (v[j].z * v[j].z + v[j].w * v[j].w); }
        const float rstd = 1.0f / sqrtf(wave_sum(s) * (1.0f / D) + EPS);
#pragma unroll
        for (int j = 0; j < 4; ++j) v[j] = v[j] * rstd * wv[j];
        if (MODE == 1) {
            float* orow = p.out + (size_t)m * D;
#pragma unroll
            for (int j = 0; j < 4; ++j) *(f32x4*)(orow + 256 * j + 4 * lane) = v[j];
        } else {
            bf16_t* hr = hb + (size_t)m * D;
#pragma unroll
            for (int j = 0; j < 4; ++j) { u32x2 o; o.x = pk2(v[j].x, v[j].y); o.y = pk2(v[j].z, v[j].w); *(u32x2*)(hr + 256 * j + 4 * lane) = o; }
            float acc8[8];
#pragma unroll
            for (int e = 0; e < 8; ++e) { float a = 0.f;
#pragma unroll
                for (int j = 0; j < 4; ++j) { const f32x4 w4 = *(const f32x4*)(wsm + e * D + 256 * j + 4 * lane); a += (v[j].x * w4.x + v[j].y * w4.y) + (v[j].z * w4.z + v[j].w * w4.w); }
                acc8[e] = wave_sum(a); }
            if (lane == 0) { *(f32x4*)(sm8 + (size_t)m * 8) = (f32x4){acc8[0], acc8[1], acc8[2], acc8[3]}; *(f32x4*)(sm8 + (size_t)m * 8 + 4) = (f32x4){acc8[4], acc8[5], acc8[6], acc8[7]}; }
        }
    }
}

namespace pg8 {
#define PG8_LAS __attribute__((address_space(3)))
constexpr int BM = 256, BK = 64, HALF = 128, HTB = HALF * BK * 2  , STAGE_BYTES = 8 * HTB, NXCD = 8, WGM = 8;

__host__ __device__ __forceinline__ int lds_byte(int r, int c) { const int st = (r >> 4) * 2 + (c >> 5), rr = r & 15, cc = c & 31, ob = rr * 64 + cc * 2; return st * 1024 + (ob ^ (((ob >> 9) & 1) << 5)); }
__host__ __device__ __forceinline__ void stage_rc(int b, int& R, int& C) { const int st = b / 1024, sb = b % 1024, swz = sb ^ (((sb >> 9) & 1) << 5); R = (st >> 1) * 16 + swz / 64; C = (st & 1) * 32 + (swz % 64) / 2; }
__host__ __device__ __forceinline__ int perm32(int rho) { const int n = rho >> 4, i = rho & 15; return 8 * (i >> 2) + 4 * n + (i & 3); }

struct Unit { int pm, pn, kb; };
struct Gemm { const bf16_t* A; const bf16_t* Bt; int lda, ldb, K; };
struct SegNone { static __device__ __forceinline__ int a(int) { return 0; } static __device__ __forceinline__ int b(int) { return 0; } };
struct StaticOrder {
    int nM, nN, nwg, G, c, nseg;
    __device__ void init(int M_, int N_, int G_, int c_, int nseg_) { nM = M_ / BM; nN = N_ / BM; nwg = nM * nN; G = G_; c = c_; nseg = nseg_; }
    __device__ bool next(int i, Unit& u) const {
        const int it = i / nseg; u.kb = i - it * nseg;
        const long L = (long)it * G + c; if (L >= nwg) return false;
        int wgid = (int)L; { const int q = nwg / NXCD, r = nwg % NXCD, xcd = wgid % NXCD, off = wgid / NXCD; wgid = (xcd < r ? xcd * (q + 1) : r * (q + 1) + (xcd - r) * q) + off; }
        const int nig = WGM * nN, gid = wgid / nig, fm = gid * WGM, gsz = (nM - fm) < WGM ? (nM - fm) : WGM;
        u.pm = fm + ((wgid % nig) % gsz); u.pn = (wgid % nig) / gsz; return true;
    }
};
__device__ __forceinline__ unsigned cvt_pk_bf16(float lo, float hi) { unsigned r; asm volatile("v_cvt_pk_bf16_f32 %0, %1, %2" : "=v"(r) : "v"(lo), "v"(hi)); return r; }
template <class Epi, class Sched, class Seg, bool ALIGN_EPI = false, bool SP2 = false>
__device__ __forceinline__ void gemm_phase(PG8_LAS unsigned char* lds, const Gemm g, const Sched& S, const Epi& E) {
    const int tid = tid_(), wid = __builtin_amdgcn_readfirstlane(tid >> 6), lane = tid & 63, wr = wid >> 2, wc = wid & 3, fr = lane & 15, fq = lane >> 4;
    const int K = g.K, nt = K / BK;
    unsigned voffA[2], voffB[2];
#pragma unroll
    for (int i = 0; i < 2; ++i) { int R, C; stage_rc(tid * 16 + i * 8192, R, C); const int Rb = Epi::PERM ? ((R & ~31) + perm32(R & 31)) : R;
        voffA[i] = (unsigned)(R * g.lda + C) * 2u; voffB[i] = (unsigned)(Rb * g.ldb + C) * 2u; }
    const size_t kstep = (size_t)(BK * 2);
    const size_t hstepA = (size_t)HALF * g.lda * 2, hstepB = (size_t)HALF * g.ldb * 2;
    const size_t tstepA = 2 * hstepA, tstepB = 2 * hstepB;
    const unsigned ldsw = (unsigned)wid * 1024u;
    const int aoff = lds_byte(wr * 64 + fr, fq * 8), boff = lds_byte(wc * 32 + fr, fq * 8);
#define PG8_SA(b, h) (((b) * 2 + (h)) * HTB)
#define PG8_SB(b, h) ((4 + (b) * 2 + (h)) * HTB)
#define PG8_STAGE(bufoff, gbase, voff) do { _Pragma("unroll") for (int _i = 0; _i < 2; ++_i) \
        __builtin_amdgcn_global_load_lds((const unsigned*)((const char*)(gbase) + (voff)[_i]), (PG8_LAS unsigned*)(lds + (bufoff) + ldsw + _i * 8192), 16, 0, 0); } while (0)
#define PG8_LDA(dst, b, h) do { _Pragma("unroll") for (int m = 0; m < 4; ++m) _Pragma("unroll") for (int k = 0; k < 2; ++k) dst[m][k] = *(const PG8_LAS bf16x8*)(lds + PG8_SA(b, h) + aoff + m * 2048 + k * 1024); } while (0)
#define PG8_LDB(dst, b, h) do { _Pragma("unroll") for (int n = 0; n < 2; ++n) _Pragma("unroll") for (int k = 0; k < 2; ++k) dst[n][k] = *(const PG8_LAS bf16x8*)(lds + PG8_SB(b, h) + boff + n * 2048 + k * 1024); } while (0)
#define PG8_MMA(ai, bj, At, Bt) do { __builtin_amdgcn_s_setprio(1); _Pragma("unroll") for (int m = 0; m < 4; ++m) _Pragma("unroll") for (int n = 0; n < 2; ++n) _Pragma("unroll") for (int k = 0; k < 2; ++k) \
        acc[ai][bj][m][n] = __builtin_amdgcn_mfma_f32_16x16x32_bf16(Bt[n][k], At[m][k], acc[ai][bj][m][n], 0, 0, 0); __builtin_amdgcn_s_setprio(0); } while (0)
#define PG8_WAIT_V(n) asm volatile("s_waitcnt vmcnt(" #n ")" ::: "memory")
#define PG8_WAIT_L(n) asm volatile("s_waitcnt lgkmcnt(" #n ")" ::: "memory")
#define PG8_BAR __builtin_amdgcn_s_barrier()
#define PG8_SCHED __builtin_amdgcn_sched_barrier(0)
    Unit cur, nxt; int ui = 0;
    if (!S.next(0, cur)) return;
    f32x4 acc[2][2][4][2];
#pragma unroll
    for (int a = 0; a < 2; ++a)
#pragma unroll
        for (int b = 0; b < 2; ++b)
#pragma unroll
            for (int m = 0; m < 4; ++m)
#pragma unroll
                for (int n = 0; n < 2; ++n) acc[a][b][m][n] = (f32x4){0.f, 0.f, 0.f, 0.f};
    bf16x8 At[4][2], B0[2][2], B1[2][2];
    const char* cA = (const char*)g.A + (size_t)cur.pm * tstepA + (size_t)Seg::a(cur.kb) * 2; const char* cB = (const char*)g.Bt + (size_t)cur.pn * tstepB + (size_t)Seg::b(cur.kb) * 2;

    if constexpr (SP2) {
        PG8_STAGE(PG8_SB(0, 0), cB, voffB); PG8_STAGE(PG8_SB(0, 1), cB + hstepB, voffB); PG8_STAGE(PG8_SA(0, 0), cA, voffA); PG8_STAGE(PG8_SA(0, 1), cA + hstepA, voffA);
        if (wr == 1) PG8_BAR;
        PG8_WAIT_V(2); PG8_BAR;
        PG8_STAGE(PG8_SB(1, 0), cB + kstep, voffB); PG8_STAGE(PG8_SA(1, 0), cA + kstep, voffA); PG8_STAGE(PG8_SB(1, 1), cB + hstepB + kstep, voffB);
        PG8_WAIT_V(6); PG8_BAR;
    } else {
        PG8_STAGE(PG8_SB(0, 0), cB, voffB); PG8_STAGE(PG8_SA(0, 0), cA, voffA); PG8_STAGE(PG8_SB(0, 1), cB + hstepB, voffB); PG8_STAGE(PG8_SA(0, 1), cA + hstepA, voffA);
        if (wr == 1) PG8_BAR;
        PG8_WAIT_V(4); PG8_BAR;
        PG8_STAGE(PG8_SB(1, 0), cB + kstep, voffB); PG8_STAGE(PG8_SA(1, 0), cA + kstep, voffA); PG8_STAGE(PG8_SB(1, 1), cB + hstepB + kstep, voffB);
        PG8_WAIT_V(6); PG8_BAR;
    }
    for (;;) {
        const bool has_next = S.next(ui + 1, nxt);
        const char* nA = has_next ? (const char*)g.A + (size_t)nxt.pm * tstepA + (size_t)Seg::a(nxt.kb) * 2 : cA; const char* nB = has_next ? (const char*)g.Bt + (size_t)nxt.pn * tstepB + (size_t)Seg::b(nxt.kb) * 2 : cB;
        for (int t = 0; t < nt; t += 2) {
            const bool last = (t == nt - 2);
            const char* a1 = cA + (size_t)(t + 1) * kstep;
            const char* a2 = last ? nA : cA + (size_t)(t + 2) * kstep; const char* b2 = last ? nB : cB + (size_t)(t + 2) * kstep;
            const char* a3 = a2 + kstep; const char* b3 = b2 + kstep;

            if constexpr (SP2) {
            PG8_LDB(B0, 0, 0); PG8_LDB(B1, 0, 1); PG8_SCHED; PG8_LDA(At, 0, 0); PG8_STAGE(PG8_SA(1, 1), a1 + hstepA, voffA);
            PG8_WAIT_V(8); PG8_WAIT_L(0); PG8_BAR; PG8_MMA(0, 0, At, B0); PG8_MMA(0, 1, At, B1); PG8_BAR; PG8_SCHED;
            PG8_LDA(At, 0, 1); PG8_STAGE(PG8_SB(0, 0), b2, voffB); PG8_STAGE(PG8_SB(0, 1), b2 + hstepB, voffB); PG8_STAGE(PG8_SA(0, 0), a2, voffA);
            PG8_WAIT_V(8); PG8_WAIT_L(0); PG8_BAR; PG8_MMA(1, 0, At, B0); PG8_MMA(1, 1, At, B1); PG8_BAR; PG8_SCHED;
            PG8_LDB(B0, 1, 0); PG8_LDB(B1, 1, 1); PG8_SCHED; PG8_LDA(At, 1, 0); PG8_STAGE(PG8_SA(0, 1), a2 + hstepA, voffA);
            PG8_WAIT_V(8); PG8_WAIT_L(0); PG8_BAR; PG8_MMA(0, 0, At, B0); PG8_MMA(0, 1, At, B1); PG8_BAR; PG8_SCHED;
            PG8_LDA(At, 1, 1); PG8_STAGE(PG8_SB(1, 0), b3, voffB); PG8_STAGE(PG8_SB(1, 1), b3 + hstepB, voffB); PG8_STAGE(PG8_SA(1, 0), a3, voffA);
            PG8_WAIT_V(8); PG8_WAIT_L(0); PG8_BAR; PG8_MMA(1, 0, At, B0); PG8_MMA(1, 1, At, B1); PG8_BAR; PG8_SCHED;
            } else {
            PG8_LDB(B0, 0, 0); PG8_SCHED; PG8_LDA(At, 0, 0); PG8_STAGE(PG8_SA(1, 1), a1 + hstepA, voffA);
            PG8_WAIT_L(8); PG8_BAR; PG8_WAIT_L(0); PG8_MMA(0, 0, At, B0); PG8_BAR; PG8_SCHED;
            PG8_LDB(B1, 0, 1); PG8_STAGE(PG8_SB(0, 0), b2, voffB);
            PG8_BAR; PG8_WAIT_L(0); PG8_MMA(0, 1, At, B1); PG8_BAR;
            PG8_LDA(At, 0, 1); PG8_STAGE(PG8_SA(0, 0), a2, voffA);
            PG8_BAR; PG8_WAIT_L(0); PG8_MMA(1, 0, At, B0); PG8_BAR; PG8_SCHED;
            PG8_STAGE(PG8_SB(0, 1), b2 + hstepB, voffB);
            PG8_WAIT_V(6); PG8_BAR; PG8_MMA(1, 1, At, B1); PG8_BAR;
            PG8_LDB(B0, 1, 0); PG8_SCHED; PG8_LDA(At, 1, 0); PG8_STAGE(PG8_SA(0, 1), a2 + hstepA, voffA);
            PG8_WAIT_L(8); PG8_BAR; PG8_WAIT_L(0); PG8_MMA(0, 0, At, B0); PG8_BAR; PG8_SCHED;
            PG8_LDB(B1, 1, 1); PG8_STAGE(PG8_SB(1, 0), b3, voffB);
            PG8_BAR; PG8_WAIT_L(0); PG8_MMA(0, 1, At, B1); PG8_BAR;
            PG8_LDA(At, 1, 1); PG8_STAGE(PG8_SA(1, 0), a3, voffA);
            PG8_BAR; PG8_WAIT_L(0); PG8_MMA(1, 0, At, B0); PG8_BAR; PG8_SCHED;
            PG8_STAGE(PG8_SB(1, 1), b3 + hstepB, voffB);
            PG8_WAIT_V(6); PG8_BAR; PG8_MMA(1, 1, At, B1); PG8_BAR;
            }
        }
        if constexpr (ALIGN_EPI) { if (wr == 0) PG8_BAR; }
        const bool keep_acc = E(acc, cur, wr, wc, fr, fq);
        if (!has_next) break;
        if (!keep_acc) {
#pragma unroll
        for (int a = 0; a < 2; ++a)
#pragma unroll
            for (int b = 0; b < 2; ++b)
#pragma unroll
                for (int m = 0; m < 4; ++m)
#pragma unroll
                    for (int n = 0; n < 2; ++n) acc[a][b][m][n] = (f32x4){0.f, 0.f, 0.f, 0.f};
        }
        cur = nxt; cA = nA; cB = nB; ++ui;
        if constexpr (ALIGN_EPI) { if (wr == 1) PG8_BAR; }
    }
    PG8_WAIT_V(0);
    if constexpr (!ALIGN_EPI) { if (wr == 0) PG8_BAR; }
    PG8_BAR;
#undef PG8_SA
#undef PG8_SB
#undef PG8_STAGE
#undef PG8_LDA
#undef PG8_LDB
#undef PG8_MMA
#undef PG8_WAIT_V
#undef PG8_WAIT_L
#undef PG8_BAR
#undef PG8_SCHED
}
}

__device__ __forceinline__ bf16_t* gate_ptr(unsigned char* ws, int br, size_t row, int d) {
    if (br == 0) return (bf16_t*)(ws + WS_P) + row * LDP + d;
    if (br == 1) return (bf16_t*)(ws + WS_P) + row * LDP + 2048 + d;
    return (bf16_t*)(ws + WS_AF) + row * 1024 + d;
}
typedef f32x4 acc_t[2][2][4][2];
struct EpiInproj {
    static constexpr bool PERM = true;
    unsigned char* ws; const float* lb_param; int l;
    __device__ __forceinline__ bool operator()(acc_t& acc, const pg8::Unit& u, int wr, int wc, int fr, int fq) const {
        bf16_t* P = (bf16_t*)(ws + WS_P); float* AF = (float*)(ws + WS_AF);
        const int row0 = u.pm * 256 + wr * 64 + fr, col0 = u.pn * 256 + wc * 32 + 8 * fq;
        const int pn = u.pn;
        if (pn == 2 || pn == 3) {
            float lb[2][8];
#pragma unroll
            for (int bj = 0; bj < 2; ++bj)
#pragma unroll
                for (int e = 0; e < 8; ++e) { float v = 0.f; if (l == 1) { const int k = col0 + bj * 128 - 512 + e; v = 1.0f / (1.0f + __expf(lb_param[k] - lb_param[512 + k])); } lb[bj][e] = v; }
#pragma unroll
            for (int ai = 0; ai < 2; ++ai)
#pragma unroll
                for (int m = 0; m < 4; ++m) { float* rowp = AF + (size_t)(row0 + ai * 128 + m * 16) * 512 + (col0 - 512);
#pragma unroll
                    for (int bj = 0; bj < 2; ++bj) { const f32x4 v0 = acc[ai][bj][m][0], v1 = acc[ai][bj][m][1]; f32x4 o0, o1;
#pragma unroll
                        for (int e = 0; e < 4; ++e) { o0[e] = lb[bj][e] + (1.0f - lb[bj][e]) * sigmoidf_(v0[e]); o1[e] = lb[bj][4 + e] + (1.0f - lb[bj][4 + e]) * sigmoidf_(v1[e]); }
                        *(f32x4*)(rowp + bj * 128) = o0; *(f32x4*)(rowp + bj * 128 + 4) = o1; } }
        } else {
            const int act = pn < 2 ? 1 : ((pn == 16 || pn == 17) ? 2 : 0);
#pragma unroll
            for (int ai = 0; ai < 2; ++ai)
#pragma unroll
                for (int m = 0; m < 4; ++m) { bf16_t* rowp = P + (size_t)(row0 + ai * 128 + m * 16) * LDP + col0;
#pragma unroll
                    for (int bj = 0; bj < 2; ++bj) { f32x4 v0 = acc[ai][bj][m][0], v1 = acc[ai][bj][m][1];
                        if (act == 1) {
#pragma unroll
                            for (int e = 0; e < 4; ++e) { v0[e] = siluf_(v0[e]); v1[e] = siluf_(v1[e]); } }
                        else if (act == 2) { v0 = v0 * 0.125f; v1 = v1 * 0.125f; }
                        u32x4 w; w.x = pk2(v0[0], v0[1]); w.y = pk2(v0[2], v0[3]); w.z = pk2(v1[0], v1[1]); w.w = pk2(v1[2], v1[3]);
                        *(u32x4*)(rowp + bj * 128) = w;
                        if (pn >= 8 && pn < 14) { const int row = row0 + ai * 128 + m * 16, tc = row & 63;
                            if (tc >= 61) *(u32x4*)((bf16_t*)(ws + WS_HALO) + ((size_t)(row >> 6) * 3 + (tc - 61)) * 1536 + (col0 + bj * 128 - PC_BQKV)) = w; } } }
        }
        return false;
    }
};
struct EpiGates {
    static constexpr bool PERM = true;
    unsigned char* ws;
    __device__ __forceinline__ bool operator()(acc_t& acc, const pg8::Unit& u, int wr, int wc, int fr, int fq) const {
        const int row0 = u.pm * 256 + wr * 64 + fr, br = u.pn >> 2, d0 = (u.pn & 3) * 256 + wc * 32 + 8 * fq;
#pragma unroll
        for (int ai = 0; ai < 2; ++ai)
#pragma unroll
            for (int m = 0; m < 4; ++m) { bf16_t* rowp = gate_ptr(ws, br, (size_t)(row0 + ai * 128 + m * 16), d0);
#pragma unroll
                for (int bj = 0; bj < 2; ++bj) { const f32x4 v0 = acc[ai][bj][m][0], v1 = acc[ai][bj][m][1];
                    u32x4 w; w.x = pk2(sigmoidf_(v0[0]), sigmoidf_(v0[1])); w.y = pk2(sigmoidf_(v0[2]), sigmoidf_(v0[3])); w.z = pk2(sigmoidf_(v1[0]), sigmoidf_(v1[1])); w.w = pk2(sigmoidf_(v1[2]), sigmoidf_(v1[3]));
                    *(u32x4*)(rowp + bj * 128) = w; } }
        return false;
    }
};
struct EpiLift {
    static constexpr bool PERM = true;
    unsigned char* ws;
    __device__ __forceinline__ bool operator()(acc_t& acc, const pg8::Unit& u, int wr, int wc, int fr, int fq) const {
        bf16_t* MG = (bf16_t*)(ws + WS_HB);
        const int row0 = u.pm * 256 + wr * 64 + fr, d0 = u.pn * 256 + wc * 32 + 8 * fq, s = u.kb;
#pragma unroll
        for (int ai = 0; ai < 2; ++ai)
#pragma unroll
            for (int m = 0; m < 4; ++m) { const size_t row = (size_t)(row0 + ai * 128 + m * 16);
#pragma unroll
                for (int bj = 0; bj < 2; ++bj) {
                    const u32x4 ga = *(const u32x4*)gate_ptr(ws, s, row, d0 + bj * 128);
                    f32x4 fa = (f32x4){bf_lo(ga.x), bf_hi(ga.x), bf_lo(ga.y), bf_hi(ga.y)}, fb = (f32x4){bf_lo(ga.z), bf_hi(ga.z), bf_lo(ga.w), bf_hi(ga.w)};
                    if (s < 2) { const u32x4 gb = *(const u32x4*)gate_ptr(ws, s + 1, row, d0 + bj * 128);
                        fa[0] *= __builtin_amdgcn_rcpf(fmaxf(bf_lo(gb.x), 1e-30f)); fa[1] *= __builtin_amdgcn_rcpf(fmaxf(bf_hi(gb.x), 1e-30f));
                        fa[2] *= __builtin_amdgcn_rcpf(fmaxf(bf_lo(gb.y), 1e-30f)); fa[3] *= __builtin_amdgcn_rcpf(fmaxf(bf_hi(gb.y), 1e-30f));
                        fb[0] *= __builtin_amdgcn_rcpf(fmaxf(bf_lo(gb.z), 1e-30f)); fb[1] *= __builtin_amdgcn_rcpf(fmaxf(bf_hi(gb.z), 1e-30f));
                        fb[2] *= __builtin_amdgcn_rcpf(fmaxf(bf_lo(gb.w), 1e-30f)); fb[3] *= __builtin_amdgcn_rcpf(fmaxf(bf_hi(gb.w), 1e-30f)); }
                    const f32x4 v0 = acc[ai][bj][m][0] * fa, v1 = acc[ai][bj][m][1] * fb;
                    acc[ai][bj][m][0] = v0; acc[ai][bj][m][1] = v1;
                    if (s == 2) { u32x4 w; w.x = pk2(v0[0], v0[1]); w.y = pk2(v0[2], v0[3]); w.z = pk2(v1[0], v1[1]); w.w = pk2(v1[2], v1[3]);
                        *(u32x4*)(MG + row * D + d0 + bj * 128) = w; }
                }
                asm volatile("" ::: "memory");
            }
        return s < 2;
    }
};
struct EpiOut {
    static constexpr bool PERM = false;
    const float* xin; float* out;
    __device__ __forceinline__ bool operator()(acc_t& acc, const pg8::Unit& u, int wr, int wc, int fr, int fq) const {
        const int row0 = u.pm * 256 + wr * 64 + fr, col0 = u.pn * 256 + wc * 32 + 4 * fq;
#pragma unroll
        for (int ai = 0; ai < 2; ++ai)
#pragma unroll
            for (int m = 0; m < 4; ++m) { const size_t off = (size_t)(row0 + ai * 128 + m * 16) * D + col0;
#pragma unroll
                for (int bj = 0; bj < 2; ++bj)
#pragma unroll
                    for (int n = 0; n < 2; ++n) { const f32x4 xv = *(const f32x4*)(xin + off + bj * 128 + n * 16); *(f32x4*)(out + off + bj * 128 + n * 16) = xv + acc[ai][bj][m][n]; }
                asm volatile("" ::: "memory"); }
        return false;
    }
};
struct SegLift { static __device__ __forceinline__ int a(int s) { return PC_AG + (s >= 1 ? PC_BZ - PC_AG : 0) + (s >= 2 ? PC_CG - PC_BZ : 0); } static __device__ __forceinline__ int b(int s) { return s * 512; } };
__device__ __forceinline__ void phase_inproj(const Params& p, int l, unsigned char* lds) {
    pg8::Gemm g{(const bf16_t*)(p.ws + WS_HB), (const bf16_t*)(p.ws + WS_WIN), D, D, D};
    pg8::StaticOrder S; S.init(M, NMIX, (int)gridDim.x, bid_(), 1);
    EpiInproj E{p.ws, p.lb_param, l};
    pg8::gemm_phase<EpiInproj, pg8::StaticOrder, pg8::SegNone, true, true>((PG8_LAS unsigned char*)lds, g, S, E);
}
__device__ __forceinline__ void phase_gates(const Params& p, unsigned char* lds) {
    pg8::Gemm g{(const bf16_t*)(p.ws + WS_HB), (const bf16_t*)(p.ws + WS_WIN) + (size_t)NMIX * D, D, D, D};
    pg8::StaticOrder S; S.init(M, NGATE, (int)gridDim.x, bid_(), 1);
    EpiGates E{p.ws};
    pg8::gemm_phase<EpiGates, pg8::StaticOrder, pg8::SegNone, true, true>((PG8_LAS unsigned char*)lds, g, S, E);
}
__device__ __forceinline__ void phase_lift(const Params& p, unsigned char* lds) {
    pg8::Gemm g{(const bf16_t*)(p.ws + WS_P), (const bf16_t*)(p.ws + WS_WB), LDP, 1536, 512};
    pg8::StaticOrder S; S.init(M, D, (int)gridDim.x, bid_(), 3);
    EpiLift E{p.ws};
    pg8::gemm_phase<EpiLift, pg8::StaticOrder, SegLift, false, true>((PG8_LAS unsigned char*)lds, g, S, E);
}
__device__ __forceinline__ void phase_outproj(const Params& p, const float* xin, unsigned char* lds) {
    pg8::Gemm g{(const bf16_t*)(p.ws + WS_HB), (const bf16_t*)(p.ws + WS_WO), D, D, D};
    pg8::StaticOrder S; S.init(M, D, (int)gridDim.x, bid_(), 1);
    EpiOut E{xin, p.out};
    pg8::gemm_phase<EpiOut, pg8::StaticOrder, pg8::SegNone, false, true>((PG8_LAS unsigned char*)lds, g, S, E);
}

constexpr int A_TB = 16;
__device__ __forceinline__ void mixer_a(const Params& p, int bh, int vs, unsigned char* lds, int dry) {
    const int tid = tid_(), lane = tid & 63, wave = tid >> 6, r = lane >> 4, i = lane & 15;
    const int b = bh >> 2, h = bh & 3;
    bf16_t* P = (bf16_t*)(p.ws + WS_P); const float* AF = (const float*)(p.ws + WS_AF);
    constexpr int BUF = 8192 + 8192 + 2048;
    float* obuf = (float*)(lds + 2 * BUF);
    const size_t row0 = (size_t)b * SEQ;
    const int fr_row = tid >> 5, fr_c4 = (tid & 31) * 4;
    const int q_row = tid >> 5, q_c4 = (tid & 31) * 4;
    const int i_row = (tid >> 3) & 15, i_c4 = (tid & 7) * 4;
    f32x4 pf; u32x2 pq; u32x2 pi;
    auto gload = [&](int t0) {
        pf = *(const f32x4*)(AF + (row0 + t0 + fr_row) * 512 + h * 128 + fr_c4);
        pq = *(const u32x2*)(P + (row0 + t0 + q_row) * LDP + PC_AQ + h * 128 + q_c4);
        if (tid < 128) pi = *(const u32x2*)(P + (row0 + t0 + i_row) * LDP + PC_AI + h * 128 + vs * 32 + i_c4);
    };
    auto lstore = [&](int bufi) {
        float* fb = (float*)(lds + bufi * BUF); float* qb = fb + 2048; float* ib = qb + 2048;
        *(f32x4*)(fb + fr_row * 128 + fr_c4) = pf;
        *(f32x4*)(qb + q_row * 128 + q_c4) = (f32x4){bf_lo(pq.x), bf_hi(pq.x), bf_lo(pq.y), bf_hi(pq.y)};
        if (tid < 128) *(f32x4*)(ib + i_row * 32 + i_c4) = (f32x4){bf_lo(pi.x), bf_hi(pi.x), bf_lo(pi.y), bf_hi(pi.y)};
    };
    float S[8];
#pragma unroll
    for (int j = 0; j < 8; ++j) S[j] = 0.f;
    gload(0); lstore(0); __syncthreads();
    constexpr int NB = SEQ / A_TB;
    for (int bt = 0; bt < NB; ++bt) {
        const int cur = bt & 1;
        if (bt + 1 < NB) gload((bt + 1) * A_TB);
        const float* fb = (const float*)(lds + cur * BUF); const float* qb = fb + 2048; const float* ib = qb + 2048;
#pragma unroll 4
        for (int t = 0; t < A_TB; ++t) {
            const f32x4 f0 = *(const f32x4*)(fb + t * 128 + 8 * i), f1 = *(const f32x4*)(fb + t * 128 + 8 * i + 4);
            const f32x4 q0 = *(const f32x4*)(qb + t * 128 + 8 * i), q1 = *(const f32x4*)(qb + t * 128 + 8 * i + 4);
            const float iv = ib[t * 32 + wave * 4 + r];
            float pa = 0.f, pb = 0.f;
            S[0] = iv + f0[0] * (S[0] - iv); pa += q0[0] * S[0];
            S[1] = iv + f0[1] * (S[1] - iv); pb += q0[1] * S[1];
            S[2] = iv + f0[2] * (S[2] - iv); pa += q0[2] * S[2];
            S[3] = iv + f0[3] * (S[3] - iv); pb += q0[3] * S[3];
            S[4] = iv + f1[0] * (S[4] - iv); pa += q1[0] * S[4];
            S[5] = iv + f1[1] * (S[5] - iv); pb += q1[1] * S[5];
            S[6] = iv + f1[2] * (S[6] - iv); pa += q1[2] * S[6];
            S[7] = iv + f1[3] * (S[7] - iv); pb += q1[3] * S[7];
            const float o = row16_sum(pa + pb);
            if (i == 0) obuf[t * 32 + wave * 4 + r] = o;
        }
        __syncthreads();
        if (!dry) { const int t = tid >> 5, v = tid & 31; P[(row0 + bt * A_TB + t) * LDP + PC_AI + h * 128 + vs * 32 + v] = (bf16_t)f2bf(obuf[t * 32 + v]); }
        if (bt + 1 < NB) lstore(cur ^ 1);
        __syncthreads();
    }
}

constexpr int B_TB = 16;
__device__ __forceinline__ void mixer_b(const Params& p, int l, int bh, int vs, unsigned char* lds, int dry) {
    const int tid = tid_(), lane = tid & 63, wave = tid >> 6, r = lane >> 5, i = lane & 31;
    const int b = bh >> 2, h = bh & 3;
    bf16_t* P = (bf16_t*)(p.ws + WS_P); const float* sm8 = (const float*)(p.ws + WS_SM);
    const float* cw = p.conv_w + (size_t)l * 4 * 1536;
    constexpr int RAWC = 272;
    float* raw = (float*)lds;
    float* qk = (float*)(lds + 20736);
    float* vv = (float*)(lds + 20736 + 16384);
    float* sc = (float*)(lds + 20736 + 16384 + 1024);
    float* obuf = (float*)(lds + 20736 + 16384 + 1024 + 256);
    const size_t row0 = (size_t)b * SEQ;
    const float a_coef = -__expf(p.a_log[l * 4 + h]); const float dtb = p.dt_bias[l * 4 + h];
    const int cqk = tid & 255; const int chq = cqk < 128 ? h * 128 + cqk : 512 + h * 128 + (cqk - 128);
    float wq[4]; float wvv[4];
#pragma unroll
    for (int j = 0; j < 4; ++j) { wq[j] = cw[j * 1536 + chq]; wvv[j] = cw[j * 1536 + 1024 + h * 128 + vs * 16 + (tid & 15)]; }
    for (int e = tid; e < 3 * RAWC; e += NTHREADS) raw[e] = 0.f;
    float S[4] = {0.f, 0.f, 0.f, 0.f};
    u32x4 st0, st1;
    auto chunk_addr = [&](int t0, int ck) -> const bf16_t* {
        const int row = ck / 34, c8 = ck % 34; const int ch = c8 < 16 ? h * 128 + c8 * 8 : (c8 < 32 ? 512 + h * 128 + (c8 - 16) * 8 : 1024 + h * 128 + vs * 16 + (c8 - 32) * 8);
        return P + (row0 + t0 + row) * LDP + PC_BQKV + ch; };
    auto gload = [&](int t0) { st0 = *(const u32x4*)chunk_addr(t0, tid); if (tid < 32) st1 = *(const u32x4*)chunk_addr(t0, 512 + tid); };
    auto rstore = [&]() {
        { const int row = tid / 34, c8 = tid % 34; float* d = raw + (3 + row) * RAWC + c8 * 8;
          *(f32x4*)d = (f32x4){bf_lo(st0.x), bf_hi(st0.x), bf_lo(st0.y), bf_hi(st0.y)}; *(f32x4*)(d + 4) = (f32x4){bf_lo(st0.z), bf_hi(st0.z), bf_lo(st0.w), bf_hi(st0.w)}; }
        if (tid < 32) { const int ck = 512 + tid; const int row = ck / 34, c8 = ck % 34; float* d = raw + (3 + row) * RAWC + c8 * 8;
          *(f32x4*)d = (f32x4){bf_lo(st1.x), bf_hi(st1.x), bf_lo(st1.y), bf_hi(st1.y)}; *(f32x4*)(d + 4) = (f32x4){bf_lo(st1.z), bf_hi(st1.z), bf_lo(st1.w), bf_hi(st1.w)}; }
    };
    gload(0);
    constexpr int NB = SEQ / B_TB;
    for (int bt = 0; bt < NB; ++bt) {
        const int t0 = bt * B_TB;
        __syncthreads();
        rstore();
        if (bt + 1 < NB) gload(t0 + B_TB);
        __syncthreads();
        {
            const int tb = (tid >> 8) * 8;
#pragma unroll
            for (int tt = 0; tt < 8; ++tt) { const int t = tb + tt;
                const float x = raw[(t + 0) * RAWC + cqk] * wq[0] + raw[(t + 1) * RAWC + cqk] * wq[1] + raw[(t + 2) * RAWC + cqk] * wq[2] + raw[(t + 3) * RAWC + cqk] * wq[3];
                qk[t * 256 + cqk] = siluf_(x); }
            if (tid < 256) { const int t = tid >> 4, c = tid & 15;
                const float x = raw[(t + 0) * RAWC + 256 + c] * wvv[0] + raw[(t + 1) * RAWC + 256 + c] * wvv[1] + raw[(t + 2) * RAWC + 256 + c] * wvv[2] + raw[(t + 3) * RAWC + 256 + c] * wvv[3];
                vv[t * 16 + c] = siluf_(x); }
            if (tid < 16) { const f32x4 lo = *(const f32x4*)(sm8 + (row0 + t0 + tid) * 8), hi = *(const f32x4*)(sm8 + (row0 + t0 + tid) * 8 + 4);
                const float bl = lo[h], al = hi[h]; const float xx = al + dtb; const float sp = xx > 20.f ? xx : log1pf(__expf(xx));
                sc[tid * 4 + 0] = __expf(a_coef * sp); sc[tid * 4 + 1] = sigmoidf_(bl); }
        }
        __syncthreads();
        {
            const int vec = tid >> 4, sub = tid & 15; const int t = vec >> 1, which = vec & 1;
            float* src = qk + t * 256 + which * 128 + sub * 8;
            f32x4 a0 = *(f32x4*)src, a1 = *(f32x4*)(src + 4);
            float ss = (a0[0] * a0[0] + a0[1] * a0[1]) + (a0[2] * a0[2] + a0[3] * a0[3]) + (a1[0] * a1[0] + a1[1] * a1[1]) + (a1[2] * a1[2] + a1[3] * a1[3]);
            ss = row16_sum(ss);
            float sc_ = 1.0f / sqrtf(ss + EPS); if (which == 0) sc_ *= 0.08838834764831845f;
            a0 = a0 * sc_; a1 = a1 * sc_;
            *(f32x4*)src = a0; *(f32x4*)(src + 4) = a1;
        }
        __syncthreads();
        if (tid < 256) { const int t = tid >> 4, sub = tid & 15; const float* qs = qk + t * 256 + sub * 8; const float* ks = qs + 128;
            float d = 0.f;
#pragma unroll
            for (int e = 0; e < 8; ++e) d += qs[e] * ks[e];
            d = row16_sum(d); if (sub == 0) sc[t * 4 + 2] = d; }
        __syncthreads();
#pragma unroll 2
        for (int t = 0; t < B_TB; ++t) {
            const f32x4 q4 = *(const f32x4*)(qk + t * 256 + 4 * i), k4 = *(const f32x4*)(qk + t * 256 + 128 + 4 * i);
            const f32x4 s4 = *(const f32x4*)(sc + t * 4); const float vt = vv[t * 16 + wave * 2 + r];
            const float alpha = s4[0], beta = s4[1], qkd = s4[2];
            float rk = (S[0] * k4[0] + S[1] * k4[1]) + (S[2] * k4[2] + S[3] * k4[3]);
            float rq = (S[0] * q4[0] + S[1] * q4[1]) + (S[2] * q4[2] + S[3] * q4[3]);
            rk = xor16_sum(row16_sum(rk)); rq = xor16_sum(row16_sum(rq));
            const float vn = beta * (vt - alpha * rk);
            const float o = alpha * rq + qkd * vn;
            S[0] = alpha * S[0] + k4[0] * vn; S[1] = alpha * S[1] + k4[1] * vn; S[2] = alpha * S[2] + k4[2] * vn; S[3] = alpha * S[3] + k4[3] * vn;
            if (i == 0) obuf[t * 16 + wave * 2 + r] = o;
        }
        __syncthreads();
        if (tid < 256 && !dry) { const int t = tid >> 4, c = tid & 15; P[(row0 + t0 + t) * LDP + PC_BQKV + 1024 + h * 128 + vs * 16 + c] = (bf16_t)f2bf(obuf[t * 16 + c]); }
        float hv0 = 0.f, hv1 = 0.f; const int e0 = tid, e1 = tid + 512;
        if (e0 < 3 * RAWC) hv0 = raw[16 * RAWC + e0];
        if (e1 < 3 * RAWC) hv1 = raw[16 * RAWC + e1];
        __syncthreads();
        if (e0 < 3 * RAWC) raw[e0] = hv0;
        if (e1 < 3 * RAWC) raw[e1] = hv1;
    }
}


#define LDS_BARRIER() do { asm volatile("s_waitcnt lgkmcnt(0)" ::: "memory"); __builtin_amdgcn_s_barrier(); asm volatile("" ::: "memory"); } while (0)
template <int KS> __device__ __forceinline__ f32x4 mma_tile(const bf16_t* a, int lda, const bf16_t* b, int ldb, f32x4 acc, int fr, int fq) {
#pragma unroll
    for (int ks = 0; ks < KS; ++ks) {
        const bf16x8 af = *(const bf16x8*)(a + fr * lda + ks * 32 + fq * 8);
        const bf16x8 bv = *(const bf16x8*)(b + fr * ldb + ks * 32 + fq * 8);
        acc = __builtin_amdgcn_mfma_f32_16x16x32_bf16(bv, af, acc, 0, 0, 0);
    }
    return acc;
}
__device__ __forceinline__ u32x2 pack4(f32x4 v) { u32x2 o; o.x = pk2(v[0], v[1]); o.y = pk2(v[2], v[3]); return o; }
__device__ __forceinline__ f32x4 unpack4(u32x2 u) { return (f32x4){bf_lo(u.x), bf_hi(u.x), bf_lo(u.y), bf_hi(u.y)}; }

__device__ __forceinline__ void bpre_unit(const Params& p, int l, int unit, unsigned char* lds, int dry) {
    const int tid = tid_(), lane = tid & 63, wave = tid >> 6, fr = lane & 15, fq = lane >> 4;
    const int h = unit & 3, c = (unit >> 2) & 63, b = unit >> 8;
    bf16_t* P = (bf16_t*)(p.ws + WS_P); const float* sm8 = (const float*)(p.ws + WS_SM); float* GC = (float*)(p.ws + WS_GC);
    const bf16_t* HALO = (const bf16_t*)(p.ws + WS_HALO);
    const float* cw = p.conv_w + (size_t)l * 4 * 1536;
    constexpr int RAWC = 384;
    float* raw = (float*)lds;
    float* qkf = (float*)(lds + 29184);
    bf16_t* KN = (bf16_t*)(lds + 45568);
    bf16_t* KB = (bf16_t*)(lds + 62976);
    bf16_t* XT = (bf16_t*)(lds + 80384);
    float* AM = (float*)(lds + 117248);
    bf16_t* TM = (bf16_t*)(lds + 133632);
    float* sgc = (float*)(lds + 142848); float* sbeta = sgc + 64; float* sg = sgc + 128;
    bf16_t* QNS = (bf16_t*)(lds + 117248);
    bf16_t* KT2 = (bf16_t*)lds;
    bf16_t* QKG = (bf16_t*)(p.ws + WS_QK) + (size_t)unit * 2560;
    const size_t row0 = (size_t)b * SEQ + (size_t)c * 64;
    const float a_coef = -__expf(p.a_log[l * 4 + h]); const float dtb = p.dt_bias[l * 4 + h];
    const int cqk = tid & 255; const int chq = cqk < 128 ? h * 128 + cqk : 512 + h * 128 + (cqk - 128);
    float wq[4], wvv[4];
#pragma unroll
    for (int j = 0; j < 4; ++j) { wq[j] = cw[j * 1536 + chq]; wvv[j] = cw[j * 1536 + 1024 + h * 128 + (tid & 127)]; }
    LDS_BARRIER();
    if (tid < 64) { const float bl = sm8[(row0 + tid) * 8 + h], al = sm8[(row0 + tid) * 8 + 4 + h]; const float xx = al + dtb; const float sp = xx > 20.f ? xx : log1pf(__expf(xx));
        sg[tid] = a_coef * sp; sbeta[tid] = sigmoidf_(bl); }
    for (int e = tid; e < 3 * RAWC; e += NTHREADS) { const int r = e / RAWC, ch = e % RAWC; const int chg = ch < 128 ? h * 128 + ch : (ch < 256 ? 512 + h * 128 + (ch - 128) : 1024 + h * 128 + (ch - 256));
        raw[e] = (c > 0) ? bf2f(HALO[((size_t)(b * 64 + c - 1) * 3 + r) * 1536 + chg]) : 0.f; }
    LDS_BARRIER();
    if (tid < 64) { float s0 = 0.f, s1 = 0.f;
#pragma unroll
        for (int j = 0; j < 64; j += 2) { s0 += (j <= tid) ? sg[j] : 0.f; s1 += (j + 1 <= tid) ? sg[j + 1] : 0.f; }
        const float s = s0 + s1; sgc[tid] = s; if (!dry) GC[(row0 + tid) * 4 + h] = s; }
    LDS_BARRIER();
#pragma unroll 1
    for (int sb = 0; sb < ((dry & 4) ? 1 : 4); ++sb) {
        const int t0 = sb * 16;
        for (int ck = tid; ck < 768; ck += NTHREADS) { const int row = ck / 48, c8 = ck % 48;
            const int chg = c8 < 16 ? h * 128 + c8 * 8 : (c8 < 32 ? 512 + h * 128 + (c8 - 16) * 8 : 1024 + h * 128 + (c8 - 32) * 8);
            const u32x4 v = *(const u32x4*)(P + (row0 + t0 + row) * LDP + PC_BQKV + chg); float* d = raw + (3 + row) * RAWC + c8 * 8;
            *(f32x4*)d = (f32x4){bf_lo(v.x), bf_hi(v.x), bf_lo(v.y), bf_hi(v.y)}; *(f32x4*)(d + 4) = (f32x4){bf_lo(v.z), bf_hi(v.z), bf_lo(v.w), bf_hi(v.w)}; }
        LDS_BARRIER();
        { const int tb = (tid >> 8) * 8;
#pragma unroll
          for (int tt = 0; tt < 8; ++tt) { const int t = tb + tt;
              const float x = raw[(t + 0) * RAWC + cqk] * wq[0] + raw[(t + 1) * RAWC + cqk] * wq[1] + raw[(t + 2) * RAWC + cqk] * wq[2] + raw[(t + 3) * RAWC + cqk] * wq[3];
              qkf[t * 256 + cqk] = siluf_(x); }
          const int cv = tid & 127, tq = (tid >> 7) * 4;
#pragma unroll
          for (int tt = 0; tt < 4; ++tt) { const int t = tq + tt;
              const float x = raw[(t + 0) * RAWC + 256 + cv] * wvv[0] + raw[(t + 1) * RAWC + 256 + cv] * wvv[1] + raw[(t + 2) * RAWC + 256 + cv] * wvv[2] + raw[(t + 3) * RAWC + 256 + cv] * wvv[3];
              XT[cv * 72 + t0 + t] = (bf16_t)f2bf(siluf_(x) * sbeta[t0 + t]); } }
        LDS_BARRIER();
        {
          const int vec = tid >> 4, sub = tid & 15; const int t = vec >> 1, which = vec & 1;
          const float* src = qkf + t * 256 + which * 128 + sub * 8;
          f32x4 a0 = *(const f32x4*)src, a1 = *(const f32x4*)(src + 4);
          float ss = (a0[0] * a0[0] + a0[1] * a0[1]) + (a0[2] * a0[2] + a0[3] * a0[3]) + (a1[0] * a1[0] + a1[1] * a1[1]) + (a1[2] * a1[2] + a1[3] * a1[3]);
          ss = row16_sum(ss);
          float sc_ = 1.0f / sqrtf(ss + EPS); if (which == 0) sc_ *= 0.08838834764831845f;
          a0 = a0 * sc_; a1 = a1 * sc_;
          u32x4 pk; pk.x = pk2(a0[0], a0[1]); pk.y = pk2(a0[2], a0[3]); pk.z = pk2(a1[0], a1[1]); pk.w = pk2(a1[2], a1[3]);
          bf16_t* grow = P + (row0 + t0 + t) * LDP + PC_BQKV + h * 128 + sub * 8;
          if (which == 0) { *(u32x4*)(QNS + (t0 + t) * 128 + ((sub ^ ((t0 + t) & 15)) * 8)) = pk;
              const float eg = __expf(sgc[t0 + t]);
              u32x4 pq; pq.x = pk2(a0[0] * eg, a0[1] * eg); pq.y = pk2(a0[2] * eg, a0[3] * eg); pq.z = pk2(a1[0] * eg, a1[1] * eg); pq.w = pk2(a1[2] * eg, a1[3] * eg);
              if (!dry) *(u32x4*)grow = pq; }
          else { *(u32x4*)(KN + (t0 + t) * 136 + sub * 8) = pk;
              const float bt = sbeta[t0 + t];
              u32x4 pb; pb.x = pk2(a0[0] * bt, a0[1] * bt); pb.y = pk2(a0[2] * bt, a0[3] * bt); pb.z = pk2(a1[0] * bt, a1[1] * bt); pb.w = pk2(a1[2] * bt, a1[3] * bt);
              *(u32x4*)(KB + (t0 + t) * 136 + sub * 8) = pb; } }
        float hv[3];
#pragma unroll
        for (int k2 = 0; k2 < 3; ++k2) { const int e = tid + k2 * 512; hv[k2] = (e < 3 * RAWC) ? raw[16 * RAWC + e] : 0.f; }
        LDS_BARRIER();
#pragma unroll
        for (int k2 = 0; k2 < 3; ++k2) { const int e = tid + k2 * 512; if (e < 3 * RAWC) raw[e] = hv[k2]; }
    }
    LDS_BARRIER();
    {
      const int t = tid & 63, d0 = (tid >> 6) * 16; const float eg = __expf(sgc[t]);
#pragma unroll
      for (int hlf = 0; hlf < 2; ++hlf) { const u32x4 kv = *(const u32x4*)(KB + t * 136 + d0 + hlf * 8); bf16_t* xt = XT + (128 + d0 + hlf * 8) * 72 + t;
          const unsigned k0 = pk2(bf_lo(kv.x) * eg, bf_hi(kv.x) * eg), k1 = pk2(bf_lo(kv.y) * eg, bf_hi(kv.y) * eg), k2 = pk2(bf_lo(kv.z) * eg, bf_hi(kv.z) * eg), k3 = pk2(bf_lo(kv.w) * eg, bf_hi(kv.w) * eg);
          xt[0 * 72] = (bf16_t)(k0 & 0xffffu); xt[1 * 72] = (bf16_t)(k0 >> 16); xt[2 * 72] = (bf16_t)(k1 & 0xffffu); xt[3 * 72] = (bf16_t)(k1 >> 16);
          xt[4 * 72] = (bf16_t)(k2 & 0xffffu); xt[5 * 72] = (bf16_t)(k2 >> 16); xt[6 * 72] = (bf16_t)(k3 & 0xffffu); xt[7 * 72] = (bf16_t)(k3 >> 16); }
      const float rg = __expf(sgc[63] - sgc[t]);
#pragma unroll
      for (int hlf = 0; hlf < 2; ++hlf) { const u32x4 kv = *(const u32x4*)(KN + t * 136 + d0 + hlf * 8); bf16_t* xt = KT2 + (d0 + hlf * 8) * 72 + t;
          const unsigned k0 = pk2(bf_lo(kv.x) * rg, bf_hi(kv.x) * rg), k1 = pk2(bf_lo(kv.y) * rg, bf_hi(kv.y) * rg), k2 = pk2(bf_lo(kv.z) * rg, bf_hi(kv.z) * rg), k3 = pk2(bf_lo(kv.w) * rg, bf_hi(kv.w) * rg);
          xt[0 * 72] = (bf16_t)(k0 & 0xffffu); xt[1 * 72] = (bf16_t)(k0 >> 16); xt[2 * 72] = (bf16_t)(k1 & 0xffffu); xt[3 * 72] = (bf16_t)(k1 >> 16);
          xt[4 * 72] = (bf16_t)(k2 & 0xffffu); xt[5 * 72] = (bf16_t)(k2 >> 16); xt[6 * 72] = (bf16_t)(k3 & 0xffffu); xt[7 * 72] = (bf16_t)(k3 >> 16); } }
#pragma unroll
    for (int i2 = 0; i2 < 2; ++i2) { const int ti = 2 * wave + i2, tm = ti >> 2, tn = ti & 3;
        if (tn <= tm) { const int qrow = tm * 16 + fr; f32x4 acc = (f32x4){0.f, 0.f, 0.f, 0.f};
#pragma unroll
            for (int ks = 0; ks < 4; ++ks) acc = __builtin_amdgcn_mfma_f32_16x16x32_bf16(*(const bf16x8*)(KN + (tn * 16 + fr) * 136 + ks * 32 + fq * 8), *(const bf16x8*)(QNS + qrow * 128 + (((ks * 4 + fq) ^ (qrow & 15)) * 8)), acc, 0, 0, 0);
            const int s0 = tn * 16 + 4 * fq; const float gt = sgc[qrow]; f32x4 o;
#pragma unroll
            for (int e = 0; e < 4; ++e) o[e] = (s0 + e <= qrow) ? acc[e] * __expf(gt - sgc[s0 + e]) : 0.f;
            if (!dry) *(u32x2*)(QKG + (tm * (tm + 1) / 2 + tn) * 256 + fr * 16 + 4 * fq) = pack4(o); } }
    LDS_BARRIER();
#pragma unroll
    for (int i2 = 0; i2 < 2; ++i2) { const int ti = 2 * wave + i2, tm = ti >> 2, tn = ti & 3;
        if (tn <= tm) { f32x4 acc = mma_tile<4>(KB + tm * 16 * 136, 136, KN + tn * 16 * 136, 136, (f32x4){0.f, 0.f, 0.f, 0.f}, fr, fq);
            const int t = tm * 16 + fr, s0 = tn * 16 + 4 * fq; const float gt = sgc[t]; f32x4 o;
#pragma unroll
            for (int e = 0; e < 4; ++e) o[e] = (s0 + e < t) ? acc[e] * __expf(gt - sgc[s0 + e]) : 0.f;
            *(f32x4*)(AM + t * 64 + s0) = o; } }
    LDS_BARRIER();
    if (wave == 0 && !(dry & 2)) {
        float Tc[64];
        int amo = 0; asm volatile("" : "+v"(amo));
#pragma unroll
        for (int t = 0; t < 64; ++t) { float ac4[4] = {0.f, 0.f, 0.f, 0.f};
#pragma unroll
            for (int s4 = 0; s4 < (t + 3) / 4; ++s4) { const f32x4 a = *(const f32x4*)(AM + amo + t * 64 + 4 * s4);
#pragma unroll
                for (int e = 0; e < 4; ++e) if (4 * s4 + e < t) ac4[e] += a[e] * Tc[4 * s4 + e]; }
            const float acc = (ac4[0] + ac4[1]) + (ac4[2] + ac4[3]);
            int ln = lane; asm volatile("" : "+v"(ln));
            Tc[t] = ((t == ln) ? 1.f : 0.f) - acc;
            TM[t * 72 + ln] = (bf16_t)f2bf(Tc[t]); }
    }
    LDS_BARRIER();
#pragma unroll
    for (int i2 = 0; i2 < 2; ++i2) { const int nt = 2 * wave + i2;
#pragma unroll
        for (int mt = 0; mt < 4; ++mt) {
            if (nt >= 8) { const f32x4 acc = mma_tile<2>(TM + mt * 16 * 72, 72, XT + nt * 16 * 72, 72, (f32x4){0.f, 0.f, 0.f, 0.f}, fr, fq);
                const int t = mt * 16 + fr, d = (nt - 8) * 16 + 4 * fq;
                if (!dry) *(u32x2*)(P + (row0 + t) * LDP + 512 + h * 128 + d) = pack4(acc); }
            else { const f32x4 acc = mma_tile<2>(XT + nt * 16 * 72, 72, TM + mt * 16 * 72, 72, (f32x4){0.f, 0.f, 0.f, 0.f}, fr, fq);
                const int v = nt * 16 + fr, t = mt * 16 + 4 * fq;
                if (!dry) *(u32x2*)(P + (row0 + (v >> 1)) * LDP + PC_BQKV + 1024 + h * 128 + (v & 1) * 64 + t) = pack4(acc); } } }
#pragma unroll
    for (int i2 = 0; i2 < 2; ++i2) { const int ck = tid + 512 * i2, k = ck >> 3, c8 = (ck & 7) * 8;
        const u32x4 v = *(const u32x4*)(KT2 + k * 72 + c8);
        if (!dry) *(u32x4*)(P + (row0 + (k >> 1)) * LDP + PC_BQKV + 512 + h * 128 + (k & 1) * 64 + c8) = v; }
}

constexpr int BS_NV = 32;
__device__ __forceinline__ void bscan_block(const Params& p, int blk, unsigned char* lds, int dry) {
    const int tid = tid_(), lane = tid & 63, wave = tid >> 6, fr = lane & 15, fq = lane >> 4;
    const int bh = blk >> 2, v0 = (blk & 3) * BS_NV, b = bh >> 2, h = bh & 3;
    const int wv = wave & 1, wt = wave >> 1;
    bf16_t* P = (bf16_t*)(p.ws + WS_P); const float* GC = (const float*)(p.ws + WS_GC); const bf16_t* QKG = (const bf16_t*)(p.ws + WS_QK);
    bf16_t* ST = (bf16_t*)lds;
    bf16_t* Wt = (bf16_t*)(lds + 8704);
    bf16_t* QD = (bf16_t*)(lds + 26112);
    bf16_t* KDT = (bf16_t*)(lds + 43520);
    bf16_t* QK = (bf16_t*)(lds + 61952);
    bf16_t* VNT = (bf16_t*)(lds + 71168);
    bf16_t* UT = (bf16_t*)(lds + 75776);
    const size_t row0 = (size_t)b * SEQ;
    f32x4 Sacc[2];
    Sacc[0] = (f32x4){0.f, 0.f, 0.f, 0.f}; Sacc[1] = (f32x4){0.f, 0.f, 0.f, 0.f};
    LDS_BARRIER();
    for (int e = tid; e < BS_NV * 136 / 2; e += NTHREADS) ((unsigned*)ST)[e] = 0u;
    for (int e = tid; e < 64 * 72 / 2; e += NTHREADS) ((unsigned*)QK)[e] = 0u;
    u32x4 rw[2], ru, rq[2], rk[2], rqk; float rge = 0.f;
    const int qk_tile = tid >> 5, qk_tm = qk_tile < 1 ? 0 : (qk_tile < 3 ? 1 : (qk_tile < 6 ? 2 : 3)), qk_tn = qk_tile - qk_tm * (qk_tm + 1) / 2;
    bf16_t* qk_dst = QK + (qk_tm * 16 + ((tid >> 1) & 15)) * 72 + qk_tn * 16 + (tid & 1) * 8;
    auto load_g1 = [&](int c) {
#pragma unroll
        for (int i2 = 0; i2 < 2; ++i2) { const int ck = tid + 512 * i2; rw[i2] = *(const u32x4*)(P + (row0 + c * 64 + (ck >> 4)) * LDP + 512 + h * 128 + (ck & 15) * 8); }
        if (tid < 256) { const int v = v0 + (tid >> 3); ru = *(const u32x4*)(P + (row0 + c * 64 + (v >> 1)) * LDP + PC_BQKV + 1024 + h * 128 + (v & 1) * 64 + (tid & 7) * 8); } };
    auto load_g2 = [&](int c) {
#pragma unroll
        for (int i2 = 0; i2 < 2; ++i2) { const int ck = tid + 512 * i2;
            rq[i2] = *(const u32x4*)(P + (row0 + c * 64 + (ck >> 4)) * LDP + PC_BQKV + h * 128 + (ck & 15) * 8);
            const int k = ck >> 3; rk[i2] = *(const u32x4*)(P + (row0 + c * 64 + (k >> 1)) * LDP + PC_BQKV + 512 + h * 128 + (k & 1) * 64 + (ck & 7) * 8); }
        if (tid < 320) rqk = *(const u32x4*)(QKG + (size_t)((b * 64 + c) * 4 + h) * 2560 + tid * 8);
        rge = GC[(row0 + c * 64 + 63) * 4 + h]; };
    auto store_g1 = [&]() {
#pragma unroll
        for (int i2 = 0; i2 < 2; ++i2) { const int ck = tid + 512 * i2; *(u32x4*)(Wt + (ck >> 4) * 136 + (ck & 15) * 8) = rw[i2]; }
        if (tid < 256) *(u32x4*)(UT + (tid >> 3) * 72 + (tid & 7) * 8) = ru; };
    float ge = 1.f;
    auto store_g2 = [&]() {
#pragma unroll
        for (int i2 = 0; i2 < 2; ++i2) { const int ck = tid + 512 * i2;
            *(u32x4*)(QD + (ck >> 4) * 136 + (ck & 15) * 8) = rq[i2]; *(u32x4*)(KDT + (ck >> 3) * 72 + (ck & 7) * 8) = rk[i2]; }
        if (tid < 320) *(u32x4*)qk_dst = rqk;
        ge = __expf(rge); };
#define LDFRAG(base, row, pitch, ks) (*(const bf16x8*)((base) + (row) * (pitch) + (ks) * 32 + fq * 8))
#define MFMA16(bfrag, afrag, acc) __builtin_amdgcn_mfma_f32_16x16x32_bf16(bfrag, afrag, acc, 0, 0, 0)
    load_g1(0); load_g2(0);
    LDS_BARRIER();
    store_g1(); load_g1(1);
    const int vrow = 16 * wv + fr;
#pragma unroll 1
    for (int c = 0; c < 64; ++c) {
        LDS_BARRIER();
        store_g2(); if (c + 1 < 64) load_g2(c + 1);
        bf16x8 sfr[4];
#pragma unroll
        for (int ks = 0; ks < 4; ++ks) sfr[ks] = LDFRAG(ST, vrow, 136, ks);
        { f32x4 acc = (f32x4){0.f, 0.f, 0.f, 0.f};
#pragma unroll
          for (int ks = 0; ks < 4; ++ks) acc = MFMA16(LDFRAG(Wt, wt * 16 + fr, 136, ks), sfr[ks], acc);
          const f32x4 u4 = unpack4(*(const u32x2*)(UT + vrow * 72 + wt * 16 + 4 * fq));
          *(u32x2*)(VNT + vrow * 72 + wt * 16 + 4 * fq) = pack4(u4 - acc); }
        LDS_BARRIER();
        if (c + 1 < 64) { store_g1(); if (c + 2 < 64) load_g1(c + 2); }
        bf16x8 vfr[2];
#pragma unroll
        for (int ks = 0; ks < 2; ++ks) vfr[ks] = LDFRAG(VNT, vrow, 72, ks);
        { f32x4 acc = (f32x4){0.f, 0.f, 0.f, 0.f};
#pragma unroll
          for (int ks = 0; ks < 4; ++ks) acc = MFMA16(sfr[ks], LDFRAG(QD, wt * 16 + fr, 136, ks), acc);
#pragma unroll
          for (int ks = 0; ks < 2; ++ks) acc = MFMA16(vfr[ks], LDFRAG(QK, wt * 16 + fr, 72, ks), acc);
          if (!dry) *(u32x2*)(P + (row0 + c * 64 + wt * 16 + fr) * LDP + PC_BQKV + 1024 + h * 128 + v0 + 16 * wv + 4 * fq) = pack4(acc); }
#pragma unroll
        for (int i2 = 0; i2 < 2; ++i2) { const int kt = 2 * wt + i2; f32x4 acc = Sacc[i2] * ge;
#pragma unroll
            for (int ks = 0; ks < 2; ++ks) acc = MFMA16(LDFRAG(KDT, kt * 16 + fr, 72, ks), vfr[ks], acc);
            Sacc[i2] = acc;
            *(u32x2*)(ST + vrow * 136 + kt * 16 + 4 * fq) = pack4(acc); }
    }
#undef LDFRAG
#undef MFMA16
}

__device__ __forceinline__ unsigned char* a_state_row(unsigned char* ws, size_t row0, int h, int v) {
    return ws + WS_AF + (row0 + (size_t)(v >> 1)) * 2048 + (size_t)h * 512 + (size_t)(v & 1) * 256;
}
__device__ __forceinline__ void ax1_unit(const Params& p, int unit, unsigned char* lds, int dry) {
    const int tid = tid_(), lane = tid & 63, wave = tid >> 6, fr = lane & 15, fq = lane >> 4;
    const int h = unit & 3, c = (unit >> 2) & 63, b = unit >> 8;
    bf16_t* P = (bf16_t*)(p.ws + WS_P); const float* AF = (const float*)(p.ws + WS_AF); float* DEC = (float*)(p.ws + WS_DEC);
    constexpr int BP = 132;
    float* BF = (float*)lds;
    bf16_t* QM = (bf16_t*)(lds + 33792);
    bf16_t* KM = (bf16_t*)(lds + 51200);
    bf16_t* KET = (bf16_t*)(lds + 68608);
    bf16_t* VT = (bf16_t*)(lds + 87040);
    bf16_t* SC = (bf16_t*)(lds + 105472);
    const size_t row0 = (size_t)b * SEQ + (size_t)c * 64;
    const int rA = tid >> 3, cA = (tid & 7) * 16;
    const int tB = tid & 63, cB = (tid >> 6) * 16;
    LDS_BARRIER();
    f32x4 fA[4];
#pragma unroll
    for (int i = 0; i < 4; ++i) { fA[i] = *(const f32x4*)(AF + (row0 + rA) * 512 + h * 128 + cA + 4 * i);
        *(f32x4*)(BF + rA * BP + cA + 4 * i) = (f32x4){__logf(fA[i][0]), __logf(fA[i][1]), __logf(fA[i][2]), __logf(fA[i][3])}; }
    f32x4 fB[4]; u32x4 vB[2];
#pragma unroll
    for (int i = 0; i < 4; ++i) fB[i] = *(const f32x4*)(AF + (row0 + tB) * 512 + h * 128 + cB + 4 * i);
#pragma unroll
    for (int i = 0; i < 2; ++i) vB[i] = *(const u32x4*)(P + (row0 + tB) * LDP + PC_AI + h * 128 + cB + 8 * i);
    u32x4 qA[2];
#pragma unroll
    for (int i = 0; i < 2; ++i) qA[i] = *(const u32x4*)(P + (row0 + rA) * LDP + PC_AQ + h * 128 + cA + 8 * i);
    LDS_BARRIER();
    if (tid < 128) { float s = 0.f;
#pragma unroll
        for (int t = 0; t < 64; ++t) { s += BF[t * BP + tid]; BF[t * BP + tid] = s; } }
    LDS_BARRIER();
    {
      float qv[16] = {bf_lo(qA[0].x), bf_hi(qA[0].x), bf_lo(qA[0].y), bf_hi(qA[0].y), bf_lo(qA[0].z), bf_hi(qA[0].z), bf_lo(qA[0].w), bf_hi(qA[0].w),
                      bf_lo(qA[1].x), bf_hi(qA[1].x), bf_lo(qA[1].y), bf_hi(qA[1].y), bf_lo(qA[1].z), bf_hi(qA[1].z), bf_lo(qA[1].w), bf_hi(qA[1].w)};
      unsigned wm[8], wk[8], wh[8];
#pragma unroll
      for (int i = 0; i < 4; ++i) { const f32x4 bt = *(const f32x4*)(BF + rA * BP + cA + 4 * i), bm = *(const f32x4*)(BF + 31 * BP + cA + 4 * i);
          float qm[4], km[4], qh[4];
#pragma unroll
          for (int e = 0; e < 4; ++e) { const float q = qv[4 * i + e], kk = 1.0f - fA[i][e]; qm[e] = q * __expf(bt[e] - bm[e]); km[e] = kk * __expf(bm[e] - bt[e]); qh[e] = q * __expf(bt[e]); }
          wm[2 * i] = pk2(qm[0], qm[1]); wm[2 * i + 1] = pk2(qm[2], qm[3]); wk[2 * i] = pk2(km[0], km[1]); wk[2 * i + 1] = pk2(km[2], km[3]); wh[2 * i] = pk2(qh[0], qh[1]); wh[2 * i + 1] = pk2(qh[2], qh[3]); }
      *(u32x4*)(QM + rA * 136 + cA) = (u32x4){wm[0], wm[1], wm[2], wm[3]}; *(u32x4*)(QM + rA * 136 + cA + 8) = (u32x4){wm[4], wm[5], wm[6], wm[7]};
      *(u32x4*)(KM + rA * 136 + cA) = (u32x4){wk[0], wk[1], wk[2], wk[3]}; *(u32x4*)(KM + rA * 136 + cA + 8) = (u32x4){wk[4], wk[5], wk[6], wk[7]};
      bf16_t* qg = P + (row0 + rA) * LDP + PC_AQ + h * 128 + cA;
      if (!dry) { *(u32x4*)qg = (u32x4){wh[0], wh[1], wh[2], wh[3]}; *(u32x4*)(qg + 8) = (u32x4){wh[4], wh[5], wh[6], wh[7]}; } }
    {
#pragma unroll
      for (int i = 0; i < 4; ++i) { const f32x4 bt = *(const f32x4*)(BF + tB * BP + cB + 4 * i), be = *(const f32x4*)(BF + 63 * BP + cB + 4 * i);
          const unsigned w0 = pk2((1.0f - fB[i][0]) * __expf(be[0] - bt[0]), (1.0f - fB[i][1]) * __expf(be[1] - bt[1])), w1 = pk2((1.0f - fB[i][2]) * __expf(be[2] - bt[2]), (1.0f - fB[i][3]) * __expf(be[3] - bt[3]));
          bf16_t* kt = KET + (cB + 4 * i) * 72 + tB;
          kt[0] = (bf16_t)(w0 & 0xffffu); kt[72] = (bf16_t)(w0 >> 16); kt[144] = (bf16_t)(w1 & 0xffffu); kt[216] = (bf16_t)(w1 >> 16); }
#pragma unroll
      for (int i = 0; i < 2; ++i) { bf16_t* vt = VT + (cB + 8 * i) * 72 + tB;
          vt[0 * 72] = (bf16_t)(vB[i].x & 0xffffu); vt[1 * 72] = (bf16_t)(vB[i].x >> 16); vt[2 * 72] = (bf16_t)(vB[i].y & 0xffffu); vt[3 * 72] = (bf16_t)(vB[i].y >> 16);
          vt[4 * 72] = (bf16_t)(vB[i].z & 0xffffu); vt[5 * 72] = (bf16_t)(vB[i].z >> 16); vt[6 * 72] = (bf16_t)(vB[i].w & 0xffffu); vt[7 * 72] = (bf16_t)(vB[i].w >> 16); } }
    if (tid < 128 && !dry) DEC[(size_t)unit * 128 + tid] = __expf(BF[63 * BP + tid]);
    LDS_BARRIER();
#pragma unroll
    for (int i2 = 0; i2 < 2; ++i2) { const int ti = 2 * wave + i2, tm = ti >> 2, tn = ti & 3; const int t = tm * 16 + fr, s0 = tn * 16 + 4 * fq; f32x4 o = (f32x4){0.f, 0.f, 0.f, 0.f};
        if (tn <= tm) { const f32x4 acc = mma_tile<4>(QM + tm * 16 * 136, 136, KM + tn * 16 * 136, 136, (f32x4){0.f, 0.f, 0.f, 0.f}, fr, fq);
#pragma unroll
            for (int e = 0; e < 4; ++e) o[e] = (s0 + e <= t) ? acc[e] : 0.f; }
        *(u32x2*)(SC + t * 72 + s0) = pack4(o); }
    LDS_BARRIER();
    { const int vrow = 16 * wave + fr;
      bf16x8 vfr[2];
#pragma unroll
      for (int ks = 0; ks < 2; ++ks) vfr[ks] = *(const bf16x8*)(VT + vrow * 72 + ks * 32 + fq * 8);
#pragma unroll
      for (int tt = 0; tt < 4; ++tt) { f32x4 acc = (f32x4){0.f, 0.f, 0.f, 0.f};
#pragma unroll
          for (int ks = 0; ks < 2; ++ks) acc = __builtin_amdgcn_mfma_f32_16x16x32_bf16(vfr[ks], *(const bf16x8*)(SC + (tt * 16 + fr) * 72 + ks * 32 + fq * 8), acc, 0, 0, 0);
          if (!dry) *(u32x2*)(P + (row0 + tt * 16 + fr) * LDP + PC_AI + h * 128 + 16 * wave + 4 * fq) = pack4(acc); }
      unsigned char* srow = a_state_row(p.ws, row0, h, vrow);
#pragma unroll
      for (int kt = 0; kt < 8; ++kt) { f32x4 acc = (f32x4){0.f, 0.f, 0.f, 0.f};
#pragma unroll
          for (int ks = 0; ks < 2; ++ks) acc = __builtin_amdgcn_mfma_f32_16x16x32_bf16(*(const bf16x8*)(KET + (kt * 16 + fr) * 72 + ks * 32 + fq * 8), vfr[ks], acc, 0, 0, 0);
          if (!dry) *(u32x2*)(srow + (kt * 16 + 4 * fq) * 2) = pack4(acc); } }
}
__device__ __forceinline__ void ax2_scan(const Params& p, int first_block, int nblocks, int dry) {
    const int tid = tid_(); const float* DEC = (const float*)(p.ws + WS_DEC);
    for (int gid = (bid_() - first_block) * NTHREADS + tid; gid < 16 * 8192; gid += nblocks * NTHREADS) {
        const int bh = gid >> 13, e2 = gid & 8191, v = e2 >> 6, kp = (e2 & 63) * 2, b = bh >> 2, h = bh & 3;
        float s0 = 0.f, s1 = 0.f;
#pragma unroll 1
        for (int c0 = 0; c0 < 64; c0 += 8) {
            unsigned x[8]; f32x2 d[8];
#pragma unroll
            for (int j = 0; j < 8; ++j) { const int c = c0 + j; x[j] = *(const unsigned*)(a_state_row(p.ws, (size_t)b * SEQ + (size_t)c * 64, h, v) + kp * 2); d[j] = *(const f32x2*)(DEC + ((size_t)(b * 256 + c * 4 + h)) * 128 + kp); }
#pragma unroll
            for (int j = 0; j < 8; ++j) { const int c = c0 + j; if (!dry) *(unsigned*)(a_state_row(p.ws, (size_t)b * SEQ + (size_t)c * 64, h, v) + kp * 2) = pk2(s0, s1);
                s0 = d[j].x * s0 + bf_lo(x[j]); s1 = d[j].y * s1 + bf_hi(x[j]); }
        }
    }
}
__device__ __forceinline__ void ax3_unit(const Params& p, int l, int unit, unsigned char* lds, int dry) {
    const int tid = tid_(), lane = tid & 63, wave = tid >> 6, fr = lane & 15, fq = lane >> 4;
    const int h = unit & 3, c = (unit >> 2) & 63, b = unit >> 8;
    bf16_t* P = (bf16_t*)(p.ws + WS_P);
    bf16_t* QH = (bf16_t*)lds;
    bf16_t* SI = (bf16_t*)(lds + 17408);
    float* OL = (float*)(lds + 52224);
    const size_t row0 = (size_t)b * SEQ + (size_t)c * 64;
    LDS_BARRIER();
#pragma unroll
    for (int i2 = 0; i2 < 2; ++i2) { const int ck = tid + 512 * i2, row = ck >> 4, c8 = (ck & 15) * 8;
        *(u32x4*)(QH + row * 136 + c8) = *(const u32x4*)(P + (row0 + row) * LDP + PC_AQ + h * 128 + c8); }
#pragma unroll
    for (int i2 = 0; i2 < 4; ++i2) { const int ck = tid + 512 * i2, v = ck >> 4, c8 = (ck & 15) * 8;
        *(u32x4*)(SI + v * 136 + c8) = *(const u32x4*)(a_state_row(p.ws, row0, h, v) + c8 * 2); }
    LDS_BARRIER();
    { const int vrow = 16 * wave + fr;
      bf16x8 sfr[4];
#pragma unroll
      for (int ks = 0; ks < 4; ++ks) sfr[ks] = *(const bf16x8*)(SI + vrow * 136 + ks * 32 + fq * 8);
#pragma unroll
      for (int tt = 0; tt < 4; ++tt) { const int t = tt * 16 + fr;
          f32x4 acc = unpack4(*(const u32x2*)(P + (row0 + t) * LDP + PC_AI + h * 128 + 16 * wave + 4 * fq));
#pragma unroll
          for (int ks = 0; ks < 4; ++ks) acc = __builtin_amdgcn_mfma_f32_16x16x32_bf16(sfr[ks], *(const bf16x8*)(QH + t * 136 + ks * 32 + fq * 8), acc, 0, 0, 0);
          *(f32x4*)(OL + t * 132 + 16 * wave + 4 * fq) = acc; } }
    LDS_BARRIER();
    { const int t = tid >> 3, v0 = (tid & 7) * 16;
      f32x4 o[4]; float ss = 0.f;
#pragma unroll
      for (int i = 0; i < 4; ++i) { o[i] = *(const f32x4*)(OL + t * 132 + v0 + 4 * i); ss += (o[i][0] * o[i][0] + o[i][1] * o[i][1]) + (o[i][2] * o[i][2] + o[i][3] * o[i][3]); }
      ss += dpp_mov<0xB1>(ss); ss += dpp_mov<0x4E>(ss); ss += dpp_mov<0x141>(ss);
      const float rs = __builtin_amdgcn_rsqf(ss * (1.0f / 128.0f) + EPS);
      bf16_t* gp = P + (row0 + t) * LDP + PC_AG + h * 128 + v0;
      const u32x4 g0 = *(const u32x4*)gp, g1 = *(const u32x4*)(gp + 8);
      const float gt[16] = {bf_lo(g0.x), bf_hi(g0.x), bf_lo(g0.y), bf_hi(g0.y), bf_lo(g0.z), bf_hi(g0.z), bf_lo(g0.w), bf_hi(g0.w), bf_lo(g1.x), bf_hi(g1.x), bf_lo(g1.y), bf_hi(g1.y), bf_lo(g1.z), bf_hi(g1.z), bf_lo(g1.w), bf_hi(g1.w)};
      unsigned w[8];
#pragma unroll
      for (int i = 0; i < 4; ++i) { const f32x4 nw = *(const f32x4*)(p.norm_a + l * 128 + v0 + 4 * i);
          const float y0 = o[i][0] * rs * nw[0] * siluf_(gt[4 * i]), y1 = o[i][1] * rs * nw[1] * siluf_(gt[4 * i + 1]), y2 = o[i][2] * rs * nw[2] * siluf_(gt[4 * i + 2]), y3 = o[i][3] * rs * nw[3] * siluf_(gt[4 * i + 3]);
          w[2 * i] = pk2(y0, y1); w[2 * i + 1] = pk2(y2, y3); }
      if (!dry) { *(u32x4*)gp = (u32x4){w[0], w[1], w[2], w[3]}; *(u32x4*)(gp + 8) = (u32x4){w[4], w[5], w[6], w[7]}; } }
}

__device__ __forceinline__ void cmma_unit(const Params& p, int l, int unit, unsigned char* lds, int dry) {
    const int tid = tid_(), lane = tid & 63, wave = tid >> 6, fr = lane & 15, fq = lane >> 4;
    const int kvh = unit & 1, nb = (unit >> 1) & 31, b = unit >> 6;
    bf16_t* P = (bf16_t*)(p.ws + WS_P);
    bf16_t* sK = (bf16_t*)lds;
    bf16_t* sVT = (bf16_t*)(lds + 36864);
    float* sBias = (float*)(lds + 70656);
    bf16_t* sP = (bf16_t*)(lds + 72704) + wave * (16 * 168);
    const size_t rowq0 = (size_t)b * SEQ + (size_t)nb * 128;
    const bool first = (nb == 0);
    LDS_BARRIER();
#pragma unroll
    for (int i2 = 0; i2 < 4; ++i2) { const int ck = tid + 512 * i2, j = ck >> 3, d8 = (ck & 7) * 8; u32x4 kv = (u32x4){0u, 0u, 0u, 0u};
        if (!first || j >= 128) kv = *(const u32x4*)(P + (rowq0 - 128 + j) * LDP + PC_CK + kvh * 64 + d8);
        *(u32x4*)(sK + j * 72 + d8) = kv; }
    { const int j = tid & 255, dh = (tid >> 8) * 32;
#pragma unroll
      for (int i = 0; i < 4; ++i) { u32x4 vv = (u32x4){0u, 0u, 0u, 0u};
          if (!first || j >= 128) vv = *(const u32x4*)(P + (rowq0 - 128 + j) * LDP + PC_CV + kvh * 64 + dh + 8 * i);
          bf16_t* vt = sVT + (dh + 8 * i) * 264 + j;
          vt[0 * 264] = (bf16_t)(vv.x & 0xffffu); vt[1 * 264] = (bf16_t)(vv.x >> 16); vt[2 * 264] = (bf16_t)(vv.y & 0xffffu); vt[3 * 264] = (bf16_t)(vv.y >> 16);
          vt[4 * 264] = (bf16_t)(vv.z & 0xffffu); vt[5 * 264] = (bf16_t)(vv.z >> 16); vt[6 * 264] = (bf16_t)(vv.w & 0xffffu); vt[7 * 264] = (bf16_t)(vv.w >> 16); } }
    { const int g = tid >> 7, dist = tid & 127; sBias[g * 128 + dist] = p.rel_bias[(int)kBucket[dist] * 8 + kvh * 4 + g]; }
    LDS_BARRIER();
    const int a = wave, kb0 = 32 * (a >> 1), qi = 16 * a + fr;
#pragma unroll 1
    for (int g = 0; g < 4; ++g) {
        const int hq = kvh * 4 + g; const size_t rowq = rowq0 + qi;
        bf16x8 qf[2];
#pragma unroll
        for (int ks = 0; ks < 2; ++ks) qf[ks] = *(const bf16x8*)(P + rowq * LDP + PC_CQ + hq * 64 + ks * 32 + fq * 8);
        f32x4 s[10];
#pragma unroll
        for (int kt = 0; kt < 10; ++kt) { f32x4 acc = (f32x4){0.f, 0.f, 0.f, 0.f};
#pragma unroll
            for (int ks = 0; ks < 2; ++ks) acc = __builtin_amdgcn_mfma_f32_16x16x32_bf16(*(const bf16x8*)(sK + (kb0 + kt * 16 + fr) * 72 + ks * 32 + fq * 8), qf[ks], acc, 0, 0, 0);
            s[kt] = acc; }
        const float sink = p.sinks[l * 8 + hq];
        float mx = sink;
#pragma unroll
        for (int kt = 0; kt < 10; ++kt)
#pragma unroll
            for (int e = 0; e < 4; ++e) { const int j = kb0 + kt * 16 + 4 * fq + e; const int dist = qi + 128 - j; const bool ok = (dist >= 0) && (dist < 128) && !(first && j < 128);
                const float v = ok ? s[kt][e] + sBias[g * 128 + (dist & 127)] : -1e30f; s[kt][e] = v; mx = fmaxf(mx, v); }
        { auto r16 = __builtin_amdgcn_permlane16_swap(__float_as_uint(mx), __float_as_uint(mx), false, false); mx = fmaxf(__uint_as_float(r16[0]), __uint_as_float(r16[1]));
          auto r32 = __builtin_amdgcn_permlane32_swap(__float_as_uint(mx), __float_as_uint(mx), false, false); mx = fmaxf(__uint_as_float(r32[0]), __uint_as_float(r32[1])); }
        float ls = 0.f;
#pragma unroll
        for (int kt = 0; kt < 10; ++kt) { f32x4 pe;
#pragma unroll
            for (int e = 0; e < 4; ++e) pe[e] = __expf(s[kt][e] - mx);
            const u32x2 pk = pack4(pe); ls += (bf_lo(pk.x) + bf_hi(pk.x)) + (bf_lo(pk.y) + bf_hi(pk.y));
            *(u32x2*)(sP + fr * 168 + kt * 16 + 4 * fq) = pk; }
        ls = xor32_sum(xor16_sum(ls)) + __expf(sink - mx);
        const float inv = __builtin_amdgcn_rcpf(ls);
        asm volatile("s_waitcnt lgkmcnt(0)" ::: "memory");
        bf16x8 pf[5];
#pragma unroll
        for (int ks = 0; ks < 5; ++ks) pf[ks] = *(const bf16x8*)(sP + fr * 168 + ks * 32 + fq * 8);
        bf16_t* gp = P + rowq * LDP + PC_CG + hq * 64;
#pragma unroll
        for (int dt = 0; dt < 4; ++dt) { f32x4 acc = (f32x4){0.f, 0.f, 0.f, 0.f};
#pragma unroll
            for (int ks = 0; ks < 5; ++ks) acc = __builtin_amdgcn_mfma_f32_16x16x32_bf16(*(const bf16x8*)(sVT + (dt * 16 + fr) * 264 + kb0 + ks * 32 + fq * 8), pf[ks], acc, 0, 0, 0);
            const f32x4 gt = unpack4(*(const u32x2*)(gp + dt * 16 + 4 * fq));
            f32x4 y;
#pragma unroll
            for (int e = 0; e < 4; ++e) y[e] = acc[e] * inv * siluf_(gt[e]);
            if (!dry) *(u32x2*)(gp + dt * 16 + 4 * fq) = pack4(y); }
        asm volatile("s_waitcnt lgkmcnt(0)" ::: "memory");
    }
}
__device__ __forceinline__ void mixer_c(const Params& p, int l, int unit, unsigned char* lds, int dry) {
    const int tid = tid_(), wave = tid >> 6;
    const int kvh = unit & 1, nb = (unit >> 1) & 31, b = unit >> 6;
    bf16_t* P = (bf16_t*)(p.ws + WS_P);
    bf16_t* sK = (bf16_t*)lds;
    bf16_t* sVT = (bf16_t*)(lds + 32768);
    float* sBias = (float*)(lds + 32768 + 64 * 264 * 2);
    constexpr int VTP = 264;
    const size_t rowq0 = (size_t)b * SEQ + (size_t)nb * 128;
    __syncthreads();
    for (int c = tid; c < 256 * 8; c += NTHREADS) {
        const int j = c >> 3, d8 = (c & 7) * 8; u32x4 kv = (u32x4){0u, 0u, 0u, 0u}, vv = (u32x4){0u, 0u, 0u, 0u};
        if (nb > 0 || j >= 128) { const size_t row = rowq0 - 128 + j; kv = *(const u32x4*)(P + row * LDP + PC_CK + kvh * 64 + d8); vv = *(const u32x4*)(P + row * LDP + PC_CV + kvh * 64 + d8); }
        *(u32x4*)(sK + j * 64 + d8) = kv;
        sVT[(d8 + 0) * VTP + j] = (bf16_t)(vv.x & 0xffff); sVT[(d8 + 1) * VTP + j] = (bf16_t)(vv.x >> 16);
        sVT[(d8 + 2) * VTP + j] = (bf16_t)(vv.y & 0xffff); sVT[(d8 + 3) * VTP + j] = (bf16_t)(vv.y >> 16);
        sVT[(d8 + 4) * VTP + j] = (bf16_t)(vv.z & 0xffff); sVT[(d8 + 5) * VTP + j] = (bf16_t)(vv.z >> 16);
        sVT[(d8 + 6) * VTP + j] = (bf16_t)(vv.w & 0xffff); sVT[(d8 + 7) * VTP + j] = (bf16_t)(vv.w >> 16);
    }
    { const int g = tid >> 7, dist = tid & 127; sBias[g * 128 + dist] = p.rel_bias[(int)kBucket[dist] * 8 + kvh * 4 + g]; }
    __syncthreads();
    const int g = tid >> 7, i = tid & 127, hq = kvh * 4 + g;
    const size_t rowq = rowq0 + i;
    unsigned qp[32];
#pragma unroll
    for (int c = 0; c < 8; ++c) { const u32x4 t = *(const u32x4*)(P + rowq * LDP + PC_CQ + hq * 64 + c * 8); qp[4 * c] = t.x; qp[4 * c + 1] = t.y; qp[4 * c + 2] = t.z; qp[4 * c + 3] = t.w; }
    float o[64];
#pragma unroll
    for (int d = 0; d < 64; ++d) o[d] = 0.f;
    const float sink = p.sinks[l * 8 + hq];
    float mrun = sink, lrun = 1.0f;
    const int jlo = 64 * (wave & 1);
    const bool first = (nb == 0);
    for (int jg = 0; jg < 24; ++jg) {
        const int j0 = jlo + jg * 8;
        float s[8];
#pragma unroll
        for (int u = 0; u < 8; ++u) {
            const int j = j0 + u; const bf16_t* kr = sK + j * 64; float a = 0.f;
#pragma unroll
            for (int c = 0; c < 8; ++c) { const u32x4 kk = *(const u32x4*)(kr + c * 8);
                a = dot2u(kk.x, qp[4 * c], a);
                a = dot2u(kk.y, qp[4 * c + 1], a);
                a = dot2u(kk.z, qp[4 * c + 2], a);
                a = dot2u(kk.w, qp[4 * c + 3], a); }
            const int dist = i + 128 - j; const bool ok = (dist >= 0) && (dist < 128) && !(first && j < 128);
            s[u] = ok ? a + sBias[g * 128 + (dist & 127)] : -1e30f;
        }
        float gm = fmaxf(fmaxf(fmaxf(s[0], s[1]), fmaxf(s[2], s[3])), fmaxf(fmaxf(s[4], s[5]), fmaxf(s[6], s[7])));
        const float mnew = fmaxf(mrun, gm); const float corr = __expf(mrun - mnew); mrun = mnew;
        float ps = 0.f; unsigned pp[4];
        float pe[8];
#pragma unroll
        for (int u = 0; u < 8; ++u) { pe[u] = __expf(s[u] - mnew); }
#pragma unroll
        for (int u = 0; u < 4; ++u) { pp[u] = pk2(pe[2 * u], pe[2 * u + 1]); ps += bf_lo(pp[u]) + bf_hi(pp[u]); }
        lrun = lrun * corr + ps;
#pragma unroll
        for (int d = 0; d < 64; ++d) {
            const u32x4 vt = *(const u32x4*)(sVT + d * VTP + j0);
            float a = o[d] * corr;
            a = dot2u(vt.x, pp[0], a);
            a = dot2u(vt.y, pp[1], a);
            a = dot2u(vt.z, pp[2], a);
            a = dot2u(vt.w, pp[3], a);
            o[d] = a;
        }
    }
    float inv = 1.0f / lrun;
#if DIAG_ZERO_C
    inv = 0.f;
#endif
    bf16_t* gp = P + rowq * LDP + PC_CG + hq * 64;
#pragma unroll
    for (int c = 0; c < 8; ++c) {
        const u32x4 gv = *(const u32x4*)(gp + c * 8); u32x4 ov;
        ov.x = pk2(o[8 * c + 0] * inv * siluf_(bf_lo(gv.x)), o[8 * c + 1] * inv * siluf_(bf_hi(gv.x)));
        ov.y = pk2(o[8 * c + 2] * inv * siluf_(bf_lo(gv.y)), o[8 * c + 3] * inv * siluf_(bf_hi(gv.y)));
        ov.z = pk2(o[8 * c + 4] * inv * siluf_(bf_lo(gv.z)), o[8 * c + 5] * inv * siluf_(bf_hi(gv.z)));
        ov.w = pk2(o[8 * c + 6] * inv * siluf_(bf_lo(gv.w)), o[8 * c + 7] * inv * siluf_(bf_hi(gv.w)));
        if (!dry) *(u32x4*)(gp + c * 8) = ov;
    }
}


#if DIAG_NAIVE_C
__device__ __forceinline__ void mixer_c_naive(const Params& p, int l, int unit) {
    const int tid = tid_();
    const int kvh = unit & 1, nb = (unit >> 1) & 31, b = unit >> 6;
    bf16_t* P = (bf16_t*)(p.ws + WS_P);
    const int g = tid >> 7, i = tid & 127, hq = kvh * 4 + g;
    const size_t rowq = (size_t)b * SEQ + (size_t)nb * 128 + i;
    float q[64], o[64];
#pragma unroll
    for (int d = 0; d < 64; ++d) { q[d] = bf2f(P[rowq * LDP + PC_CQ + hq * 64 + d]); o[d] = 0.f; }
    float m = p.sinks[l * 8 + hq], lsum = 1.0f;
    const int tpos = nb * 128 + i;
    for (int kp = tpos - 127; kp <= tpos; ++kp) {
        if (kp < 0) continue;
        const size_t rowk = (size_t)b * SEQ + kp;
        float s = 0.f;
#pragma unroll
        for (int d = 0; d < 64; ++d) s += q[d] * bf2f(P[rowk * LDP + PC_CK + kvh * 64 + d]);
        s += p.rel_bias[(int)kBucket[tpos - kp] * 8 + hq];
        const float mn = fmaxf(m, s); const float corr = __expf(m - mn); const float pe = __expf(s - mn); m = mn;
        lsum = lsum * corr + pe;
#pragma unroll
        for (int d = 0; d < 64; ++d) o[d] = o[d] * corr + pe * bf2f(P[rowk * LDP + PC_CV + kvh * 64 + d]);
    }
    const float inv = 1.0f / lsum;
#pragma unroll
    for (int d = 0; d < 64; ++d) { const size_t a = rowq * LDP + PC_CG + hq * 64 + d; P[a] = (bf16_t)f2bf(o[d] * inv * siluf_(bf2f(P[a]))); }
}
#endif
__device__ __forceinline__ void phase_mixers(const Params& p, int l, unsigned char* lds, int dry, int mask) {
    const int vb = bid_(), G = gridDim.x;
#pragma unroll 1
    for (int u = vb; u < 1024; u += G) { if (mask & 2) bpre_unit(p, l, u, lds, dry); if (mask & 1) ax1_unit(p, u, lds, dry); }
    if (mask & 4) {
#pragma unroll 1
    for (int u = vb; u < 256; u += G) cmma_unit(p, l, u, lds, dry); }
}
__device__ __forceinline__ void phase_scan(const Params& p, int l, unsigned char* lds, int dry, int mask) {
    const int vb = bid_();
    if (vb < 64) { if (mask & 2) bscan_block(p, vb, lds, dry); }
    else if (vb < 256) { if (mask & 1) ax2_scan(p, 64, 192, dry); }
}
__device__ __forceinline__ void phase_ax3(const Params& p, int l, unsigned char* lds, int dry) {
#pragma unroll 1
    for (int u = bid_(); u < 1024; u += gridDim.x) ax3_unit(p, l, u, lds, dry);
}
__device__ __forceinline__ void phase_finalize(const Params& p, int l) {
    const int tid = tid_(), lane = tid & 63, wave = tid >> 6;
    bf16_t* P = (bf16_t*)(p.ws + WS_P);
    const int hh = lane >> 4, v8 = (lane & 15) * 8;
    float wa[8], wb[8];
#pragma unroll
    for (int e = 0; e < 8; ++e) { wa[e] = p.norm_a[l * 128 + v8 + e]; wb[e] = p.norm_b[l * 128 + v8 + e]; }
    const int gw = bid_() * 8 + wave, NGW = gridDim.x * 8;
    for (int m = gw; m < M; m += NGW) {
        bf16_t* pr = P + (size_t)m * LDP;
#pragma unroll
        for (int br = 1; br < 2; ++br) {
            const int ocol = br == 0 ? PC_AI + hh * 128 + v8 : PC_BQKV + 1024 + hh * 128 + v8;
            const int gcol = br == 0 ? PC_AG + hh * 128 + v8 : PC_BZ + hh * 128 + v8;
            const u32x4 ov = *(const u32x4*)(pr + ocol); const u32x4 gv = *(const u32x4*)(pr + gcol);
            float o[8] = {bf_lo(ov.x), bf_hi(ov.x), bf_lo(ov.y), bf_hi(ov.y), bf_lo(ov.z), bf_hi(ov.z), bf_lo(ov.w), bf_hi(ov.w)};
            float gt[8] = {bf_lo(gv.x), bf_hi(gv.x), bf_lo(gv.y), bf_hi(gv.y), bf_lo(gv.z), bf_hi(gv.z), bf_lo(gv.w), bf_hi(gv.w)};
            float ss = 0.f;
#pragma unroll
            for (int e = 0; e < 8; ++e) ss += o[e] * o[e];
            ss = row16_sum(ss);
            const float rs = 1.0f / sqrtf(ss * (1.0f / 128.0f) + EPS);
            float y[8];
#pragma unroll
            for (int e = 0; e < 8; ++e) y[e] = o[e] * rs * (br == 0 ? wa[e] : wb[e]) * siluf_(gt[e]);
            u32x4 yo; yo.x = pk2(y[0], y[1]); yo.y = pk2(y[2], y[3]); yo.z = pk2(y[4], y[5]); yo.w = pk2(y[6], y[7]);
            *(u32x4*)(pr + gcol) = yo;
        }
    }
}

__device__ __forceinline__ int launder_i(int v) { asm volatile("" : "+s"(v)); return v; }
__device__ __forceinline__ Params launder(Params p) {
    asm volatile("" : "+s"(p.x), "+s"(p.norm_w), "+s"(p.w_in), "+s"(p.conv_w), "+s"(p.a_log), "+s"(p.dt_bias), "+s"(p.lb_param), "+s"(p.norm_a));
    asm volatile("" : "+s"(p.norm_b), "+s"(p.sinks), "+s"(p.rel_bias), "+s"(p.w_branch), "+s"(p.w_out), "+s"(p.final_norm), "+s"(p.out), "+s"(p.ws));
    return p;
}
#define XB_TMO      128
#define XB_XCNT(j)  (256  + 64 * (j))
#define XB_XSUB(j)  (1280 + 64 * (j))
#define XB_XGEN(j)  (2304 + 64 * (j))
#define XB_TOP      3328
#define XB_TOPGEN   3392
#define XCD_BAR_WORDS 3456
#define XB_SPIN_CAP (1u << 18)

__device__ __forceinline__ unsigned xb_ld(unsigned* p)              { return __hip_atomic_load(p, __ATOMIC_RELAXED, __HIP_MEMORY_SCOPE_AGENT); }
__device__ __forceinline__ unsigned xb_add(unsigned* p, unsigned v) { return __hip_atomic_fetch_add(p, v, __ATOMIC_RELAXED, __HIP_MEMORY_SCOPE_AGENT); }
__device__ __forceinline__ unsigned xb_xcc_id() { return (unsigned)__builtin_amdgcn_s_getreg((3 << 11) | 20) & 0xFu; }
#define XB_SPIN(cond, bar) do { unsigned _sp = 0; while (cond) { __builtin_amdgcn_s_sleep(1); \
    if ((++_sp & 255u) == 0u) { if (xb_ld(&(bar)[XB_TMO])) break; if (_sp > XB_SPIN_CAP) { atomicAdd(&(bar)[XB_TMO], 1u); break; } } } } while (0)

struct XcdBarrier {
    unsigned* bar; unsigned x;
    volatile __attribute__((address_space(3))) unsigned* st;
};

__device__ __forceinline__ XcdBarrier xcd_barrier_post(unsigned* bar, volatile __attribute__((address_space(3))) unsigned* st) {
    XcdBarrier b; b.bar = bar; b.x = xb_xcc_id(); b.st = st;
    if (threadIdx.x == 0) (void)xb_add(&bar[XB_XCNT(b.x)], 1u);
    return b;
}
__device__ __forceinline__ void xcd_barrier_complete(unsigned* bar, unsigned x, unsigned& nloc, unsigned& nx) {
    const unsigned G = gridDim.x * gridDim.y * gridDim.z;
    unsigned sum, cnt, mine, sp = 0u;
    for (;;) {
        sum = 0u; cnt = 0u; mine = 0u;
#pragma unroll
        for (unsigned j = 0; j < 16; ++j) { const unsigned c = xb_ld(&bar[XB_XCNT(j)]); sum += c; cnt += (c > 0u) ? 1u : 0u; mine = (j == x) ? c : mine; }
        if (sum == G) break;
        __builtin_amdgcn_s_sleep(1);
        if ((++sp & 255u) == 0u) { if (xb_ld(&bar[XB_TMO])) break; if (sp > XB_SPIN_CAP) { atomicAdd(&bar[XB_TMO], 1u); break; } }
    }
    nloc = mine > 0u ? mine : 1u; nx = cnt > 0u ? cnt : 1u;
}

__device__ __forceinline__ void xcd_barrier(const XcdBarrier& b) {
    asm volatile("s_waitcnt vmcnt(0)" ::: "memory");
    __syncthreads();
    if (threadIdx.x == 0) {
        unsigned* bar = b.bar;
        __builtin_amdgcn_s_waitcnt(0);
        unsigned nloc = b.st[0], nx = b.st[1];
        if (nloc == 0u) { xcd_barrier_complete(bar, b.x, nloc, nx); b.st[0] = nloc; b.st[1] = nx; }
        const unsigned old = xb_add(&bar[XB_XSUB(b.x)], 1u);
        const unsigned gen = old / nloc;
        if (old + 1u == (gen + 1u) * nloc) {
            __builtin_amdgcn_fence(__ATOMIC_RELEASE, "agent");
            asm volatile("s_waitcnt vmcnt(0)" ::: "memory");
            const unsigned og = xb_add(&bar[XB_TOP], 1u);
            const unsigned tg = og / nx;
            if (og + 1u == (tg + 1u) * nx) xb_add(&bar[XB_TOPGEN], 1u);
            else XB_SPIN(xb_ld(&bar[XB_TOPGEN]) == tg, bar);
            __builtin_amdgcn_fence(__ATOMIC_ACQUIRE, "agent");
            xb_add(&bar[XB_XGEN(b.x)], 1u);
            asm volatile("s_waitcnt vmcnt(0)" ::: "memory");
        } else {
            XB_SPIN(xb_ld(&bar[XB_XGEN(b.x)]) == gen, bar);
            __builtin_amdgcn_fence(__ATOMIC_ACQUIRE, "agent");
            asm volatile("s_waitcnt vmcnt(0)" ::: "memory");
        }
    }
    __syncthreads();
}


__global__ void __launch_bounds__(NTHREADS, 2) fwd_megakernel(Params p) {
    extern __shared__ __attribute__((aligned(16))) unsigned char lds[];
    cg::grid_group grid = cg::this_grid();
    volatile __attribute__((address_space(3))) unsigned* bst = (volatile __attribute__((address_space(3))) unsigned*)((__attribute__((address_space(3))) unsigned char*)lds + (LDS_BYTES - 16));
    if (threadIdx.x < 4) bst[threadIdx.x] = 0u;
    __syncthreads();
    XcdBarrier xbar = xcd_barrier_post((unsigned*)(p.ws + WS_BAR), bst);
#define GRID_BAR() xcd_barrier(xbar)
#pragma unroll 1
    for (int l0 = 0; l0 < DEPTH; ++l0) {
        { const Params q = launder(p); const int l = launder_i(l0); phase_convert_weights(q, l, lds); }
        __syncthreads();
        { const Params q = launder(p); const int l = launder_i(l0); phase_rowpass<0>(q, (l == 0) ? q.x : q.out, q.norm_w + (size_t)l * D, l, lds); }
        grid.sync();
#if DIAG_DUP == 1
        { const Params q = launder(p); const int l = launder_i(l0); phase_convert_weights(q, l, lds); }
        __syncthreads();
        { const Params q = launder(p); const int l = launder_i(l0); phase_rowpass<0>(q, (l == 0) ? q.x : q.out, q.norm_w + (size_t)l * D, l, lds); }
        GRID_BAR();
#endif
#if DIAG_DUP == 2
        { const Params q = launder(p); const int l = launder_i(l0); phase_inproj(q, l, lds); }
        GRID_BAR();
#endif
        { const Params q = launder(p); const int l = launder_i(l0); phase_inproj(q, l, lds); }
        GRID_BAR();
#if DIAG_DUP >= 10 && DIAG_DUP < 20
        { const Params q = launder(p); const int l = launder_i(l0); phase_mixers(q, l, lds, launder_i(DIAG_DRYMODE), launder_i(DIAG_DUP - 10)); }
        GRID_BAR();
#endif
        { const Params q = launder(p); const int l = launder_i(l0); phase_mixers(q, l, lds, launder_i(0), launder_i(7)); }
        GRID_BAR();
#if DIAG_DUP >= 20 && DIAG_DUP < 30
        { const Params q = launder(p); const int l = launder_i(l0); phase_scan(q, l, lds, launder_i(1), launder_i(DIAG_DUP - 20)); }
        GRID_BAR();
#endif
        { const Params q = launder(p); const int l = launder_i(l0); phase_scan(q, l, lds, launder_i(0), launder_i(3)); }
        GRID_BAR();
#if DIAG_DUP == 3
        { const Params q = launder(p); const int l = launder_i(l0); phase_ax3(q, l, lds, launder_i(1)); }
        GRID_BAR();
#endif
        { const Params q = launder(p); const int l = launder_i(l0); phase_ax3(q, l, lds, launder_i(0)); }
        { const Params q = launder(p); const int l = launder_i(l0); phase_finalize(q, l); }
        GRID_BAR();
#if DIAG_DUP == 4
        { const Params q = launder(p); phase_gates(q, lds); }
        GRID_BAR();
#endif
        { const Params q = launder(p); phase_gates(q, lds); }
        GRID_BAR();
#if DIAG_DUP == 5
        { const Params q = launder(p); phase_lift(q, lds); }
        GRID_BAR();
#endif
        { const Params q = launder(p); phase_lift(q, lds); }
        GRID_BAR();
        { const Params q = launder(p); const int l = launder_i(l0); phase_outproj(q, (l == 0) ? q.x : q.out, lds); }
        GRID_BAR();
#if DIAG_DUP == 6
        GRID_BAR(); GRID_BAR(); GRID_BAR(); GRID_BAR(); GRID_BAR(); GRID_BAR(); GRID_BAR(); GRID_BAR(); GRID_BAR(); GRID_BAR();
#endif
    }
    { const Params q = launder(p); phase_rowpass<1>(q, q.out, q.final_norm, 0, lds); }
}

extern "C" void kernel_launch(void* const* d_in, const int* in_sizes, int n_in, void* d_out, int out_size, void* d_ws, size_t ws_size, hipStream_t stream) {
    static int grid_blocks = 0;
    if (grid_blocks == 0) {
        if (n_in != 14 || in_sizes[0] != M * D || out_size != M * D || ws_size < WS_END) {
            fprintf(stderr, "kernel_launch: unexpected shapes n_in=%d in0=%d out=%d ws=%zu (need %zu)\n", n_in, n_in > 0 ? in_sizes[0] : -1, out_size, ws_size, (size_t)WS_END); grid_blocks = -1; return; }
        int dev = 0, cus = 0, per_cu = 0;
        hipGetDevice(&dev);
        hipDeviceGetAttribute(&cus, hipDeviceAttributeMultiprocessorCount, dev);
        hipFuncSetAttribute((const void*)fwd_megakernel, hipFuncAttributeMaxDynamicSharedMemorySize, LDS_BYTES);
        hipOccupancyMaxActiveBlocksPerMultiprocessor(&per_cu, (const void*)fwd_megakernel, NTHREADS, LDS_BYTES);
        if (per_cu < 1) { fprintf(stderr, "kernel_launch: occupancy query says %d blocks/CU\n", per_cu); per_cu = 1; }
        if (per_cu > 1) per_cu = 1;
        grid_blocks = cus * per_cu;
        if (grid_blocks < 256) { fprintf(stderr, "kernel_launch: needs >= 256 resident blocks, got %d\n", grid_blocks); grid_blocks = -1; return; }
    }
    if (grid_blocks < 0) return;
    Params p{};
    p.x = (const float*)d_in[0]; p.norm_w = (const float*)d_in[1]; p.w_in = (const float*)d_in[2]; p.conv_w = (const float*)d_in[3];
    p.a_log = (const float*)d_in[4]; p.dt_bias = (const float*)d_in[5]; p.lb_param = (const float*)d_in[6]; p.norm_a = (const float*)d_in[7];
    p.norm_b = (const float*)d_in[8]; p.sinks = (const float*)d_in[9]; p.rel_bias = (const float*)d_in[10]; p.w_branch = (const float*)d_in[11];
    p.w_out = (const float*)d_in[12]; p.final_norm = (const float*)d_in[13];
    p.out = (float*)d_out; p.ws = (unsigned char*)d_ws;
    (void)hipMemsetAsync((char*)d_ws + WS_BAR, 0, 16384, stream);
    void* args[] = {&p};
    hipError_t e = hipLaunchCooperativeKernel((const void*)fwd_megakernel, dim3(grid_blocks), dim3(NTHREADS), args, LDS_BYTES, stream);
    if (e != hipSuccess) fprintf(stderr, "cooperative launch failed: %s (grid %d)\n", hipGetErrorString(e), grid_blocks);
}
```

```cpp
#include <hip/hip_runtime.h>
#include <hip/hip_cooperative_groups.h>
#include <cstdio>
#include <cstdint>
namespace cg = cooperative_groups;

typedef unsigned short bf16_t;
typedef short bf16x8 __attribute__((ext_vector_type(8)));
typedef float f32x4 __attribute__((ext_vector_type(4)));
typedef float f32x2 __attribute__((ext_vector_type(2)));
typedef unsigned u32x4 __attribute__((ext_vector_type(4)));
typedef unsigned u32x2 __attribute__((ext_vector_type(2)));
typedef __bf16 bf16x2v __attribute__((ext_vector_type(2)));

constexpr int BATCH = 4, SEQ = 4096, M = BATCH * SEQ, D = 1024, DEPTH = 2;
constexpr int NORIG = 8456;
constexpr int NMIX = 5376;
constexpr int NGATE = 3072;
constexpr int NALL = NMIX + NGATE;
constexpr int LDP = NMIX;
constexpr int PC_AQ = 0, PC_AI = 1024, PC_AG = 1536, PC_BQKV = 2048, PC_BZ = 3584, PC_CQ = 4096, PC_CK = 4608, PC_CV = 4736, PC_CG = 4864;
constexpr float EPS = 1e-6f;
constexpr int NTHREADS = 512;
constexpr int LDS_BYTES = 155648;
#define DIAG_ZERO_C 0
#define DIAG_NAIVE_C 0
#define DIAG_DUP 0
#define DIAG_DRYMODE 1
#define DIAG_DRY 1

constexpr size_t WS_P = 0;
constexpr size_t WS_AF = WS_P + (size_t)M * LDP * 2;
constexpr size_t WS_HB = WS_AF + (size_t)M * 512 * 4;
constexpr size_t WS_WIN = WS_HB + (size_t)M * D * 2;
constexpr size_t WS_WB = WS_WIN + (size_t)NALL * D * 2;
constexpr size_t WS_WO = WS_WB + (size_t)D * 1536 * 2;
constexpr size_t WS_SM = WS_WO + (size_t)D * D * 2;
constexpr size_t WS_HALO = WS_SM + (size_t)M * 8 * 4;
constexpr size_t WS_GC = WS_HALO + (size_t)256 * 3 * 1536 * 2;
constexpr size_t WS_DEC = WS_GC + (size_t)M * 4 * 4;
constexpr size_t WS_BAR = WS_DEC + (size_t)1024 * 128 * 4;
constexpr size_t WS_QK = WS_BAR + 16384;
constexpr size_t WS_END = WS_QK + (size_t)1024 * 2560 * 2;

__device__ const unsigned char kBucket[128] = {0, 1, 2, 3, 4, 5, 6, 7, 8, 9, 10, 11, 12, 13, 14, 15, 16, 16, 16, 17, 17, 18, 18, 18, 19, 19, 19, 20, 20, 20, 20, 21, 21, 21, 21, 22, 22, 22, 22, 22, 23, 23, 23, 23, 23, 23, 24, 24, 24, 24, 24, 24, 25, 25, 25, 25, 25, 25, 25, 26, 26, 26, 26, 26, 26, 26, 26, 27, 27, 27, 27, 27, 27, 27, 27, 27, 27, 28, 28, 28, 28, 28, 28, 28, 28, 28, 28, 29, 29, 29, 29, 29, 29, 29, 29, 29, 29, 29, 29, 30, 30, 30, 30, 30, 30, 30, 30, 30, 30, 30, 30, 30, 30, 31, 31, 31, 31, 31, 31, 31, 31, 31, 31, 31, 31, 31, 31, 31};

struct Params {
    const float* x; const float* norm_w; const float* w_in; const float* conv_w; const float* a_log; const float* dt_bias;
    const float* lb_param; const float* norm_a; const float* norm_b; const float* sinks; const float* rel_bias;
    const float* w_branch; const float* w_out; const float* final_norm;
    float* out; unsigned char* ws;
};

__device__ __forceinline__ unsigned f2bf(float f) { unsigned u = __builtin_bit_cast(unsigned, f); return (u + 0x7fffu + ((u >> 16) & 1u)) >> 16; }
__device__ __forceinline__ unsigned pk2(float lo, float hi) { const f32x2 v = {lo, hi}; const bf16x2v b = __builtin_convertvector(v, bf16x2v); return __builtin_bit_cast(unsigned, b); }
__device__ __forceinline__ float bf_lo(unsigned u) { return __builtin_bit_cast(float, u << 16); }
__device__ __forceinline__ float bf_hi(unsigned u) { return __builtin_bit_cast(float, u & 0xffff0000u); }
__device__ __forceinline__ float bf2f(bf16_t b) { return __builtin_bit_cast(float, (unsigned)b << 16); }
__device__ __forceinline__ int tid_() { int t = threadIdx.x; asm volatile("" : "+v"(t)); return t; }
__device__ __forceinline__ int bid_() { int b = blockIdx.x; asm volatile("" : "+s"(b)); return b; }
__device__ __forceinline__ float dot2u(unsigned k, unsigned q, float acc) { return __builtin_amdgcn_fdot2_f32_bf16(__builtin_bit_cast(bf16x2v, k), __builtin_bit_cast(bf16x2v, q), acc, false); }
__device__ __forceinline__ float sigmoidf_(float x) { return __builtin_amdgcn_rcpf(1.0f + __expf(-x)); }
__device__ __forceinline__ float siluf_(float x) { return x * __builtin_amdgcn_rcpf(1.0f + __expf(-x)); }
template <int CTRL> __device__ __forceinline__ float dpp_mov(float x) { return __builtin_bit_cast(float, __builtin_amdgcn_mov_dpp(__builtin_bit_cast(int, x), CTRL, 0xf, 0xf, true)); }
__device__ __forceinline__ float row16_sum(float x) { x += dpp_mov<0xB1>(x); x += dpp_mov<0x4E>(x); x += dpp_mov<0x141>(x); x += dpp_mov<0x128>(x); return x; }
__device__ __forceinline__ float xor16_sum(float x) { auto s = __builtin_amdgcn_permlane16_swap(__float_as_uint(x), __float_as_uint(x), false, false); return __uint_as_float(s[0]) + __uint_as_float(s[1]); }
__device__ __forceinline__ float xor32_sum(float x) { auto s = __builtin_amdgcn_permlane32_swap(__float_as_uint(x), __float_as_uint(x), false, false); return __uint_as_float(s[0]) + __uint_as_float(s[1]); }
__device__ __forceinline__ float wave_sum(float x) { return xor32_sum(xor16_sum(row16_sum(x))); }

__device__ __forceinline__ void transpose_item(const float* W, int ldsrc, int k0, int nsrc0, bf16_t* WT, int ldd, int ndst0, int kdst0, float* scr, int lane) {
    float tv[32];
#pragma unroll
    for (int i = 0; i < 32; ++i) { const int kk = 2 * i + (lane >> 5); tv[i] = W[(size_t)(k0 + kk) * ldsrc + nsrc0 + (lane & 31)]; }
#pragma unroll
    for (int i = 0; i < 32; ++i) { const int kk = 2 * i + (lane >> 5); scr[kk * 33 + (lane & 31)] = tv[i]; }
    __builtin_amdgcn_wave_barrier();
    asm volatile("s_waitcnt lgkmcnt(0)" ::: "memory");
    const int c = lane & 7;
#pragma unroll
    for (int j = 0; j < 4; ++j) { const int n = (lane >> 3) + 8 * j; const float* s = scr + (8 * c) * 33 + n;
        u32x4 o; o.x = pk2(s[0 * 33], s[1 * 33]); o.y = pk2(s[2 * 33], s[3 * 33]); o.z = pk2(s[4 * 33], s[5 * 33]); o.w = pk2(s[6 * 33], s[7 * 33]);
        *(u32x4*)(WT + (size_t)(ndst0 + n) * ldd + kdst0 + k0 + 8 * c) = o; }
    asm volatile("s_waitcnt lgkmcnt(0)" ::: "memory");
    __builtin_amdgcn_wave_barrier();
}
__device__ __forceinline__ void phase_convert_weights(const Params& p, int l, unsigned char* lds) {
    const int tid = tid_(), lane = tid & 63, wave = tid >> 6;
    float* scr = (float*)(lds) + wave * (64 * 33);
    bf16_t* WinT = (bf16_t*)(p.ws + WS_WIN); bf16_t* WbT = (bf16_t*)(p.ws + WS_WB); bf16_t* WoT = (bf16_t*)(p.ws + WS_WO);
    const float* win = p.w_in + (size_t)l * D * NORIG; const float* wbr = p.w_branch + (size_t)l * 3 * 512 * D; const float* wo = p.w_out + (size_t)l * D * D;
    constexpr int I_IN = (D / 64) * (NALL / 32), I_B = (512 / 64) * (D / 32), I_O = (D / 64) * (D / 32);
    constexpr int NITEMS = I_IN + 3 * I_B + I_O;
    const int gw = bid_() * 8 + wave, NGW = gridDim.x * 8;
    for (int it = gw; it < NITEMS; it += NGW) {
        int r = it;
        if (r < I_IN) { const int nb = r % (NALL / 32), kb = r / (NALL / 32); const int n0 = nb * 32; const int ns = n0 < 4096 ? n0 : n0 + 8;
            transpose_item(win, NORIG, kb * 64, ns, WinT, D, n0, 0, scr, lane); continue; }
        r -= I_IN;
        if (r < 3 * I_B) { const int br = r / I_B; const int q = r % I_B; const int nb = q % (D / 32), kb = q / (D / 32);
            transpose_item(wbr + (size_t)br * 512 * D, D, kb * 64, nb * 32, WbT, 1536, nb * 32, br * 512, scr, lane); continue; }
        r -= 3 * I_B;
        { const int nb = r % (D / 32), kb = r / (D / 32); transpose_item(wo, D, kb * 64, nb * 32, WoT, D, nb * 32, 0, scr, lane); }
    }
}

template <int MODE>
__device__ __forceinline__ void phase_rowpass(const Params& p, const float* xin, const float* nw, int l, unsigned char* lds) {
    const int tid = tid_(), lane = tid & 63, wave = tid >> 6;
    float* wsm = (float*)lds;
    if (MODE == 0) {
        const float* win = p.w_in + (size_t)l * D * NORIG;
        for (int i = tid; i < 8 * D; i += NTHREADS) { const int k = i >> 3, e = i & 7; wsm[e * D + k] = win[(size_t)k * NORIG + 4096 + e]; }
        __syncthreads();
    }
    bf16_t* hb = (bf16_t*)(p.ws + WS_HB); float* sm8 = (float*)(p.ws + WS_SM);
    const int gw = bid_() * 8 + wave, NGW = gridDim.x * 8;
    f32x4 wv[4];
#pragma unroll
    for (int j = 0; j < 4; ++j) wv[j] = *(const f32x4*)(nw + 256 * j + 4 * lane);
    f32x4 wr[8][4];
    if (MODE == 0) {
#pragma unroll
        for (int e = 0; e < 8; ++e)
#pragma unroll
            for (int j = 0; j < 4; ++j) wr[e][j] = *(const f32x4*)(wsm + e * D + 256 * j + 4 * lane);
    }
    f32x4 pa[4], pb[4];
#pragma unroll
    for (int j = 0; j < 4; ++j) { pa[j] = (gw < M) ? *(const f32x4*)(xin + (size_t)gw * D + 256 * j + 4 * lane) : (f32x4){0.f, 0.f, 0.f, 0.f};
        pb[j] = (gw + NGW < M) ? *(const f32x4*)(xin + (size_t)(gw + NGW) * D + 256 * j + 4 * lane) : (f32x4){0.f, 0.f, 0.f, 0.f}; }
    for (int m = gw; m < M; m += NGW) {
        f32x4 v[4]; float s = 0.f;
#pragma unroll
        for (int j = 0; j < 4; ++j) { v[j] = pa[j]; pa[j] = pb[j]; if (m + 2 * NGW < M) pb[j] = *(const f32x4*)(xin + (size_t)(m + 2 * NGW) * D + 256 * j + 4 * lane);
            s += (v[j].x * v[j].x + v[j].y * v[j].y) + (v[j].z * v[j].z + v[j].w * v[j].w); }
        const float rstd = __builtin_amdgcn_rsqf(wave_sum(s) * (1.0f / D) + EPS);
#pragma unroll
        for (int j = 0; j < 4; ++j) v[j] = v[j] * rstd * wv[j];
        if (MODE == 1) {
            float* orow = p.out + (size_t)m * D;
#pragma unroll
            for (int j = 0; j < 4; ++j) *(f32x4*)(orow + 256 * j + 4 * lane) = v[j];
        } else {
            bf16_t* hr = hb + (size_t)m * D;
#pragma unroll
            for (int j = 0; j < 4; ++j) { u32x2 o; o.x = pk2(v[j].x, v[j].y); o.y = pk2(v[j].z, v[j].w); *(u32x2*)(hr + 256 * j + 4 * lane) = o; }
            float a[8];
#pragma unroll
            for (int e = 0; e < 8; ++e) { float t = 0.f;
#pragma unroll
                for (int j = 0; j < 4; ++j) t += (v[j].x * wr[e][j].x + v[j].y * wr[e][j].y) + (v[j].z * wr[e][j].z + v[j].w * wr[e][j].w);
                a[e] = t; }
            const bool b0 = lane & 1, b1 = lane & 2;
            const float s01 = b0 ? a[1] : a[0], o01 = b0 ? a[0] : a[1], s23 = b0 ? a[3] : a[2], o23 = b0 ? a[2] : a[3];
            const float s45 = b0 ? a[5] : a[4], o45 = b0 ? a[4] : a[5], s67 = b0 ? a[7] : a[6], o67 = b0 ? a[6] : a[7];
            const float r01 = s01 + dpp_mov<0xB1>(o01), r23 = s23 + dpp_mov<0xB1>(o23), r45 = s45 + dpp_mov<0xB1>(o45), r67 = s67 + dpp_mov<0xB1>(o67);
            const float t0 = b1 ? r23 : r01, u0 = b1 ? r01 : r23, t1 = b1 ? r67 : r45, u1 = b1 ? r45 : r67;
            float q0 = t0 + dpp_mov<0x4E>(u0);
            float q1 = t1 + dpp_mov<0x4E>(u1);
            q0 += dpp_mov<0x124>(q0); q0 += dpp_mov<0x128>(q0); q1 += dpp_mov<0x124>(q1); q1 += dpp_mov<0x128>(q1);
            q0 = xor32_sum(xor16_sum(q0)); q1 = xor32_sum(xor16_sum(q1));
            if (lane < 4) { sm8[(size_t)m * 8 + lane] = q0; sm8[(size_t)m * 8 + 4 + lane] = q1; }
        }
    }
}

namespace pg8 {
#define PG8_LAS __attribute__((address_space(3)))
constexpr int BM = 256, BK = 64, HALF = 128, HTB = HALF * BK * 2  , STAGE_BYTES = 8 * HTB, NXCD = 8, WGM = 8;

__host__ __device__ __forceinline__ int lds_byte(int r, int c) { const int st = (r >> 4) * 2 + (c >> 5), rr = r & 15, cc = c & 31, ob = rr * 64 + cc * 2; return st * 1024 + (ob ^ (((ob >> 9) & 1) << 5)); }
__host__ __device__ __forceinline__ void stage_rc(int b, int& R, int& C) { const int st = b / 1024, sb = b % 1024, swz = sb ^ (((sb >> 9) & 1) << 5); R = (st >> 1) * 16 + swz / 64; C = (st & 1) * 32 + (swz % 64) / 2; }
__host__ __device__ __forceinline__ int perm32(int rho) { const int n = rho >> 4, i = rho & 15; return 8 * (i >> 2) + 4 * n + (i & 3); }

struct Unit { int pm, pn, kb; };
struct Gemm { const bf16_t* A; const bf16_t* Bt; int lda, ldb, K; };
struct SegNone { static __device__ __forceinline__ int a(int) { return 0; } static __device__ __forceinline__ int b(int) { return 0; } };
struct StaticOrder {
    int nM, nN, nwg, G, c, nseg;
    __device__ void init(int M_, int N_, int G_, int c_, int nseg_) { nM = M_ / BM; nN = N_ / BM; nwg = nM * nN; G = G_; c = c_; nseg = nseg_; }
    __device__ bool next(int i, Unit& u) const {
        const int it = i / nseg; u.kb = i - it * nseg;
        const long L = (long)it * G + c; if (L >= nwg) return false;
        int wgid = (int)L; { const int q = nwg / NXCD, r = nwg % NXCD, xcd = wgid % NXCD, off = wgid / NXCD; wgid = (xcd < r ? xcd * (q + 1) : r * (q + 1) + (xcd - r) * q) + off; }
        const int nig = WGM * nN, gid = wgid / nig, fm = gid * WGM, gsz = (nM - fm) < WGM ? (nM - fm) : WGM;
        u.pm = fm + ((wgid % nig) % gsz); u.pn = (wgid % nig) / gsz; return true;
    }
};
__device__ __forceinline__ unsigned cvt_pk_bf16(float lo, float hi) { unsigned r; asm volatile("v_cvt_pk_bf16_f32 %0, %1, %2" : "=v"(r) : "v"(lo), "v"(hi)); return r; }
template <class Epi, class Sched, class Seg, bool ALIGN_EPI = false, bool SP2 = false>
__device__ __forceinline__ void gemm_phase(PG8_LAS unsigned char* lds, const Gemm g, const Sched& S, const Epi& E) {
    const int tid = tid_(), wid = __builtin_amdgcn_readfirstlane(tid >> 6), lane = tid & 63, wr = wid >> 2, wc = wid & 3, fr = lane & 15, fq = lane >> 4;
    const int K = g.K, nt = K / BK;
    unsigned voffA[2], voffB[2];
#pragma unroll
    for (int i = 0; i < 2; ++i) { int R, C; stage_rc(tid * 16 + i * 8192, R, C); const int Rb = Epi::PERM ? ((R & ~31) + perm32(R & 31)) : R;
        voffA[i] = (unsigned)(R * g.lda + C) * 2u; voffB[i] = (unsigned)(Rb * g.ldb + C) * 2u; }
    const size_t kstep = (size_t)(BK * 2);
    const size_t hstepA = (size_t)HALF * g.lda * 2, hstepB = (size_t)HALF * g.ldb * 2;
    const size_t tstepA = 2 * hstepA, tstepB = 2 * hstepB;
    const unsigned ldsw = (unsigned)wid * 1024u;
    const int aoff = lds_byte(wr * 64 + fr, fq * 8), boff = lds_byte(wc * 32 + fr, fq * 8);
#define PG8_SA(b, h) (((b) * 2 + (h)) * HTB)
#define PG8_SB(b, h) ((4 + (b) * 2 + (h)) * HTB)
#define PG8_STAGE(bufoff, gbase, voff) do { _Pragma("unroll") for (int _i = 0; _i < 2; ++_i) \
        __builtin_amdgcn_global_load_lds((const unsigned*)((const char*)(gbase) + (voff)[_i]), (PG8_LAS unsigned*)(lds + (bufoff) + ldsw + _i * 8192), 16, 0, 0); } while (0)
#define PG8_LDA(dst, b, h) do { _Pragma("unroll") for (int m = 0; m < 4; ++m) _Pragma("unroll") for (int k = 0; k < 2; ++k) dst[m][k] = *(const PG8_LAS bf16x8*)(lds + PG8_SA(b, h) + aoff + m * 2048 + k * 1024); } while (0)
#define PG8_LDB(dst, b, h) do { _Pragma("unroll") for (int n = 0; n < 2; ++n) _Pragma("unroll") for (int k = 0; k < 2; ++k) dst[n][k] = *(const PG8_LAS bf16x8*)(lds + PG8_SB(b, h) + boff + n * 2048 + k * 1024); } while (0)
#define PG8_MMA(ai, bj, At, Bt) do { __builtin_amdgcn_s_setprio(1); _Pragma("unroll") for (int m = 0; m < 4; ++m) _Pragma("unroll") for (int n = 0; n < 2; ++n) _Pragma("unroll") for (int k = 0; k < 2; ++k) \
        acc[ai][bj][m][n] = __builtin_amdgcn_mfma_f32_16x16x32_bf16(Bt[n][k], At[m][k], acc[ai][bj][m][n], 0, 0, 0); __builtin_amdgcn_s_setprio(0); } while (0)
#define PG8_WAIT_V(n) asm volatile("s_waitcnt vmcnt(" #n ")" ::: "memory")
#define PG8_WAIT_L(n) asm volatile("s_waitcnt lgkmcnt(" #n ")" ::: "memory")
#define PG8_BAR __builtin_amdgcn_s_barrier()
#define PG8_SCHED __builtin_amdgcn_sched_barrier(0)
    Unit cur, nxt; int ui = 0;
    if (!S.next(0, cur)) return;
    f32x4 acc[2][2][4][2];
#pragma unroll
    for (int a = 0; a < 2; ++a)
#pragma unroll
        for (int b = 0; b < 2; ++b)
#pragma unroll
            for (int m = 0; m < 4; ++m)
#pragma unroll
                for (int n = 0; n < 2; ++n) acc[a][b][m][n] = (f32x4){0.f, 0.f, 0.f, 0.f};
    bf16x8 At[4][2], B0[2][2], B1[2][2];
    const char* cA = (const char*)g.A + (size_t)cur.pm * tstepA + (size_t)Seg::a(cur.kb) * 2; const char* cB = (const char*)g.Bt + (size_t)cur.pn * tstepB + (size_t)Seg::b(cur.kb) * 2;

    if constexpr (SP2) {
        PG8_STAGE(PG8_SB(0, 0), cB, voffB); PG8_STAGE(PG8_SB(0, 1), cB + hstepB, voffB); PG8_STAGE(PG8_SA(0, 0), cA, voffA); PG8_STAGE(PG8_SA(0, 1), cA + hstepA, voffA);
        if (wr == 1) PG8_BAR;
        PG8_WAIT_V(2); PG8_BAR;
        PG8_STAGE(PG8_SB(1, 0), cB + kstep, voffB); PG8_STAGE(PG8_SA(1, 0), cA + kstep, voffA); PG8_STAGE(PG8_SB(1, 1), cB + hstepB + kstep, voffB);
        PG8_WAIT_V(6); PG8_BAR;
    } else {
        PG8_STAGE(PG8_SB(0, 0), cB, voffB); PG8_STAGE(PG8_SA(0, 0), cA, voffA); PG8_STAGE(PG8_SB(0, 1), cB + hstepB, voffB); PG8_STAGE(PG8_SA(0, 1), cA + hstepA, voffA);
        if (wr == 1) PG8_BAR;
        PG8_WAIT_V(4); PG8_BAR;
        PG8_STAGE(PG8_SB(1, 0), cB + kstep, voffB); PG8_STAGE(PG8_SA(1, 0), cA + kstep, voffA); PG8_STAGE(PG8_SB(1, 1), cB + hstepB + kstep, voffB);
        PG8_WAIT_V(6); PG8_BAR;
    }
    for (;;) {
        const bool has_next = S.next(ui + 1, nxt);
        const char* nA = has_next ? (const char*)g.A + (size_t)nxt.pm * tstepA + (size_t)Seg::a(nxt.kb) * 2 : cA; const char* nB = has_next ? (const char*)g.Bt + (size_t)nxt.pn * tstepB + (size_t)Seg::b(nxt.kb) * 2 : cB;
        for (int t = 0; t < nt; t += 2) {
            const bool last = (t == nt - 2);
            const char* a1 = cA + (size_t)(t + 1) * kstep;
            const char* a2 = last ? nA : cA + (size_t)(t + 2) * kstep; const char* b2 = last ? nB : cB + (size_t)(t + 2) * kstep;
            const char* a3 = a2 + kstep; const char* b3 = b2 + kstep;

            if constexpr (SP2) {
            PG8_LDB(B0, 0, 0); PG8_LDB(B1, 0, 1); PG8_SCHED; PG8_LDA(At, 0, 0); PG8_STAGE(PG8_SA(1, 1), a1 + hstepA, voffA);
            PG8_WAIT_V(8); PG8_WAIT_L(0); PG8_BAR; PG8_MMA(0, 0, At, B0); PG8_MMA(0, 1, At, B1); PG8_BAR; PG8_SCHED;
            PG8_LDA(At, 0, 1); PG8_STAGE(PG8_SB(0, 0), b2, voffB); PG8_STAGE(PG8_SB(0, 1), b2 + hstepB, voffB); PG8_STAGE(PG8_SA(0, 0), a2, voffA);
            PG8_WAIT_V(8); PG8_WAIT_L(0); PG8_BAR; PG8_MMA(1, 0, At, B0); PG8_MMA(1, 1, At, B1); PG8_BAR; PG8_SCHED;
            PG8_LDB(B0, 1, 0); PG8_LDB(B1, 1, 1); PG8_SCHED; PG8_LDA(At, 1, 0); PG8_STAGE(PG8_SA(0, 1), a2 + hstepA, voffA);
            PG8_WAIT_V(8); PG8_WAIT_L(0); PG8_BAR; PG8_MMA(0, 0, At, B0); PG8_MMA(0, 1, At, B1); PG8_BAR; PG8_SCHED;
            PG8_LDA(At, 1, 1); PG8_STAGE(PG8_SB(1, 0), b3, voffB); PG8_STAGE(PG8_SB(1, 1), b3 + hstepB, voffB); PG8_STAGE(PG8_SA(1, 0), a3, voffA);
            PG8_WAIT_V(8); PG8_WAIT_L(0); PG8_BAR; PG8_MMA(1, 0, At, B0); PG8_MMA(1, 1, At, B1); PG8_BAR; PG8_SCHED;
            } else {
            PG8_LDB(B0, 0, 0); PG8_SCHED; PG8_LDA(At, 0, 0); PG8_STAGE(PG8_SA(1, 1), a1 + hstepA, voffA);
            PG8_WAIT_L(8); PG8_BAR; PG8_WAIT_L(0); PG8_MMA(0, 0, At, B0); PG8_BAR; PG8_SCHED;
            PG8_LDB(B1, 0, 1); PG8_STAGE(PG8_SB(0, 0), b2, voffB);
            PG8_BAR; PG8_WAIT_L(0); PG8_MMA(0, 1, At, B1); PG8_BAR;
            PG8_LDA(At, 0, 1); PG8_STAGE(PG8_SA(0, 0), a2, voffA);
            PG8_BAR; PG8_WAIT_L(0); PG8_MMA(1, 0, At, B0); PG8_BAR; PG8_SCHED;
            PG8_STAGE(PG8_SB(0, 1), b2 + hstepB, voffB);
            PG8_WAIT_V(6); PG8_BAR; PG8_MMA(1, 1, At, B1); PG8_BAR;
            PG8_LDB(B0, 1, 0); PG8_SCHED; PG8_LDA(At, 1, 0); PG8_STAGE(PG8_SA(0, 1), a2 + hstepA, voffA);
            PG8_WAIT_L(8); PG8_BAR; PG8_WAIT_L(0); PG8_MMA(0, 0, At, B0); PG8_BAR; PG8_SCHED;
            PG8_LDB(B1, 1, 1); PG8_STAGE(PG8_SB(1, 0), b3, voffB);
            PG8_BAR; PG8_WAIT_L(0); PG8_MMA(0, 1, At, B1); PG8_BAR;
            PG8_LDA(At, 1, 1); PG8_STAGE(PG8_SA(1, 0), a3, voffA);
            PG8_BAR; PG8_WAIT_L(0); PG8_MMA(1, 0, At, B0); PG8_BAR; PG8_SCHED;
            PG8_STAGE(PG8_SB(1, 1), b3 + hstepB, voffB);
            PG8_WAIT_V(6); PG8_BAR; PG8_MMA(1, 1, At, B1); PG8_BAR;
            }
        }
        if constexpr (ALIGN_EPI) { if (wr == 0) PG8_BAR; }
        const bool keep_acc = E(acc, cur, wr, wc, fr, fq);
        if (!has_next) break;
        if (!keep_acc) {
#pragma unroll
        for (int a = 0; a < 2; ++a)
#pragma unroll
            for (int b = 0; b < 2; ++b)
#pragma unroll
                for (int m = 0; m < 4; ++m)
#pragma unroll
                    for (int n = 0; n < 2; ++n) acc[a][b][m][n] = (f32x4){0.f, 0.f, 0.f, 0.f};
        }
        cur = nxt; cA = nA; cB = nB; ++ui;
        if constexpr (ALIGN_EPI) { if (wr == 1) PG8_BAR; }
    }
    PG8_WAIT_V(0);
    if constexpr (!ALIGN_EPI) { if (wr == 0) PG8_BAR; }
    PG8_BAR;
#undef PG8_SA
#undef PG8_SB
#undef PG8_STAGE
#undef PG8_LDA
#undef PG8_LDB
#undef PG8_MMA
#undef PG8_WAIT_V
#undef PG8_WAIT_L
#undef PG8_BAR
#undef PG8_SCHED
}
}

__device__ __forceinline__ bf16_t* gate_ptr(unsigned char* ws, int br, size_t row, int d) {
    if (br == 0) return (bf16_t*)(ws + WS_P) + row * LDP + d;
    if (br == 1) return (bf16_t*)(ws + WS_P) + row * LDP + 2048 + d;
    return (bf16_t*)(ws + WS_AF) + row * 1024 + d;
}
typedef f32x4 acc_t[2][2][4][2];
struct EpiInproj {
    static constexpr bool PERM = true;
    unsigned char* ws; const float* lb_param; int l;
    __device__ __forceinline__ bool operator()(acc_t& acc, const pg8::Unit& u, int wr, int wc, int fr, int fq) const {
        bf16_t* P = (bf16_t*)(ws + WS_P); float* AF = (float*)(ws + WS_AF);
        const int row0 = u.pm * 256 + wr * 64 + fr, col0 = u.pn * 256 + wc * 32 + 8 * fq;
        const int pn = u.pn;
        if (pn == 2 || pn == 3) {
            float lb[2][8];
#pragma unroll
            for (int bj = 0; bj < 2; ++bj)
#pragma unroll
                for (int e = 0; e < 8; ++e) { float v = 0.f; if (l == 1) { const int k = col0 + bj * 128 - 512 + e; v = 1.0f / (1.0f + __expf(lb_param[k] - lb_param[512 + k])); } lb[bj][e] = v; }
#pragma unroll
            for (int ai = 0; ai < 2; ++ai)
#pragma unroll
                for (int m = 0; m < 4; ++m) { float* rowp = AF + (size_t)(row0 + ai * 128 + m * 16) * 512 + (col0 - 512);
#pragma unroll
                    for (int bj = 0; bj < 2; ++bj) { const f32x4 v0 = acc[ai][bj][m][0], v1 = acc[ai][bj][m][1]; f32x4 o0, o1;
#pragma unroll
                        for (int e = 0; e < 4; ++e) { o0[e] = lb[bj][e] + (1.0f - lb[bj][e]) * sigmoidf_(v0[e]); o1[e] = lb[bj][4 + e] + (1.0f - lb[bj][4 + e]) * sigmoidf_(v1[e]); }
                        *(f32x4*)(rowp + bj * 128) = o0; *(f32x4*)(rowp + bj * 128 + 4) = o1; } }
        } else {
            const int act = pn < 2 ? 1 : ((pn == 16 || pn == 17) ? 2 : 0);
#pragma unroll
            for (int ai = 0; ai < 2; ++ai)
#pragma unroll
                for (int m = 0; m < 4; ++m) { bf16_t* rowp = P + (size_t)(row0 + ai * 128 + m * 16) * LDP + col0;
#pragma unroll
                    for (int bj = 0; bj < 2; ++bj) { f32x4 v0 = acc[ai][bj][m][0], v1 = acc[ai][bj][m][1];
                        if (act == 1) {
#pragma unroll
                            for (int e = 0; e < 4; ++e) { v0[e] = siluf_(v0[e]); v1[e] = siluf_(v1[e]); } }
                        else if (act == 2) { v0 = v0 * 0.125f; v1 = v1 * 0.125f; }
                        u32x4 w; w.x = pk2(v0[0], v0[1]); w.y = pk2(v0[2], v0[3]); w.z = pk2(v1[0], v1[1]); w.w = pk2(v1[2], v1[3]);
                        *(u32x4*)(rowp + bj * 128) = w;
                        if (pn >= 8 && pn < 14) { const int row = row0 + ai * 128 + m * 16, tc = row & 63;
                            if (tc >= 61) *(u32x4*)((bf16_t*)(ws + WS_HALO) + ((size_t)(row >> 6) * 3 + (tc - 61)) * 1536 + (col0 + bj * 128 - PC_BQKV)) = w; } } }
        }
        return false;
    }
};
struct EpiGates {
    static constexpr bool PERM = true;
    unsigned char* ws;
    __device__ __forceinline__ bool operator()(acc_t& acc, const pg8::Unit& u, int wr, int wc, int fr, int fq) const {
        const int row0 = u.pm * 256 + wr * 64 + fr, br = u.pn >> 2, d0 = (u.pn & 3) * 256 + wc * 32 + 8 * fq;
#pragma unroll
        for (int ai = 0; ai < 2; ++ai)
#pragma unroll
            for (int m = 0; m < 4; ++m) { bf16_t* rowp = gate_ptr(ws, br, (size_t)(row0 + ai * 128 + m * 16), d0);
#pragma unroll
                for (int bj = 0; bj < 2; ++bj) { const f32x4 v0 = acc[ai][bj][m][0], v1 = acc[ai][bj][m][1];
                    u32x4 w; w.x = pk2(sigmoidf_(v0[0]), sigmoidf_(v0[1])); w.y = pk2(sigmoidf_(v0[2]), sigmoidf_(v0[3])); w.z = pk2(sigmoidf_(v1[0]), sigmoidf_(v1[1])); w.w = pk2(sigmoidf_(v1[2]), sigmoidf_(v1[3]));
                    *(u32x4*)(rowp + bj * 128) = w; } }
        return false;
    }
};
struct EpiLift {
    static constexpr bool PERM = true;
    unsigned char* ws;
    __device__ __forceinline__ bool operator()(acc_t& acc, const pg8::Unit& u, int wr, int wc, int fr, int fq) const {
        bf16_t* MG = (bf16_t*)(ws + WS_HB);
        const int row0 = u.pm * 256 + wr * 64 + fr, d0 = u.pn * 256 + wc * 32 + 8 * fq, s = u.kb;
        u32x4 ga[2][2], gb[2][2];
        auto gload = [&](int g, int slot) { const size_t row = (size_t)(row0 + (g >> 2) * 128 + (g & 3) * 16);
#pragma unroll
            for (int bj = 0; bj < 2; ++bj) { ga[slot][bj] = *(const u32x4*)gate_ptr(ws, s, row, d0 + bj * 128); if (s < 2) gb[slot][bj] = *(const u32x4*)gate_ptr(ws, s + 1, row, d0 + bj * 128); } };
        gload(0, 0);
#pragma unroll
        for (int g = 0; g < 8; ++g) { const int ai = g >> 2, m = g & 3, slot = g & 1; const size_t row = (size_t)(row0 + ai * 128 + m * 16);
            if (g + 1 < 8) gload(g + 1, slot ^ 1);
#pragma unroll
            for (int bj = 0; bj < 2; ++bj) { const u32x4 a4 = ga[slot][bj];
                f32x4 fa = (f32x4){bf_lo(a4.x), bf_hi(a4.x), bf_lo(a4.y), bf_hi(a4.y)}, fb = (f32x4){bf_lo(a4.z), bf_hi(a4.z), bf_lo(a4.w), bf_hi(a4.w)};
                if (s < 2) { const u32x4 b4 = gb[slot][bj];
                    fa[0] *= __builtin_amdgcn_rcpf(fmaxf(bf_lo(b4.x), 1e-30f)); fa[1] *= __builtin_amdgcn_rcpf(fmaxf(bf_hi(b4.x), 1e-30f));
                    fa[2] *= __builtin_amdgcn_rcpf(fmaxf(bf_lo(b4.y), 1e-30f)); fa[3] *= __builtin_amdgcn_rcpf(fmaxf(bf_hi(b4.y), 1e-30f));
                    fb[0] *= __builtin_amdgcn_rcpf(fmaxf(bf_lo(b4.z), 1e-30f)); fb[1] *= __builtin_amdgcn_rcpf(fmaxf(bf_hi(b4.z), 1e-30f));
                    fb[2] *= __builtin_amdgcn_rcpf(fmaxf(bf_lo(b4.w), 1e-30f)); fb[3] *= __builtin_amdgcn_rcpf(fmaxf(bf_hi(b4.w), 1e-30f)); }
                const f32x4 v0 = acc[ai][bj][m][0] * fa, v1 = acc[ai][bj][m][1] * fb;
                acc[ai][bj][m][0] = v0; acc[ai][bj][m][1] = v1;
                if (s == 2) { u32x4 w; w.x = pk2(v0[0], v0[1]); w.y = pk2(v0[2], v0[3]); w.z = pk2(v1[0], v1[1]); w.w = pk2(v1[2], v1[3]);
                    *(u32x4*)(MG + row * D + d0 + bj * 128) = w; }
            }
        }
        return s < 2;
    }
};
struct EpiOut {
    static constexpr bool PERM = false;
    const float* xin; float* out;
    __device__ __forceinline__ bool operator()(acc_t& acc, const pg8::Unit& u, int wr, int wc, int fr, int fq) const {
        const int row0 = u.pm * 256 + wr * 64 + fr, col0 = u.pn * 256 + wc * 32 + 4 * fq;
#pragma unroll
        for (int ai = 0; ai < 2; ++ai)
#pragma unroll
            for (int m = 0; m < 4; ++m) { const size_t off = (size_t)(row0 + ai * 128 + m * 16) * D + col0;
#pragma unroll
                for (int bj = 0; bj < 2; ++bj)
#pragma unroll
                    for (int n = 0; n < 2; ++n) { const f32x4 xv = *(const f32x4*)(xin + off + bj * 128 + n * 16); *(f32x4*)(out + off + bj * 128 + n * 16) = xv + acc[ai][bj][m][n]; }
                asm volatile("" ::: "memory"); }
        return false;
    }
};
struct SegLift { static __device__ __forceinline__ int a(int s) { return PC_AG + (s >= 1 ? PC_BZ - PC_AG : 0) + (s >= 2 ? PC_CG - PC_BZ : 0); } static __device__ __forceinline__ int b(int s) { return s * 512; } };
__device__ __forceinline__ void phase_inproj(const Params& p, int l, unsigned char* lds) {
    pg8::Gemm g{(const bf16_t*)(p.ws + WS_HB), (const bf16_t*)(p.ws + WS_WIN), D, D, D};
    pg8::StaticOrder S; S.init(M, NMIX, (int)gridDim.x, bid_(), 1);
    EpiInproj E{p.ws, p.lb_param, l};
    pg8::gemm_phase<EpiInproj, pg8::StaticOrder, pg8::SegNone, true, true>((PG8_LAS unsigned char*)lds, g, S, E);
}
__device__ __forceinline__ void phase_gates(const Params& p, unsigned char* lds) {
    pg8::Gemm g{(const bf16_t*)(p.ws + WS_HB), (const bf16_t*)(p.ws + WS_WIN) + (size_t)NMIX * D, D, D, D};
    pg8::StaticOrder S; S.init(M, NGATE, (int)gridDim.x, bid_(), 1);
    EpiGates E{p.ws};
    pg8::gemm_phase<EpiGates, pg8::StaticOrder, pg8::SegNone, true, true>((PG8_LAS unsigned char*)lds, g, S, E);
}
__device__ __forceinline__ void phase_lift(const Params& p, unsigned char* lds) {
    pg8::Gemm g{(const bf16_t*)(p.ws + WS_P), (const bf16_t*)(p.ws + WS_WB), LDP, 1536, 512};
    pg8::StaticOrder S; S.init(M, D, (int)gridDim.x, bid_(), 3);
    EpiLift E{p.ws};
    pg8::gemm_phase<EpiLift, pg8::StaticOrder, SegLift, false, true>((PG8_LAS unsigned char*)lds, g, S, E);
}
__device__ __forceinline__ void phase_outproj(const Params& p, const float* xin, unsigned char* lds) {
    pg8::Gemm g{(const bf16_t*)(p.ws + WS_HB), (const bf16_t*)(p.ws + WS_WO), D, D, D};
    pg8::StaticOrder S; S.init(M, D, (int)gridDim.x, bid_(), 1);
    EpiOut E{xin, p.out};
    pg8::gemm_phase<EpiOut, pg8::StaticOrder, pg8::SegNone, false, true>((PG8_LAS unsigned char*)lds, g, S, E);
}

constexpr int A_TB = 16;
__device__ __forceinline__ void mixer_a(const Params& p, int bh, int vs, unsigned char* lds, int dry) {
    const int tid = tid_(), lane = tid & 63, wave = tid >> 6, r = lane >> 4, i = lane & 15;
    const int b = bh >> 2, h = bh & 3;
    bf16_t* P = (bf16_t*)(p.ws + WS_P); const float* AF = (const float*)(p.ws + WS_AF);
    constexpr int BUF = 8192 + 8192 + 2048;
    float* obuf = (float*)(lds + 2 * BUF);
    const size_t row0 = (size_t)b * SEQ;
    const int fr_row = tid >> 5, fr_c4 = (tid & 31) * 4;
    const int q_row = tid >> 5, q_c4 = (tid & 31) * 4;
    const int i_row = (tid >> 3) & 15, i_c4 = (tid & 7) * 4;
    f32x4 pf; u32x2 pq; u32x2 pi;
    auto gload = [&](int t0) {
        pf = *(const f32x4*)(AF + (row0 + t0 + fr_row) * 512 + h * 128 + fr_c4);
        pq = *(const u32x2*)(P + (row0 + t0 + q_row) * LDP + PC_AQ + h * 128 + q_c4);
        if (tid < 128) pi = *(const u32x2*)(P + (row0 + t0 + i_row) * LDP + PC_AI + h * 128 + vs * 32 + i_c4);
    };
    auto lstore = [&](int bufi) {
        float* fb = (float*)(lds + bufi * BUF); float* qb = fb + 2048; float* ib = qb + 2048;
        *(f32x4*)(fb + fr_row * 128 + fr_c4) = pf;
        *(f32x4*)(qb + q_row * 128 + q_c4) = (f32x4){bf_lo(pq.x), bf_hi(pq.x), bf_lo(pq.y), bf_hi(pq.y)};
        if (tid < 128) *(f32x4*)(ib + i_row * 32 + i_c4) = (f32x4){bf_lo(pi.x), bf_hi(pi.x), bf_lo(pi.y), bf_hi(pi.y)};
    };
    float S[8];
#pragma unroll
    for (int j = 0; j < 8; ++j) S[j] = 0.f;
    gload(0); lstore(0); __syncthreads();
    constexpr int NB = SEQ / A_TB;
    for (int bt = 0; bt < NB; ++bt) {
        const int cur = bt & 1;
        if (bt + 1 < NB) gload((bt + 1) * A_TB);
        const float* fb = (const float*)(lds + cur * BUF); const float* qb = fb + 2048; const float* ib = qb + 2048;
#pragma unroll 4
        for (int t = 0; t < A_TB; ++t) {
            const f32x4 f0 = *(const f32x4*)(fb + t * 128 + 8 * i), f1 = *(const f32x4*)(fb + t * 128 + 8 * i + 4);
            const f32x4 q0 = *(const f32x4*)(qb + t * 128 + 8 * i), q1 = *(const f32x4*)(qb + t * 128 + 8 * i + 4);
            const float iv = ib[t * 32 + wave * 4 + r];
            float pa = 0.f, pb = 0.f;
            S[0] = iv + f0[0] * (S[0] - iv); pa += q0[0] * S[0];
            S[1] = iv + f0[1] * (S[1] - iv); pb += q0[1] * S[1];
            S[2] = iv + f0[2] * (S[2] - iv); pa += q0[2] * S[2];
            S[3] = iv + f0[3] * (S[3] - iv); pb += q0[3] * S[3];
            S[4] = iv + f1[0] * (S[4] - iv); pa += q1[0] * S[4];
            S[5] = iv + f1[1] * (S[5] - iv); pb += q1[1] * S[5];
            S[6] = iv + f1[2] * (S[6] - iv); pa += q1[2] * S[6];
            S[7] = iv + f1[3] * (S[7] - iv); pb += q1[3] * S[7];
            const float o = row16_sum(pa + pb);
            if (i == 0) obuf[t * 32 + wave * 4 + r] = o;
        }
        __syncthreads();
        if (!dry) { const int t = tid >> 5, v = tid & 31; P[(row0 + bt * A_TB + t) * LDP + PC_AI + h * 128 + vs * 32 + v] = (bf16_t)f2bf(obuf[t * 32 + v]); }
        if (bt + 1 < NB) lstore(cur ^ 1);
        __syncthreads();
    }
}

constexpr int B_TB = 16;
__device__ __forceinline__ void mixer_b(const Params& p, int l, int bh, int vs, unsigned char* lds, int dry) {
    const int tid = tid_(), lane = tid & 63, wave = tid >> 6, r = lane >> 5, i = lane & 31;
    const int b = bh >> 2, h = bh & 3;
    bf16_t* P = (bf16_t*)(p.ws + WS_P); const float* sm8 = (const float*)(p.ws + WS_SM);
    const float* cw = p.conv_w + (size_t)l * 4 * 1536;
    constexpr int RAWC = 272;
    float* raw = (float*)lds;
    float* qk = (float*)(lds + 20736);
    float* vv = (float*)(lds + 20736 + 16384);
    float* sc = (float*)(lds + 20736 + 16384 + 1024);
    float* obuf = (float*)(lds + 20736 + 16384 + 1024 + 256);
    const size_t row0 = (size_t)b * SEQ;
    const float a_coef = -__expf(p.a_log[l * 4 + h]); const float dtb = p.dt_bias[l * 4 + h];
    const int cqk = tid & 255; const int chq = cqk < 128 ? h * 128 + cqk : 512 + h * 128 + (cqk - 128);
    float wq[4]; float wvv[4];
#pragma unroll
    for (int j = 0; j < 4; ++j) { wq[j] = cw[j * 1536 + chq]; wvv[j] = cw[j * 1536 + 1024 + h * 128 + vs * 16 + (tid & 15)]; }
    for (int e = tid; e < 3 * RAWC; e += NTHREADS) raw[e] = 0.f;
    float S[4] = {0.f, 0.f, 0.f, 0.f};
    u32x4 st0, st1;
    auto chunk_addr = [&](int t0, int ck) -> const bf16_t* {
        const int row = ck / 34, c8 = ck % 34; const int ch = c8 < 16 ? h * 128 + c8 * 8 : (c8 < 32 ? 512 + h * 128 + (c8 - 16) * 8 : 1024 + h * 128 + vs * 16 + (c8 - 32) * 8);
        return P + (row0 + t0 + row) * LDP + PC_BQKV + ch; };
    auto gload = [&](int t0) { st0 = *(const u32x4*)chunk_addr(t0, tid); if (tid < 32) st1 = *(const u32x4*)chunk_addr(t0, 512 + tid); };
    auto rstore = [&]() {
        { const int row = tid / 34, c8 = tid % 34; float* d = raw + (3 + row) * RAWC + c8 * 8;
          *(f32x4*)d = (f32x4){bf_lo(st0.x), bf_hi(st0.x), bf_lo(st0.y), bf_hi(st0.y)}; *(f32x4*)(d + 4) = (f32x4){bf_lo(st0.z), bf_hi(st0.z), bf_lo(st0.w), bf_hi(st0.w)}; }
        if (tid < 32) { const int ck = 512 + tid; const int row = ck / 34, c8 = ck % 34; float* d = raw + (3 + row) * RAWC + c8 * 8;
          *(f32x4*)d = (f32x4){bf_lo(st1.x), bf_hi(st1.x), bf_lo(st1.y), bf_hi(st1.y)}; *(f32x4*)(d + 4) = (f32x4){bf_lo(st1.z), bf_hi(st1.z), bf_lo(st1.w), bf_hi(st1.w)}; }
    };
    gload(0);
    constexpr int NB = SEQ / B_TB;
    for (int bt = 0; bt < NB; ++bt) {
        const int t0 = bt * B_TB;
        __syncthreads();
        rstore();
        if (bt + 1 < NB) gload(t0 + B_TB);
        __syncthreads();
        {
            const int tb = (tid >> 8) * 8;
#pragma unroll
            for (int tt = 0; tt < 8; ++tt) { const int t = tb + tt;
                const float x = raw[(t + 0) * RAWC + cqk] * wq[0] + raw[(t + 1) * RAWC + cqk] * wq[1] + raw[(t + 2) * RAWC + cqk] * wq[2] + raw[(t + 3) * RAWC + cqk] * wq[3];
                qk[t * 256 + cqk] = siluf_(x); }
            if (tid < 256) { const int t = tid >> 4, c = tid & 15;
                const float x = raw[(t + 0) * RAWC + 256 + c] * wvv[0] + raw[(t + 1) * RAWC + 256 + c] * wvv[1] + raw[(t + 2) * RAWC + 256 + c] * wvv[2] + raw[(t + 3) * RAWC + 256 + c] * wvv[3];
                vv[t * 16 + c] = siluf_(x); }
            if (tid < 16) { const f32x4 lo = *(const f32x4*)(sm8 + (row0 + t0 + tid) * 8), hi = *(const f32x4*)(sm8 + (row0 + t0 + tid) * 8 + 4);
                const float bl = lo[h], al = hi[h]; const float xx = al + dtb; const float sp = xx > 20.f ? xx : log1pf(__expf(xx));
                sc[tid * 4 + 0] = __expf(a_coef * sp); sc[tid * 4 + 1] = sigmoidf_(bl); }
        }
        __syncthreads();
        {
            const int vec = tid >> 4, sub = tid & 15; const int t = vec >> 1, which = vec & 1;
            float* src = qk + t * 256 + which * 128 + sub * 8;
            f32x4 a0 = *(f32x4*)src, a1 = *(f32x4*)(src + 4);
            float ss = (a0[0] * a0[0] + a0[1] * a0[1]) + (a0[2] * a0[2] + a0[3] * a0[3]) + (a1[0] * a1[0] + a1[1] * a1[1]) + (a1[2] * a1[2] + a1[3] * a1[3]);
            ss = row16_sum(ss);
            float sc_ = 1.0f / sqrtf(ss + EPS); if (which == 0) sc_ *= 0.08838834764831845f;
            a0 = a0 * sc_; a1 = a1 * sc_;
            *(f32x4*)src = a0; *(f32x4*)(src + 4) = a1;
        }
        __syncthreads();
        if (tid < 256) { const int t = tid >> 4, sub = tid & 15; const float* qs = qk + t * 256 + sub * 8; const float* ks = qs + 128;
            float d = 0.f;
#pragma unroll
            for (int e = 0; e < 8; ++e) d += qs[e] * ks[e];
            d = row16_sum(d); if (sub == 0) sc[t * 4 + 2] = d; }
        __syncthreads();
#pragma unroll 2
        for (int t = 0; t < B_TB; ++t) {
            const f32x4 q4 = *(const f32x4*)(qk + t * 256 + 4 * i), k4 = *(const f32x4*)(qk + t * 256 + 128 + 4 * i);
            const f32x4 s4 = *(const f32x4*)(sc + t * 4); const float vt = vv[t * 16 + wave * 2 + r];
            const float alpha = s4[0], beta = s4[1], qkd = s4[2];
            float rk = (S[0] * k4[0] + S[1] * k4[1]) + (S[2] * k4[2] + S[3] * k4[3]);
            float rq = (S[0] * q4[0] + S[1] * q4[1]) + (S[2] * q4[2] + S[3] * q4[3]);
            rk = xor16_sum(row16_sum(rk)); rq = xor16_sum(row16_sum(rq));
            const float vn = beta * (vt - alpha * rk);
            const float o = alpha * rq + qkd * vn;
            S[0] = alpha * S[0] + k4[0] * vn; S[1] = alpha * S[1] + k4[1] * vn; S[2] = alpha * S[2] + k4[2] * vn; S[3] = alpha * S[3] + k4[3] * vn;
            if (i == 0) obuf[t * 16 + wave * 2 + r] = o;
        }
        __syncthreads();
        if (tid < 256 && !dry) { const int t = tid >> 4, c = tid & 15; P[(row0 + t0 + t) * LDP + PC_BQKV + 1024 + h * 128 + vs * 16 + c] = (bf16_t)f2bf(obuf[t * 16 + c]); }
        float hv0 = 0.f, hv1 = 0.f; const int e0 = tid, e1 = tid + 512;
        if (e0 < 3 * RAWC) hv0 = raw[16 * RAWC + e0];
        if (e1 < 3 * RAWC) hv1 = raw[16 * RAWC + e1];
        __syncthreads();
        if (e0 < 3 * RAWC) raw[e0] = hv0;
        if (e1 < 3 * RAWC) raw[e1] = hv1;
    }
}


#define LDS_BARRIER() do { asm volatile("s_waitcnt lgkmcnt(0)" ::: "memory"); __builtin_amdgcn_s_barrier(); asm volatile("" ::: "memory"); } while (0)
template <int KS> __device__ __forceinline__ f32x4 mma_tile(const bf16_t* a, int lda, const bf16_t* b, int ldb, f32x4 acc, int fr, int fq) {
#pragma unroll
    for (int ks = 0; ks < KS; ++ks) {
        const bf16x8 af = *(const bf16x8*)(a + fr * lda + ks * 32 + fq * 8);
        const bf16x8 bv = *(const bf16x8*)(b + fr * ldb + ks * 32 + fq * 8);
        acc = __builtin_amdgcn_mfma_f32_16x16x32_bf16(bv, af, acc, 0, 0, 0);
    }
    return acc;
}
__device__ __forceinline__ u32x2 pack4(f32x4 v) { u32x2 o; o.x = pk2(v[0], v[1]); o.y = pk2(v[2], v[3]); return o; }
__device__ __forceinline__ f32x4 unpack4(u32x2 u) { return (f32x4){bf_lo(u.x), bf_hi(u.x), bf_lo(u.y), bf_hi(u.y)}; }

__device__ __forceinline__ void bpre_unit(const Params& p, int l, int unit, unsigned char* lds, int dry) {
    const int tid = tid_(), lane = tid & 63, wave = tid >> 6, fr = lane & 15, fq = lane >> 4;
    const int h = unit & 3, c = (unit >> 2) & 63, b = unit >> 8;
    bf16_t* P = (bf16_t*)(p.ws + WS_P); const float* sm8 = (const float*)(p.ws + WS_SM); float* GC = (float*)(p.ws + WS_GC);
    const bf16_t* HALO = (const bf16_t*)(p.ws + WS_HALO);
    const float* cw = p.conv_w + (size_t)l * 4 * 1536;
    constexpr int RP = 392;
    bf16_t* RAW = (bf16_t*)lds;
    bf16_t* KT2 = (bf16_t*)lds;
    float* TF = (float*)(lds + 18432);
    float* MS = (float*)(lds + 26880);
    bf16_t* KN = (bf16_t*)(lds + 52528);
    bf16_t* KB = (bf16_t*)(lds + 69936);
    bf16_t* XT = (bf16_t*)(lds + 87344);
    float* AM = (float*)(lds + 124208);
    bf16_t* QNS = (bf16_t*)(lds + 124208);
    bf16_t* TM = (bf16_t*)(lds + 140592);
    float* sgc = (float*)(lds + 149808); float* sbeta = sgc + 64; float* sg = sgc + 128;
    bf16_t* QKG = (bf16_t*)(p.ws + WS_QK) + (size_t)unit * 2560;
    const size_t row0 = (size_t)b * SEQ + (size_t)c * 64;
    const float a_coef = -__expf(p.a_log[l * 4 + h]); const float dtb = p.dt_bias[l * 4 + h];
    LDS_BARRIER();
#pragma unroll
    for (int i2 = 0; i2 < 6; ++i2) { const int ck = tid + 512 * i2, row = ck / 48, c8 = ck % 48;
        const int chg = c8 < 16 ? h * 128 + c8 * 8 : (c8 < 32 ? 512 + h * 128 + (c8 - 16) * 8 : 1024 + h * 128 + (c8 - 32) * 8);
        *(u32x4*)(RAW + (3 + row) * RP + c8 * 8) = *(const u32x4*)(P + (row0 + row) * LDP + PC_BQKV + chg); }
    if (tid < 144) { const int row = tid / 48, c8 = tid % 48;
        const int chg = c8 < 16 ? h * 128 + c8 * 8 : (c8 < 32 ? 512 + h * 128 + (c8 - 16) * 8 : 1024 + h * 128 + (c8 - 32) * 8);
        u32x4 v = (u32x4){0u, 0u, 0u, 0u}; if (c > 0) v = *(const u32x4*)(HALO + ((size_t)(b * 64 + c - 1) * 3 + row) * 1536 + chg);
        *(u32x4*)(RAW + row * RP + c8 * 8) = v; }
    if (tid < 64) { const float bl = sm8[(row0 + tid) * 8 + h], al = sm8[(row0 + tid) * 8 + 4 + h]; const float xx = al + dtb; const float sp = xx > 20.f ? xx : log1pf(__expf(xx));
        sg[tid] = a_coef * sp; sbeta[tid] = sigmoidf_(bl); }
    LDS_BARRIER();
    if (tid < 64) { float s0 = 0.f, s1 = 0.f;
#pragma unroll
        for (int j = 0; j < 64; j += 2) { s0 += (j <= tid) ? sg[j] : 0.f; s1 += (j + 1 <= tid) ? sg[j + 1] : 0.f; }
        const float s = s0 + s1; sgc[tid] = s; if (!dry) GC[(row0 + tid) * 4 + h] = s; }
    LDS_BARRIER();
    if (!(dry & 4)) {
    { const int sub = tid & 15, which = (tid >> 4) & 1, tb = tid >> 5; const int ch0 = which * 128 + sub * 8;
      float wq[4][8];
#pragma unroll
      for (int j = 0; j < 4; ++j)
#pragma unroll
          for (int e = 0; e < 8; ++e) wq[j][e] = cw[j * 1536 + which * 512 + h * 128 + sub * 8 + e];
#pragma unroll 1
      for (int jt = 0; jt < 4; ++jt) { const int t = tb + 16 * jt;
          float x[8] = {0.f, 0.f, 0.f, 0.f, 0.f, 0.f, 0.f, 0.f};
#pragma unroll
          for (int j = 0; j < 4; ++j) { const u32x4 r = *(const u32x4*)(RAW + (t + j) * RP + ch0);
              x[0] += bf_lo(r.x) * wq[j][0]; x[1] += bf_hi(r.x) * wq[j][1]; x[2] += bf_lo(r.y) * wq[j][2]; x[3] += bf_hi(r.y) * wq[j][3];
              x[4] += bf_lo(r.z) * wq[j][4]; x[5] += bf_hi(r.z) * wq[j][5]; x[6] += bf_lo(r.w) * wq[j][6]; x[7] += bf_hi(r.w) * wq[j][7]; }
          float ss = 0.f;
#pragma unroll
          for (int e = 0; e < 8; ++e) { x[e] = siluf_(x[e]); ss += x[e] * x[e]; }
          ss = row16_sum(ss);
          float sc_ = __builtin_amdgcn_rsqf(ss + EPS); if (which == 0) sc_ *= 0.08838834764831845f;
#pragma unroll
          for (int e = 0; e < 8; ++e) x[e] *= sc_;
          const u32x4 pk = (u32x4){pk2(x[0], x[1]), pk2(x[2], x[3]), pk2(x[4], x[5]), pk2(x[6], x[7])};
          if (which == 0) { *(u32x4*)(QNS + t * 128 + ((sub ^ (t & 15)) * 8)) = pk;
              const float eg = __expf(sgc[t]);
              const u32x4 pq = (u32x4){pk2(x[0] * eg, x[1] * eg), pk2(x[2] * eg, x[3] * eg), pk2(x[4] * eg, x[5] * eg), pk2(x[6] * eg, x[7] * eg)};
              if (!dry) *(u32x4*)(P + (row0 + t) * LDP + PC_BQKV + h * 128 + sub * 8) = pq; }
          else { *(u32x4*)(KN + t * 136 + sub * 8) = pk; const float bt = sbeta[t];
              *(u32x4*)(KB + t * 136 + sub * 8) = (u32x4){pk2(x[0] * bt, x[1] * bt), pk2(x[2] * bt, x[3] * bt), pk2(x[4] * bt, x[5] * bt), pk2(x[6] * bt, x[7] * bt)}; } } }
    { const int t = tid & 63, cg = tid >> 6; const float bt = sbeta[t];
#pragma unroll
      for (int hf = 0; hf < 2; ++hf) { const int cv = cg * 16 + hf * 8; float x[8] = {0.f, 0.f, 0.f, 0.f, 0.f, 0.f, 0.f, 0.f};
#pragma unroll
          for (int j = 0; j < 4; ++j) { const u32x4 r = *(const u32x4*)(RAW + (t + j) * RP + 256 + cv); const float* wj = cw + j * 1536 + 1024 + h * 128 + cv;
              x[0] += bf_lo(r.x) * wj[0]; x[1] += bf_hi(r.x) * wj[1]; x[2] += bf_lo(r.y) * wj[2]; x[3] += bf_hi(r.y) * wj[3];
              x[4] += bf_lo(r.z) * wj[4]; x[5] += bf_hi(r.z) * wj[5]; x[6] += bf_lo(r.w) * wj[6]; x[7] += bf_hi(r.w) * wj[7]; }
          bf16_t* xt = XT + cv * 72 + t;
#pragma unroll
          for (int e = 0; e < 8; e += 2) { const unsigned w2 = pk2(siluf_(x[e]) * bt, siluf_(x[e + 1]) * bt); xt[e * 72] = (bf16_t)(w2 & 0xffffu); xt[(e + 1) * 72] = (bf16_t)(w2 >> 16); } } }
    }
    LDS_BARRIER();
    {
      const int t = tid & 63, d0 = (tid >> 6) * 16; const float eg = __expf(sgc[t]), rg = __expf(sgc[63] - sgc[t]);
#pragma unroll
      for (int hlf = 0; hlf < 2; ++hlf) { const u32x4 kv = *(const u32x4*)(KB + t * 136 + d0 + hlf * 8); bf16_t* xt = XT + (128 + d0 + hlf * 8) * 72 + t;
          const unsigned k0 = pk2(bf_lo(kv.x) * eg, bf_hi(kv.x) * eg), k1 = pk2(bf_lo(kv.y) * eg, bf_hi(kv.y) * eg), k2 = pk2(bf_lo(kv.z) * eg, bf_hi(kv.z) * eg), k3 = pk2(bf_lo(kv.w) * eg, bf_hi(kv.w) * eg);
          xt[0 * 72] = (bf16_t)(k0 & 0xffffu); xt[1 * 72] = (bf16_t)(k0 >> 16); xt[2 * 72] = (bf16_t)(k1 & 0xffffu); xt[3 * 72] = (bf16_t)(k1 >> 16);
          xt[4 * 72] = (bf16_t)(k2 & 0xffffu); xt[5 * 72] = (bf16_t)(k2 >> 16); xt[6 * 72] = (bf16_t)(k3 & 0xffffu); xt[7 * 72] = (bf16_t)(k3 >> 16); }
#pragma unroll
      for (int hlf = 0; hlf < 2; ++hlf) { const u32x4 kv = *(const u32x4*)(KN + t * 136 + d0 + hlf * 8); bf16_t* xt = KT2 + (d0 + hlf * 8) * 72 + t;
          const unsigned k0 = pk2(bf_lo(kv.x) * rg, bf_hi(kv.x) * rg), k1 = pk2(bf_lo(kv.y) * rg, bf_hi(kv.y) * rg), k2 = pk2(bf_lo(kv.z) * rg, bf_hi(kv.z) * rg), k3 = pk2(bf_lo(kv.w) * rg, bf_hi(kv.w) * rg);
          xt[0 * 72] = (bf16_t)(k0 & 0xffffu); xt[1 * 72] = (bf16_t)(k0 >> 16); xt[2 * 72] = (bf16_t)(k1 & 0xffffu); xt[3 * 72] = (bf16_t)(k1 >> 16);
          xt[4 * 72] = (bf16_t)(k2 & 0xffffu); xt[5 * 72] = (bf16_t)(k2 >> 16); xt[6 * 72] = (bf16_t)(k3 & 0xffffu); xt[7 * 72] = (bf16_t)(k3 >> 16); } }
#pragma unroll
    for (int i2 = 0; i2 < 2; ++i2) { const int ti = 2 * wave + i2, tm = ti >> 2, tn = ti & 3;
        if (tn <= tm) { const int qrow = tm * 16 + fr; f32x4 acc = (f32x4){0.f, 0.f, 0.f, 0.f};
#pragma unroll
            for (int ks = 0; ks < 4; ++ks) acc = __builtin_amdgcn_mfma_f32_16x16x32_bf16(*(const bf16x8*)(KN + (tn * 16 + fr) * 136 + ks * 32 + fq * 8), *(const bf16x8*)(QNS + qrow * 128 + (((ks * 4 + fq) ^ (qrow & 15)) * 8)), acc, 0, 0, 0);
            const int s0 = tn * 16 + 4 * fq; const float gt = sgc[qrow]; f32x4 o;
#pragma unroll
            for (int e = 0; e < 4; ++e) o[e] = (s0 + e <= qrow) ? acc[e] * __expf(gt - sgc[s0 + e]) : 0.f;
            if (!dry) *(u32x2*)(QKG + (tm * (tm + 1) / 2 + tn) * 256 + fr * 16 + 4 * fq) = pack4(o); } }
    LDS_BARRIER();
#pragma unroll
    for (int i2 = 0; i2 < 2; ++i2) { const int ti = 2 * wave + i2, tm = ti >> 2, tn = ti & 3;
        if (tn <= tm) { f32x4 acc = mma_tile<4>(KB + tm * 16 * 136, 136, KN + tn * 16 * 136, 136, (f32x4){0.f, 0.f, 0.f, 0.f}, fr, fq);
            const int t = tm * 16 + fr, s0 = tn * 16 + 4 * fq; const float gt = sgc[t]; f32x4 o;
#pragma unroll
            for (int e = 0; e < 4; ++e) o[e] = (s0 + e < t) ? acc[e] * __expf(gt - sgc[s0 + e]) : 0.f;
            *(f32x4*)(AM + t * 64 + s0) = o; } }
    LDS_BARRIER();
    if (wave == 0 && !(dry & 2)) {
        const int off = (lane >> 5) * 32, cc = lane & 31;
        float Tc[32];
        const float* ab = AM + off * 64 + off;
        float* tf = TF + (lane >> 5) * (32 * 33) + cc;
#pragma unroll
        for (int t = 0; t < 32; ++t) { float ac4[4] = {0.f, 0.f, 0.f, 0.f};
#pragma unroll
            for (int s4 = 0; s4 < (t + 3) / 4; ++s4) { const f32x4 a = *(const f32x4*)(ab + t * 64 + 4 * s4);
#pragma unroll
                for (int e = 0; e < 4; ++e) if (4 * s4 + e < t) ac4[e] += a[e] * Tc[4 * s4 + e]; }
            int ln = cc; asm volatile("" : "+v"(ln));
            Tc[t] = ((t == ln) ? 1.f : 0.f) - ((ac4[0] + ac4[1]) + (ac4[2] + ac4[3]));
            tf[t * 33] = Tc[t];
            TM[(off + t) * 72 + off + ln] = (bf16_t)f2bf(Tc[t]);
            if (off == 0) TM[t * 72 + 32 + ln] = (bf16_t)0; }
    }
    LDS_BARRIER();
    {
      const int i = tid >> 4, j = (tid & 15) * 2; float m0 = 0.f, m1 = 0.f;
#pragma unroll
      for (int k4 = 0; k4 < 8; ++k4) { const f32x4 a = *(const f32x4*)(AM + (32 + i) * 64 + 4 * k4);
#pragma unroll
          for (int e = 0; e < 4; ++e) { const int k = 4 * k4 + e; m0 += a[e] * TF[k * 33 + j]; m1 += a[e] * TF[k * 33 + j + 1]; } }
      MS[i * 33 + j] = m0; MS[i * 33 + j + 1] = m1; }
    LDS_BARRIER();
    {
      const int i = tid >> 4, j = (tid & 15) * 2; float m0 = 0.f, m1 = 0.f;
#pragma unroll
      for (int k = 0; k < 32; ++k) { const float tk = TF[32 * 33 + i * 33 + k]; m0 += tk * MS[k * 33 + j]; m1 += tk * MS[k * 33 + j + 1]; }
      *(unsigned*)(TM + (32 + i) * 72 + j) = pk2(-m0, -m1); }
    LDS_BARRIER();
    if (!(dry & 8))
#pragma unroll
    for (int i2 = 0; i2 < 2; ++i2) { const int nt = 2 * wave + i2;
#pragma unroll
        for (int mt = 0; mt < 4; ++mt) {
            if (nt >= 8) { const f32x4 acc = mma_tile<2>(TM + mt * 16 * 72, 72, XT + nt * 16 * 72, 72, (f32x4){0.f, 0.f, 0.f, 0.f}, fr, fq);
                const int t = mt * 16 + fr, d = (nt - 8) * 16 + 4 * fq;
                if (!dry) *(u32x2*)(P + (row0 + t) * LDP + 512 + h * 128 + d) = pack4(acc); }
            else { const f32x4 acc = mma_tile<2>(XT + nt * 16 * 72, 72, TM + mt * 16 * 72, 72, (f32x4){0.f, 0.f, 0.f, 0.f}, fr, fq);
                const int v = nt * 16 + fr, t = mt * 16 + 4 * fq;
                if (!dry) *(u32x2*)(P + (row0 + (v >> 1)) * LDP + PC_BQKV + 1024 + h * 128 + (v & 1) * 64 + t) = pack4(acc); } } }
#pragma unroll
    for (int i2 = 0; i2 < 2; ++i2) { const int ck = tid + 512 * i2, k = ck >> 3, c8 = (ck & 7) * 8;
        const u32x4 v = *(const u32x4*)(KT2 + k * 72 + c8);
        if (!dry) *(u32x4*)(P + (row0 + (k >> 1)) * LDP + PC_BQKV + 512 + h * 128 + (k & 1) * 64 + c8) = v; }
}

constexpr int BS_NV = 32;
__device__ __forceinline__ void bscan_block(const Params& p, int blk, unsigned char* lds, int dry) {
    const int tid = tid_(), lane = tid & 63, wave = tid >> 6, fr = lane & 15, fq = lane >> 4;
    const int bh = blk >> 2, v0 = (blk & 3) * BS_NV, b = bh >> 2, h = bh & 3;
    const int wv = wave & 1, wt = wave >> 1;
    bf16_t* P = (bf16_t*)(p.ws + WS_P); const float* GC = (const float*)(p.ws + WS_GC); const bf16_t* QKG = (const bf16_t*)(p.ws + WS_QK);
    bf16_t* ST = (bf16_t*)lds;
    bf16_t* Wt = (bf16_t*)(lds + 8704);
    bf16_t* QD = (bf16_t*)(lds + 26112);
    bf16_t* KDT = (bf16_t*)(lds + 43520);
    bf16_t* QK = (bf16_t*)(lds + 61952);
    bf16_t* VNT = (bf16_t*)(lds + 71168);
    bf16_t* UT = (bf16_t*)(lds + 75776);
    const size_t row0 = (size_t)b * SEQ;
    f32x4 Sacc[2];
    Sacc[0] = (f32x4){0.f, 0.f, 0.f, 0.f}; Sacc[1] = (f32x4){0.f, 0.f, 0.f, 0.f};
    LDS_BARRIER();
    for (int e = tid; e < BS_NV * 136 / 2; e += NTHREADS) ((unsigned*)ST)[e] = 0u;
    for (int e = tid; e < 64 * 72 / 2; e += NTHREADS) ((unsigned*)QK)[e] = 0u;
    u32x4 rw[2], ru, rq[2], rk[2], rqk; float rge = 0.f;
    const int qk_tile = tid >> 5, qk_tm = qk_tile < 1 ? 0 : (qk_tile < 3 ? 1 : (qk_tile < 6 ? 2 : 3)), qk_tn = qk_tile - qk_tm * (qk_tm + 1) / 2;
    bf16_t* qk_dst = QK + (qk_tm * 16 + ((tid >> 1) & 15)) * 72 + qk_tn * 16 + (tid & 1) * 8;
    auto load_g1 = [&](int c) {
#pragma unroll
        for (int i2 = 0; i2 < 2; ++i2) { const int ck = tid + 512 * i2; rw[i2] = *(const u32x4*)(P + (row0 + c * 64 + (ck >> 4)) * LDP + 512 + h * 128 + (ck & 15) * 8); }
        if (tid < 256) { const int v = v0 + (tid >> 3); ru = *(const u32x4*)(P + (row0 + c * 64 + (v >> 1)) * LDP + PC_BQKV + 1024 + h * 128 + (v & 1) * 64 + (tid & 7) * 8); } };
    auto load_g2 = [&](int c) {
#pragma unroll
        for (int i2 = 0; i2 < 2; ++i2) { const int ck = tid + 512 * i2;
            rq[i2] = *(const u32x4*)(P + (row0 + c * 64 + (ck >> 4)) * LDP + PC_BQKV + h * 128 + (ck & 15) * 8);
            const int k = ck >> 3; rk[i2] = *(const u32x4*)(P + (row0 + c * 64 + (k >> 1)) * LDP + PC_BQKV + 512 + h * 128 + (k & 1) * 64 + (ck & 7) * 8); }
        if (tid < 320) rqk = *(const u32x4*)(QKG + (size_t)((b * 64 + c) * 4 + h) * 2560 + tid * 8);
        rge = GC[(row0 + c * 64 + 63) * 4 + h]; };
    auto store_g1 = [&]() {
#pragma unroll
        for (int i2 = 0; i2 < 2; ++i2) { const int ck = tid + 512 * i2; *(u32x4*)(Wt + (ck >> 4) * 136 + (ck & 15) * 8) = rw[i2]; }
        if (tid < 256) *(u32x4*)(UT + (tid >> 3) * 72 + (tid & 7) * 8) = ru; };
    float ge = 1.f;
    auto store_g2 = [&]() {
#pragma unroll
        for (int i2 = 0; i2 < 2; ++i2) { const int ck = tid + 512 * i2;
            *(u32x4*)(QD + (ck >> 4) * 136 + (ck & 15) * 8) = rq[i2]; *(u32x4*)(KDT + (ck >> 3) * 72 + (ck & 7) * 8) = rk[i2]; }
        if (tid < 320) *(u32x4*)qk_dst = rqk;
        ge = __expf(rge); };
#define LDFRAG(base, row, pitch, ks) (*(const bf16x8*)((base) + (row) * (pitch) + (ks) * 32 + fq * 8))
#define MFMA16(bfrag, afrag, acc) __builtin_amdgcn_mfma_f32_16x16x32_bf16(bfrag, afrag, acc, 0, 0, 0)
    load_g1(0); load_g2(0);
    LDS_BARRIER();
    store_g1(); load_g1(1);
    const int vrow = 16 * wv + fr;
#pragma unroll 1
    for (int c = 0; c < 64; ++c) {
        LDS_BARRIER();
        store_g2(); if (c + 1 < 64) load_g2(c + 1);
        bf16x8 sfr[4];
#pragma unroll
        for (int ks = 0; ks < 4; ++ks) sfr[ks] = LDFRAG(ST, vrow, 136, ks);
        { f32x4 acc = (f32x4){0.f, 0.f, 0.f, 0.f};
#pragma unroll
          for (int ks = 0; ks < 4; ++ks) acc = MFMA16(LDFRAG(Wt, wt * 16 + fr, 136, ks), sfr[ks], acc);
          const f32x4 u4 = unpack4(*(const u32x2*)(UT + vrow * 72 + wt * 16 + 4 * fq));
          *(u32x2*)(VNT + vrow * 72 + wt * 16 + 4 * fq) = pack4(u4 - acc); }
        LDS_BARRIER();
        if (c + 1 < 64) { store_g1(); if (c + 2 < 64) load_g1(c + 2); }
        bf16x8 vfr[2];
#pragma unroll
        for (int ks = 0; ks < 2; ++ks) vfr[ks] = LDFRAG(VNT, vrow, 72, ks);
        { f32x4 acc = (f32x4){0.f, 0.f, 0.f, 0.f};
#pragma unroll
          for (int ks = 0; ks < 4; ++ks) acc = MFMA16(sfr[ks], LDFRAG(QD, wt * 16 + fr, 136, ks), acc);
#pragma unroll
          for (int ks = 0; ks < 2; ++ks) acc = MFMA16(vfr[ks], LDFRAG(QK, wt * 16 + fr, 72, ks), acc);
          if (!dry) *(u32x2*)(P + (row0 + c * 64 + wt * 16 + fr) * LDP + PC_BQKV + 1024 + h * 128 + v0 + 16 * wv + 4 * fq) = pack4(acc); }
#pragma unroll
        for (int i2 = 0; i2 < 2; ++i2) { const int kt = 2 * wt + i2; f32x4 acc = Sacc[i2] * ge;
#pragma unroll
            for (int ks = 0; ks < 2; ++ks) acc = MFMA16(LDFRAG(KDT, kt * 16 + fr, 72, ks), vfr[ks], acc);
            Sacc[i2] = acc;
            *(u32x2*)(ST + vrow * 136 + kt * 16 + 4 * fq) = pack4(acc); }
    }
#undef LDFRAG
#undef MFMA16
}

__device__ __forceinline__ unsigned char* a_state_row(unsigned char* ws, size_t row0, int h, int v) {
    return ws + WS_AF + (row0 + (size_t)(v >> 1)) * 2048 + (size_t)h * 512 + (size_t)(v & 1) * 256;
}
__device__ __forceinline__ void ax1_unit(const Params& p, int unit, unsigned char* lds, int dry) {
    const int tid = tid_(), lane = tid & 63, wave = tid >> 6, fr = lane & 15, fq = lane >> 4;
    const int h = unit & 3, c = (unit >> 2) & 63, b = unit >> 8;
    bf16_t* P = (bf16_t*)(p.ws + WS_P); const float* AF = (const float*)(p.ws + WS_AF); float* DEC = (float*)(p.ws + WS_DEC);
    constexpr int BP = 132;
    float* BF = (float*)lds;
    bf16_t* QM = (bf16_t*)(lds + 33792);
    bf16_t* KM = (bf16_t*)(lds + 51200);
    bf16_t* KET = (bf16_t*)(lds + 68608);
    bf16_t* VT = (bf16_t*)(lds + 87040);
    bf16_t* SC = (bf16_t*)(lds + 105472);
    const size_t row0 = (size_t)b * SEQ + (size_t)c * 64;
    const int rA = tid >> 3, cA = (tid & 7) * 16;
    const int tB = tid & 63, cB = (tid >> 6) * 16;
    LDS_BARRIER();
    f32x4 fA[4];
#pragma unroll
    for (int i = 0; i < 4; ++i) { fA[i] = *(const f32x4*)(AF + (row0 + rA) * 512 + h * 128 + cA + 4 * i);
        *(f32x4*)(BF + rA * BP + cA + 4 * i) = (f32x4){__logf(fA[i][0]), __logf(fA[i][1]), __logf(fA[i][2]), __logf(fA[i][3])}; }
    f32x4 fB[4]; u32x4 vB[2];
#pragma unroll
    for (int i = 0; i < 4; ++i) fB[i] = *(const f32x4*)(AF + (row0 + tB) * 512 + h * 128 + cB + 4 * i);
#pragma unroll
    for (int i = 0; i < 2; ++i) vB[i] = *(const u32x4*)(P + (row0 + tB) * LDP + PC_AI + h * 128 + cB + 8 * i);
    u32x4 qA[2];
#pragma unroll
    for (int i = 0; i < 2; ++i) qA[i] = *(const u32x4*)(P + (row0 + rA) * LDP + PC_AQ + h * 128 + cA + 8 * i);
    LDS_BARRIER();
    if (tid < 128) { float s = 0.f;
#pragma unroll
        for (int t = 0; t < 64; ++t) { s += BF[t * BP + tid]; BF[t * BP + tid] = s; } }
    LDS_BARRIER();
    {
      float qv[16] = {bf_lo(qA[0].x), bf_hi(qA[0].x), bf_lo(qA[0].y), bf_hi(qA[0].y), bf_lo(qA[0].z), bf_hi(qA[0].z), bf_lo(qA[0].w), bf_hi(qA[0].w),
                      bf_lo(qA[1].x), bf_hi(qA[1].x), bf_lo(qA[1].y), bf_hi(qA[1].y), bf_lo(qA[1].z), bf_hi(qA[1].z), bf_lo(qA[1].w), bf_hi(qA[1].w)};
      unsigned wm[8], wk[8], wh[8];
#pragma unroll
      for (int i = 0; i < 4; ++i) { const f32x4 bt = *(const f32x4*)(BF + rA * BP + cA + 4 * i), bm = *(const f32x4*)(BF + 31 * BP + cA + 4 * i);
          float qm[4], km[4], qh[4];
#pragma unroll
          for (int e = 0; e < 4; ++e) { const float q = qv[4 * i + e], kk = 1.0f - fA[i][e]; qm[e] = q * __expf(bt[e] - bm[e]); km[e] = kk * __expf(bm[e] - bt[e]); qh[e] = q * __expf(bt[e]); }
          wm[2 * i] = pk2(qm[0], qm[1]); wm[2 * i + 1] = pk2(qm[2], qm[3]); wk[2 * i] = pk2(km[0], km[1]); wk[2 * i + 1] = pk2(km[2], km[3]); wh[2 * i] = pk2(qh[0], qh[1]); wh[2 * i + 1] = pk2(qh[2], qh[3]); }
      *(u32x4*)(QM + rA * 136 + cA) = (u32x4){wm[0], wm[1], wm[2], wm[3]}; *(u32x4*)(QM + rA * 136 + cA + 8) = (u32x4){wm[4], wm[5], wm[6], wm[7]};
      *(u32x4*)(KM + rA * 136 + cA) = (u32x4){wk[0], wk[1], wk[2], wk[3]}; *(u32x4*)(KM + rA * 136 + cA + 8) = (u32x4){wk[4], wk[5], wk[6], wk[7]};
      bf16_t* qg = P + (row0 + rA) * LDP + PC_AQ + h * 128 + cA;
      if (!dry) { *(u32x4*)qg = (u32x4){wh[0], wh[1], wh[2], wh[3]}; *(u32x4*)(qg + 8) = (u32x4){wh[4], wh[5], wh[6], wh[7]}; } }
    {
#pragma unroll
      for (int i = 0; i < 4; ++i) { const f32x4 bt = *(const f32x4*)(BF + tB * BP + cB + 4 * i), be = *(const f32x4*)(BF + 63 * BP + cB + 4 * i);
          const unsigned w0 = pk2((1.0f - fB[i][0]) * __expf(be[0] - bt[0]), (1.0f - fB[i][1]) * __expf(be[1] - bt[1])), w1 = pk2((1.0f - fB[i][2]) * __expf(be[2] - bt[2]), (1.0f - fB[i][3]) * __expf(be[3] - bt[3]));
          bf16_t* kt = KET + (cB + 4 * i) * 72 + tB;
          kt[0] = (bf16_t)(w0 & 0xffffu); kt[72] = (bf16_t)(w0 >> 16); kt[144] = (bf16_t)(w1 & 0xffffu); kt[216] = (bf16_t)(w1 >> 16); }
#pragma unroll
      for (int i = 0; i < 2; ++i) { bf16_t* vt = VT + (cB + 8 * i) * 72 + tB;
          vt[0 * 72] = (bf16_t)(vB[i].x & 0xffffu); vt[1 * 72] = (bf16_t)(vB[i].x >> 16); vt[2 * 72] = (bf16_t)(vB[i].y & 0xffffu); vt[3 * 72] = (bf16_t)(vB[i].y >> 16);
          vt[4 * 72] = (bf16_t)(vB[i].z & 0xffffu); vt[5 * 72] = (bf16_t)(vB[i].z >> 16); vt[6 * 72] = (bf16_t)(vB[i].w & 0xffffu); vt[7 * 72] = (bf16_t)(vB[i].w >> 16); } }
    if (tid < 128 && !dry) DEC[(size_t)unit * 128 + tid] = __expf(BF[63 * BP + tid]);
    LDS_BARRIER();
#pragma unroll
    for (int i2 = 0; i2 < 2; ++i2) { const int ti = 2 * wave + i2, tm = ti >> 2, tn = ti & 3; const int t = tm * 16 + fr, s0 = tn * 16 + 4 * fq; f32x4 o = (f32x4){0.f, 0.f, 0.f, 0.f};
        if (tn <= tm) { const f32x4 acc = mma_tile<4>(QM + tm * 16 * 136, 136, KM + tn * 16 * 136, 136, (f32x4){0.f, 0.f, 0.f, 0.f}, fr, fq);
#pragma unroll
            for (int e = 0; e < 4; ++e) o[e] = (s0 + e <= t) ? acc[e] : 0.f; }
        *(u32x2*)(SC + t * 72 + s0) = pack4(o); }
    LDS_BARRIER();
    { const int vrow = 16 * wave + fr;
      bf16x8 vfr[2];
#pragma unroll
      for (int ks = 0; ks < 2; ++ks) vfr[ks] = *(const bf16x8*)(VT + vrow * 72 + ks * 32 + fq * 8);
#pragma unroll
      for (int tt = 0; tt < 4; ++tt) { f32x4 acc = (f32x4){0.f, 0.f, 0.f, 0.f};
#pragma unroll
          for (int ks = 0; ks < 2; ++ks) acc = __builtin_amdgcn_mfma_f32_16x16x32_bf16(vfr[ks], *(const bf16x8*)(SC + (tt * 16 + fr) * 72 + ks * 32 + fq * 8), acc, 0, 0, 0);
          if (!dry) *(u32x2*)(P + (row0 + tt * 16 + fr) * LDP + PC_AI + h * 128 + 16 * wave + 4 * fq) = pack4(acc); }
      unsigned char* srow = a_state_row(p.ws, row0, h, vrow);
#pragma unroll
      for (int kt = 0; kt < 8; ++kt) { f32x4 acc = (f32x4){0.f, 0.f, 0.f, 0.f};
#pragma unroll
          for (int ks = 0; ks < 2; ++ks) acc = __builtin_amdgcn_mfma_f32_16x16x32_bf16(*(const bf16x8*)(KET + (kt * 16 + fr) * 72 + ks * 32 + fq * 8), vfr[ks], acc, 0, 0, 0);
          if (!dry) *(u32x2*)(srow + (kt * 16 + 4 * fq) * 2) = pack4(acc); } }
}
__device__ __forceinline__ void ax2_scan(const Params& p, int first_block, int nblocks, int dry) {
    const int tid = tid_(); const float* DEC = (const float*)(p.ws + WS_DEC);
    for (int gid = (bid_() - first_block) * NTHREADS + tid; gid < 16 * 8192; gid += nblocks * NTHREADS) {
        const int bh = gid >> 13, e2 = gid & 8191, v = e2 >> 6, kp = (e2 & 63) * 2, b = bh >> 2, h = bh & 3;
        float s0 = 0.f, s1 = 0.f;
#pragma unroll 1
        for (int c0 = 0; c0 < 64; c0 += 8) {
            unsigned x[8]; f32x2 d[8];
#pragma unroll
            for (int j = 0; j < 8; ++j) { const int c = c0 + j; x[j] = *(const unsigned*)(a_state_row(p.ws, (size_t)b * SEQ + (size_t)c * 64, h, v) + kp * 2); d[j] = *(const f32x2*)(DEC + ((size_t)(b * 256 + c * 4 + h)) * 128 + kp); }
#pragma unroll
            for (int j = 0; j < 8; ++j) { const int c = c0 + j; if (!dry) *(unsigned*)(a_state_row(p.ws, (size_t)b * SEQ + (size_t)c * 64, h, v) + kp * 2) = pk2(s0, s1);
                s0 = d[j].x * s0 + bf_lo(x[j]); s1 = d[j].y * s1 + bf_hi(x[j]); }
        }
    }
}
__device__ __forceinline__ void ax3_unit(const Params& p, int l, int unit, unsigned char* lds, int dry) {
    const int tid = tid_(), lane = tid & 63, wave = tid >> 6, fr = lane & 15, fq = lane >> 4;
    const int h = unit & 3, c = (unit >> 2) & 63, b = unit >> 8;
    bf16_t* P = (bf16_t*)(p.ws + WS_P);
    bf16_t* QH = (bf16_t*)lds;
    bf16_t* SI = (bf16_t*)(lds + 17408);
    float* OL = (float*)(lds + 52224);
    const size_t row0 = (size_t)b * SEQ + (size_t)c * 64;
    LDS_BARRIER();
#pragma unroll
    for (int i2 = 0; i2 < 2; ++i2) { const int ck = tid + 512 * i2, row = ck >> 4, c8 = (ck & 15) * 8;
        *(u32x4*)(QH + row * 136 + c8) = *(const u32x4*)(P + (row0 + row) * LDP + PC_AQ + h * 128 + c8); }
#pragma unroll
    for (int i2 = 0; i2 < 4; ++i2) { const int ck = tid + 512 * i2, v = ck >> 4, c8 = (ck & 15) * 8;
        *(u32x4*)(SI + v * 136 + c8) = *(const u32x4*)(a_state_row(p.ws, row0, h, v) + c8 * 2); }
    LDS_BARRIER();
    { const int vrow = 16 * wave + fr;
      bf16x8 sfr[4];
#pragma unroll
      for (int ks = 0; ks < 4; ++ks) sfr[ks] = *(const bf16x8*)(SI + vrow * 136 + ks * 32 + fq * 8);
#pragma unroll
      for (int tt = 0; tt < 4; ++tt) { const int t = tt * 16 + fr;
          f32x4 acc = unpack4(*(const u32x2*)(P + (row0 + t) * LDP + PC_AI + h * 128 + 16 * wave + 4 * fq));
#pragma unroll
          for (int ks = 0; ks < 4; ++ks) acc = __builtin_amdgcn_mfma_f32_16x16x32_bf16(sfr[ks], *(const bf16x8*)(QH + t * 136 + ks * 32 + fq * 8), acc, 0, 0, 0);
          *(f32x4*)(OL + t * 132 + 16 * wave + 4 * fq) = acc; } }
    LDS_BARRIER();
    { const int t = tid >> 3, v0 = (tid & 7) * 16;
      f32x4 o[4]; float ss = 0.f;
#pragma unroll
      for (int i = 0; i < 4; ++i) { o[i] = *(const f32x4*)(OL + t * 132 + v0 + 4 * i); ss += (o[i][0] * o[i][0] + o[i][1] * o[i][1]) + (o[i][2] * o[i][2] + o[i][3] * o[i][3]); }
      ss += dpp_mov<0xB1>(ss); ss += dpp_mov<0x4E>(ss); ss += dpp_mov<0x141>(ss);
      const float rs = __builtin_amdgcn_rsqf(ss * (1.0f / 128.0f) + EPS);
      bf16_t* gp = P + (row0 + t) * LDP + PC_AG + h * 128 + v0;
      const u32x4 g0 = *(const u32x4*)gp, g1 = *(const u32x4*)(gp + 8);
      const float gt[16] = {bf_lo(g0.x), bf_hi(g0.x), bf_lo(g0.y), bf_hi(g0.y), bf_lo(g0.z), bf_hi(g0.z), bf_lo(g0.w), bf_hi(g0.w), bf_lo(g1.x), bf_hi(g1.x), bf_lo(g1.y), bf_hi(g1.y), bf_lo(g1.z), bf_hi(g1.z), bf_lo(g1.w), bf_hi(g1.w)};
      unsigned w[8];
#pragma unroll
      for (int i = 0; i < 4; ++i) { const f32x4 nw = *(const f32x4*)(p.norm_a + l * 128 + v0 + 4 * i);
          const float y0 = o[i][0] * rs * nw[0] * siluf_(gt[4 * i]), y1 = o[i][1] * rs * nw[1] * siluf_(gt[4 * i + 1]), y2 = o[i][2] * rs * nw[2] * siluf_(gt[4 * i + 2]), y3 = o[i][3] * rs * nw[3] * siluf_(gt[4 * i + 3]);
          w[2 * i] = pk2(y0, y1); w[2 * i + 1] = pk2(y2, y3); }
      if (!dry) { *(u32x4*)gp = (u32x4){w[0], w[1], w[2], w[3]}; *(u32x4*)(gp + 8) = (u32x4){w[4], w[5], w[6], w[7]}; } }
}


__device__ __forceinline__ void a2_block(const Params& p, int blk, unsigned char* lds) {
    const int tid = tid_(), lane = tid & 63, wave = tid >> 6, fr = lane & 15, fq = lane >> 4;
    const int bh = blk >> 3, v0 = (blk & 7) * 16, b = bh >> 2, h = bh & 3;
    bf16_t* P = (bf16_t*)(p.ws + WS_P); const float* DEC = (const float*)(p.ws + WS_DEC);
    const int sv = tid >> 5, sk = (tid & 31) * 4;
    f32x4 S = (f32x4){0.f, 0.f, 0.f, 0.f};
    u32x4 rq[2]; u32x2 rds; f32x4 rd;
    auto gload = [&](int c) { const size_t row0 = (size_t)b * SEQ + (size_t)c * 64;
#pragma unroll
        for (int i2 = 0; i2 < 2; ++i2) { const int ck = tid + 512 * i2; rq[i2] = *(const u32x4*)(P + (row0 + (ck >> 4)) * LDP + PC_AQ + h * 128 + (ck & 15) * 8); }
        rds = *(const u32x2*)(a_state_row(p.ws, row0, h, v0 + sv) + sk * 2);
        rd = *(const f32x4*)(DEC + (size_t)((b * 64 + c) * 4 + h) * 128 + sk); };
    gload(0);
    LDS_BARRIER();
#pragma unroll 1
    for (int c = 0; c < 64; ++c) {
        bf16_t* QH = (bf16_t*)(lds + (c & 1) * 21760); bf16_t* SI = QH + 64 * 136;
#pragma unroll
        for (int i2 = 0; i2 < 2; ++i2) { const int ck = tid + 512 * i2; *(u32x4*)(QH + (ck >> 4) * 136 + (ck & 15) * 8) = rq[i2]; }
        *(u32x2*)(SI + sv * 136 + sk) = pack4(S);
        S = S * rd + unpack4(rds);
        if (c + 1 < 64) gload(c + 1);
        LDS_BARRIER();
        if (wave < 4) { const size_t row0 = (size_t)b * SEQ + (size_t)c * 64; const int t = wave * 16 + fr;
            bf16_t* op = P + (row0 + t) * LDP + PC_AI + h * 128 + v0 + 4 * fq;
            f32x4 acc = unpack4(*(const u32x2*)op);
#pragma unroll
            for (int ks = 0; ks < 4; ++ks) acc = __builtin_amdgcn_mfma_f32_16x16x32_bf16(*(const bf16x8*)(SI + fr * 136 + ks * 32 + fq * 8), *(const bf16x8*)(QH + t * 136 + ks * 32 + fq * 8), acc, 0, 0, 0);
            *(u32x2*)op = pack4(acc); }
    }
}
__device__ __forceinline__ void cmma_unit(const Params& p, int l, int unit, unsigned char* lds, int dry) {
    const int tid = tid_(), lane = tid & 63, wave = tid >> 6, fr = lane & 15, fq = lane >> 4;
    const int kvh = unit & 1, nb = (unit >> 1) & 31, b = unit >> 6;
    bf16_t* P = (bf16_t*)(p.ws + WS_P);
    bf16_t* sK = (bf16_t*)lds;
    bf16_t* sVT = (bf16_t*)(lds + 36864);
    float* sBias = (float*)(lds + 70656);
    bf16_t* sP = (bf16_t*)(lds + 72704) + wave * (16 * 168);
    const size_t rowq0 = (size_t)b * SEQ + (size_t)nb * 128;
    const bool first = (nb == 0);
    LDS_BARRIER();
#pragma unroll
    for (int i2 = 0; i2 < 4; ++i2) { const int ck = tid + 512 * i2, j = ck >> 3, d8 = (ck & 7) * 8; u32x4 kv = (u32x4){0u, 0u, 0u, 0u};
        if (!first || j >= 128) kv = *(const u32x4*)(P + (rowq0 - 128 + j) * LDP + PC_CK + kvh * 64 + d8);
        *(u32x4*)(sK + j * 72 + d8) = kv; }
    { const int j = tid & 255, dh = (tid >> 8) * 32;
#pragma unroll
      for (int i = 0; i < 4; ++i) { u32x4 vv = (u32x4){0u, 0u, 0u, 0u};
          if (!first || j >= 128) vv = *(const u32x4*)(P + (rowq0 - 128 + j) * LDP + PC_CV + kvh * 64 + dh + 8 * i);
          bf16_t* vt = sVT + (dh + 8 * i) * 264 + j;
          vt[0 * 264] = (bf16_t)(vv.x & 0xffffu); vt[1 * 264] = (bf16_t)(vv.x >> 16); vt[2 * 264] = (bf16_t)(vv.y & 0xffffu); vt[3 * 264] = (bf16_t)(vv.y >> 16);
          vt[4 * 264] = (bf16_t)(vv.z & 0xffffu); vt[5 * 264] = (bf16_t)(vv.z >> 16); vt[6 * 264] = (bf16_t)(vv.w & 0xffffu); vt[7 * 264] = (bf16_t)(vv.w >> 16); } }
    { const int g = tid >> 7, dist = tid & 127; sBias[g * 128 + dist] = p.rel_bias[(int)kBucket[dist] * 8 + kvh * 4 + g]; }
    LDS_BARRIER();
    const int a = wave, kb0 = 32 * (a >> 1), qi = 16 * a + fr;
#pragma unroll 1
    for (int g = 0; g < 4; ++g) {
        const int hq = kvh * 4 + g; const size_t rowq = rowq0 + qi;
        bf16x8 qf[2];
#pragma unroll
        for (int ks = 0; ks < 2; ++ks) qf[ks] = *(const bf16x8*)(P + rowq * LDP + PC_CQ + hq * 64 + ks * 32 + fq * 8);
        f32x4 s[10];
#pragma unroll
        for (int kt = 0; kt < 10; ++kt) { f32x4 acc = (f32x4){0.f, 0.f, 0.f, 0.f};
#pragma unroll
            for (int ks = 0; ks < 2; ++ks) acc = __builtin_amdgcn_mfma_f32_16x16x32_bf16(*(const bf16x8*)(sK + (kb0 + kt * 16 + fr) * 72 + ks * 32 + fq * 8), qf[ks], acc, 0, 0, 0);
            s[kt] = acc; }
        const float sink = p.sinks[l * 8 + hq];
        float mx = sink;
#pragma unroll
        for (int kt = 0; kt < 10; ++kt)
#pragma unroll
            for (int e = 0; e < 4; ++e) { const int j = kb0 + kt * 16 + 4 * fq + e; const int dist = qi + 128 - j; const bool ok = (dist >= 0) && (dist < 128) && !(first && j < 128);
                const float v = ok ? s[kt][e] + sBias[g * 128 + (dist & 127)] : -1e30f; s[kt][e] = v; mx = fmaxf(mx, v); }
        { auto r16 = __builtin_amdgcn_permlane16_swap(__float_as_uint(mx), __float_as_uint(mx), false, false); mx = fmaxf(__uint_as_float(r16[0]), __uint_as_float(r16[1]));
          auto r32 = __builtin_amdgcn_permlane32_swap(__float_as_uint(mx), __float_as_uint(mx), false, false); mx = fmaxf(__uint_as_float(r32[0]), __uint_as_float(r32[1])); }
        float ls = 0.f;
#pragma unroll
        for (int kt = 0; kt < 10; ++kt) { f32x4 pe;
#pragma unroll
            for (int e = 0; e < 4; ++e) pe[e] = __expf(s[kt][e] - mx);
            const u32x2 pk = pack4(pe); ls += (bf_lo(pk.x) + bf_hi(pk.x)) + (bf_lo(pk.y) + bf_hi(pk.y));
            *(u32x2*)(sP + fr * 168 + kt * 16 + 4 * fq) = pk; }
        ls = xor32_sum(xor16_sum(ls)) + __expf(sink - mx);
        const float inv = __builtin_amdgcn_rcpf(ls);
        asm volatile("s_waitcnt lgkmcnt(0)" ::: "memory");
        bf16x8 pf[5];
#pragma unroll
        for (int ks = 0; ks < 5; ++ks) pf[ks] = *(const bf16x8*)(sP + fr * 168 + ks * 32 + fq * 8);
        bf16_t* gp = P + rowq * LDP + PC_CG + hq * 64;
#pragma unroll
        for (int dt = 0; dt < 4; ++dt) { f32x4 acc = (f32x4){0.f, 0.f, 0.f, 0.f};
#pragma unroll
            for (int ks = 0; ks < 5; ++ks) acc = __builtin_amdgcn_mfma_f32_16x16x32_bf16(*(const bf16x8*)(sVT + (dt * 16 + fr) * 264 + kb0 + ks * 32 + fq * 8), pf[ks], acc, 0, 0, 0);
            const f32x4 gt = unpack4(*(const u32x2*)(gp + dt * 16 + 4 * fq));
            f32x4 y;
#pragma unroll
            for (int e = 0; e < 4; ++e) y[e] = acc[e] * inv * siluf_(gt[e]);
            if (!dry) *(u32x2*)(gp + dt * 16 + 4 * fq) = pack4(y); }
        asm volatile("s_waitcnt lgkmcnt(0)" ::: "memory");
    }
}
__device__ __forceinline__ void mixer_c(const Params& p, int l, int unit, unsigned char* lds, int dry) {
    const int tid = tid_(), wave = tid >> 6;
    const int kvh = unit & 1, nb = (unit >> 1) & 31, b = unit >> 6;
    bf16_t* P = (bf16_t*)(p.ws + WS_P);
    bf16_t* sK = (bf16_t*)lds;
    bf16_t* sVT = (bf16_t*)(lds + 32768);
    float* sBias = (float*)(lds + 32768 + 64 * 264 * 2);
    constexpr int VTP = 264;
    const size_t rowq0 = (size_t)b * SEQ + (size_t)nb * 128;
    __syncthreads();
    for (int c = tid; c < 256 * 8; c += NTHREADS) {
        const int j = c >> 3, d8 = (c & 7) * 8; u32x4 kv = (u32x4){0u, 0u, 0u, 0u}, vv = (u32x4){0u, 0u, 0u, 0u};
        if (nb > 0 || j >= 128) { const size_t row = rowq0 - 128 + j; kv = *(const u32x4*)(P + row * LDP + PC_CK + kvh * 64 + d8); vv = *(const u32x4*)(P + row * LDP + PC_CV + kvh * 64 + d8); }
        *(u32x4*)(sK + j * 64 + d8) = kv;
        sVT[(d8 + 0) * VTP + j] = (bf16_t)(vv.x & 0xffff); sVT[(d8 + 1) * VTP + j] = (bf16_t)(vv.x >> 16);
        sVT[(d8 + 2) * VTP + j] = (bf16_t)(vv.y & 0xffff); sVT[(d8 + 3) * VTP + j] = (bf16_t)(vv.y >> 16);
        sVT[(d8 + 4) * VTP + j] = (bf16_t)(vv.z & 0xffff); sVT[(d8 + 5) * VTP + j] = (bf16_t)(vv.z >> 16);
        sVT[(d8 + 6) * VTP + j] = (bf16_t)(vv.w & 0xffff); sVT[(d8 + 7) * VTP + j] = (bf16_t)(vv.w >> 16);
    }
    { const int g = tid >> 7, dist = tid & 127; sBias[g * 128 + dist] = p.rel_bias[(int)kBucket[dist] * 8 + kvh * 4 + g]; }
    __syncthreads();
    const int g = tid >> 7, i = tid & 127, hq = kvh * 4 + g;
    const size_t rowq = rowq0 + i;
    unsigned qp[32];
#pragma unroll
    for (int c = 0; c < 8; ++c) { const u32x4 t = *(const u32x4*)(P + rowq * LDP + PC_CQ + hq * 64 + c * 8); qp[4 * c] = t.x; qp[4 * c + 1] = t.y; qp[4 * c + 2] = t.z; qp[4 * c + 3] = t.w; }
    float o[64];
#pragma unroll
    for (int d = 0; d < 64; ++d) o[d] = 0.f;
    const float sink = p.sinks[l * 8 + hq];
    float mrun = sink, lrun = 1.0f;
    const int jlo = 64 * (wave & 1);
    const bool first = (nb == 0);
    for (int jg = 0; jg < 24; ++jg) {
        const int j0 = jlo + jg * 8;
        float s[8];
#pragma unroll
        for (int u = 0; u < 8; ++u) {
            const int j = j0 + u; const bf16_t* kr = sK + j * 64; float a = 0.f;
#pragma unroll
            for (int c = 0; c < 8; ++c) { const u32x4 kk = *(const u32x4*)(kr + c * 8);
                a = dot2u(kk.x, qp[4 * c], a);
                a = dot2u(kk.y, qp[4 * c + 1], a);
                a = dot2u(kk.z, qp[4 * c + 2], a);
                a = dot2u(kk.w, qp[4 * c + 3], a); }
            const int dist = i + 128 - j; const bool ok = (dist >= 0) && (dist < 128) && !(first && j < 128);
            s[u] = ok ? a + sBias[g * 128 + (dist & 127)] : -1e30f;
        }
        float gm = fmaxf(fmaxf(fmaxf(s[0], s[1]), fmaxf(s[2], s[3])), fmaxf(fmaxf(s[4], s[5]), fmaxf(s[6], s[7])));
        const float mnew = fmaxf(mrun, gm); const float corr = __expf(mrun - mnew); mrun = mnew;
        float ps = 0.f; unsigned pp[4];
        float pe[8];
#pragma unroll
        for (int u = 0; u < 8; ++u) { pe[u] = __expf(s[u] - mnew); }
#pragma unroll
        for (int u = 0; u < 4; ++u) { pp[u] = pk2(pe[2 * u], pe[2 * u + 1]); ps += bf_lo(pp[u]) + bf_hi(pp[u]); }
        lrun = lrun * corr + ps;
#pragma unroll
        for (int d = 0; d < 64; ++d) {
            const u32x4 vt = *(const u32x4*)(sVT + d * VTP + j0);
            float a = o[d] * corr;
            a = dot2u(vt.x, pp[0], a);
            a = dot2u(vt.y, pp[1], a);
            a = dot2u(vt.z, pp[2], a);
            a = dot2u(vt.w, pp[3], a);
            o[d] = a;
        }
    }
    float inv = 1.0f / lrun;
#if DIAG_ZERO_C
    inv = 0.f;
#endif
    bf16_t* gp = P + rowq * LDP + PC_CG + hq * 64;
#pragma unroll
    for (int c = 0; c < 8; ++c) {
        const u32x4 gv = *(const u32x4*)(gp + c * 8); u32x4 ov;
        ov.x = pk2(o[8 * c + 0] * inv * siluf_(bf_lo(gv.x)), o[8 * c + 1] * inv * siluf_(bf_hi(gv.x)));
        ov.y = pk2(o[8 * c + 2] * inv * siluf_(bf_lo(gv.y)), o[8 * c + 3] * inv * siluf_(bf_hi(gv.y)));
        ov.z = pk2(o[8 * c + 4] * inv * siluf_(bf_lo(gv.z)), o[8 * c + 5] * inv * siluf_(bf_hi(gv.z)));
        ov.w = pk2(o[8 * c + 6] * inv * siluf_(bf_lo(gv.w)), o[8 * c + 7] * inv * siluf_(bf_hi(gv.w)));
        if (!dry) *(u32x4*)(gp + c * 8) = ov;
    }
}


#if DIAG_NAIVE_C
__device__ __forceinline__ void mixer_c_naive(const Params& p, int l, int unit) {
    const int tid = tid_();
    const int kvh = unit & 1, nb = (unit >> 1) & 31, b = unit >> 6;
    bf16_t* P = (bf16_t*)(p.ws + WS_P);
    const int g = tid >> 7, i = tid & 127, hq = kvh * 4 + g;
    const size_t rowq = (size_t)b * SEQ + (size_t)nb * 128 + i;
    float q[64], o[64];
#pragma unroll
    for (int d = 0; d < 64; ++d) { q[d] = bf2f(P[rowq * LDP + PC_CQ + hq * 64 + d]); o[d] = 0.f; }
    float m = p.sinks[l * 8 + hq], lsum = 1.0f;
    const int tpos = nb * 128 + i;
    for (int kp = tpos - 127; kp <= tpos; ++kp) {
        if (kp < 0) continue;
        const size_t rowk = (size_t)b * SEQ + kp;
        float s = 0.f;
#pragma unroll
        for (int d = 0; d < 64; ++d) s += q[d] * bf2f(P[rowk * LDP + PC_CK + kvh * 64 + d]);
        s += p.rel_bias[(int)kBucket[tpos - kp] * 8 + hq];
        const float mn = fmaxf(m, s); const float corr = __expf(m - mn); const float pe = __expf(s - mn); m = mn;
        lsum = lsum * corr + pe;
#pragma unroll
        for (int d = 0; d < 64; ++d) o[d] = o[d] * corr + pe * bf2f(P[rowk * LDP + PC_CV + kvh * 64 + d]);
    }
    const float inv = 1.0f / lsum;
#pragma unroll
    for (int d = 0; d < 64; ++d) { const size_t a = rowq * LDP + PC_CG + hq * 64 + d; P[a] = (bf16_t)f2bf(o[d] * inv * siluf_(bf2f(P[a]))); }
}
#endif
__device__ __forceinline__ void phase_mixers(const Params& p, int l, unsigned char* lds, int dry, int mask) {
    const int vb = bid_(), G = gridDim.x;
#pragma unroll 1
    for (int u = vb; u < 1024; u += G) { if (mask & 2) bpre_unit(p, l, u, lds, dry); if (mask & 1) ax1_unit(p, u, lds, dry); }
    if (mask & 4) {
#pragma unroll 1
    for (int u = vb; u < 256; u += G) cmma_unit(p, l, u, lds, dry); }
}
__device__ __forceinline__ void phase_scan(const Params& p, int l, unsigned char* lds, int dry, int mask) {
    const int vb = bid_();
    if (vb < 64) { if (mask & 2) bscan_block(p, vb, lds, dry); }
    else if (vb < 192) { if ((mask & 1) && !dry) a2_block(p, vb - 64, lds); }
}
__device__ __forceinline__ void phase_finalize(const Params& p, int l) {
    const int tid = tid_(), lane = tid & 63, wave = tid >> 6;
    bf16_t* P = (bf16_t*)(p.ws + WS_P);
    const int hh = lane >> 4, v8 = (lane & 15) * 8;
    float wa[8], wb[8];
#pragma unroll
    for (int e = 0; e < 8; ++e) { wa[e] = p.norm_a[l * 128 + v8 + e]; wb[e] = p.norm_b[l * 128 + v8 + e]; }
    const int gw = bid_() * 8 + wave, NGW = gridDim.x * 8;
    for (int m = gw; m < M; m += NGW) {
        bf16_t* pr = P + (size_t)m * LDP;
#pragma unroll
        for (int br = 0; br < 2; ++br) {
            const int ocol = br == 0 ? PC_AI + hh * 128 + v8 : PC_BQKV + 1024 + hh * 128 + v8;
            const int gcol = br == 0 ? PC_AG + hh * 128 + v8 : PC_BZ + hh * 128 + v8;
            const u32x4 ov = *(const u32x4*)(pr + ocol); const u32x4 gv = *(const u32x4*)(pr + gcol);
            float o[8] = {bf_lo(ov.x), bf_hi(ov.x), bf_lo(ov.y), bf_hi(ov.y), bf_lo(ov.z), bf_hi(ov.z), bf_lo(ov.w), bf_hi(ov.w)};
            float gt[8] = {bf_lo(gv.x), bf_hi(gv.x), bf_lo(gv.y), bf_hi(gv.y), bf_lo(gv.z), bf_hi(gv.z), bf_lo(gv.w), bf_hi(gv.w)};
            float ss = 0.f;
#pragma unroll
            for (int e = 0; e < 8; ++e) ss += o[e] * o[e];
            ss = row16_sum(ss);
            const float rs = 1.0f / sqrtf(ss * (1.0f / 128.0f) + EPS);
            float y[8];
#pragma unroll
            for (int e = 0; e < 8; ++e) y[e] = o[e] * rs * (br == 0 ? wa[e] : wb[e]) * siluf_(gt[e]);
            u32x4 yo; yo.x = pk2(y[0], y[1]); yo.y = pk2(y[2], y[3]); yo.z = pk2(y[4], y[5]); yo.w = pk2(y[6], y[7]);
            *(u32x4*)(pr + gcol) = yo;
        }
    }
}

__device__ __forceinline__ int launder_i(int v) { asm volatile("" : "+s"(v)); return v; }
__device__ __forceinline__ Params launder(Params p) {
    asm volatile("" : "+s"(p.x), "+s"(p.norm_w), "+s"(p.w_in), "+s"(p.conv_w), "+s"(p.a_log), "+s"(p.dt_bias), "+s"(p.lb_param), "+s"(p.norm_a));
    asm volatile("" : "+s"(p.norm_b), "+s"(p.sinks), "+s"(p.rel_bias), "+s"(p.w_branch), "+s"(p.w_out), "+s"(p.final_norm), "+s"(p.out), "+s"(p.ws));
    return p;
}
#define XB_TMO      128
#define XB_XCNT(j)  (256  + 64 * (j))
#define XB_XSUB(j)  (1280 + 64 * (j))
#define XB_XGEN(j)  (2304 + 64 * (j))
#define XB_TOP      3328
#define XB_TOPGEN   3392
#define XCD_BAR_WORDS 3456
#define XB_SPIN_CAP (1u << 18)

__device__ __forceinline__ unsigned xb_ld(unsigned* p)              { return __hip_atomic_load(p, __ATOMIC_RELAXED, __HIP_MEMORY_SCOPE_AGENT); }
__device__ __forceinline__ unsigned xb_add(unsigned* p, unsigned v) { return __hip_atomic_fetch_add(p, v, __ATOMIC_RELAXED, __HIP_MEMORY_SCOPE_AGENT); }
__device__ __forceinline__ unsigned xb_xcc_id() { return (unsigned)__builtin_amdgcn_s_getreg((3 << 11) | 20) & 0xFu; }
#define XB_SPIN(cond, bar) do { unsigned _sp = 0; while (cond) { __builtin_amdgcn_s_sleep(1); \
    if ((++_sp & 255u) == 0u) { if (xb_ld(&(bar)[XB_TMO])) break; if (_sp > XB_SPIN_CAP) { atomicAdd(&(bar)[XB_TMO], 1u); break; } } } } while (0)

struct XcdBarrier {
    unsigned* bar; unsigned x;
    volatile __attribute__((address_space(3))) unsigned* st;
};

__device__ __forceinline__ XcdBarrier xcd_barrier_post(unsigned* bar, volatile __attribute__((address_space(3))) unsigned* st) {
    XcdBarrier b; b.bar = bar; b.x = xb_xcc_id(); b.st = st;
    if (threadIdx.x == 0) (void)xb_add(&bar[XB_XCNT(b.x)], 1u);
    return b;
}
__device__ __forceinline__ void xcd_barrier_complete(unsigned* bar, unsigned x, unsigned& nloc, unsigned& nx) {
    const unsigned G = gridDim.x * gridDim.y * gridDim.z;
    unsigned sum, cnt, mine, sp = 0u;
    for (;;) {
        sum = 0u; cnt = 0u; mine = 0u;
#pragma unroll
        for (unsigned j = 0; j < 16; ++j) { const unsigned c = xb_ld(&bar[XB_XCNT(j)]); sum += c; cnt += (c > 0u) ? 1u : 0u; mine = (j == x) ? c : mine; }
        if (sum == G) break;
        __builtin_amdgcn_s_sleep(1);
        if ((++sp & 255u) == 0u) { if (xb_ld(&bar[XB_TMO])) break; if (sp > XB_SPIN_CAP) { atomicAdd(&bar[XB_TMO], 1u); break; } }
    }
    nloc = mine > 0u ? mine : 1u; nx = cnt > 0u ? cnt : 1u;
}

__device__ __forceinline__ void xcd_barrier(const XcdBarrier& b) {
    asm volatile("s_waitcnt vmcnt(0)" ::: "memory");
    __syncthreads();
    if (threadIdx.x == 0) {
        unsigned* bar = b.bar;
        __builtin_amdgcn_s_waitcnt(0);
        unsigned nloc = b.st[0], nx = b.st[1];
        if (nloc == 0u) { xcd_barrier_complete(bar, b.x, nloc, nx); b.st[0] = nloc; b.st[1] = nx; }
        const unsigned old = xb_add(&bar[XB_XSUB(b.x)], 1u);
        const unsigned gen = old / nloc;
        if (old + 1u == (gen + 1u) * nloc) {
            __builtin_amdgcn_fence(__ATOMIC_RELEASE, "agent");
            asm volatile("s_waitcnt vmcnt(0)" ::: "memory");
            const unsigned og = xb_add(&bar[XB_TOP], 1u);
            const unsigned tg = og / nx;
            if (og + 1u == (tg + 1u) * nx) xb_add(&bar[XB_TOPGEN], 1u);
            else XB_SPIN(xb_ld(&bar[XB_TOPGEN]) == tg, bar);
            __builtin_amdgcn_fence(__ATOMIC_ACQUIRE, "agent");
            xb_add(&bar[XB_XGEN(b.x)], 1u);
            asm volatile("s_waitcnt vmcnt(0)" ::: "memory");
        } else {
            XB_SPIN(xb_ld(&bar[XB_XGEN(b.x)]) == gen, bar);
            __builtin_amdgcn_fence(__ATOMIC_ACQUIRE, "agent");
            asm volatile("s_waitcnt vmcnt(0)" ::: "memory");
        }
    }
    __syncthreads();
}


__global__ void __launch_bounds__(NTHREADS, 2) fwd_megakernel(Params p) {
    extern __shared__ __attribute__((aligned(16))) unsigned char lds[];
    cg::grid_group grid = cg::this_grid();
    volatile __attribute__((address_space(3))) unsigned* bst = (volatile __attribute__((address_space(3))) unsigned*)((__attribute__((address_space(3))) unsigned char*)lds + (LDS_BYTES - 16));
    if (threadIdx.x < 4) bst[threadIdx.x] = 0u;
    __syncthreads();
    XcdBarrier xbar = xcd_barrier_post((unsigned*)(p.ws + WS_BAR), bst);
#define GRID_BAR() xcd_barrier(xbar)
#pragma unroll 1
    for (int l0 = 0; l0 < DEPTH; ++l0) {
        { const Params q = launder(p); const int l = launder_i(l0); phase_convert_weights(q, l, lds); }
        __syncthreads();
        { const Params q = launder(p); const int l = launder_i(l0); phase_rowpass<0>(q, (l == 0) ? q.x : q.out, q.norm_w + (size_t)l * D, l, lds); }
        grid.sync();
#if DIAG_DUP == 1
        { const Params q = launder(p); const int l = launder_i(l0); phase_convert_weights(q, l, lds); }
        __syncthreads();
        { const Params q = launder(p); const int l = launder_i(l0); phase_rowpass<0>(q, (l == 0) ? q.x : q.out, q.norm_w + (size_t)l * D, l, lds); }
        GRID_BAR();
#endif
#if DIAG_DUP == 7
        { const Params q = launder(p); const int l = launder_i(l0); phase_convert_weights(q, l, lds); }
        GRID_BAR();
#endif
#if DIAG_DUP == 8
        { const Params q = launder(p); const int l = launder_i(l0); phase_rowpass<0>(q, (l == 0) ? q.x : q.out, q.norm_w + (size_t)l * D, l, lds); }
        GRID_BAR();
#endif
#if DIAG_DUP == 2
        { const Params q = launder(p); const int l = launder_i(l0); phase_inproj(q, l, lds); }
        GRID_BAR();
#endif
        { const Params q = launder(p); const int l = launder_i(l0); phase_inproj(q, l, lds); }
        GRID_BAR();
#if DIAG_DUP >= 10 && DIAG_DUP < 20
        { const Params q = launder(p); const int l = launder_i(l0); phase_mixers(q, l, lds, launder_i(DIAG_DRYMODE), launder_i(DIAG_DUP - 10)); }
        GRID_BAR();
#endif
        { const Params q = launder(p); const int l = launder_i(l0); phase_mixers(q, l, lds, launder_i(0), launder_i(7)); }
        GRID_BAR();
#if DIAG_DUP >= 20 && DIAG_DUP < 30
        { const Params q = launder(p); const int l = launder_i(l0); phase_scan(q, l, lds, launder_i(1), launder_i(DIAG_DUP - 20)); }
        GRID_BAR();
#endif
        { const Params q = launder(p); const int l = launder_i(l0); phase_scan(q, l, lds, launder_i(0), launder_i(3)); }
        GRID_BAR();
        { const Params q = launder(p); const int l = launder_i(l0); phase_finalize(q, l); }
#if DIAG_DUP == 4
        { const Params q = launder(p); phase_gates(q, lds); }
        GRID_BAR();
#endif
        { const Params q = launder(p); phase_gates(q, lds); }
        GRID_BAR();
#if DIAG_DUP == 5
        { const Params q = launder(p); phase_lift(q, lds); }
        GRID_BAR();
#endif
        { const Params q = launder(p); phase_lift(q, lds); }
        GRID_BAR();
        { const Params q = launder(p); const int l = launder_i(l0); phase_outproj(q, (l == 0) ? q.x : q.out, lds); }
        GRID_BAR();
#if DIAG_DUP == 6
        GRID_BAR(); GRID_BAR(); GRID_BAR(); GRID_BAR(); GRID_BAR(); GRID_BAR(); GRID_BAR(); GRID_BAR(); GRID_BAR(); GRID_BAR();
#endif
    }
    { const Params q = launder(p); phase_rowpass<1>(q, q.out, q.final_norm, 0, lds); }
}

extern "C" void kernel_launch(void* const* d_in, const int* in_sizes, int n_in, void* d_out, int out_size, void* d_ws, size_t ws_size, hipStream_t stream) {
    static int grid_blocks = 0;
    if (grid_blocks == 0) {
        if (n_in != 14 || in_sizes[0] != M * D || out_size != M * D || ws_size < WS_END) {
            fprintf(stderr, "kernel_launch: unexpected shapes n_in=%d in0=%d out=%d ws=%zu (need %zu)\n", n_in, n_in > 0 ? in_sizes[0] : -1, out_size, ws_size, (size_t)WS_END); grid_blocks = -1; return; }
        int dev = 0, cus = 0, per_cu = 0;
        hipGetDevice(&dev);
        hipDeviceGetAttribute(&cus, hipDeviceAttributeMultiprocessorCount, dev);
        hipFuncSetAttribute((const void*)fwd_megakernel, hipFuncAttributeMaxDynamicSharedMemorySize, LDS_BYTES);
        hipOccupancyMaxActiveBlocksPerMultiprocessor(&per_cu, (const void*)fwd_megakernel, NTHREADS, LDS_BYTES);
        if (per_cu < 1) { fprintf(stderr, "kernel_launch: occupancy query says %d blocks/CU\n", per_cu); per_cu = 1; }
        if (per_cu > 1) per_cu = 1;
        grid_blocks = cus * per_cu;
        if (grid_blocks < 256) { fprintf(stderr, "kernel_launch: needs >= 256 resident blocks, got %d\n", grid_blocks); grid_blocks = -1; return; }
    }
    if (grid_blocks < 0) return;
    Params p{};
    p.x = (const float*)d_in[0]; p.norm_w = (const float*)d_in[1]; p.w_in = (const float*)d_in[2]; p.conv_w = (const float*)d_in[3];
    p.a_log = (const float*)d_in[4]; p.dt_bias = (const float*)d_in[5]; p.lb_param = (const float*)d_in[6]; p.norm_a = (const float*)d_in[7];
    p.norm_b = (const float*)d_in[8]; p.sinks = (const float*)d_in[9]; p.rel_bias = (const float*)d_in[10]; p.w_branch = (const float*)d_in[11];
    p.w_out = (const float*)d_in[12]; p.final_norm = (const float*)d_in[13];
    p.out = (float*)d_out; p.ws = (unsigned char*)d_ws;
    (void)hipMemsetAsync((char*)d_ws + WS_BAR, 0, 16384, stream);
    void* args[] = {&p};
    hipError_t e = hipLaunchCooperativeKernel((const void*)fwd_megakernel, dim3(grid_blocks), dim3(NTHREADS), args, LDS_BYTES, stream);
    if (e != hipSuccess) fprintf(stderr, "cooperative launch failed: %s (grid %d)\n", hipGetErrorString(e), grid_blocks);
}
```

```cpp
#include <hip/hip_runtime.h>
#include <hip/hip_cooperative_groups.h>
#include <cstdio>
#include <cstdint>
namespace cg = cooperative_groups;

typedef unsigned short bf16_t;
typedef short bf16x8 __attribute__((ext_vector_type(8)));
typedef float f32x4 __attribute__((ext_vector_type(4)));
typedef float f32x2 __attribute__((ext_vector_type(2)));
typedef unsigned u32x4 __attribute__((ext_vector_type(4)));
typedef unsigned u32x2 __attribute__((ext_vector_type(2)));
typedef __bf16 bf16x2v __attribute__((ext_vector_type(2)));

constexpr int BATCH = 4, SEQ = 4096, M = BATCH * SEQ, D = 1024, DEPTH = 2;
constexpr int NORIG = 8456;
constexpr int NMIX = 5376;
constexpr int NGATE = 3072;
constexpr int NALL = NMIX + NGATE;
constexpr int LDP = NMIX;
constexpr int PC_AQ = 0, PC_AI = 1024, PC_AG = 1536, PC_BQKV = 2048, PC_BZ = 3584, PC_CQ = 4096, PC_CK = 4608, PC_CV = 4736, PC_CG = 4864;
constexpr float EPS = 1e-6f;
constexpr int NTHREADS = 512;
constexpr int LDS_BYTES = 155648;
#define DIAG_ZERO_C 0
#define DIAG_NAIVE_C 0
#define DIAG_DUP 0
#define DIAG_DRYMODE 1
#define DIAG_DRY 1

constexpr size_t WS_P = 0;
constexpr size_t WS_AF = WS_P + (size_t)M * LDP * 2;
constexpr size_t WS_HB = WS_AF + (size_t)M * 512 * 4;
constexpr size_t WS_WIN = WS_HB + (size_t)M * D * 2;
constexpr size_t WS_WB = WS_WIN + (size_t)NALL * D * 2;
constexpr size_t WS_WO = WS_WB + (size_t)D * 1536 * 2;
constexpr size_t WS_SM = WS_WO + (size_t)D * D * 2;
constexpr size_t WS_HALO = WS_SM + (size_t)M * 8 * 4;
constexpr size_t WS_GC = WS_HALO + (size_t)256 * 3 * 1536 * 2;
constexpr size_t WS_DEC = WS_GC + (size_t)M * 4 * 4;
constexpr size_t WS_BAR = WS_DEC + (size_t)1024 * 128 * 4;
constexpr size_t WS_QK = WS_BAR + 16384;
constexpr size_t WS_END = WS_QK + (size_t)1024 * 2560 * 2;

__device__ const unsigned char kBucket[128] = {0, 1, 2, 3, 4, 5, 6, 7, 8, 9, 10, 11, 12, 13, 14, 15, 16, 16, 16, 17, 17, 18, 18, 18, 19, 19, 19, 20, 20, 20, 20, 21, 21, 21, 21, 22, 22, 22, 22, 22, 23, 23, 23, 23, 23, 23, 24, 24, 24, 24, 24, 24, 25, 25, 25, 25, 25, 25, 25, 26, 26, 26, 26, 26, 26, 26, 26, 27, 27, 27, 27, 27, 27, 27, 27, 27, 27, 28, 28, 28, 28, 28, 28, 28, 28, 28, 28, 29, 29, 29, 29, 29, 29, 29, 29, 29, 29, 29, 29, 30, 30, 30, 30, 30, 30, 30, 30, 30, 30, 30, 30, 30, 30, 31, 31, 31, 31, 31, 31, 31, 31, 31, 31, 31, 31, 31, 31, 31};

struct Params {
    const float* x; const float* norm_w; const float* w_in; const float* conv_w; const float* a_log; const float* dt_bias;
    const float* lb_param; const float* norm_a; const float* norm_b; const float* sinks; const float* rel_bias;
    const float* w_branch; const float* w_out; const float* final_norm;
    float* out; unsigned char* ws;
};

__device__ __forceinline__ unsigned f2bf(float f) { unsigned u = __builtin_bit_cast(unsigned, f); return (u + 0x7fffu + ((u >> 16) & 1u)) >> 16; }
__device__ __forceinline__ unsigned pk2(float lo, float hi) { const f32x2 v = {lo, hi}; const bf16x2v b = __builtin_convertvector(v, bf16x2v); return __builtin_bit_cast(unsigned, b); }
__device__ __forceinline__ float bf_lo(unsigned u) { return __builtin_bit_cast(float, u << 16); }
__device__ __forceinline__ float bf_hi(unsigned u) { return __builtin_bit_cast(float, u & 0xffff0000u); }
__device__ __forceinline__ float bf2f(bf16_t b) { return __builtin_bit_cast(float, (unsigned)b << 16); }
__device__ __forceinline__ int tid_() { int t = threadIdx.x; asm volatile("" : "+v"(t)); return t; }
__device__ __forceinline__ int bid_() { int b = blockIdx.x; asm volatile("" : "+s"(b)); return b; }
__device__ __forceinline__ float dot2u(unsigned k, unsigned q, float acc) { return __builtin_amdgcn_fdot2_f32_bf16(__builtin_bit_cast(bf16x2v, k), __builtin_bit_cast(bf16x2v, q), acc, false); }
__device__ __forceinline__ float sigmoidf_(float x) { return __builtin_amdgcn_rcpf(1.0f + __expf(-x)); }
__device__ __forceinline__ float siluf_(float x) { return x * __builtin_amdgcn_rcpf(1.0f + __expf(-x)); }
template <int CTRL> __device__ __forceinline__ float dpp_mov(float x) { return __builtin_bit_cast(float, __builtin_amdgcn_mov_dpp(__builtin_bit_cast(int, x), CTRL, 0xf, 0xf, true)); }
__device__ __forceinline__ float row16_sum(float x) { x += dpp_mov<0xB1>(x); x += dpp_mov<0x4E>(x); x += dpp_mov<0x141>(x); x += dpp_mov<0x128>(x); return x; }
__device__ __forceinline__ float xor16_sum(float x) { auto s = __builtin_amdgcn_permlane16_swap(__float_as_uint(x), __float_as_uint(x), false, false); return __uint_as_float(s[0]) + __uint_as_float(s[1]); }
__device__ __forceinline__ float xor32_sum(float x) { auto s = __builtin_amdgcn_permlane32_swap(__float_as_uint(x), __float_as_uint(x), false, false); return __uint_as_float(s[0]) + __uint_as_float(s[1]); }
__device__ __forceinline__ float wave_sum(float x) { return xor32_sum(xor16_sum(row16_sum(x))); }

__device__ __forceinline__ void transpose_item(const float* W, int ldsrc, int k0, int nsrc0, bf16_t* WT, int ldd, int ndst0, int kdst0, float* scr, int lane) {
    float tv[32];
#pragma unroll
    for (int i = 0; i < 32; ++i) { const int kk = 2 * i + (lane >> 5); tv[i] = W[(size_t)(k0 + kk) * ldsrc + nsrc0 + (lane & 31)]; }
#pragma unroll
    for (int i = 0; i < 32; ++i) { const int kk = 2 * i + (lane >> 5); scr[kk * 33 + (lane & 31)] = tv[i]; }
    __builtin_amdgcn_wave_barrier();
    asm volatile("s_waitcnt lgkmcnt(0)" ::: "memory");
    const int c = lane & 7;
#pragma unroll
    for (int j = 0; j < 4; ++j) { const int n = (lane >> 3) + 8 * j; const float* s = scr + (8 * c) * 33 + n;
        u32x4 o; o.x = pk2(s[0 * 33], s[1 * 33]); o.y = pk2(s[2 * 33], s[3 * 33]); o.z = pk2(s[4 * 33], s[5 * 33]); o.w = pk2(s[6 * 33], s[7 * 33]);
        *(u32x4*)(WT + (size_t)(ndst0 + n) * ldd + kdst0 + k0 + 8 * c) = o; }
    asm volatile("s_waitcnt lgkmcnt(0)" ::: "memory");
    __builtin_amdgcn_wave_barrier();
}
__device__ __forceinline__ void phase_convert_weights(const Params& p, int l, unsigned char* lds) {
    const int tid = tid_(), lane = tid & 63, wave = tid >> 6;
    float* scr = (float*)(lds) + wave * (64 * 33);
    bf16_t* WinT = (bf16_t*)(p.ws + WS_WIN); bf16_t* WbT = (bf16_t*)(p.ws + WS_WB); bf16_t* WoT = (bf16_t*)(p.ws + WS_WO);
    const float* win = p.w_in + (size_t)l * D * NORIG; const float* wbr = p.w_branch + (size_t)l * 3 * 512 * D; const float* wo = p.w_out + (size_t)l * D * D;
    constexpr int I_IN = (D / 64) * (NALL / 32), I_B = (512 / 64) * (D / 32), I_O = (D / 64) * (D / 32);
    constexpr int NITEMS = I_IN + 3 * I_B + I_O;
    const int gw = bid_() * 8 + wave, NGW = gridDim.x * 8;
    for (int it = gw; it < NITEMS; it += NGW) {
        int r = it;
        if (r < I_IN) { const int nb = r % (NALL / 32), kb = r / (NALL / 32); const int n0 = nb * 32; const int ns = n0 < 4096 ? n0 : n0 + 8;
            transpose_item(win, NORIG, kb * 64, ns, WinT, D, n0, 0, scr, lane); continue; }
        r -= I_IN;
        if (r < 3 * I_B) { const int br = r / I_B; const int q = r % I_B; const int nb = q % (D / 32), kb = q / (D / 32);
            transpose_item(wbr + (size_t)br * 512 * D, D, kb * 64, nb * 32, WbT, 1536, nb * 32, br * 512, scr, lane); continue; }
        r -= 3 * I_B;
        { const int nb = r % (D / 32), kb = r / (D / 32); transpose_item(wo, D, kb * 64, nb * 32, WoT, D, nb * 32, 0, scr, lane); }
    }
}

template <int MODE>
__device__ __forceinline__ void phase_rowpass(const Params& p, const float* xin, const float* nw, int l, unsigned char* lds) {
    const int tid = tid_(), lane = tid & 63, wave = tid >> 6;
    float* wsm = (float*)lds;
    if (MODE == 0) {
        const float* win = p.w_in + (size_t)l * D * NORIG;
        for (int i = tid; i < 8 * D; i += NTHREADS) { const int k = i >> 3, e = i & 7; wsm[e * D + k] = win[(size_t)k * NORIG + 4096 + e]; }
        __syncthreads();
    }
    bf16_t* hb = (bf16_t*)(p.ws + WS_HB); float* sm8 = (float*)(p.ws + WS_SM);
    const int gw = bid_() * 8 + wave, NGW = gridDim.x * 8;
    f32x4 wv[4];
#pragma unroll
    for (int j = 0; j < 4; ++j) wv[j] = *(const f32x4*)(nw + 256 * j + 4 * lane);
    f32x4 wr[8][4];
    if (MODE == 0) {
#pragma unroll
        for (int e = 0; e < 8; ++e)
#pragma unroll
            for (int j = 0; j < 4; ++j) wr[e][j] = *(const f32x4*)(wsm + e * D + 256 * j + 4 * lane);
    }
    f32x4 pa[4], pb[4];
#pragma unroll
    for (int j = 0; j < 4; ++j) { pa[j] = (gw < M) ? *(const f32x4*)(xin + (size_t)gw * D + 256 * j + 4 * lane) : (f32x4){0.f, 0.f, 0.f, 0.f};
        pb[j] = (gw + NGW < M) ? *(const f32x4*)(xin + (size_t)(gw + NGW) * D + 256 * j + 4 * lane) : (f32x4){0.f, 0.f, 0.f, 0.f}; }
    for (int m = gw; m < M; m += NGW) {
        f32x4 v[4]; float s = 0.f;
#pragma unroll
        for (int j = 0; j < 4; ++j) { v[j] = pa[j]; pa[j] = pb[j]; if (m + 2 * NGW < M) pb[j] = *(const f32x4*)(xin + (size_t)(m + 2 * NGW) * D + 256 * j + 4 * lane);
            s += (v[j].x * v[j].x + v[j].y * v[j].y) + (v[j].z * v[j].z + v[j].w * v[j].w); }
        const float rstd = __builtin_amdgcn_rsqf(wave_sum(s) * (1.0f / D) + EPS);
#pragma unroll
        for (int j = 0; j < 4; ++j) v[j] = v[j] * rstd * wv[j];
        if (MODE == 1) {
            float* orow = p.out + (size_t)m * D;
#pragma unroll
            for (int j = 0; j < 4; ++j) *(f32x4*)(orow + 256 * j + 4 * lane) = v[j];
        } else {
            bf16_t* hr = hb + (size_t)m * D;
#pragma unroll
            for (int j = 0; j < 4; ++j) { u32x2 o; o.x = pk2(v[j].x, v[j].y); o.y = pk2(v[j].z, v[j].w); *(u32x2*)(hr + 256 * j + 4 * lane) = o; }
            float a[8];
#pragma unroll
            for (int e = 0; e < 8; ++e) { float t = 0.f;
#pragma unroll
                for (int j = 0; j < 4; ++j) t += (v[j].x * wr[e][j].x + v[j].y * wr[e][j].y) + (v[j].z * wr[e][j].z + v[j].w * wr[e][j].w);
                a[e] = t; }
            const bool b0 = lane & 1, b1 = lane & 2;
            const float s01 = b0 ? a[1] : a[0], o01 = b0 ? a[0] : a[1], s23 = b0 ? a[3] : a[2], o23 = b0 ? a[2] : a[3];
            const float s45 = b0 ? a[5] : a[4], o45 = b0 ? a[4] : a[5], s67 = b0 ? a[7] : a[6], o67 = b0 ? a[6] : a[7];
            const float r01 = s01 + dpp_mov<0xB1>(o01), r23 = s23 + dpp_mov<0xB1>(o23), r45 = s45 + dpp_mov<0xB1>(o45), r67 = s67 + dpp_mov<0xB1>(o67);
            const float t0 = b1 ? r23 : r01, u0 = b1 ? r01 : r23, t1 = b1 ? r67 : r45, u1 = b1 ? r45 : r67;
            float q0 = t0 + dpp_mov<0x4E>(u0);
            float q1 = t1 + dpp_mov<0x4E>(u1);
            q0 += dpp_mov<0x124>(q0); q0 += dpp_mov<0x128>(q0); q1 += dpp_mov<0x124>(q1); q1 += dpp_mov<0x128>(q1);
            q0 = xor32_sum(xor16_sum(q0)); q1 = xor32_sum(xor16_sum(q1));
            if (lane < 4) { sm8[(size_t)m * 8 + lane] = q0; sm8[(size_t)m * 8 + 4 + lane] = q1; }
        }
    }
}

namespace pg8 {
#define PG8_LAS __attribute__((address_space(3)))
constexpr int BM = 256, BK = 64, HALF = 128, HTB = HALF * BK * 2  , STAGE_BYTES = 8 * HTB, NXCD = 8, WGM = 8;

__host__ __device__ __forceinline__ int lds_byte(int r, int c) { const int st = (r >> 4) * 2 + (c >> 5), rr = r & 15, cc = c & 31, ob = rr * 64 + cc * 2; return st * 1024 + (ob ^ (((ob >> 9) & 1) << 5)); }
__host__ __device__ __forceinline__ void stage_rc(int b, int& R, int& C) { const int st = b / 1024, sb = b % 1024, swz = sb ^ (((sb >> 9) & 1) << 5); R = (st >> 1) * 16 + swz / 64; C = (st & 1) * 32 + (swz % 64) / 2; }
__host__ __device__ __forceinline__ int perm32(int rho) { const int n = rho >> 4, i = rho & 15; return 8 * (i >> 2) + 4 * n + (i & 3); }

struct Unit { int pm, pn, kb; };
struct Gemm { const bf16_t* A; const bf16_t* Bt; int lda, ldb, K; };
struct SegNone { static __device__ __forceinline__ int a(int) { return 0; } static __device__ __forceinline__ int b(int) { return 0; } };
struct StaticOrder {
    int nM, nN, nwg, G, c, nseg;
    __device__ void init(int M_, int N_, int G_, int c_, int nseg_) { nM = M_ / BM; nN = N_ / BM; nwg = nM * nN; G = G_; c = c_; nseg = nseg_; }
    __device__ bool next(int i, Unit& u) const {
        const int it = i / nseg; u.kb = i - it * nseg;
        const long L = (long)it * G + c; if (L >= nwg) return false;
        int wgid = (int)L; { const int q = nwg / NXCD, r = nwg % NXCD, xcd = wgid % NXCD, off = wgid / NXCD; wgid = (xcd < r ? xcd * (q + 1) : r * (q + 1) + (xcd - r) * q) + off; }
        const int nig = WGM * nN, gid = wgid / nig, fm = gid * WGM, gsz = (nM - fm) < WGM ? (nM - fm) : WGM;
        u.pm = fm + ((wgid % nig) % gsz); u.pn = (wgid % nig) / gsz; return true;
    }
};
__device__ __forceinline__ unsigned cvt_pk_bf16(float lo, float hi) { unsigned r; asm volatile("v_cvt_pk_bf16_f32 %0, %1, %2" : "=v"(r) : "v"(lo), "v"(hi)); return r; }
template <class Epi, class Sched, class Seg, bool ALIGN_EPI = false, bool SP2 = false>
__device__ __forceinline__ void gemm_phase(PG8_LAS unsigned char* lds, const Gemm g, const Sched& S, const Epi& E) {
    const int tid = tid_(), wid = __builtin_amdgcn_readfirstlane(tid >> 6), lane = tid & 63, wr = wid >> 2, wc = wid & 3, fr = lane & 15, fq = lane >> 4;
    const int K = g.K, nt = K / BK;
    unsigned voffA[2], voffB[2];
#pragma unroll
    for (int i = 0; i < 2; ++i) { int R, C; stage_rc(tid * 16 + i * 8192, R, C); const int Rb = Epi::PERM ? ((R & ~31) + perm32(R & 31)) : R;
        voffA[i] = (unsigned)(R * g.lda + C) * 2u; voffB[i] = (unsigned)(Rb * g.ldb + C) * 2u; }
    const size_t kstep = (size_t)(BK * 2);
    const size_t hstepA = (size_t)HALF * g.lda * 2, hstepB = (size_t)HALF * g.ldb * 2;
    const size_t tstepA = 2 * hstepA, tstepB = 2 * hstepB;
    const unsigned ldsw = (unsigned)wid * 1024u;
    const int aoff = lds_byte(wr * 64 + fr, fq * 8), boff = lds_byte(wc * 32 + fr, fq * 8);
#define PG8_SA(b, h) (((b) * 2 + (h)) * HTB)
#define PG8_SB(b, h) ((4 + (b) * 2 + (h)) * HTB)
#define PG8_STAGE(bufoff, gbase, voff) do { _Pragma("unroll") for (int _i = 0; _i < 2; ++_i) \
        __builtin_amdgcn_global_load_lds((const unsigned*)((const char*)(gbase) + (voff)[_i]), (PG8_LAS unsigned*)(lds + (bufoff) + ldsw + _i * 8192), 16, 0, 0); } while (0)
#define PG8_LDA(dst, b, h) do { _Pragma("unroll") for (int m = 0; m < 4; ++m) _Pragma("unroll") for (int k = 0; k < 2; ++k) dst[m][k] = *(const PG8_LAS bf16x8*)(lds + PG8_SA(b, h) + aoff + m * 2048 + k * 1024); } while (0)
#define PG8_LDB(dst, b, h) do { _Pragma("unroll") for (int n = 0; n < 2; ++n) _Pragma("unroll") for (int k = 0; k < 2; ++k) dst[n][k] = *(const PG8_LAS bf16x8*)(lds + PG8_SB(b, h) + boff + n * 2048 + k * 1024); } while (0)
#define PG8_MMA(ai, bj, At, Bt) do { __builtin_amdgcn_s_setprio(1); _Pragma("unroll") for (int m = 0; m < 4; ++m) _Pragma("unroll") for (int n = 0; n < 2; ++n) _Pragma("unroll") for (int k = 0; k < 2; ++k) \
        acc[ai][bj][m][n] = __builtin_amdgcn_mfma_f32_16x16x32_bf16(Bt[n][k], At[m][k], acc[ai][bj][m][n], 0, 0, 0); __builtin_amdgcn_s_setprio(0); } while (0)
#define PG8_WAIT_V(n) asm volatile("s_waitcnt vmcnt(" #n ")" ::: "memory")
#define PG8_WAIT_L(n) asm volatile("s_waitcnt lgkmcnt(" #n ")" ::: "memory")
#define PG8_BAR __builtin_amdgcn_s_barrier()
#define PG8_SCHED __builtin_amdgcn_sched_barrier(0)
    Unit cur, nxt; int ui = 0;
    if (!S.next(0, cur)) return;
    f32x4 acc[2][2][4][2];
#pragma unroll
    for (int a = 0; a < 2; ++a)
#pragma unroll
        for (int b = 0; b < 2; ++b)
#pragma unroll
            for (int m = 0; m < 4; ++m)
#pragma unroll
                for (int n = 0; n < 2; ++n) acc[a][b][m][n] = (f32x4){0.f, 0.f, 0.f, 0.f};
    bf16x8 At[4][2], B0[2][2], B1[2][2];
    const char* cA = (const char*)g.A + (size_t)cur.pm * tstepA + (size_t)Seg::a(cur.kb) * 2; const char* cB = (const char*)g.Bt + (size_t)cur.pn * tstepB + (size_t)Seg::b(cur.kb) * 2;

    if constexpr (SP2) {
        PG8_STAGE(PG8_SB(0, 0), cB, voffB); PG8_STAGE(PG8_SB(0, 1), cB + hstepB, voffB); PG8_STAGE(PG8_SA(0, 0), cA, voffA); PG8_STAGE(PG8_SA(0, 1), cA + hstepA, voffA);
        if (wr == 1) PG8_BAR;
        PG8_WAIT_V(2); PG8_BAR;
        PG8_STAGE(PG8_SB(1, 0), cB + kstep, voffB); PG8_STAGE(PG8_SA(1, 0), cA + kstep, voffA); PG8_STAGE(PG8_SB(1, 1), cB + hstepB + kstep, voffB);
        PG8_WAIT_V(6); PG8_BAR;
    } else {
        PG8_STAGE(PG8_SB(0, 0), cB, voffB); PG8_STAGE(PG8_SA(0, 0), cA, voffA); PG8_STAGE(PG8_SB(0, 1), cB + hstepB, voffB); PG8_STAGE(PG8_SA(0, 1), cA + hstepA, voffA);
        if (wr == 1) PG8_BAR;
        PG8_WAIT_V(4); PG8_BAR;
        PG8_STAGE(PG8_SB(1, 0), cB + kstep, voffB); PG8_STAGE(PG8_SA(1, 0), cA + kstep, voffA); PG8_STAGE(PG8_SB(1, 1), cB + hstepB + kstep, voffB);
        PG8_WAIT_V(6); PG8_BAR;
    }
    for (;;) {
        const bool has_next = S.next(ui + 1, nxt);
        const char* nA = has_next ? (const char*)g.A + (size_t)nxt.pm * tstepA + (size_t)Seg::a(nxt.kb) * 2 : cA; const char* nB = has_next ? (const char*)g.Bt + (size_t)nxt.pn * tstepB + (size_t)Seg::b(nxt.kb) * 2 : cB;
        for (int t = 0; t < nt; t += 2) {
            const bool last = (t == nt - 2);
            const char* a1 = cA + (size_t)(t + 1) * kstep;
            const char* a2 = last ? nA : cA + (size_t)(t + 2) * kstep; const char* b2 = last ? nB : cB + (size_t)(t + 2) * kstep;
            const char* a3 = a2 + kstep; const char* b3 = b2 + kstep;

            if constexpr (SP2) {
            PG8_LDB(B0, 0, 0); PG8_LDB(B1, 0, 1); PG8_SCHED; PG8_LDA(At, 0, 0); PG8_STAGE(PG8_SA(1, 1), a1 + hstepA, voffA);
            PG8_WAIT_V(8); PG8_WAIT_L(0); PG8_BAR; PG8_MMA(0, 0, At, B0); PG8_MMA(0, 1, At, B1); PG8_BAR; PG8_SCHED;
            PG8_LDA(At, 0, 1); PG8_STAGE(PG8_SB(0, 0), b2, voffB); PG8_STAGE(PG8_SB(0, 1), b2 + hstepB, voffB); PG8_STAGE(PG8_SA(0, 0), a2, voffA);
            PG8_WAIT_V(8); PG8_WAIT_L(0); PG8_BAR; PG8_MMA(1, 0, At, B0); PG8_MMA(1, 1, At, B1); PG8_BAR; PG8_SCHED;
            PG8_LDB(B0, 1, 0); PG8_LDB(B1, 1, 1); PG8_SCHED; PG8_LDA(At, 1, 0); PG8_STAGE(PG8_SA(0, 1), a2 + hstepA, voffA);
            PG8_WAIT_V(8); PG8_WAIT_L(0); PG8_BAR; PG8_MMA(0, 0, At, B0); PG8_MMA(0, 1, At, B1); PG8_BAR; PG8_SCHED;
            PG8_LDA(At, 1, 1); PG8_STAGE(PG8_SB(1, 0), b3, voffB); PG8_STAGE(PG8_SB(1, 1), b3 + hstepB, voffB); PG8_STAGE(PG8_SA(1, 0), a3, voffA);
            PG8_WAIT_V(8); PG8_WAIT_L(0); PG8_BAR; PG8_MMA(1, 0, At, B0); PG8_MMA(1, 1, At, B1); PG8_BAR; PG8_SCHED;
            } else {
            PG8_LDB(B0, 0, 0); PG8_SCHED; PG8_LDA(At, 0, 0); PG8_STAGE(PG8_SA(1, 1), a1 + hstepA, voffA);
            PG8_WAIT_L(8); PG8_BAR; PG8_WAIT_L(0); PG8_MMA(0, 0, At, B0); PG8_BAR; PG8_SCHED;
            PG8_LDB(B1, 0, 1); PG8_STAGE(PG8_SB(0, 0), b2, voffB);
            PG8_BAR; PG8_WAIT_L(0); PG8_MMA(0, 1, At, B1); PG8_BAR;
            PG8_LDA(At, 0, 1); PG8_STAGE(PG8_SA(0, 0), a2, voffA);
            PG8_BAR; PG8_WAIT_L(0); PG8_MMA(1, 0, At, B0); PG8_BAR; PG8_SCHED;
            PG8_STAGE(PG8_SB(0, 1), b2 + hstepB, voffB);
            PG8_WAIT_V(6); PG8_BAR; PG8_MMA(1, 1, At, B1); PG8_BAR;
            PG8_LDB(B0, 1, 0); PG8_SCHED; PG8_LDA(At, 1, 0); PG8_STAGE(PG8_SA(0, 1), a2 + hstepA, voffA);
            PG8_WAIT_L(8); PG8_BAR; PG8_WAIT_L(0); PG8_MMA(0, 0, At, B0); PG8_BAR; PG8_SCHED;
            PG8_LDB(B1, 1, 1); PG8_STAGE(PG8_SB(1, 0), b3, voffB);
            PG8_BAR; PG8_WAIT_L(0); PG8_MMA(0, 1, At, B1); PG8_BAR;
            PG8_LDA(At, 1, 1); PG8_STAGE(PG8_SA(1, 0), a3, voffA);
            PG8_BAR; PG8_WAIT_L(0); PG8_MMA(1, 0, At, B0); PG8_BAR; PG8_SCHED;
            PG8_STAGE(PG8_SB(1, 1), b3 + hstepB, voffB);
            PG8_WAIT_V(6); PG8_BAR; PG8_MMA(1, 1, At, B1); PG8_BAR;
            }
        }
        if constexpr (ALIGN_EPI) { if (wr == 0) PG8_BAR; }
        const bool keep_acc = E(acc, cur, wr, wc, fr, fq);
        if (!has_next) break;
        if (!keep_acc) {
#pragma unroll
        for (int a = 0; a < 2; ++a)
#pragma unroll
            for (int b = 0; b < 2; ++b)
#pragma unroll
                for (int m = 0; m < 4; ++m)
#pragma unroll
                    for (int n = 0; n < 2; ++n) acc[a][b][m][n] = (f32x4){0.f, 0.f, 0.f, 0.f};
        }
        cur = nxt; cA = nA; cB = nB; ++ui;
        if constexpr (ALIGN_EPI) { if (wr == 1) PG8_BAR; }
    }
    PG8_WAIT_V(0);
    if constexpr (!ALIGN_EPI) { if (wr == 0) PG8_BAR; }
    PG8_BAR;
#undef PG8_SA
#undef PG8_SB
#undef PG8_STAGE
#undef PG8_LDA
#undef PG8_LDB
#undef PG8_MMA
#undef PG8_WAIT_V
#undef PG8_WAIT_L
#undef PG8_BAR
#undef PG8_SCHED
}
}

__device__ __forceinline__ bf16_t* gate_ptr(unsigned char* ws, int br, size_t row, int d) {
    if (br == 0) return (bf16_t*)(ws + WS_P) + row * LDP + d;
    if (br == 1) return (bf16_t*)(ws + WS_P) + row * LDP + 2048 + d;
    return (bf16_t*)(ws + WS_AF) + row * 1024 + d;
}
typedef f32x4 acc_t[2][2][4][2];
struct EpiInproj {
    static constexpr bool PERM = true;
    unsigned char* ws; const float* lb_param; int l;
    __device__ __forceinline__ bool operator()(acc_t& acc, const pg8::Unit& u, int wr, int wc, int fr, int fq) const {
        bf16_t* P = (bf16_t*)(ws + WS_P); float* AF = (float*)(ws + WS_AF);
        const int row0 = u.pm * 256 + wr * 64 + fr, col0 = u.pn * 256 + wc * 32 + 8 * fq;
        const int pn = u.pn;
        if (pn == 2 || pn == 3) {
            float lb[2][8];
#pragma unroll
            for (int bj = 0; bj < 2; ++bj)
#pragma unroll
                for (int e = 0; e < 8; ++e) { float v = 0.f; if (l == 1) { const int k = col0 + bj * 128 - 512 + e; v = 1.0f / (1.0f + __expf(lb_param[k] - lb_param[512 + k])); } lb[bj][e] = v; }
#pragma unroll
            for (int ai = 0; ai < 2; ++ai)
#pragma unroll
                for (int m = 0; m < 4; ++m) { float* rowp = AF + (size_t)(row0 + ai * 128 + m * 16) * 512 + (col0 - 512);
#pragma unroll
                    for (int bj = 0; bj < 2; ++bj) { const f32x4 v0 = acc[ai][bj][m][0], v1 = acc[ai][bj][m][1]; f32x4 o0, o1;
#pragma unroll
                        for (int e = 0; e < 4; ++e) { o0[e] = lb[bj][e] + (1.0f - lb[bj][e]) * sigmoidf_(v0[e]); o1[e] = lb[bj][4 + e] + (1.0f - lb[bj][4 + e]) * sigmoidf_(v1[e]); }
                        *(f32x4*)(rowp + bj * 128) = o0; *(f32x4*)(rowp + bj * 128 + 4) = o1; } }
        } else {
            const int act = pn < 2 ? 1 : ((pn == 16 || pn == 17) ? 2 : 0);
#pragma unroll
            for (int ai = 0; ai < 2; ++ai)
#pragma unroll
                for (int m = 0; m < 4; ++m) { bf16_t* rowp = P + (size_t)(row0 + ai * 128 + m * 16) * LDP + col0;
#pragma unroll
                    for (int bj = 0; bj < 2; ++bj) { f32x4 v0 = acc[ai][bj][m][0], v1 = acc[ai][bj][m][1];
                        if (act == 1) {
#pragma unroll
                            for (int e = 0; e < 4; ++e) { v0[e] = siluf_(v0[e]); v1[e] = siluf_(v1[e]); } }
                        else if (act == 2) { v0 = v0 * 0.125f; v1 = v1 * 0.125f; }
                        u32x4 w; w.x = pk2(v0[0], v0[1]); w.y = pk2(v0[2], v0[3]); w.z = pk2(v1[0], v1[1]); w.w = pk2(v1[2], v1[3]);
                        *(u32x4*)(rowp + bj * 128) = w;
                        if (pn >= 8 && pn < 14) { const int row = row0 + ai * 128 + m * 16, tc = row & 63;
                            if (tc >= 61) *(u32x4*)((bf16_t*)(ws + WS_HALO) + ((size_t)(row >> 6) * 3 + (tc - 61)) * 1536 + (col0 + bj * 128 - PC_BQKV)) = w; } } }
        }
        return false;
    }
};
struct EpiGates {
    static constexpr bool PERM = true;
    unsigned char* ws;
    __device__ __forceinline__ bool operator()(acc_t& acc, const pg8::Unit& u, int wr, int wc, int fr, int fq) const {
        const int row0 = u.pm * 256 + wr * 64 + fr, br = u.pn >> 2, d0 = (u.pn & 3) * 256 + wc * 32 + 8 * fq;
#pragma unroll
        for (int ai = 0; ai < 2; ++ai)
#pragma unroll
            for (int m = 0; m < 4; ++m) { bf16_t* rowp = gate_ptr(ws, br, (size_t)(row0 + ai * 128 + m * 16), d0);
#pragma unroll
                for (int bj = 0; bj < 2; ++bj) { const f32x4 v0 = acc[ai][bj][m][0], v1 = acc[ai][bj][m][1];
                    u32x4 w; w.x = pk2(sigmoidf_(v0[0]), sigmoidf_(v0[1])); w.y = pk2(sigmoidf_(v0[2]), sigmoidf_(v0[3])); w.z = pk2(sigmoidf_(v1[0]), sigmoidf_(v1[1])); w.w = pk2(sigmoidf_(v1[2]), sigmoidf_(v1[3]));
                    *(u32x4*)(rowp + bj * 128) = w; } }
        return false;
    }
};
struct EpiLift {
    static constexpr bool PERM = true;
    unsigned char* ws;
    __device__ __forceinline__ bool operator()(acc_t& acc, const pg8::Unit& u, int wr, int wc, int fr, int fq) const {
        bf16_t* MG = (bf16_t*)(ws + WS_HB);
        const int row0 = u.pm * 256 + wr * 64 + fr, d0 = u.pn * 256 + wc * 32 + 8 * fq, s = u.kb;
        u32x4 ga[2][2], gb[2][2];
        auto gload = [&](int g, int slot) { const size_t row = (size_t)(row0 + (g >> 2) * 128 + (g & 3) * 16);
#pragma unroll
            for (int bj = 0; bj < 2; ++bj) { ga[slot][bj] = *(const u32x4*)gate_ptr(ws, s, row, d0 + bj * 128); if (s < 2) gb[slot][bj] = *(const u32x4*)gate_ptr(ws, s + 1, row, d0 + bj * 128); } };
        gload(0, 0);
#pragma unroll
        for (int g = 0; g < 8; ++g) { const int ai = g >> 2, m = g & 3, slot = g & 1; const size_t row = (size_t)(row0 + ai * 128 + m * 16);
            if (g + 1 < 8) gload(g + 1, slot ^ 1);
#pragma unroll
            for (int bj = 0; bj < 2; ++bj) { const u32x4 a4 = ga[slot][bj];
                f32x4 fa = (f32x4){bf_lo(a4.x), bf_hi(a4.x), bf_lo(a4.y), bf_hi(a4.y)}, fb = (f32x4){bf_lo(a4.z), bf_hi(a4.z), bf_lo(a4.w), bf_hi(a4.w)};
                if (s < 2) { const u32x4 b4 = gb[slot][bj];
                    fa[0] *= __builtin_amdgcn_rcpf(fmaxf(bf_lo(b4.x), 1e-30f)); fa[1] *= __builtin_amdgcn_rcpf(fmaxf(bf_hi(b4.x), 1e-30f));
                    fa[2] *= __builtin_amdgcn_rcpf(fmaxf(bf_lo(b4.y), 1e-30f)); fa[3] *= __builtin_amdgcn_rcpf(fmaxf(bf_hi(b4.y), 1e-30f));
                    fb[0] *= __builtin_amdgcn_rcpf(fmaxf(bf_lo(b4.z), 1e-30f)); fb[1] *= __builtin_amdgcn_rcpf(fmaxf(bf_hi(b4.z), 1e-30f));
                    fb[2] *= __builtin_amdgcn_rcpf(fmaxf(bf_lo(b4.w), 1e-30f)); fb[3] *= __builtin_amdgcn_rcpf(fmaxf(bf_hi(b4.w), 1e-30f)); }
                const f32x4 v0 = acc[ai][bj][m][0] * fa, v1 = acc[ai][bj][m][1] * fb;
                acc[ai][bj][m][0] = v0; acc[ai][bj][m][1] = v1;
                if (s == 2) { u32x4 w; w.x = pk2(v0[0], v0[1]); w.y = pk2(v0[2], v0[3]); w.z = pk2(v1[0], v1[1]); w.w = pk2(v1[2], v1[3]);
                    *(u32x4*)(MG + row * D + d0 + bj * 128) = w; }
            }
        }
        return s < 2;
    }
};
struct EpiOut {
    static constexpr bool PERM = false;
    const float* xin; float* out;
    __device__ __forceinline__ bool operator()(acc_t& acc, const pg8::Unit& u, int wr, int wc, int fr, int fq) const {
        const int row0 = u.pm * 256 + wr * 64 + fr, col0 = u.pn * 256 + wc * 32 + 4 * fq;
        f32x4 xv[2][4];
        auto gload = [&](int g, int slot) { const size_t off = (size_t)(row0 + (g >> 2) * 128 + (g & 3) * 16) * D + col0;
#pragma unroll
            for (int q = 0; q < 4; ++q) xv[slot][q] = *(const f32x4*)(xin + off + (q >> 1) * 128 + (q & 1) * 16); };
        gload(0, 0);
#pragma unroll
        for (int g = 0; g < 8; ++g) { const int ai = g >> 2, m = g & 3, slot = g & 1; const size_t off = (size_t)(row0 + ai * 128 + m * 16) * D + col0;
            if (g + 1 < 8) gload(g + 1, slot ^ 1);
#pragma unroll
            for (int q = 0; q < 4; ++q) *(f32x4*)(out + off + (q >> 1) * 128 + (q & 1) * 16) = xv[slot][q] + acc[ai][q >> 1][m][q & 1]; }
        return false;
    }
};
struct SegLift { static __device__ __forceinline__ int a(int s) { return PC_AG + (s >= 1 ? PC_BZ - PC_AG : 0) + (s >= 2 ? PC_CG - PC_BZ : 0); } static __device__ __forceinline__ int b(int s) { return s * 512; } };
__device__ __forceinline__ void phase_inproj(const Params& p, int l, unsigned char* lds) {
    pg8::Gemm g{(const bf16_t*)(p.ws + WS_HB), (const bf16_t*)(p.ws + WS_WIN), D, D, D};
    pg8::StaticOrder S; S.init(M, NMIX, (int)gridDim.x, bid_(), 1);
    EpiInproj E{p.ws, p.lb_param, l};
    pg8::gemm_phase<EpiInproj, pg8::StaticOrder, pg8::SegNone, true, true>((PG8_LAS unsigned char*)lds, g, S, E);
}
__device__ __forceinline__ void phase_gates(const Params& p, unsigned char* lds) {
    pg8::Gemm g{(const bf16_t*)(p.ws + WS_HB), (const bf16_t*)(p.ws + WS_WIN) + (size_t)NMIX * D, D, D, D};
    pg8::StaticOrder S; S.init(M, NGATE, (int)gridDim.x, bid_(), 1);
    EpiGates E{p.ws};
    pg8::gemm_phase<EpiGates, pg8::StaticOrder, pg8::SegNone, true, true>((PG8_LAS unsigned char*)lds, g, S, E);
}
__device__ __forceinline__ void phase_lift(const Params& p, unsigned char* lds) {
    pg8::Gemm g{(const bf16_t*)(p.ws + WS_P), (const bf16_t*)(p.ws + WS_WB), LDP, 1536, 512};
    pg8::StaticOrder S; S.init(M, D, (int)gridDim.x, bid_(), 3);
    EpiLift E{p.ws};
    pg8::gemm_phase<EpiLift, pg8::StaticOrder, SegLift, false, true>((PG8_LAS unsigned char*)lds, g, S, E);
}
__device__ __forceinline__ void phase_outproj(const Params& p, const float* xin, unsigned char* lds) {
    pg8::Gemm g{(const bf16_t*)(p.ws + WS_HB), (const bf16_t*)(p.ws + WS_WO), D, D, D};
    pg8::StaticOrder S; S.init(M, D, (int)gridDim.x, bid_(), 1);
    EpiOut E{xin, p.out};
    pg8::gemm_phase<EpiOut, pg8::StaticOrder, pg8::SegNone, false, true>((PG8_LAS unsigned char*)lds, g, S, E);
}

constexpr int A_TB = 16;
__device__ __forceinline__ void mixer_a(const Params& p, int bh, int vs, unsigned char* lds, int dry) {
    const int tid = tid_(), lane = tid & 63, wave = tid >> 6, r = lane >> 4, i = lane & 15;
    const int b = bh >> 2, h = bh & 3;
    bf16_t* P = (bf16_t*)(p.ws + WS_P); const float* AF = (const float*)(p.ws + WS_AF);
    constexpr int BUF = 8192 + 8192 + 2048;
    float* obuf = (float*)(lds + 2 * BUF);
    const size_t row0 = (size_t)b * SEQ;
    const int fr_row = tid >> 5, fr_c4 = (tid & 31) * 4;
    const int q_row = tid >> 5, q_c4 = (tid & 31) * 4;
    const int i_row = (tid >> 3) & 15, i_c4 = (tid & 7) * 4;
    f32x4 pf; u32x2 pq; u32x2 pi;
    auto gload = [&](int t0) {
        pf = *(const f32x4*)(AF + (row0 + t0 + fr_row) * 512 + h * 128 + fr_c4);
        pq = *(const u32x2*)(P + (row0 + t0 + q_row) * LDP + PC_AQ + h * 128 + q_c4);
        if (tid < 128) pi = *(const u32x2*)(P + (row0 + t0 + i_row) * LDP + PC_AI + h * 128 + vs * 32 + i_c4);
    };
    auto lstore = [&](int bufi) {
        float* fb = (float*)(lds + bufi * BUF); float* qb = fb + 2048; float* ib = qb + 2048;
        *(f32x4*)(fb + fr_row * 128 + fr_c4) = pf;
        *(f32x4*)(qb + q_row * 128 + q_c4) = (f32x4){bf_lo(pq.x), bf_hi(pq.x), bf_lo(pq.y), bf_hi(pq.y)};
        if (tid < 128) *(f32x4*)(ib + i_row * 32 + i_c4) = (f32x4){bf_lo(pi.x), bf_hi(pi.x), bf_lo(pi.y), bf_hi(pi.y)};
    };
    float S[8];
#pragma unroll
    for (int j = 0; j < 8; ++j) S[j] = 0.f;
    gload(0); lstore(0); __syncthreads();
    constexpr int NB = SEQ / A_TB;
    for (int bt = 0; bt < NB; ++bt) {
        const int cur = bt & 1;
        if (bt + 1 < NB) gload((bt + 1) * A_TB);
        const float* fb = (const float*)(lds + cur * BUF); const float* qb = fb + 2048; const float* ib = qb + 2048;
#pragma unroll 4
        for (int t = 0; t < A_TB; ++t) {
            const f32x4 f0 = *(const f32x4*)(fb + t * 128 + 8 * i), f1 = *(const f32x4*)(fb + t * 128 + 8 * i + 4);
            const f32x4 q0 = *(const f32x4*)(qb + t * 128 + 8 * i), q1 = *(const f32x4*)(qb + t * 128 + 8 * i + 4);
            const float iv = ib[t * 32 + wave * 4 + r];
            float pa = 0.f, pb = 0.f;
            S[0] = iv + f0[0] * (S[0] - iv); pa += q0[0] * S[0];
            S[1] = iv + f0[1] * (S[1] - iv); pb += q0[1] * S[1];
            S[2] = iv + f0[2] * (S[2] - iv); pa += q0[2] * S[2];
            S[3] = iv + f0[3] * (S[3] - iv); pb += q0[3] * S[3];
            S[4] = iv + f1[0] * (S[4] - iv); pa += q1[0] * S[4];
            S[5] = iv + f1[1] * (S[5] - iv); pb += q1[1] * S[5];
            S[6] = iv + f1[2] * (S[6] - iv); pa += q1[2] * S[6];
            S[7] = iv + f1[3] * (S[7] - iv); pb += q1[3] * S[7];
            const float o = row16_sum(pa + pb);
            if (i == 0) obuf[t * 32 + wave * 4 + r] = o;
        }
        __syncthreads();
        if (!dry) { const int t = tid >> 5, v = tid & 31; P[(row0 + bt * A_TB + t) * LDP + PC_AI + h * 128 + vs * 32 + v] = (bf16_t)f2bf(obuf[t * 32 + v]); }
        if (bt + 1 < NB) lstore(cur ^ 1);
        __syncthreads();
    }
}

constexpr int B_TB = 16;
__device__ __forceinline__ void mixer_b(const Params& p, int l, int bh, int vs, unsigned char* lds, int dry) {
    const int tid = tid_(), lane = tid & 63, wave = tid >> 6, r = lane >> 5, i = lane & 31;
    const int b = bh >> 2, h = bh & 3;
    bf16_t* P = (bf16_t*)(p.ws + WS_P); const float* sm8 = (const float*)(p.ws + WS_SM);
    const float* cw = p.conv_w + (size_t)l * 4 * 1536;
    constexpr int RAWC = 272;
    float* raw = (float*)lds;
    float* qk = (float*)(lds + 20736);
    float* vv = (float*)(lds + 20736 + 16384);
    float* sc = (float*)(lds + 20736 + 16384 + 1024);
    float* obuf = (float*)(lds + 20736 + 16384 + 1024 + 256);
    const size_t row0 = (size_t)b * SEQ;
    const float a_coef = -__expf(p.a_log[l * 4 + h]); const float dtb = p.dt_bias[l * 4 + h];
    const int cqk = tid & 255; const int chq = cqk < 128 ? h * 128 + cqk : 512 + h * 128 + (cqk - 128);
    float wq[4]; float wvv[4];
#pragma unroll
    for (int j = 0; j < 4; ++j) { wq[j] = cw[j * 1536 + chq]; wvv[j] = cw[j * 1536 + 1024 + h * 128 + vs * 16 + (tid & 15)]; }
    for (int e = tid; e < 3 * RAWC; e += NTHREADS) raw[e] = 0.f;
    float S[4] = {0.f, 0.f, 0.f, 0.f};
    u32x4 st0, st1;
    auto chunk_addr = [&](int t0, int ck) -> const bf16_t* {
        const int row = ck / 34, c8 = ck % 34; const int ch = c8 < 16 ? h * 128 + c8 * 8 : (c8 < 32 ? 512 + h * 128 + (c8 - 16) * 8 : 1024 + h * 128 + vs * 16 + (c8 - 32) * 8);
        return P + (row0 + t0 + row) * LDP + PC_BQKV + ch; };
    auto gload = [&](int t0) { st0 = *(const u32x4*)chunk_addr(t0, tid); if (tid < 32) st1 = *(const u32x4*)chunk_addr(t0, 512 + tid); };
    auto rstore = [&]() {
        { const int row = tid / 34, c8 = tid % 34; float* d = raw + (3 + row) * RAWC + c8 * 8;
          *(f32x4*)d = (f32x4){bf_lo(st0.x), bf_hi(st0.x), bf_lo(st0.y), bf_hi(st0.y)}; *(f32x4*)(d + 4) = (f32x4){bf_lo(st0.z), bf_hi(st0.z), bf_lo(st0.w), bf_hi(st0.w)}; }
        if (tid < 32) { const int ck = 512 + tid; const int row = ck / 34, c8 = ck % 34; float* d = raw + (3 + row) * RAWC + c8 * 8;
          *(f32x4*)d = (f32x4){bf_lo(st1.x), bf_hi(st1.x), bf_lo(st1.y), bf_hi(st1.y)}; *(f32x4*)(d + 4) = (f32x4){bf_lo(st1.z), bf_hi(st1.z), bf_lo(st1.w), bf_hi(st1.w)}; }
    };
    gload(0);
    constexpr int NB = SEQ / B_TB;
    for (int bt = 0; bt < NB; ++bt) {
        const int t0 = bt * B_TB;
        __syncthreads();
        rstore();
        if (bt + 1 < NB) gload(t0 + B_TB);
        __syncthreads();
        {
            const int tb = (tid >> 8) * 8;
#pragma unroll
            for (int tt = 0; tt < 8; ++tt) { const int t = tb + tt;
                const float x = raw[(t + 0) * RAWC + cqk] * wq[0] + raw[(t + 1) * RAWC + cqk] * wq[1] + raw[(t + 2) * RAWC + cqk] * wq[2] + raw[(t + 3) * RAWC + cqk] * wq[3];
                qk[t * 256 + cqk] = siluf_(x); }
            if (tid < 256) { const int t = tid >> 4, c = tid & 15;
                const float x = raw[(t + 0) * RAWC + 256 + c] * wvv[0] + raw[(t + 1) * RAWC + 256 + c] * wvv[1] + raw[(t + 2) * RAWC + 256 + c] * wvv[2] + raw[(t + 3) * RAWC + 256 + c] * wvv[3];
                vv[t * 16 + c] = siluf_(x); }
            if (tid < 16) { const f32x4 lo = *(const f32x4*)(sm8 + (row0 + t0 + tid) * 8), hi = *(const f32x4*)(sm8 + (row0 + t0 + tid) * 8 + 4);
                const float bl = lo[h], al = hi[h]; const float xx = al + dtb; const float sp = xx > 20.f ? xx : log1pf(__expf(xx));
                sc[tid * 4 + 0] = __expf(a_coef * sp); sc[tid * 4 + 1] = sigmoidf_(bl); }
        }
        __syncthreads();
        {
            const int vec = tid >> 4, sub = tid & 15; const int t = vec >> 1, which = vec & 1;
            float* src = qk + t * 256 + which * 128 + sub * 8;
            f32x4 a0 = *(f32x4*)src, a1 = *(f32x4*)(src + 4);
            float ss = (a0[0] * a0[0] + a0[1] * a0[1]) + (a0[2] * a0[2] + a0[3] * a0[3]) + (a1[0] * a1[0] + a1[1] * a1[1]) + (a1[2] * a1[2] + a1[3] * a1[3]);
            ss = row16_sum(ss);
            float sc_ = 1.0f / sqrtf(ss + EPS); if (which == 0) sc_ *= 0.08838834764831845f;
            a0 = a0 * sc_; a1 = a1 * sc_;
            *(f32x4*)src = a0; *(f32x4*)(src + 4) = a1;
        }
        __syncthreads();
        if (tid < 256) { const int t = tid >> 4, sub = tid & 15; const float* qs = qk + t * 256 + sub * 8; const float* ks = qs + 128;
            float d = 0.f;
#pragma unroll
            for (int e = 0; e < 8; ++e) d += qs[e] * ks[e];
            d = row16_sum(d); if (sub == 0) sc[t * 4 + 2] = d; }
        __syncthreads();
#pragma unroll 2
        for (int t = 0; t < B_TB; ++t) {
            const f32x4 q4 = *(const f32x4*)(qk + t * 256 + 4 * i), k4 = *(const f32x4*)(qk + t * 256 + 128 + 4 * i);
            const f32x4 s4 = *(const f32x4*)(sc + t * 4); const float vt = vv[t * 16 + wave * 2 + r];
            const float alpha = s4[0], beta = s4[1], qkd = s4[2];
            float rk = (S[0] * k4[0] + S[1] * k4[1]) + (S[2] * k4[2] + S[3] * k4[3]);
            float rq = (S[0] * q4[0] + S[1] * q4[1]) + (S[2] * q4[2] + S[3] * q4[3]);
            rk = xor16_sum(row16_sum(rk)); rq = xor16_sum(row16_sum(rq));
            const float vn = beta * (vt - alpha * rk);
            const float o = alpha * rq + qkd * vn;
            S[0] = alpha * S[0] + k4[0] * vn; S[1] = alpha * S[1] + k4[1] * vn; S[2] = alpha * S[2] + k4[2] * vn; S[3] = alpha * S[3] + k4[3] * vn;
            if (i == 0) obuf[t * 16 + wave * 2 + r] = o;
        }
        __syncthreads();
        if (tid < 256 && !dry) { const int t = tid >> 4, c = tid & 15; P[(row0 + t0 + t) * LDP + PC_BQKV + 1024 + h * 128 + vs * 16 + c] = (bf16_t)f2bf(obuf[t * 16 + c]); }
        float hv0 = 0.f, hv1 = 0.f; const int e0 = tid, e1 = tid + 512;
        if (e0 < 3 * RAWC) hv0 = raw[16 * RAWC + e0];
        if (e1 < 3 * RAWC) hv1 = raw[16 * RAWC + e1];
        __syncthreads();
        if (e0 < 3 * RAWC) raw[e0] = hv0;
        if (e1 < 3 * RAWC) raw[e1] = hv1;
    }
}


#define LDS_BARRIER() do { asm volatile("s_waitcnt lgkmcnt(0)" ::: "memory"); __builtin_amdgcn_s_barrier(); asm volatile("" ::: "memory"); } while (0)
template <int KS> __device__ __forceinline__ f32x4 mma_tile(const bf16_t* a, int lda, const bf16_t* b, int ldb, f32x4 acc, int fr, int fq) {
#pragma unroll
    for (int ks = 0; ks < KS; ++ks) {
        const bf16x8 af = *(const bf16x8*)(a + fr * lda + ks * 32 + fq * 8);
        const bf16x8 bv = *(const bf16x8*)(b + fr * ldb + ks * 32 + fq * 8);
        acc = __builtin_amdgcn_mfma_f32_16x16x32_bf16(bv, af, acc, 0, 0, 0);
    }
    return acc;
}
__device__ __forceinline__ u32x2 pack4(f32x4 v) { u32x2 o; o.x = pk2(v[0], v[1]); o.y = pk2(v[2], v[3]); return o; }
__device__ __forceinline__ f32x4 unpack4(u32x2 u) { return (f32x4){bf_lo(u.x), bf_hi(u.x), bf_lo(u.y), bf_hi(u.y)}; }

__device__ __forceinline__ void bpre_unit(const Params& p, int l, int unit, unsigned char* lds, int dry) {
    const int tid = tid_(), lane = tid & 63, wave = tid >> 6, fr = lane & 15, fq = lane >> 4;
    const int h = unit & 3, c = (unit >> 2) & 63, b = unit >> 8;
    bf16_t* P = (bf16_t*)(p.ws + WS_P); const float* sm8 = (const float*)(p.ws + WS_SM); float* GC = (float*)(p.ws + WS_GC);
    const bf16_t* HALO = (const bf16_t*)(p.ws + WS_HALO);
    const float* cw = p.conv_w + (size_t)l * 4 * 1536;
    constexpr int RP = 392;
    bf16_t* RAW = (bf16_t*)lds;
    bf16_t* KT2 = (bf16_t*)lds;
    float* TF = (float*)(lds + 18432);
    float* MS = (float*)(lds + 26880);
    bf16_t* KN = (bf16_t*)(lds + 52528);
    bf16_t* KB = (bf16_t*)(lds + 69936);
    bf16_t* XT = (bf16_t*)(lds + 87344);
    float* AM = (float*)(lds + 124208);
    bf16_t* QNS = (bf16_t*)(lds + 124208);
    bf16_t* TM = (bf16_t*)(lds + 140592);
    float* sgc = (float*)(lds + 149808); float* sbeta = sgc + 64; float* sg = sgc + 128;
    bf16_t* QKG = (bf16_t*)(p.ws + WS_QK) + (size_t)unit * 2560;
    const size_t row0 = (size_t)b * SEQ + (size_t)c * 64;
    const float a_coef = -__expf(p.a_log[l * 4 + h]); const float dtb = p.dt_bias[l * 4 + h];
    LDS_BARRIER();
#pragma unroll
    for (int i2 = 0; i2 < 6; ++i2) { const int ck = tid + 512 * i2, row = ck / 48, c8 = ck % 48;
        const int chg = c8 < 16 ? h * 128 + c8 * 8 : (c8 < 32 ? 512 + h * 128 + (c8 - 16) * 8 : 1024 + h * 128 + (c8 - 32) * 8);
        *(u32x4*)(RAW + (3 + row) * RP + c8 * 8) = *(const u32x4*)(P + (row0 + row) * LDP + PC_BQKV + chg); }
    if (tid < 144) { const int row = tid / 48, c8 = tid % 48;
        const int chg = c8 < 16 ? h * 128 + c8 * 8 : (c8 < 32 ? 512 + h * 128 + (c8 - 16) * 8 : 1024 + h * 128 + (c8 - 32) * 8);
        u32x4 v = (u32x4){0u, 0u, 0u, 0u}; if (c > 0) v = *(const u32x4*)(HALO + ((size_t)(b * 64 + c - 1) * 3 + row) * 1536 + chg);
        *(u32x4*)(RAW + row * RP + c8 * 8) = v; }
    if (tid < 64) { const float bl = sm8[(row0 + tid) * 8 + h], al = sm8[(row0 + tid) * 8 + 4 + h]; const float xx = al + dtb; const float sp = xx > 20.f ? xx : log1pf(__expf(xx));
        sg[tid] = a_coef * sp; sbeta[tid] = sigmoidf_(bl); }
    LDS_BARRIER();
    if (tid < 64) { float s0 = 0.f, s1 = 0.f;
#pragma unroll
        for (int j = 0; j < 64; j += 2) { s0 += (j <= tid) ? sg[j] : 0.f; s1 += (j + 1 <= tid) ? sg[j + 1] : 0.f; }
        const float s = s0 + s1; sgc[tid] = s; if (!dry) GC[(row0 + tid) * 4 + h] = s; }
    LDS_BARRIER();
    if (!(dry & 4)) {
    { const int sub = tid & 15, which = (tid >> 4) & 1, tb = tid >> 5; const int ch0 = which * 128 + sub * 8;
      float wq[4][8];
#pragma unroll
      for (int j = 0; j < 4; ++j)
#pragma unroll
          for (int e = 0; e < 8; ++e) wq[j][e] = cw[j * 1536 + which * 512 + h * 128 + sub * 8 + e];
#pragma unroll 1
      for (int jt = 0; jt < 4; ++jt) { const int t = tb + 16 * jt;
          float x[8] = {0.f, 0.f, 0.f, 0.f, 0.f, 0.f, 0.f, 0.f};
#pragma unroll
          for (int j = 0; j < 4; ++j) { const u32x4 r = *(const u32x4*)(RAW + (t + j) * RP + ch0);
              x[0] += bf_lo(r.x) * wq[j][0]; x[1] += bf_hi(r.x) * wq[j][1]; x[2] += bf_lo(r.y) * wq[j][2]; x[3] += bf_hi(r.y) * wq[j][3];
              x[4] += bf_lo(r.z) * wq[j][4]; x[5] += bf_hi(r.z) * wq[j][5]; x[6] += bf_lo(r.w) * wq[j][6]; x[7] += bf_hi(r.w) * wq[j][7]; }
          float ss = 0.f;
#pragma unroll
          for (int e = 0; e < 8; ++e) { x[e] = siluf_(x[e]); ss += x[e] * x[e]; }
          ss = row16_sum(ss);
          float sc_ = __builtin_amdgcn_rsqf(ss + EPS); if (which == 0) sc_ *= 0.08838834764831845f;
#pragma unroll
          for (int e = 0; e < 8; ++e) x[e] *= sc_;
          const u32x4 pk = (u32x4){pk2(x[0], x[1]), pk2(x[2], x[3]), pk2(x[4], x[5]), pk2(x[6], x[7])};
          if (which == 0) { *(u32x4*)(QNS + t * 128 + ((sub ^ (t & 15)) * 8)) = pk;
              const float eg = __expf(sgc[t]);
              const u32x4 pq = (u32x4){pk2(x[0] * eg, x[1] * eg), pk2(x[2] * eg, x[3] * eg), pk2(x[4] * eg, x[5] * eg), pk2(x[6] * eg, x[7] * eg)};
              if (!dry) *(u32x4*)(P + (row0 + t) * LDP + PC_BQKV + h * 128 + sub * 8) = pq; }
          else { *(u32x4*)(KN + t * 136 + sub * 8) = pk; const float bt = sbeta[t];
              *(u32x4*)(KB + t * 136 + sub * 8) = (u32x4){pk2(x[0] * bt, x[1] * bt), pk2(x[2] * bt, x[3] * bt), pk2(x[4] * bt, x[5] * bt), pk2(x[6] * bt, x[7] * bt)}; } } }
    { const int t = tid & 63, cg = tid >> 6; const float bt = sbeta[t];
#pragma unroll
      for (int hf = 0; hf < 2; ++hf) { const int cv = cg * 16 + hf * 8; float x[8] = {0.f, 0.f, 0.f, 0.f, 0.f, 0.f, 0.f, 0.f};
#pragma unroll
          for (int j = 0; j < 4; ++j) { const u32x4 r = *(const u32x4*)(RAW + (t + j) * RP + 256 + cv); const float* wj = cw + j * 1536 + 1024 + h * 128 + cv;
              x[0] += bf_lo(r.x) * wj[0]; x[1] += bf_hi(r.x) * wj[1]; x[2] += bf_lo(r.y) * wj[2]; x[3] += bf_hi(r.y) * wj[3];
              x[4] += bf_lo(r.z) * wj[4]; x[5] += bf_hi(r.z) * wj[5]; x[6] += bf_lo(r.w) * wj[6]; x[7] += bf_hi(r.w) * wj[7]; }
          bf16_t* xt = XT + cv * 72 + t;
#pragma unroll
          for (int e = 0; e < 8; e += 2) { const unsigned w2 = pk2(siluf_(x[e]) * bt, siluf_(x[e + 1]) * bt); xt[e * 72] = (bf16_t)(w2 & 0xffffu); xt[(e + 1) * 72] = (bf16_t)(w2 >> 16); } } }
    }
    LDS_BARRIER();
    {
      const int t = tid & 63, d0 = (tid >> 6) * 16; const float eg = __expf(sgc[t]), rg = __expf(sgc[63] - sgc[t]);
#pragma unroll
      for (int hlf = 0; hlf < 2; ++hlf) { const u32x4 kv = *(const u32x4*)(KB + t * 136 + d0 + hlf * 8); bf16_t* xt = XT + (128 + d0 + hlf * 8) * 72 + t;
          const unsigned k0 = pk2(bf_lo(kv.x) * eg, bf_hi(kv.x) * eg), k1 = pk2(bf_lo(kv.y) * eg, bf_hi(kv.y) * eg), k2 = pk2(bf_lo(kv.z) * eg, bf_hi(kv.z) * eg), k3 = pk2(bf_lo(kv.w) * eg, bf_hi(kv.w) * eg);
          xt[0 * 72] = (bf16_t)(k0 & 0xffffu); xt[1 * 72] = (bf16_t)(k0 >> 16); xt[2 * 72] = (bf16_t)(k1 & 0xffffu); xt[3 * 72] = (bf16_t)(k1 >> 16);
          xt[4 * 72] = (bf16_t)(k2 & 0xffffu); xt[5 * 72] = (bf16_t)(k2 >> 16); xt[6 * 72] = (bf16_t)(k3 & 0xffffu); xt[7 * 72] = (bf16_t)(k3 >> 16); }
#pragma unroll
      for (int hlf = 0; hlf < 2; ++hlf) { const u32x4 kv = *(const u32x4*)(KN + t * 136 + d0 + hlf * 8); bf16_t* xt = KT2 + (d0 + hlf * 8) * 72 + t;
          const unsigned k0 = pk2(bf_lo(kv.x) * rg, bf_hi(kv.x) * rg), k1 = pk2(bf_lo(kv.y) * rg, bf_hi(kv.y) * rg), k2 = pk2(bf_lo(kv.z) * rg, bf_hi(kv.z) * rg), k3 = pk2(bf_lo(kv.w) * rg, bf_hi(kv.w) * rg);
          xt[0 * 72] = (bf16_t)(k0 & 0xffffu); xt[1 * 72] = (bf16_t)(k0 >> 16); xt[2 * 72] = (bf16_t)(k1 & 0xffffu); xt[3 * 72] = (bf16_t)(k1 >> 16);
          xt[4 * 72] = (bf16_t)(k2 & 0xffffu); xt[5 * 72] = (bf16_t)(k2 >> 16); xt[6 * 72] = (bf16_t)(k3 & 0xffffu); xt[7 * 72] = (bf16_t)(k3 >> 16); } }
#pragma unroll
    for (int i2 = 0; i2 < 2; ++i2) { const int ti = 2 * wave + i2, tm = ti >> 2, tn = ti & 3;
        if (tn <= tm) { const int qrow = tm * 16 + fr; f32x4 acc = (f32x4){0.f, 0.f, 0.f, 0.f};
#pragma unroll
            for (int ks = 0; ks < 4; ++ks) acc = __builtin_amdgcn_mfma_f32_16x16x32_bf16(*(const bf16x8*)(KN + (tn * 16 + fr) * 136 + ks * 32 + fq * 8), *(const bf16x8*)(QNS + qrow * 128 + (((ks * 4 + fq) ^ (qrow & 15)) * 8)), acc, 0, 0, 0);
            const int s0 = tn * 16 + 4 * fq; const float gt = sgc[qrow]; f32x4 o;
#pragma unroll
            for (int e = 0; e < 4; ++e) o[e] = (s0 + e <= qrow) ? acc[e] * __expf(gt - sgc[s0 + e]) : 0.f;
            if (!dry) *(u32x2*)(QKG + (tm * (tm + 1) / 2 + tn) * 256 + fr * 16 + 4 * fq) = pack4(o); } }
    LDS_BARRIER();
#pragma unroll
    for (int i2 = 0; i2 < 2; ++i2) { const int ti = 2 * wave + i2, tm = ti >> 2, tn = ti & 3;
        if (tn <= tm) { f32x4 acc = mma_tile<4>(KB + tm * 16 * 136, 136, KN + tn * 16 * 136, 136, (f32x4){0.f, 0.f, 0.f, 0.f}, fr, fq);
            const int t = tm * 16 + fr, s0 = tn * 16 + 4 * fq; const float gt = sgc[t]; f32x4 o;
#pragma unroll
            for (int e = 0; e < 4; ++e) o[e] = (s0 + e < t) ? acc[e] * __expf(gt - sgc[s0 + e]) : 0.f;
            *(f32x4*)(AM + t * 64 + s0) = o; } }
    LDS_BARRIER();
    if (wave == 0 && !(dry & 2)) {
        const int off = (lane >> 5) * 32, cc = lane & 31;
        float Tc[32];
        const float* ab = AM + off * 64 + off;
        float* tf = TF + (lane >> 5) * (32 * 33) + cc;
#pragma unroll
        for (int t = 0; t < 32; ++t) { float ac4[4] = {0.f, 0.f, 0.f, 0.f};
#pragma unroll
            for (int s4 = 0; s4 < (t + 3) / 4; ++s4) { const f32x4 a = *(const f32x4*)(ab + t * 64 + 4 * s4);
#pragma unroll
                for (int e = 0; e < 4; ++e) if (4 * s4 + e < t) ac4[e] += a[e] * Tc[4 * s4 + e]; }
            int ln = cc; asm volatile("" : "+v"(ln));
            Tc[t] = ((t == ln) ? 1.f : 0.f) - ((ac4[0] + ac4[1]) + (ac4[2] + ac4[3]));
            tf[t * 33] = Tc[t];
            TM[(off + t) * 72 + off + ln] = (bf16_t)f2bf(Tc[t]);
            if (off == 0) TM[t * 72 + 32 + ln] = (bf16_t)0; }
    }
    LDS_BARRIER();
    {
      const int i = tid >> 4, j = (tid & 15) * 2; float m0 = 0.f, m1 = 0.f;
#pragma unroll
      for (int k4 = 0; k4 < 8; ++k4) { const f32x4 a = *(const f32x4*)(AM + (32 + i) * 64 + 4 * k4);
#pragma unroll
          for (int e = 0; e < 4; ++e) { const int k = 4 * k4 + e; m0 += a[e] * TF[k * 33 + j]; m1 += a[e] * TF[k * 33 + j + 1]; } }
      MS[i * 33 + j] = m0; MS[i * 33 + j + 1] = m1; }
    LDS_BARRIER();
    {
      const int i = tid >> 4, j = (tid & 15) * 2; float m0 = 0.f, m1 = 0.f;
#pragma unroll
      for (int k = 0; k < 32; ++k) { const float tk = TF[32 * 33 + i * 33 + k]; m0 += tk * MS[k * 33 + j]; m1 += tk * MS[k * 33 + j + 1]; }
      *(unsigned*)(TM + (32 + i) * 72 + j) = pk2(-m0, -m1); }
    LDS_BARRIER();
    if (!(dry & 8))
#pragma unroll
    for (int i2 = 0; i2 < 2; ++i2) { const int nt = 2 * wave + i2;
#pragma unroll
        for (int mt = 0; mt < 4; ++mt) {
            if (nt >= 8) { const f32x4 acc = mma_tile<2>(TM + mt * 16 * 72, 72, XT + nt * 16 * 72, 72, (f32x4){0.f, 0.f, 0.f, 0.f}, fr, fq);
                const int t = mt * 16 + fr, d = (nt - 8) * 16 + 4 * fq;
                if (!dry) *(u32x2*)(P + (row0 + t) * LDP + 512 + h * 128 + d) = pack4(acc); }
            else { const f32x4 acc = mma_tile<2>(XT + nt * 16 * 72, 72, TM + mt * 16 * 72, 72, (f32x4){0.f, 0.f, 0.f, 0.f}, fr, fq);
                const int v = nt * 16 + fr, t = mt * 16 + 4 * fq;
                if (!dry) *(u32x2*)(P + (row0 + (v >> 1)) * LDP + PC_BQKV + 1024 + h * 128 + (v & 1) * 64 + t) = pack4(acc); } } }
#pragma unroll
    for (int i2 = 0; i2 < 2; ++i2) { const int ck = tid + 512 * i2, k = ck >> 3, c8 = (ck & 7) * 8;
        const u32x4 v = *(const u32x4*)(KT2 + k * 72 + c8);
        if (!dry) *(u32x4*)(P + (row0 + (k >> 1)) * LDP + PC_BQKV + 512 + h * 128 + (k & 1) * 64 + c8) = v; }
}

constexpr int BS_NV = 32;
__device__ __forceinline__ void bscan_block(const Params& p, int blk, unsigned char* lds, int dry) {
    const int tid = tid_(), lane = tid & 63, wave = tid >> 6, fr = lane & 15, fq = lane >> 4;
    const int bh = blk >> 2, v0 = (blk & 3) * BS_NV, b = bh >> 2, h = bh & 3;
    const int wv = wave & 1, wt = wave >> 1;
    bf16_t* P = (bf16_t*)(p.ws + WS_P); const float* GC = (const float*)(p.ws + WS_GC); const bf16_t* QKG = (const bf16_t*)(p.ws + WS_QK);
    bf16_t* ST = (bf16_t*)lds;
    bf16_t* Wt = (bf16_t*)(lds + 8704);
    bf16_t* QD = (bf16_t*)(lds + 26112);
    bf16_t* KDT = (bf16_t*)(lds + 43520);
    bf16_t* QK = (bf16_t*)(lds + 61952);
    bf16_t* VNT = (bf16_t*)(lds + 71168);
    bf16_t* UT = (bf16_t*)(lds + 75776);
    const size_t row0 = (size_t)b * SEQ;
    f32x4 Sacc[2];
    Sacc[0] = (f32x4){0.f, 0.f, 0.f, 0.f}; Sacc[1] = (f32x4){0.f, 0.f, 0.f, 0.f};
    LDS_BARRIER();
    for (int e = tid; e < BS_NV * 136 / 2; e += NTHREADS) ((unsigned*)ST)[e] = 0u;
    for (int e = tid; e < 64 * 72 / 2; e += NTHREADS) ((unsigned*)QK)[e] = 0u;
    u32x4 rw[2], ru, rq[2], rk[2], rqk; float rge = 0.f;
    const int qk_tile = tid >> 5, qk_tm = qk_tile < 1 ? 0 : (qk_tile < 3 ? 1 : (qk_tile < 6 ? 2 : 3)), qk_tn = qk_tile - qk_tm * (qk_tm + 1) / 2;
    bf16_t* qk_dst = QK + (qk_tm * 16 + ((tid >> 1) & 15)) * 72 + qk_tn * 16 + (tid & 1) * 8;
    auto load_g1 = [&](int c) {
#pragma unroll
        for (int i2 = 0; i2 < 2; ++i2) { const int ck = tid + 512 * i2; rw[i2] = *(const u32x4*)(P + (row0 + c * 64 + (ck >> 4)) * LDP + 512 + h * 128 + (ck & 15) * 8); }
        if (tid < 256) { const int v = v0 + (tid >> 3); ru = *(const u32x4*)(P + (row0 + c * 64 + (v >> 1)) * LDP + PC_BQKV + 1024 + h * 128 + (v & 1) * 64 + (tid & 7) * 8); } };
    auto load_g2 = [&](int c) {
#pragma unroll
        for (int i2 = 0; i2 < 2; ++i2) { const int ck = tid + 512 * i2;
            rq[i2] = *(const u32x4*)(P + (row0 + c * 64 + (ck >> 4)) * LDP + PC_BQKV + h * 128 + (ck & 15) * 8);
            const int k = ck >> 3; rk[i2] = *(const u32x4*)(P + (row0 + c * 64 + (k >> 1)) * LDP + PC_BQKV + 512 + h * 128 + (k & 1) * 64 + (ck & 7) * 8); }
        if (tid < 320) rqk = *(const u32x4*)(QKG + (size_t)((b * 64 + c) * 4 + h) * 2560 + tid * 8);
        rge = GC[(row0 + c * 64 + 63) * 4 + h]; };
    auto store_g1 = [&]() {
#pragma unroll
        for (int i2 = 0; i2 < 2; ++i2) { const int ck = tid + 512 * i2; *(u32x4*)(Wt + (ck >> 4) * 136 + (ck & 15) * 8) = rw[i2]; }
        if (tid < 256) *(u32x4*)(UT + (tid >> 3) * 72 + (tid & 7) * 8) = ru; };
    float ge = 1.f;
    auto store_g2 = [&]() {
#pragma unroll
        for (int i2 = 0; i2 < 2; ++i2) { const int ck = tid + 512 * i2;
            *(u32x4*)(QD + (ck >> 4) * 136 + (ck & 15) * 8) = rq[i2]; *(u32x4*)(KDT + (ck >> 3) * 72 + (ck & 7) * 8) = rk[i2]; }
        if (tid < 320) *(u32x4*)qk_dst = rqk;
        ge = __expf(rge); };
#define LDFRAG(base, row, pitch, ks) (*(const bf16x8*)((base) + (row) * (pitch) + (ks) * 32 + fq * 8))
#define MFMA16(bfrag, afrag, acc) __builtin_amdgcn_mfma_f32_16x16x32_bf16(bfrag, afrag, acc, 0, 0, 0)
    load_g1(0); load_g2(0);
    LDS_BARRIER();
    store_g1(); load_g1(1);
    const int vrow = 16 * wv + fr;
#pragma unroll 1
    for (int c = 0; c < 64; ++c) {
        LDS_BARRIER();
        store_g2(); if (c + 1 < 64) load_g2(c + 1);
        bf16x8 sfr[4];
#pragma unroll
        for (int ks = 0; ks < 4; ++ks) sfr[ks] = LDFRAG(ST, vrow, 136, ks);
        { f32x4 acc = (f32x4){0.f, 0.f, 0.f, 0.f};
#pragma unroll
          for (int ks = 0; ks < 4; ++ks) acc = MFMA16(LDFRAG(Wt, wt * 16 + fr, 136, ks), sfr[ks], acc);
          const f32x4 u4 = unpack4(*(const u32x2*)(UT + vrow * 72 + wt * 16 + 4 * fq));
          *(u32x2*)(VNT + vrow * 72 + wt * 16 + 4 * fq) = pack4(u4 - acc); }
        LDS_BARRIER();
        if (c + 1 < 64) { store_g1(); if (c + 2 < 64) load_g1(c + 2); }
        bf16x8 vfr[2];
#pragma unroll
        for (int ks = 0; ks < 2; ++ks) vfr[ks] = LDFRAG(VNT, vrow, 72, ks);
        { f32x4 acc = (f32x4){0.f, 0.f, 0.f, 0.f};
#pragma unroll
          for (int ks = 0; ks < 4; ++ks) acc = MFMA16(sfr[ks], LDFRAG(QD, wt * 16 + fr, 136, ks), acc);
#pragma unroll
          for (int ks = 0; ks < 2; ++ks) acc = MFMA16(vfr[ks], LDFRAG(QK, wt * 16 + fr, 72, ks), acc);
          { const int t = wt * 16 + fr;
            if (!dry) *(u32x2*)(P + (row0 + c * 64 + (v0 >> 1) + (t >> 2)) * LDP + PC_BQKV + 1024 + h * 128 + (t & 3) * 32 + 16 * wv + 4 * fq) = pack4(acc); } }
#pragma unroll
        for (int i2 = 0; i2 < 2; ++i2) { const int kt = 2 * wt + i2; f32x4 acc = Sacc[i2] * ge;
#pragma unroll
            for (int ks = 0; ks < 2; ++ks) acc = MFMA16(LDFRAG(KDT, kt * 16 + fr, 72, ks), vfr[ks], acc);
            Sacc[i2] = acc;
            *(u32x2*)(ST + vrow * 136 + kt * 16 + 4 * fq) = pack4(acc); }
    }
#undef LDFRAG
#undef MFMA16
}

__device__ __forceinline__ unsigned char* a_state_row(unsigned char* ws, size_t row0, int h, int v) {
    return ws + WS_AF + (row0 + (size_t)(v >> 1)) * 2048 + (size_t)h * 512 + (size_t)(v & 1) * 256;
}
__device__ __forceinline__ void ax1_unit(const Params& p, int unit, unsigned char* lds, int dry) {
    const int tid = tid_(), lane = tid & 63, wave = tid >> 6, fr = lane & 15, fq = lane >> 4;
    const int h = unit & 3, c = (unit >> 2) & 63, b = unit >> 8;
    bf16_t* P = (bf16_t*)(p.ws + WS_P); const float* AF = (const float*)(p.ws + WS_AF); float* DEC = (float*)(p.ws + WS_DEC);
    constexpr int BP = 132;
    float* BF = (float*)lds;
    bf16_t* QM = (bf16_t*)(lds + 33792);
    bf16_t* KM = (bf16_t*)(lds + 51200);
    bf16_t* KET = (bf16_t*)(lds + 68608);
    bf16_t* VT = (bf16_t*)(lds + 87040);
    bf16_t* SC = (bf16_t*)(lds + 105472);
    const size_t row0 = (size_t)b * SEQ + (size_t)c * 64;
    const int rA = tid >> 3, cA = (tid & 7) * 16;
    const int tB = tid & 63, cB = (tid >> 6) * 16;
    LDS_BARRIER();
    f32x4 fA[4];
#pragma unroll
    for (int i = 0; i < 4; ++i) { fA[i] = *(const f32x4*)(AF + (row0 + rA) * 512 + h * 128 + cA + 4 * i);
        *(f32x4*)(BF + rA * BP + cA + 4 * i) = (f32x4){__logf(fA[i][0]), __logf(fA[i][1]), __logf(fA[i][2]), __logf(fA[i][3])}; }
    f32x4 fB[4]; u32x4 vB[2];
#pragma unroll
    for (int i = 0; i < 4; ++i) fB[i] = *(const f32x4*)(AF + (row0 + tB) * 512 + h * 128 + cB + 4 * i);
#pragma unroll
    for (int i = 0; i < 2; ++i) vB[i] = *(const u32x4*)(P + (row0 + tB) * LDP + PC_AI + h * 128 + cB + 8 * i);
    u32x4 qA[2];
#pragma unroll
    for (int i = 0; i < 2; ++i) qA[i] = *(const u32x4*)(P + (row0 + rA) * LDP + PC_AQ + h * 128 + cA + 8 * i);
    LDS_BARRIER();
    if (tid < 128) { float s = 0.f;
#pragma unroll
        for (int t = 0; t < 64; ++t) { s += BF[t * BP + tid]; BF[t * BP + tid] = s; } }
    LDS_BARRIER();
    {
      float qv[16] = {bf_lo(qA[0].x), bf_hi(qA[0].x), bf_lo(qA[0].y), bf_hi(qA[0].y), bf_lo(qA[0].z), bf_hi(qA[0].z), bf_lo(qA[0].w), bf_hi(qA[0].w),
                      bf_lo(qA[1].x), bf_hi(qA[1].x), bf_lo(qA[1].y), bf_hi(qA[1].y), bf_lo(qA[1].z), bf_hi(qA[1].z), bf_lo(qA[1].w), bf_hi(qA[1].w)};
      unsigned wm[8], wk[8], wh[8];
#pragma unroll
      for (int i = 0; i < 4; ++i) { const f32x4 bt = *(const f32x4*)(BF + rA * BP + cA + 4 * i), bm = *(const f32x4*)(BF + 31 * BP + cA + 4 * i);
          float qm[4], km[4], qh[4];
#pragma unroll
          for (int e = 0; e < 4; ++e) { const float q = qv[4 * i + e], kk = 1.0f - fA[i][e]; qm[e] = q * __expf(bt[e] - bm[e]); km[e] = kk * __expf(bm[e] - bt[e]); qh[e] = q * __expf(bt[e]); }
          wm[2 * i] = pk2(qm[0], qm[1]); wm[2 * i + 1] = pk2(qm[2], qm[3]); wk[2 * i] = pk2(km[0], km[1]); wk[2 * i + 1] = pk2(km[2], km[3]); wh[2 * i] = pk2(qh[0], qh[1]); wh[2 * i + 1] = pk2(qh[2], qh[3]); }
      *(u32x4*)(QM + rA * 136 + cA) = (u32x4){wm[0], wm[1], wm[2], wm[3]}; *(u32x4*)(QM + rA * 136 + cA + 8) = (u32x4){wm[4], wm[5], wm[6], wm[7]};
      *(u32x4*)(KM + rA * 136 + cA) = (u32x4){wk[0], wk[1], wk[2], wk[3]}; *(u32x4*)(KM + rA * 136 + cA + 8) = (u32x4){wk[4], wk[5], wk[6], wk[7]};
      bf16_t* qg = P + (row0 + rA) * LDP + PC_AQ + h * 128 + cA;
      if (!dry) { *(u32x4*)qg = (u32x4){wh[0], wh[1], wh[2], wh[3]}; *(u32x4*)(qg + 8) = (u32x4){wh[4], wh[5], wh[6], wh[7]}; } }
    {
#pragma unroll
      for (int i = 0; i < 4; ++i) { const f32x4 bt = *(const f32x4*)(BF + tB * BP + cB + 4 * i), be = *(const f32x4*)(BF + 63 * BP + cB + 4 * i);
          const unsigned w0 = pk2((1.0f - fB[i][0]) * __expf(be[0] - bt[0]), (1.0f - fB[i][1]) * __expf(be[1] - bt[1])), w1 = pk2((1.0f - fB[i][2]) * __expf(be[2] - bt[2]), (1.0f - fB[i][3]) * __expf(be[3] - bt[3]));
          bf16_t* kt = KET + (cB + 4 * i) * 72 + tB;
          kt[0] = (bf16_t)(w0 & 0xffffu); kt[72] = (bf16_t)(w0 >> 16); kt[144] = (bf16_t)(w1 & 0xffffu); kt[216] = (bf16_t)(w1 >> 16); }
#pragma unroll
      for (int i = 0; i < 2; ++i) { bf16_t* vt = VT + (cB + 8 * i) * 72 + tB;
          vt[0 * 72] = (bf16_t)(vB[i].x & 0xffffu); vt[1 * 72] = (bf16_t)(vB[i].x >> 16); vt[2 * 72] = (bf16_t)(vB[i].y & 0xffffu); vt[3 * 72] = (bf16_t)(vB[i].y >> 16);
          vt[4 * 72] = (bf16_t)(vB[i].z & 0xffffu); vt[5 * 72] = (bf16_t)(vB[i].z >> 16); vt[6 * 72] = (bf16_t)(vB[i].w & 0xffffu); vt[7 * 72] = (bf16_t)(vB[i].w >> 16); } }
    if (tid < 128 && !dry) DEC[(size_t)unit * 128 + tid] = __expf(BF[63 * BP + tid]);
    LDS_BARRIER();
#pragma unroll
    for (int i2 = 0; i2 < 2; ++i2) { const int ti = 2 * wave + i2, tm = ti >> 2, tn = ti & 3; const int t = tm * 16 + fr, s0 = tn * 16 + 4 * fq; f32x4 o = (f32x4){0.f, 0.f, 0.f, 0.f};
        if (tn <= tm) { const f32x4 acc = mma_tile<4>(QM + tm * 16 * 136, 136, KM + tn * 16 * 136, 136, (f32x4){0.f, 0.f, 0.f, 0.f}, fr, fq);
#pragma unroll
            for (int e = 0; e < 4; ++e) o[e] = (s0 + e <= t) ? acc[e] : 0.f; }
        *(u32x2*)(SC + t * 72 + s0) = pack4(o); }
    LDS_BARRIER();
    { const int vrow = 16 * wave + fr;
      bf16x8 vfr[2];
#pragma unroll
      for (int ks = 0; ks < 2; ++ks) vfr[ks] = *(const bf16x8*)(VT + vrow * 72 + ks * 32 + fq * 8);
#pragma unroll
      for (int tt = 0; tt < 4; ++tt) { f32x4 acc = (f32x4){0.f, 0.f, 0.f, 0.f};
#pragma unroll
          for (int ks = 0; ks < 2; ++ks) acc = __builtin_amdgcn_mfma_f32_16x16x32_bf16(vfr[ks], *(const bf16x8*)(SC + (tt * 16 + fr) * 72 + ks * 32 + fq * 8), acc, 0, 0, 0);
          if (!dry) *(u32x2*)(P + (row0 + tt * 16 + fr) * LDP + PC_AI + h * 128 + 16 * wave + 4 * fq) = pack4(acc); }
      unsigned char* srow = a_state_row(p.ws, row0, h, vrow);
#pragma unroll
      for (int kt = 0; kt < 8; ++kt) { f32x4 acc = (f32x4){0.f, 0.f, 0.f, 0.f};
#pragma unroll
          for (int ks = 0; ks < 2; ++ks) acc = __builtin_amdgcn_mfma_f32_16x16x32_bf16(*(const bf16x8*)(KET + (kt * 16 + fr) * 72 + ks * 32 + fq * 8), vfr[ks], acc, 0, 0, 0);
          if (!dry) *(u32x2*)(srow + (kt * 16 + 4 * fq) * 2) = pack4(acc); } }
}
__device__ __forceinline__ void ax2_scan(const Params& p, int first_block, int nblocks, int dry) {
    const int tid = tid_(); const float* DEC = (const float*)(p.ws + WS_DEC);
    for (int gid = (bid_() - first_block) * NTHREADS + tid; gid < 16 * 8192; gid += nblocks * NTHREADS) {
        const int bh = gid >> 13, e2 = gid & 8191, v = e2 >> 6, kp = (e2 & 63) * 2, b = bh >> 2, h = bh & 3;
        float s0 = 0.f, s1 = 0.f;
#pragma unroll 1
        for (int c0 = 0; c0 < 64; c0 += 8) {
            unsigned x[8]; f32x2 d[8];
#pragma unroll
            for (int j = 0; j < 8; ++j) { const int c = c0 + j; x[j] = *(const unsigned*)(a_state_row(p.ws, (size_t)b * SEQ + (size_t)c * 64, h, v) + kp * 2); d[j] = *(const f32x2*)(DEC + ((size_t)(b * 256 + c * 4 + h)) * 128 + kp); }
#pragma unroll
            for (int j = 0; j < 8; ++j) { const int c = c0 + j; if (!dry) *(unsigned*)(a_state_row(p.ws, (size_t)b * SEQ + (size_t)c * 64, h, v) + kp * 2) = pk2(s0, s1);
                s0 = d[j].x * s0 + bf_lo(x[j]); s1 = d[j].y * s1 + bf_hi(x[j]); }
        }
    }
}
__device__ __forceinline__ void ax3_unit(const Params& p, int l, int unit, unsigned char* lds, int dry) {
    const int tid = tid_(), lane = tid & 63, wave = tid >> 6, fr = lane & 15, fq = lane >> 4;
    const int h = unit & 3, c = (unit >> 2) & 63, b = unit >> 8;
    bf16_t* P = (bf16_t*)(p.ws + WS_P);
    bf16_t* QH = (bf16_t*)lds;
    bf16_t* SI = (bf16_t*)(lds + 17408);
    float* OL = (float*)(lds + 52224);
    const size_t row0 = (size_t)b * SEQ + (size_t)c * 64;
    LDS_BARRIER();
#pragma unroll
    for (int i2 = 0; i2 < 2; ++i2) { const int ck = tid + 512 * i2, row = ck >> 4, c8 = (ck & 15) * 8;
        *(u32x4*)(QH + row * 136 + c8) = *(const u32x4*)(P + (row0 + row) * LDP + PC_AQ + h * 128 + c8); }
#pragma unroll
    for (int i2 = 0; i2 < 4; ++i2) { const int ck = tid + 512 * i2, v = ck >> 4, c8 = (ck & 15) * 8;
        *(u32x4*)(SI + v * 136 + c8) = *(const u32x4*)(a_state_row(p.ws, row0, h, v) + c8 * 2); }
    LDS_BARRIER();
    { const int vrow = 16 * wave + fr;
      bf16x8 sfr[4];
#pragma unroll
      for (int ks = 0; ks < 4; ++ks) sfr[ks] = *(const bf16x8*)(SI + vrow * 136 + ks * 32 + fq * 8);
#pragma unroll
      for (int tt = 0; tt < 4; ++tt) { const int t = tt * 16 + fr;
          f32x4 acc = unpack4(*(const u32x2*)(P + (row0 + t) * LDP + PC_AI + h * 128 + 16 * wave + 4 * fq));
#pragma unroll
          for (int ks = 0; ks < 4; ++ks) acc = __builtin_amdgcn_mfma_f32_16x16x32_bf16(sfr[ks], *(const bf16x8*)(QH + t * 136 + ks * 32 + fq * 8), acc, 0, 0, 0);
          *(f32x4*)(OL + t * 132 + 16 * wave + 4 * fq) = acc; } }
    LDS_BARRIER();
    { const int t = tid >> 3, v0 = (tid & 7) * 16;
      f32x4 o[4]; float ss = 0.f;
#pragma unroll
      for (int i = 0; i < 4; ++i) { o[i] = *(const f32x4*)(OL + t * 132 + v0 + 4 * i); ss += (o[i][0] * o[i][0] + o[i][1] * o[i][1]) + (o[i][2] * o[i][2] + o[i][3] * o[i][3]); }
      ss += dpp_mov<0xB1>(ss); ss += dpp_mov<0x4E>(ss); ss += dpp_mov<0x141>(ss);
      const float rs = __builtin_amdgcn_rsqf(ss * (1.0f / 128.0f) + EPS);
      bf16_t* gp = P + (row0 + t) * LDP + PC_AG + h * 128 + v0;
      const u32x4 g0 = *(const u32x4*)gp, g1 = *(const u32x4*)(gp + 8);
      const float gt[16] = {bf_lo(g0.x), bf_hi(g0.x), bf_lo(g0.y), bf_hi(g0.y), bf_lo(g0.z), bf_hi(g0.z), bf_lo(g0.w), bf_hi(g0.w), bf_lo(g1.x), bf_hi(g1.x), bf_lo(g1.y), bf_hi(g1.y), bf_lo(g1.z), bf_hi(g1.z), bf_lo(g1.w), bf_hi(g1.w)};
      unsigned w[8];
#pragma unroll
      for (int i = 0; i < 4; ++i) { const f32x4 nw = *(const f32x4*)(p.norm_a + l * 128 + v0 + 4 * i);
          const float y0 = o[i][0] * rs * nw[0] * siluf_(gt[4 * i]), y1 = o[i][1] * rs * nw[1] * siluf_(gt[4 * i + 1]), y2 = o[i][2] * rs * nw[2] * siluf_(gt[4 * i + 2]), y3 = o[i][3] * rs * nw[3] * siluf_(gt[4 * i + 3]);
          w[2 * i] = pk2(y0, y1); w[2 * i + 1] = pk2(y2, y3); }
      if (!dry) { *(u32x4*)gp = (u32x4){w[0], w[1], w[2], w[3]}; *(u32x4*)(gp + 8) = (u32x4){w[4], w[5], w[6], w[7]}; } }
}


__device__ __forceinline__ void a2_block(const Params& p, int blk, unsigned char* lds) {
    const int tid = tid_(), lane = tid & 63, wave = tid >> 6, fr = lane & 15, fq = lane >> 4;
    const int bh = blk >> 3, v0 = (blk & 7) * 16, b = bh >> 2, h = bh & 3;
    bf16_t* P = (bf16_t*)(p.ws + WS_P); const float* DEC = (const float*)(p.ws + WS_DEC);
    const int sv = tid >> 5, sk = (tid & 31) * 4;
    f32x4 S = (f32x4){0.f, 0.f, 0.f, 0.f};
    u32x4 rq[2]; u32x2 rds; f32x4 rd;
    auto gload = [&](int c) { const size_t row0 = (size_t)b * SEQ + (size_t)c * 64;
#pragma unroll
        for (int i2 = 0; i2 < 2; ++i2) { const int ck = tid + 512 * i2; rq[i2] = *(const u32x4*)(P + (row0 + (ck >> 4)) * LDP + PC_AQ + h * 128 + (ck & 15) * 8); }
        rds = *(const u32x2*)(a_state_row(p.ws, row0, h, v0 + sv) + sk * 2);
        rd = *(const f32x4*)(DEC + (size_t)((b * 64 + c) * 4 + h) * 128 + sk); };
    gload(0);
    LDS_BARRIER();
#pragma unroll 1
    for (int c = 0; c < 64; ++c) {
        bf16_t* QH = (bf16_t*)(lds + (c & 1) * 21760); bf16_t* SI = QH + 64 * 136;
#pragma unroll
        for (int i2 = 0; i2 < 2; ++i2) { const int ck = tid + 512 * i2; *(u32x4*)(QH + (ck >> 4) * 136 + (ck & 15) * 8) = rq[i2]; }
        *(u32x2*)(SI + sv * 136 + sk) = pack4(S);
        S = S * rd + unpack4(rds);
        if (c + 1 < 64) gload(c + 1);
        LDS_BARRIER();
        if (wave < 4) { const size_t row0 = (size_t)b * SEQ + (size_t)c * 64; const int t = wave * 16 + fr;
            bf16_t* op = P + (row0 + t) * LDP + PC_AI + h * 128 + v0 + 4 * fq;
            f32x4 acc = unpack4(*(const u32x2*)op);
#pragma unroll
            for (int ks = 0; ks < 4; ++ks) acc = __builtin_amdgcn_mfma_f32_16x16x32_bf16(*(const bf16x8*)(SI + fr * 136 + ks * 32 + fq * 8), *(const bf16x8*)(QH + t * 136 + ks * 32 + fq * 8), acc, 0, 0, 0);
            *(u32x2*)op = pack4(acc); }
    }
}
__device__ __forceinline__ void cmma_unit(const Params& p, int l, int unit, unsigned char* lds, int dry) {
    const int tid = tid_(), lane = tid & 63, wave = tid >> 6, fr = lane & 15, fq = lane >> 4;
    const int kvh = unit & 1, nb = (unit >> 1) & 31, b = unit >> 6;
    bf16_t* P = (bf16_t*)(p.ws + WS_P);
    bf16_t* sK = (bf16_t*)lds;
    bf16_t* sVT = (bf16_t*)(lds + 36864);
    float* sBias = (float*)(lds + 70656);
    bf16_t* sP = (bf16_t*)(lds + 72704) + wave * (16 * 168);
    const size_t rowq0 = (size_t)b * SEQ + (size_t)nb * 128;
    const bool first = (nb == 0);
    LDS_BARRIER();
#pragma unroll
    for (int i2 = 0; i2 < 4; ++i2) { const int ck = tid + 512 * i2, j = ck >> 3, d8 = (ck & 7) * 8; u32x4 kv = (u32x4){0u, 0u, 0u, 0u};
        if (!first || j >= 128) kv = *(const u32x4*)(P + (rowq0 - 128 + j) * LDP + PC_CK + kvh * 64 + d8);
        *(u32x4*)(sK + j * 72 + d8) = kv; }
    { const int j = tid & 255, dh = (tid >> 8) * 32;
#pragma unroll
      for (int i = 0; i < 4; ++i) { u32x4 vv = (u32x4){0u, 0u, 0u, 0u};
          if (!first || j >= 128) vv = *(const u32x4*)(P + (rowq0 - 128 + j) * LDP + PC_CV + kvh * 64 + dh + 8 * i);
          bf16_t* vt = sVT + (dh + 8 * i) * 264 + j;
          vt[0 * 264] = (bf16_t)(vv.x & 0xffffu); vt[1 * 264] = (bf16_t)(vv.x >> 16); vt[2 * 264] = (bf16_t)(vv.y & 0xffffu); vt[3 * 264] = (bf16_t)(vv.y >> 16);
          vt[4 * 264] = (bf16_t)(vv.z & 0xffffu); vt[5 * 264] = (bf16_t)(vv.z >> 16); vt[6 * 264] = (bf16_t)(vv.w & 0xffffu); vt[7 * 264] = (bf16_t)(vv.w >> 16); } }
    { const int g = tid >> 7, dist = tid & 127; sBias[g * 128 + dist] = p.rel_bias[(int)kBucket[dist] * 8 + kvh * 4 + g]; }
    LDS_BARRIER();
    const int a = wave, kb0 = 32 * (a >> 1), qi = 16 * a + fr;
#pragma unroll 1
    for (int g = 0; g < 4; ++g) {
        const int hq = kvh * 4 + g; const size_t rowq = rowq0 + qi;
        bf16x8 qf[2];
#pragma unroll
        for (int ks = 0; ks < 2; ++ks) qf[ks] = *(const bf16x8*)(P + rowq * LDP + PC_CQ + hq * 64 + ks * 32 + fq * 8);
        f32x4 s[10];
#pragma unroll
        for (int kt = 0; kt < 10; ++kt) { f32x4 acc = (f32x4){0.f, 0.f, 0.f, 0.f};
#pragma unroll
            for (int ks = 0; ks < 2; ++ks) acc = __builtin_amdgcn_mfma_f32_16x16x32_bf16(*(const bf16x8*)(sK + (kb0 + kt * 16 + fr) * 72 + ks * 32 + fq * 8), qf[ks], acc, 0, 0, 0);
            s[kt] = acc; }
        const float sink = p.sinks[l * 8 + hq];
        float mx = sink;
#pragma unroll
        for (int kt = 0; kt < 10; ++kt)
#pragma unroll
            for (int e = 0; e < 4; ++e) { const int j = kb0 + kt * 16 + 4 * fq + e; const int dist = qi + 128 - j; const bool ok = (dist >= 0) && (dist < 128) && !(first && j < 128);
                const float v = ok ? s[kt][e] + sBias[g * 128 + (dist & 127)] : -1e30f; s[kt][e] = v; mx = fmaxf(mx, v); }
        { auto r16 = __builtin_amdgcn_permlane16_swap(__float_as_uint(mx), __float_as_uint(mx), false, false); mx = fmaxf(__uint_as_float(r16[0]), __uint_as_float(r16[1]));
          auto r32 = __builtin_amdgcn_permlane32_swap(__float_as_uint(mx), __float_as_uint(mx), false, false); mx = fmaxf(__uint_as_float(r32[0]), __uint_as_float(r32[1])); }
        float ls = 0.f;
#pragma unroll
        for (int kt = 0; kt < 10; ++kt) { f32x4 pe;
#pragma unroll
            for (int e = 0; e < 4; ++e) pe[e] = __expf(s[kt][e] - mx);
            const u32x2 pk = pack4(pe); ls += (bf_lo(pk.x) + bf_hi(pk.x)) + (bf_lo(pk.y) + bf_hi(pk.y));
            *(u32x2*)(sP + fr * 168 + kt * 16 + 4 * fq) = pk; }
        ls = xor32_sum(xor16_sum(ls)) + __expf(sink - mx);
        const float inv = __builtin_amdgcn_rcpf(ls);
        asm volatile("s_waitcnt lgkmcnt(0)" ::: "memory");
        bf16x8 pf[5];
#pragma unroll
        for (int ks = 0; ks < 5; ++ks) pf[ks] = *(const bf16x8*)(sP + fr * 168 + ks * 32 + fq * 8);
        bf16_t* gp = P + rowq * LDP + PC_CG + hq * 64;
#pragma unroll
        for (int dt = 0; dt < 4; ++dt) { f32x4 acc = (f32x4){0.f, 0.f, 0.f, 0.f};
#pragma unroll
            for (int ks = 0; ks < 5; ++ks) acc = __builtin_amdgcn_mfma_f32_16x16x32_bf16(*(const bf16x8*)(sVT + (dt * 16 + fr) * 264 + kb0 + ks * 32 + fq * 8), pf[ks], acc, 0, 0, 0);
            const f32x4 gt = unpack4(*(const u32x2*)(gp + dt * 16 + 4 * fq));
            f32x4 y;
#pragma unroll
            for (int e = 0; e < 4; ++e) y[e] = acc[e] * inv * siluf_(gt[e]);
            if (!dry) *(u32x2*)(gp + dt * 16 + 4 * fq) = pack4(y); }
        asm volatile("s_waitcnt lgkmcnt(0)" ::: "memory");
    }
}
__device__ __forceinline__ void mixer_c(const Params& p, int l, int unit, unsigned char* lds, int dry) {
    const int tid = tid_(), wave = tid >> 6;
    const int kvh = unit & 1, nb = (unit >> 1) & 31, b = unit >> 6;
    bf16_t* P = (bf16_t*)(p.ws + WS_P);
    bf16_t* sK = (bf16_t*)lds;
    bf16_t* sVT = (bf16_t*)(lds + 32768);
    float* sBias = (float*)(lds + 32768 + 64 * 264 * 2);
    constexpr int VTP = 264;
    const size_t rowq0 = (size_t)b * SEQ + (size_t)nb * 128;
    __syncthreads();
    for (int c = tid; c < 256 * 8; c += NTHREADS) {
        const int j = c >> 3, d8 = (c & 7) * 8; u32x4 kv = (u32x4){0u, 0u, 0u, 0u}, vv = (u32x4){0u, 0u, 0u, 0u};
        if (nb > 0 || j >= 128) { const size_t row = rowq0 - 128 + j; kv = *(const u32x4*)(P + row * LDP + PC_CK + kvh * 64 + d8); vv = *(const u32x4*)(P + row * LDP + PC_CV + kvh * 64 + d8); }
        *(u32x4*)(sK + j * 64 + d8) = kv;
        sVT[(d8 + 0) * VTP + j] = (bf16_t)(vv.x & 0xffff); sVT[(d8 + 1) * VTP + j] = (bf16_t)(vv.x >> 16);
        sVT[(d8 + 2) * VTP + j] = (bf16_t)(vv.y & 0xffff); sVT[(d8 + 3) * VTP + j] = (bf16_t)(vv.y >> 16);
        sVT[(d8 + 4) * VTP + j] = (bf16_t)(vv.z & 0xffff); sVT[(d8 + 5) * VTP + j] = (bf16_t)(vv.z >> 16);
        sVT[(d8 + 6) * VTP + j] = (bf16_t)(vv.w & 0xffff); sVT[(d8 + 7) * VTP + j] = (bf16_t)(vv.w >> 16);
    }
    { const int g = tid >> 7, dist = tid & 127; sBias[g * 128 + dist] = p.rel_bias[(int)kBucket[dist] * 8 + kvh * 4 + g]; }
    __syncthreads();
    const int g = tid >> 7, i = tid & 127, hq = kvh * 4 + g;
    const size_t rowq = rowq0 + i;
    unsigned qp[32];
#pragma unroll
    for (int c = 0; c < 8; ++c) { const u32x4 t = *(const u32x4*)(P + rowq * LDP + PC_CQ + hq * 64 + c * 8); qp[4 * c] = t.x; qp[4 * c + 1] = t.y; qp[4 * c + 2] = t.z; qp[4 * c + 3] = t.w; }
    float o[64];
#pragma unroll
    for (int d = 0; d < 64; ++d) o[d] = 0.f;
    const float sink = p.sinks[l * 8 + hq];
    float mrun = sink, lrun = 1.0f;
    const int jlo = 64 * (wave & 1);
    const bool first = (nb == 0);
    for (int jg = 0; jg < 24; ++jg) {
        const int j0 = jlo + jg * 8;
        float s[8];
#pragma unroll
        for (int u = 0; u < 8; ++u) {
            const int j = j0 + u; const bf16_t* kr = sK + j * 64; float a = 0.f;
#pragma unroll
            for (int c = 0; c < 8; ++c) { const u32x4 kk = *(const u32x4*)(kr + c * 8);
                a = dot2u(kk.x, qp[4 * c], a);
                a = dot2u(kk.y, qp[4 * c + 1], a);
                a = dot2u(kk.z, qp[4 * c + 2], a);
                a = dot2u(kk.w, qp[4 * c + 3], a); }
            const int dist = i + 128 - j; const bool ok = (dist >= 0) && (dist < 128) && !(first && j < 128);
            s[u] = ok ? a + sBias[g * 128 + (dist & 127)] : -1e30f;
        }
        float gm = fmaxf(fmaxf(fmaxf(s[0], s[1]), fmaxf(s[2], s[3])), fmaxf(fmaxf(s[4], s[5]), fmaxf(s[6], s[7])));
        const float mnew = fmaxf(mrun, gm); const float corr = __expf(mrun - mnew); mrun = mnew;
        float ps = 0.f; unsigned pp[4];
        float pe[8];
#pragma unroll
        for (int u = 0; u < 8; ++u) { pe[u] = __expf(s[u] - mnew); }
#pragma unroll
        for (int u = 0; u < 4; ++u) { pp[u] = pk2(pe[2 * u], pe[2 * u + 1]); ps += bf_lo(pp[u]) + bf_hi(pp[u]); }
        lrun = lrun * corr + ps;
#pragma unroll
        for (int d = 0; d < 64; ++d) {
            const u32x4 vt = *(const u32x4*)(sVT + d * VTP + j0);
            float a = o[d] * corr;
            a = dot2u(vt.x, pp[0], a);
            a = dot2u(vt.y, pp[1], a);
            a = dot2u(vt.z, pp[2], a);
            a = dot2u(vt.w, pp[3], a);
            o[d] = a;
        }
    }
    float inv = 1.0f / lrun;
#if DIAG_ZERO_C
    inv = 0.f;
#endif
    bf16_t* gp = P + rowq * LDP + PC_CG + hq * 64;
#pragma unroll
    for (int c = 0; c < 8; ++c) {
        const u32x4 gv = *(const u32x4*)(gp + c * 8); u32x4 ov;
        ov.x = pk2(o[8 * c + 0] * inv * siluf_(bf_lo(gv.x)), o[8 * c + 1] * inv * siluf_(bf_hi(gv.x)));
        ov.y = pk2(o[8 * c + 2] * inv * siluf_(bf_lo(gv.y)), o[8 * c + 3] * inv * siluf_(bf_hi(gv.y)));
        ov.z = pk2(o[8 * c + 4] * inv * siluf_(bf_lo(gv.z)), o[8 * c + 5] * inv * siluf_(bf_hi(gv.z)));
        ov.w = pk2(o[8 * c + 6] * inv * siluf_(bf_lo(gv.w)), o[8 * c + 7] * inv * siluf_(bf_hi(gv.w)));
        if (!dry) *(u32x4*)(gp + c * 8) = ov;
    }
}


#if DIAG_NAIVE_C
__device__ __forceinline__ void mixer_c_naive(const Params& p, int l, int unit) {
    const int tid = tid_();
    const int kvh = unit & 1, nb = (unit >> 1) & 31, b = unit >> 6;
    bf16_t* P = (bf16_t*)(p.ws + WS_P);
    const int g = tid >> 7, i = tid & 127, hq = kvh * 4 + g;
    const size_t rowq = (size_t)b * SEQ + (size_t)nb * 128 + i;
    float q[64], o[64];
#pragma unroll
    for (int d = 0; d < 64; ++d) { q[d] = bf2f(P[rowq * LDP + PC_CQ + hq * 64 + d]); o[d] = 0.f; }
    float m = p.sinks[l * 8 + hq], lsum = 1.0f;
    const int tpos = nb * 128 + i;
    for (int kp = tpos - 127; kp <= tpos; ++kp) {
        if (kp < 0) continue;
        const size_t rowk = (size_t)b * SEQ + kp;
        float s = 0.f;
#pragma unroll
        for (int d = 0; d < 64; ++d) s += q[d] * bf2f(P[rowk * LDP + PC_CK + kvh * 64 + d]);
        s += p.rel_bias[(int)kBucket[tpos - kp] * 8 + hq];
        const float mn = fmaxf(m, s); const float corr = __expf(m - mn); const float pe = __expf(s - mn); m = mn;
        lsum = lsum * corr + pe;
#pragma unroll
        for (int d = 0; d < 64; ++d) o[d] = o[d] * corr + pe * bf2f(P[rowk * LDP + PC_CV + kvh * 64 + d]);
    }
    const float inv = 1.0f / lsum;
#pragma unroll
    for (int d = 0; d < 64; ++d) { const size_t a = rowq * LDP + PC_CG + hq * 64 + d; P[a] = (bf16_t)f2bf(o[d] * inv * siluf_(bf2f(P[a]))); }
}
#endif
__device__ __forceinline__ void phase_mixers(const Params& p, int l, unsigned char* lds, int dry, int mask) {
    const int vb = bid_(), G = gridDim.x;
#pragma unroll 1
    for (int u = vb; u < 1024; u += G) { if (mask & 2) bpre_unit(p, l, u, lds, dry); if (mask & 1) ax1_unit(p, u, lds, dry); }
    if (mask & 4) {
#pragma unroll 1
    for (int u = vb; u < 256; u += G) cmma_unit(p, l, u, lds, dry); }
}
__device__ __forceinline__ void phase_scan(const Params& p, int l, unsigned char* lds, int dry, int mask) {
    const int vb = bid_();
    if (vb < 64) { if (mask & 2) bscan_block(p, vb, lds, dry); }
    else if (vb < 192) { if ((mask & 1) && !dry) a2_block(p, vb - 64, lds); }
}
__device__ __forceinline__ void phase_finalize(const Params& p, int l, int dry) {
    const int tid = tid_(), lane = tid & 63, wave = tid >> 6;
    bf16_t* P = (bf16_t*)(p.ws + WS_P);
    const int hh = lane >> 4, v8 = (lane & 15) * 8;
    float wa[8], wb[8];
#pragma unroll
    for (int e = 0; e < 8; ++e) { wa[e] = p.norm_a[l * 128 + v8 + e]; wb[e] = p.norm_b[l * 128 + v8 + e]; }
    const int gw = bid_() * 8 + wave, NGW = gridDim.x * 8;
    for (int m = gw; m < M; m += NGW) {
        bf16_t* pr = P + (size_t)m * LDP;
#pragma unroll
        for (int br = 0; br < 2; ++br) {
            const int ocol = br == 0 ? PC_AI + hh * 128 + v8 : PC_BQKV + 1024 + hh * 128 + (m & 3) * 32 + (v8 & 31);
            const int gcol = br == 0 ? PC_AG + hh * 128 + v8 : PC_BZ + hh * 128 + v8;
            const bf16_t* po = br == 0 ? pr : P + (size_t)((m & ~63) + 16 * (v8 >> 5) + ((m & 63) >> 2)) * LDP;
            const u32x4 ov = *(const u32x4*)(po + ocol); const u32x4 gv = *(const u32x4*)(pr + gcol);
            float o[8] = {bf_lo(ov.x), bf_hi(ov.x), bf_lo(ov.y), bf_hi(ov.y), bf_lo(ov.z), bf_hi(ov.z), bf_lo(ov.w), bf_hi(ov.w)};
            float gt[8] = {bf_lo(gv.x), bf_hi(gv.x), bf_lo(gv.y), bf_hi(gv.y), bf_lo(gv.z), bf_hi(gv.z), bf_lo(gv.w), bf_hi(gv.w)};
            float ss = 0.f;
#pragma unroll
            for (int e = 0; e < 8; ++e) ss += o[e] * o[e];
            ss = row16_sum(ss);
            const float rs = 1.0f / sqrtf(ss * (1.0f / 128.0f) + EPS);
            float y[8];
#pragma unroll
            for (int e = 0; e < 8; ++e) y[e] = o[e] * rs * (br == 0 ? wa[e] : wb[e]) * siluf_(gt[e]);
            u32x4 yo; yo.x = pk2(y[0], y[1]); yo.y = pk2(y[2], y[3]); yo.z = pk2(y[4], y[5]); yo.w = pk2(y[6], y[7]);
            if (!dry) *(u32x4*)(pr + gcol) = yo;
        }
    }
}

__device__ __forceinline__ int launder_i(int v) { asm volatile("" : "+s"(v)); return v; }
__device__ __forceinline__ Params launder(Params p) {
    asm volatile("" : "+s"(p.x), "+s"(p.norm_w), "+s"(p.w_in), "+s"(p.conv_w), "+s"(p.a_log), "+s"(p.dt_bias), "+s"(p.lb_param), "+s"(p.norm_a));
    asm volatile("" : "+s"(p.norm_b), "+s"(p.sinks), "+s"(p.rel_bias), "+s"(p.w_branch), "+s"(p.w_out), "+s"(p.final_norm), "+s"(p.out), "+s"(p.ws));
    return p;
}
#define XB_TMO      128
#define XB_XCNT(j)  (256  + 64 * (j))
#define XB_XSUB(j)  (1280 + 64 * (j))
#define XB_XGEN(j)  (2304 + 64 * (j))
#define XB_TOP      3328
#define XB_TOPGEN   3392
#define XCD_BAR_WORDS 3456
#define XB_SPIN_CAP (1u << 18)

__device__ __forceinline__ unsigned xb_ld(unsigned* p)              { return __hip_atomic_load(p, __ATOMIC_RELAXED, __HIP_MEMORY_SCOPE_AGENT); }
__device__ __forceinline__ unsigned xb_add(unsigned* p, unsigned v) { return __hip_atomic_fetch_add(p, v, __ATOMIC_RELAXED, __HIP_MEMORY_SCOPE_AGENT); }
__device__ __forceinline__ unsigned xb_xcc_id() { return (unsigned)__builtin_amdgcn_s_getreg((3 << 11) | 20) & 0xFu; }
#define XB_SPIN(cond, bar) do { unsigned _sp = 0; while (cond) { __builtin_amdgcn_s_sleep(1); \
    if ((++_sp & 255u) == 0u) { if (xb_ld(&(bar)[XB_TMO])) break; if (_sp > XB_SPIN_CAP) { atomicAdd(&(bar)[XB_TMO], 1u); break; } } } } while (0)

struct XcdBarrier {
    unsigned* bar; unsigned x;
    volatile __attribute__((address_space(3))) unsigned* st;
};

__device__ __forceinline__ XcdBarrier xcd_barrier_post(unsigned* bar, volatile __attribute__((address_space(3))) unsigned* st) {
    XcdBarrier b; b.bar = bar; b.x = xb_xcc_id(); b.st = st;
    if (threadIdx.x == 0) (void)xb_add(&bar[XB_XCNT(b.x)], 1u);
    return b;
}
__device__ __forceinline__ void xcd_barrier_complete(unsigned* bar, unsigned x, unsigned& nloc, unsigned& nx) {
    const unsigned G = gridDim.x * gridDim.y * gridDim.z;
    unsigned sum, cnt, mine, sp = 0u;
    for (;;) {
        sum = 0u; cnt = 0u; mine = 0u;
#pragma unroll
        for (unsigned j = 0; j < 16; ++j) { const unsigned c = xb_ld(&bar[XB_XCNT(j)]); sum += c; cnt += (c > 0u) ? 1u : 0u; mine = (j == x) ? c : mine; }
        if (sum == G) break;
        __builtin_amdgcn_s_sleep(1);
        if ((++sp & 255u) == 0u) { if (xb_ld(&bar[XB_TMO])) break; if (sp > XB_SPIN_CAP) { atomicAdd(&bar[XB_TMO], 1u); break; } }
    }
    nloc = mine > 0u ? mine : 1u; nx = cnt > 0u ? cnt : 1u;
}

__device__ __forceinline__ void xcd_barrier(const XcdBarrier& b) {
    asm volatile("s_waitcnt vmcnt(0)" ::: "memory");
    __syncthreads();
    if (threadIdx.x == 0) {
        unsigned* bar = b.bar;
        __builtin_amdgcn_s_waitcnt(0);
        unsigned nloc = b.st[0], nx = b.st[1];
        if (nloc == 0u) { xcd_barrier_complete(bar, b.x, nloc, nx); b.st[0] = nloc; b.st[1] = nx; }
        const unsigned old = xb_add(&bar[XB_XSUB(b.x)], 1u);
        const unsigned gen = old / nloc;
        if (old + 1u == (gen + 1u) * nloc) {
            __builtin_amdgcn_fence(__ATOMIC_RELEASE, "agent");
            asm volatile("s_waitcnt vmcnt(0)" ::: "memory");
            const unsigned og = xb_add(&bar[XB_TOP], 1u);
            const unsigned tg = og / nx;
            if (og + 1u == (tg + 1u) * nx) xb_add(&bar[XB_TOPGEN], 1u);
            else XB_SPIN(xb_ld(&bar[XB_TOPGEN]) == tg, bar);
            __builtin_amdgcn_fence(__ATOMIC_ACQUIRE, "agent");
            xb_add(&bar[XB_XGEN(b.x)], 1u);
            asm volatile("s_waitcnt vmcnt(0)" ::: "memory");
        } else {
            XB_SPIN(xb_ld(&bar[XB_XGEN(b.x)]) == gen, bar);
            __builtin_amdgcn_fence(__ATOMIC_ACQUIRE, "agent");
            asm volatile("s_waitcnt vmcnt(0)" ::: "memory");
        }
    }
    __syncthreads();
}


__global__ void __launch_bounds__(NTHREADS, 2) fwd_megakernel(Params p) {
    extern __shared__ __attribute__((aligned(16))) unsigned char lds[];
    cg::grid_group grid = cg::this_grid();
    volatile __attribute__((address_space(3))) unsigned* bst = (volatile __attribute__((address_space(3))) unsigned*)((__attribute__((address_space(3))) unsigned char*)lds + (LDS_BYTES - 16));
    if (threadIdx.x < 4) bst[threadIdx.x] = 0u;
    __syncthreads();
    XcdBarrier xbar = xcd_barrier_post((unsigned*)(p.ws + WS_BAR), bst);
#define GRID_BAR() xcd_barrier(xbar)
#pragma unroll 1
    for (int l0 = 0; l0 < DEPTH; ++l0) {
        { const Params q = launder(p); const int l = launder_i(l0); phase_convert_weights(q, l, lds); }
        __syncthreads();
        { const Params q = launder(p); const int l = launder_i(l0); phase_rowpass<0>(q, (l == 0) ? q.x : q.out, q.norm_w + (size_t)l * D, l, lds); }
        if (l0 == 0) grid.sync(); else GRID_BAR();
#if DIAG_DUP == 1
        { const Params q = launder(p); const int l = launder_i(l0); phase_convert_weights(q, l, lds); }
        __syncthreads();
        { const Params q = launder(p); const int l = launder_i(l0); phase_rowpass<0>(q, (l == 0) ? q.x : q.out, q.norm_w + (size_t)l * D, l, lds); }
        GRID_BAR();
#endif
#if DIAG_DUP == 7
        { const Params q = launder(p); const int l = launder_i(l0); phase_convert_weights(q, l, lds); }
        GRID_BAR();
#endif
#if DIAG_DUP == 8
        { const Params q = launder(p); const int l = launder_i(l0); phase_rowpass<0>(q, (l == 0) ? q.x : q.out, q.norm_w + (size_t)l * D, l, lds); }
        GRID_BAR();
#endif
#if DIAG_DUP == 2
        { const Params q = launder(p); const int l = launder_i(l0); phase_inproj(q, l, lds); }
        GRID_BAR();
#endif
        { const Params q = launder(p); const int l = launder_i(l0); phase_inproj(q, l, lds); }
        GRID_BAR();
#if DIAG_DUP >= 10 && DIAG_DUP < 20
        { const Params q = launder(p); const int l = launder_i(l0); phase_mixers(q, l, lds, launder_i(DIAG_DRYMODE), launder_i(DIAG_DUP - 10)); }
        GRID_BAR();
#endif
        { const Params q = launder(p); const int l = launder_i(l0); phase_mixers(q, l, lds, launder_i(0), launder_i(7)); }
        GRID_BAR();
#if DIAG_DUP >= 20 && DIAG_DUP < 30
        { const Params q = launder(p); const int l = launder_i(l0); phase_scan(q, l, lds, launder_i(1), launder_i(DIAG_DUP - 20)); }
        GRID_BAR();
#endif
        { const Params q = launder(p); const int l = launder_i(l0); phase_scan(q, l, lds, launder_i(0), launder_i(3)); }
        GRID_BAR();
#if DIAG_DUP == 9
        { const Params q = launder(p); const int l = launder_i(l0); phase_finalize(q, l, launder_i(1)); }
        GRID_BAR();
#endif
        { const Params q = launder(p); const int l = launder_i(l0); phase_finalize(q, l, launder_i(0)); }
#if DIAG_DUP == 4
        { const Params q = launder(p); phase_gates(q, lds); }
        GRID_BAR();
#endif
        { const Params q = launder(p); phase_gates(q, lds); }
        GRID_BAR();
#if DIAG_DUP == 5
        { const Params q = launder(p); phase_lift(q, lds); }
        GRID_BAR();
#endif
        { const Params q = launder(p); phase_lift(q, lds); }
        GRID_BAR();
#if DIAG_DUP == 30
        if (l0 == 0) { { const Params q = launder(p); phase_outproj(q, q.x, lds); } GRID_BAR(); }
#endif
        { const Params q = launder(p); const int l = launder_i(l0); phase_outproj(q, (l == 0) ? q.x : q.out, lds); }
        GRID_BAR();
#if DIAG_DUP == 6
        GRID_BAR(); GRID_BAR(); GRID_BAR(); GRID_BAR(); GRID_BAR(); GRID_BAR(); GRID_BAR(); GRID_BAR(); GRID_BAR(); GRID_BAR();
#endif
    }
    { const Params q = launder(p); phase_rowpass<1>(q, q.out, q.final_norm, 0, lds); }
}

extern "C" void kernel_launch(void* const* d_in, const int* in_sizes, int n_in, void* d_out, int out_size, void* d_ws, size_t ws_size, hipStream_t stream) {
    static int grid_blocks = 0;
    if (grid_blocks == 0) {
        if (n_in != 14 || in_sizes[0] != M * D || out_size != M * D || ws_size < WS_END) {
            fprintf(stderr, "kernel_launch: unexpected shapes n_in=%d in0=%d out=%d ws=%zu (need %zu)\n", n_in, n_in > 0 ? in_sizes[0] : -1, out_size, ws_size, (size_t)WS_END); grid_blocks = -1; return; }
        int dev = 0, cus = 0, per_cu = 0;
        hipGetDevice(&dev);
        hipDeviceGetAttribute(&cus, hipDeviceAttributeMultiprocessorCount, dev);
        hipFuncSetAttribute((const void*)fwd_megakernel, hipFuncAttributeMaxDynamicSharedMemorySize, LDS_BYTES);
        hipOccupancyMaxActiveBlocksPerMultiprocessor(&per_cu, (const void*)fwd_megakernel, NTHREADS, LDS_BYTES);
        if (per_cu < 1) { fprintf(stderr, "kernel_launch: occupancy query says %d blocks/CU\n", per_cu); per_cu = 1; }
        if (per_cu > 1) per_cu = 1;
        grid_blocks = cus * per_cu;
        if (grid_blocks < 256) { fprintf(stderr, "kernel_launch: needs >= 256 resident blocks, got %d\n", grid_blocks); grid_blocks = -1; return; }
    }
    if (grid_blocks < 0) return;
    Params p{};
    p.x = (const float*)d_in[0]; p.norm_w = (const float*)d_in[1]; p.w_in = (const float*)d_in[2]; p.conv_w = (const float*)d_in[3];
    p.a_log = (const float*)d_in[4]; p.dt_bias = (const float*)d_in[5]; p.lb_param = (const float*)d_in[6]; p.norm_a = (const float*)d_in[7];
    p.norm_b = (const float*)d_in[8]; p.sinks = (const float*)d_in[9]; p.rel_bias = (const float*)d_in[10]; p.w_branch = (const float*)d_in[11];
    p.w_out = (const float*)d_in[12]; p.final_norm = (const float*)d_in[13];
    p.out = (float*)d_out; p.ws = (unsigned char*)d_ws;
    (void)hipMemsetAsync((char*)d_ws + WS_BAR, 0, 16384, stream);
    void* args[] = {&p};
    hipError_t e = hipLaunchCooperativeKernel((const void*)fwd_megakernel, dim3(grid_blocks), dim3(NTHREADS), args, LDS_BYTES, stream);
    if (e != hipSuccess) fprintf(stderr, "cooperative launch failed: %s (grid %d)\n", hipGetErrorString(e), grid_blocks);
}
```

```cpp
#include <hip/hip_runtime.h>
#include <hip/hip_cooperative_groups.h>
#include <cstdio>
#include <cstdint>
namespace cg = cooperative_groups;

typedef unsigned short bf16_t;
typedef short bf16x8 __attribute__((ext_vector_type(8)));
typedef float f32x4 __attribute__((ext_vector_type(4)));
typedef float f32x2 __attribute__((ext_vector_type(2)));
typedef unsigned u32x4 __attribute__((ext_vector_type(4)));
typedef unsigned u32x2 __attribute__((ext_vector_type(2)));
typedef __bf16 bf16x2v __attribute__((ext_vector_type(2)));

constexpr int BATCH = 4, SEQ = 4096, M = BATCH * SEQ, D = 1024, DEPTH = 2;
constexpr int NORIG = 8456;
constexpr int NMIX = 5376;
constexpr int NGATE = 3072;
constexpr int NALL = NMIX + NGATE;
constexpr int LDP = NMIX;
constexpr int PC_AQ = 0, PC_AI = 1024, PC_AG = 1536, PC_BQKV = 2048, PC_BZ = 3584, PC_CQ = 4096, PC_CK = 4608, PC_CV = 4736, PC_CG = 4864;
constexpr float EPS = 1e-6f;
constexpr int NTHREADS = 512;
constexpr int LDS_BYTES = 155648;

constexpr size_t WS_P = 0;
constexpr size_t WS_AF = WS_P + (size_t)M * LDP * 2;
constexpr size_t WS_HB = WS_AF + (size_t)M * 512 * 4;
constexpr size_t WS_WIN = WS_HB + (size_t)M * D * 2;
constexpr size_t WS_WB = WS_WIN + (size_t)NALL * D * 2;
constexpr size_t WS_WO = WS_WB + (size_t)D * 1536 * 2;
constexpr size_t WS_SM = WS_WO + (size_t)D * D * 2;
constexpr size_t WS_HALO = WS_SM + (size_t)M * 8 * 4;
constexpr size_t WS_GC = WS_HALO + (size_t)256 * 3 * 1536 * 2;
constexpr size_t WS_DEC = WS_GC + (size_t)M * 4 * 4;
constexpr size_t WS_BAR = WS_DEC + (size_t)1024 * 128 * 4;
constexpr size_t WS_QK = WS_BAR + 16384;
constexpr size_t WS_END = WS_QK + (size_t)1024 * 2560 * 2;

__device__ const unsigned char kBucket[128] = {0, 1, 2, 3, 4, 5, 6, 7, 8, 9, 10, 11, 12, 13, 14, 15, 16, 16, 16, 17, 17, 18, 18, 18, 19, 19, 19, 20, 20, 20, 20, 21, 21, 21, 21, 22, 22, 22, 22, 22, 23, 23, 23, 23, 23, 23, 24, 24, 24, 24, 24, 24, 25, 25, 25, 25, 25, 25, 25, 26, 26, 26, 26, 26, 26, 26, 26, 27, 27, 27, 27, 27, 27, 27, 27, 27, 27, 28, 28, 28, 28, 28, 28, 28, 28, 28, 28, 29, 29, 29, 29, 29, 29, 29, 29, 29, 29, 29, 29, 30, 30, 30, 30, 30, 30, 30, 30, 30, 30, 30, 30, 30, 30, 31, 31, 31, 31, 31, 31, 31, 31, 31, 31, 31, 31, 31, 31, 31};

struct Params {
    const float* x; const float* norm_w; const float* w_in; const float* conv_w; const float* a_log; const float* dt_bias;
    const float* lb_param; const float* norm_a; const float* norm_b; const float* sinks; const float* rel_bias;
    const float* w_branch; const float* w_out; const float* final_norm;
    float* out; unsigned char* ws;
};

__device__ __forceinline__ unsigned f2bf(float f) { unsigned u = __builtin_bit_cast(unsigned, f); return (u + 0x7fffu + ((u >> 16) & 1u)) >> 16; }
__device__ __forceinline__ unsigned pk2(float lo, float hi) { const f32x2 v = {lo, hi}; const bf16x2v b = __builtin_convertvector(v, bf16x2v); return __builtin_bit_cast(unsigned, b); }
__device__ __forceinline__ float bf_lo(unsigned u) { return __builtin_bit_cast(float, u << 16); }
__device__ __forceinline__ float bf_hi(unsigned u) { return __builtin_bit_cast(float, u & 0xffff0000u); }
__device__ __forceinline__ float bf2f(bf16_t b) { return __builtin_bit_cast(float, (unsigned)b << 16); }
__device__ __forceinline__ int tid_() { int t = threadIdx.x; asm volatile("" : "+v"(t)); return t; }
__device__ __forceinline__ int bid_() { int b = blockIdx.x; asm volatile("" : "+s"(b)); return b; }
__device__ __forceinline__ float dot2u(unsigned k, unsigned q, float acc) { return __builtin_amdgcn_fdot2_f32_bf16(__builtin_bit_cast(bf16x2v, k), __builtin_bit_cast(bf16x2v, q), acc, false); }
__device__ __forceinline__ float sigmoidf_(float x) { return __builtin_amdgcn_rcpf(1.0f + __expf(-x)); }
__device__ __forceinline__ float siluf_(float x) { return x * __builtin_amdgcn_rcpf(1.0f + __expf(-x)); }
template <int CTRL> __device__ __forceinline__ float dpp_mov(float x) { return __builtin_bit_cast(float, __builtin_amdgcn_mov_dpp(__builtin_bit_cast(int, x), CTRL, 0xf, 0xf, true)); }
__device__ __forceinline__ float row16_sum(float x) { x += dpp_mov<0xB1>(x); x += dpp_mov<0x4E>(x); x += dpp_mov<0x141>(x); x += dpp_mov<0x128>(x); return x; }
__device__ __forceinline__ float xor16_sum(float x) { auto s = __builtin_amdgcn_permlane16_swap(__float_as_uint(x), __float_as_uint(x), false, false); return __uint_as_float(s[0]) + __uint_as_float(s[1]); }
__device__ __forceinline__ float xor32_sum(float x) { auto s = __builtin_amdgcn_permlane32_swap(__float_as_uint(x), __float_as_uint(x), false, false); return __uint_as_float(s[0]) + __uint_as_float(s[1]); }
__device__ __forceinline__ float wave_sum(float x) { return xor32_sum(xor16_sum(row16_sum(x))); }

__device__ __forceinline__ void transpose_item(const float* W, int ldsrc, int k0, int nsrc0, bf16_t* WT, int ldd, int ndst0, int kdst0, float* scr, int lane) {
    float tv[32];
#pragma unroll
    for (int i = 0; i < 32; ++i) { const int kk = 2 * i + (lane >> 5); tv[i] = W[(size_t)(k0 + kk) * ldsrc + nsrc0 + (lane & 31)]; }
#pragma unroll
    for (int i = 0; i < 32; ++i) { const int kk = 2 * i + (lane >> 5); scr[kk * 33 + (lane & 31)] = tv[i]; }
    __builtin_amdgcn_wave_barrier();
    asm volatile("s_waitcnt lgkmcnt(0)" ::: "memory");
    const int c = lane & 7;
#pragma unroll
    for (int j = 0; j < 4; ++j) { const int n = (lane >> 3) + 8 * j; const float* s = scr + (8 * c) * 33 + n;
        u32x4 o; o.x = pk2(s[0 * 33], s[1 * 33]); o.y = pk2(s[2 * 33], s[3 * 33]); o.z = pk2(s[4 * 33], s[5 * 33]); o.w = pk2(s[6 * 33], s[7 * 33]);
        *(u32x4*)(WT + (size_t)(ndst0 + n) * ldd + kdst0 + k0 + 8 * c) = o; }
    asm volatile("s_waitcnt lgkmcnt(0)" ::: "memory");
    __builtin_amdgcn_wave_barrier();
}
__device__ __forceinline__ void phase_convert_weights(const Params& p, int l, unsigned char* lds) {
    const int tid = tid_(), lane = tid & 63, wave = tid >> 6;
    float* scr = (float*)(lds) + wave * (64 * 33);
    bf16_t* WinT = (bf16_t*)(p.ws + WS_WIN); bf16_t* WbT = (bf16_t*)(p.ws + WS_WB); bf16_t* WoT = (bf16_t*)(p.ws + WS_WO);
    const float* win = p.w_in + (size_t)l * D * NORIG; const float* wbr = p.w_branch + (size_t)l * 3 * 512 * D; const float* wo = p.w_out + (size_t)l * D * D;
    constexpr int I_IN = (D / 64) * (NALL / 32), I_B = (512 / 64) * (D / 32), I_O = (D / 64) * (D / 32);
    constexpr int NITEMS = I_IN + 3 * I_B + I_O;
    const int gw = bid_() * 8 + wave, NGW = gridDim.x * 8;
    for (int it = gw; it < NITEMS; it += NGW) {
        int r = it;
        if (r < I_IN) { const int nb = r % (NALL / 32), kb = r / (NALL / 32); const int n0 = nb * 32; const int ns = n0 < 4096 ? n0 : n0 + 8;
            transpose_item(win, NORIG, kb * 64, ns, WinT, D, n0, 0, scr, lane); continue; }
        r -= I_IN;
        if (r < 3 * I_B) { const int br = r / I_B; const int q = r % I_B; const int nb = q % (D / 32), kb = q / (D / 32);
            transpose_item(wbr + (size_t)br * 512 * D, D, kb * 64, nb * 32, WbT, 1536, nb * 32, br * 512, scr, lane); continue; }
        r -= 3 * I_B;
        { const int nb = r % (D / 32), kb = r / (D / 32); transpose_item(wo, D, kb * 64, nb * 32, WoT, D, nb * 32, 0, scr, lane); }
    }
}

template <int MODE>
__device__ __forceinline__ void phase_rowpass(const Params& p, const float* xin, const float* nw, int l, unsigned char* lds) {
    const int tid = tid_(), lane = tid & 63, wave = tid >> 6;
    float* wsm = (float*)lds;
    if (MODE == 0) {
        const float* win = p.w_in + (size_t)l * D * NORIG;
        for (int i = tid; i < 8 * D; i += NTHREADS) { const int k = i >> 3, e = i & 7; wsm[e * D + k] = win[(size_t)k * NORIG + 4096 + e]; }
        __syncthreads();
    }
    bf16_t* hb = (bf16_t*)(p.ws + WS_HB); float* sm8 = (float*)(p.ws + WS_SM);
    const int gw = bid_() * 8 + wave, NGW = gridDim.x * 8;
    f32x4 wv[4];
#pragma unroll
    for (int j = 0; j < 4; ++j) wv[j] = *(const f32x4*)(nw + 256 * j + 4 * lane);
    f32x4 wr[8][4];
    if (MODE == 0) {
#pragma unroll
        for (int e = 0; e < 8; ++e)
#pragma unroll
            for (int j = 0; j < 4; ++j) wr[e][j] = *(const f32x4*)(wsm + e * D + 256 * j + 4 * lane);
    }
    f32x4 pa[4], pb[4];
#pragma unroll
    for (int j = 0; j < 4; ++j) { pa[j] = (gw < M) ? *(const f32x4*)(xin + (size_t)gw * D + 256 * j + 4 * lane) : (f32x4){0.f, 0.f, 0.f, 0.f};
        pb[j] = (gw + NGW < M) ? *(const f32x4*)(xin + (size_t)(gw + NGW) * D + 256 * j + 4 * lane) : (f32x4){0.f, 0.f, 0.f, 0.f}; }
    for (int m = gw; m < M; m += NGW) {
        f32x4 v[4]; float s = 0.f;
#pragma unroll
        for (int j = 0; j < 4; ++j) { v[j] = pa[j]; pa[j] = pb[j]; if (m + 2 * NGW < M) pb[j] = *(const f32x4*)(xin + (size_t)(m + 2 * NGW) * D + 256 * j + 4 * lane);
            s += (v[j].x * v[j].x + v[j].y * v[j].y) + (v[j].z * v[j].z + v[j].w * v[j].w); }
        const float rstd = __builtin_amdgcn_rsqf(wave_sum(s) * (1.0f / D) + EPS);
#pragma unroll
        for (int j = 0; j < 4; ++j) v[j] = v[j] * rstd * wv[j];
        if (MODE == 1) {
            float* orow = p.out + (size_t)m * D;
#pragma unroll
            for (int j = 0; j < 4; ++j) *(f32x4*)(orow + 256 * j + 4 * lane) = v[j];
        } else {
            bf16_t* hr = hb + (size_t)m * D;
#pragma unroll
            for (int j = 0; j < 4; ++j) { u32x2 o; o.x = pk2(v[j].x, v[j].y); o.y = pk2(v[j].z, v[j].w); *(u32x2*)(hr + 256 * j + 4 * lane) = o; }
            float a[8];
#pragma unroll
            for (int e = 0; e < 8; ++e) { float t = 0.f;
#pragma unroll
                for (int j = 0; j < 4; ++j) t += (v[j].x * wr[e][j].x + v[j].y * wr[e][j].y) + (v[j].z * wr[e][j].z + v[j].w * wr[e][j].w);
                a[e] = t; }
            const bool b0 = lane & 1, b1 = lane & 2;
            const float s01 = b0 ? a[1] : a[0], o01 = b0 ? a[0] : a[1], s23 = b0 ? a[3] : a[2], o23 = b0 ? a[2] : a[3];
            const float s45 = b0 ? a[5] : a[4], o45 = b0 ? a[4] : a[5], s67 = b0 ? a[7] : a[6], o67 = b0 ? a[6] : a[7];
            const float r01 = s01 + dpp_mov<0xB1>(o01), r23 = s23 + dpp_mov<0xB1>(o23), r45 = s45 + dpp_mov<0xB1>(o45), r67 = s67 + dpp_mov<0xB1>(o67);
            const float t0 = b1 ? r23 : r01, u0 = b1 ? r01 : r23, t1 = b1 ? r67 : r45, u1 = b1 ? r45 : r67;
            float q0 = t0 + dpp_mov<0x4E>(u0);
            float q1 = t1 + dpp_mov<0x4E>(u1);
            q0 += dpp_mov<0x124>(q0); q0 += dpp_mov<0x128>(q0); q1 += dpp_mov<0x124>(q1); q1 += dpp_mov<0x128>(q1);
            q0 = xor32_sum(xor16_sum(q0)); q1 = xor32_sum(xor16_sum(q1));
            if (lane < 4) { sm8[(size_t)m * 8 + lane] = q0; sm8[(size_t)m * 8 + 4 + lane] = q1; }
        }
    }
}

namespace pg8 {
#define PG8_LAS __attribute__((address_space(3)))
constexpr int BM = 256, BK = 64, HALF = 128, HTB = HALF * BK * 2  , STAGE_BYTES = 8 * HTB, NXCD = 8, WGM = 8;

__host__ __device__ __forceinline__ int lds_byte(int r, int c) { const int st = (r >> 4) * 2 + (c >> 5), rr = r & 15, cc = c & 31, ob = rr * 64 + cc * 2; return st * 1024 + (ob ^ (((ob >> 9) & 1) << 5)); }
__host__ __device__ __forceinline__ void stage_rc(int b, int& R, int& C) { const int st = b / 1024, sb = b % 1024, swz = sb ^ (((sb >> 9) & 1) << 5); R = (st >> 1) * 16 + swz / 64; C = (st & 1) * 32 + (swz % 64) / 2; }
__host__ __device__ __forceinline__ int perm32(int rho) { const int n = rho >> 4, i = rho & 15; return 8 * (i >> 2) + 4 * n + (i & 3); }

struct Unit { int pm, pn, kb; };
struct Gemm { const bf16_t* A; const bf16_t* Bt; int lda, ldb, K; };
struct SegNone { static __device__ __forceinline__ int a(int) { return 0; } static __device__ __forceinline__ int b(int) { return 0; } };
struct StaticOrder {
    int nM, nN, nwg, G, c, nseg, skip;
    __device__ void init(int M_, int N_, int G_, int c_, int nseg_, int skip_ = -1) { nM = M_ / BM; nN = N_ / BM - (skip_ >= 0 ? 1 : 0); nwg = nM * nN; G = G_; c = c_; nseg = nseg_; skip = skip_; }
    __device__ bool next(int i, Unit& u) const {
        const int it = i / nseg; u.kb = i - it * nseg;
        const long L = (long)it * G + c; if (L >= nwg) return false;
        int wgid = (int)L; { const int q = nwg / NXCD, r = nwg % NXCD, xcd = wgid % NXCD, off = wgid / NXCD; wgid = (xcd < r ? xcd * (q + 1) : r * (q + 1) + (xcd - r) * q) + off; }
        const int nig = WGM * nN, gid = wgid / nig, fm = gid * WGM, gsz = (nM - fm) < WGM ? (nM - fm) : WGM;
        u.pm = fm + ((wgid % nig) % gsz); u.pn = (wgid % nig) / gsz; if (skip >= 0 && u.pn >= skip) ++u.pn; return true;
    }
};
struct OneTile { int pm, pn; bool on;
    __device__ bool next(int i, Unit& u) const { if (i != 0 || !on) return false; u.pm = pm; u.pn = pn; u.kb = 0; return true; } };
__device__ __forceinline__ unsigned cvt_pk_bf16(float lo, float hi) { unsigned r; asm volatile("v_cvt_pk_bf16_f32 %0, %1, %2" : "=v"(r) : "v"(lo), "v"(hi)); return r; }
template <class Epi, class Sched, class Seg, bool ALIGN_EPI = false, bool SP2 = false>
__device__ __forceinline__ void gemm_phase(PG8_LAS unsigned char* lds, const Gemm g, const Sched& S, const Epi& E) {
    const int tid = tid_(), wid = __builtin_amdgcn_readfirstlane(tid >> 6), lane = tid & 63, wr = wid >> 2, wc = wid & 3, fr = lane & 15, fq = lane >> 4;
    const int K = g.K, nt = K / BK;
    unsigned voffA[2], voffB[2];
#pragma unroll
    for (int i = 0; i < 2; ++i) { int R, C; stage_rc(tid * 16 + i * 8192, R, C); const int Rb = Epi::PERM ? ((R & ~31) + perm32(R & 31)) : R;
        voffA[i] = (unsigned)(R * g.lda + C) * 2u; voffB[i] = (unsigned)(Rb * g.ldb + C) * 2u; }
    const size_t kstep = (size_t)(BK * 2);
    const size_t hstepA = (size_t)HALF * g.lda * 2, hstepB = (size_t)HALF * g.ldb * 2;
    const size_t tstepA = 2 * hstepA, tstepB = 2 * hstepB;
    const unsigned ldsw = (unsigned)wid * 1024u;
    const int aoff = lds_byte(wr * 64 + fr, fq * 8), boff = lds_byte(wc * 32 + fr, fq * 8);
#define PG8_SA(b, h) (((b) * 2 + (h)) * HTB)
#define PG8_SB(b, h) ((4 + (b) * 2 + (h)) * HTB)
#define PG8_STAGE(bufoff, gbase, voff) do { _Pragma("unroll") for (int _i = 0; _i < 2; ++_i) \
        __builtin_amdgcn_global_load_lds((const unsigned*)((const char*)(gbase) + (voff)[_i]), (PG8_LAS unsigned*)(lds + (bufoff) + ldsw + _i * 8192), 16, 0, 0); } while (0)
#define PG8_LDA(dst, b, h) do { _Pragma("unroll") for (int m = 0; m < 4; ++m) _Pragma("unroll") for (int k = 0; k < 2; ++k) dst[m][k] = *(const PG8_LAS bf16x8*)(lds + PG8_SA(b, h) + aoff + m * 2048 + k * 1024); } while (0)
#define PG8_LDB(dst, b, h) do { _Pragma("unroll") for (int n = 0; n < 2; ++n) _Pragma("unroll") for (int k = 0; k < 2; ++k) dst[n][k] = *(const PG8_LAS bf16x8*)(lds + PG8_SB(b, h) + boff + n * 2048 + k * 1024); } while (0)
#define PG8_MMA(ai, bj, At, Bt) do { __builtin_amdgcn_s_setprio(1); _Pragma("unroll") for (int m = 0; m < 4; ++m) _Pragma("unroll") for (int n = 0; n < 2; ++n) _Pragma("unroll") for (int k = 0; k < 2; ++k) \
        acc[ai][bj][m][n] = __builtin_amdgcn_mfma_f32_16x16x32_bf16(Bt[n][k], At[m][k], acc[ai][bj][m][n], 0, 0, 0); __builtin_amdgcn_s_setprio(0); } while (0)
#define PG8_WAIT_V(n) asm volatile("s_waitcnt vmcnt(" #n ")" ::: "memory")
#define PG8_WAIT_L(n) asm volatile("s_waitcnt lgkmcnt(" #n ")" ::: "memory")
#define PG8_BAR __builtin_amdgcn_s_barrier()
#define PG8_SCHED __builtin_amdgcn_sched_barrier(0)
    Unit cur, nxt; int ui = 0;
    if (!S.next(0, cur)) return;
    f32x4 acc[2][2][4][2];
#pragma unroll
    for (int a = 0; a < 2; ++a)
#pragma unroll
        for (int b = 0; b < 2; ++b)
#pragma unroll
            for (int m = 0; m < 4; ++m)
#pragma unroll
                for (int n = 0; n < 2; ++n) acc[a][b][m][n] = (f32x4){0.f, 0.f, 0.f, 0.f};
    bf16x8 At[4][2], B0[2][2], B1[2][2];
    const char* cA = (const char*)g.A + (size_t)cur.pm * tstepA + (size_t)Seg::a(cur.kb) * 2; const char* cB = (const char*)g.Bt + (size_t)cur.pn * tstepB + (size_t)Seg::b(cur.kb) * 2;

    if constexpr (SP2) {
        PG8_STAGE(PG8_SB(0, 0), cB, voffB); PG8_STAGE(PG8_SB(0, 1), cB + hstepB, voffB); PG8_STAGE(PG8_SA(0, 0), cA, voffA); PG8_STAGE(PG8_SA(0, 1), cA + hstepA, voffA);
        if (wr == 1) PG8_BAR;
        PG8_WAIT_V(2); PG8_BAR;
        PG8_STAGE(PG8_SB(1, 0), cB + kstep, voffB); PG8_STAGE(PG8_SA(1, 0), cA + kstep, voffA); PG8_STAGE(PG8_SB(1, 1), cB + hstepB + kstep, voffB);
        PG8_WAIT_V(6); PG8_BAR;
    } else {
        PG8_STAGE(PG8_SB(0, 0), cB, voffB); PG8_STAGE(PG8_SA(0, 0), cA, voffA); PG8_STAGE(PG8_SB(0, 1), cB + hstepB, voffB); PG8_STAGE(PG8_SA(0, 1), cA + hstepA, voffA);
        if (wr == 1) PG8_BAR;
        PG8_WAIT_V(4); PG8_BAR;
        PG8_STAGE(PG8_SB(1, 0), cB + kstep, voffB); PG8_STAGE(PG8_SA(1, 0), cA + kstep, voffA); PG8_STAGE(PG8_SB(1, 1), cB + hstepB + kstep, voffB);
        PG8_WAIT_V(6); PG8_BAR;
    }
    for (;;) {
        const bool has_next = S.next(ui + 1, nxt);
        const char* nA = has_next ? (const char*)g.A + (size_t)nxt.pm * tstepA + (size_t)Seg::a(nxt.kb) * 2 : cA; const char* nB = has_next ? (const char*)g.Bt + (size_t)nxt.pn * tstepB + (size_t)Seg::b(nxt.kb) * 2 : cB;
        for (int t = 0; t < nt; t += 2) {
            const bool last = (t == nt - 2);
            const char* a1 = cA + (size_t)(t + 1) * kstep;
            const char* a2 = last ? nA : cA + (size_t)(t + 2) * kstep; const char* b2 = last ? nB : cB + (size_t)(t + 2) * kstep;
            const char* a3 = a2 + kstep; const char* b3 = b2 + kstep;

            if constexpr (SP2) {
            PG8_LDB(B0, 0, 0); PG8_LDB(B1, 0, 1); PG8_SCHED; PG8_LDA(At, 0, 0); PG8_STAGE(PG8_SA(1, 1), a1 + hstepA, voffA);
            PG8_WAIT_V(8); PG8_WAIT_L(0); PG8_BAR; PG8_MMA(0, 0, At, B0); PG8_MMA(0, 1, At, B1); PG8_BAR; PG8_SCHED;
            PG8_LDA(At, 0, 1); PG8_STAGE(PG8_SB(0, 0), b2, voffB); PG8_STAGE(PG8_SB(0, 1), b2 + hstepB, voffB); PG8_STAGE(PG8_SA(0, 0), a2, voffA);
            PG8_WAIT_V(8); PG8_WAIT_L(0); PG8_BAR; PG8_MMA(1, 0, At, B0); PG8_MMA(1, 1, At, B1); PG8_BAR; PG8_SCHED;
            PG8_LDB(B0, 1, 0); PG8_LDB(B1, 1, 1); PG8_SCHED; PG8_LDA(At, 1, 0); PG8_STAGE(PG8_SA(0, 1), a2 + hstepA, voffA);
            PG8_WAIT_V(8); PG8_WAIT_L(0); PG8_BAR; PG8_MMA(0, 0, At, B0); PG8_MMA(0, 1, At, B1); PG8_BAR; PG8_SCHED;
            PG8_LDA(At, 1, 1); PG8_STAGE(PG8_SB(1, 0), b3, voffB); PG8_STAGE(PG8_SB(1, 1), b3 + hstepB, voffB); PG8_STAGE(PG8_SA(1, 0), a3, voffA);
            PG8_WAIT_V(8); PG8_WAIT_L(0); PG8_BAR; PG8_MMA(1, 0, At, B0); PG8_MMA(1, 1, At, B1); PG8_BAR; PG8_SCHED;
            } else {
            PG8_LDB(B0, 0, 0); PG8_SCHED; PG8_LDA(At, 0, 0); PG8_STAGE(PG8_SA(1, 1), a1 + hstepA, voffA);
            PG8_WAIT_L(8); PG8_BAR; PG8_WAIT_L(0); PG8_MMA(0, 0, At, B0); PG8_BAR; PG8_SCHED;
            PG8_LDB(B1, 0, 1); PG8_STAGE(PG8_SB(0, 0), b2, voffB);
            PG8_BAR; PG8_WAIT_L(0); PG8_MMA(0, 1, At, B1); PG8_BAR;
            PG8_LDA(At, 0, 1); PG8_STAGE(PG8_SA(0, 0), a2, voffA);
            PG8_BAR; PG8_WAIT_L(0); PG8_MMA(1, 0, At, B0); PG8_BAR; PG8_SCHED;
            PG8_STAGE(PG8_SB(0, 1), b2 + hstepB, voffB);
            PG8_WAIT_V(6); PG8_BAR; PG8_MMA(1, 1, At, B1); PG8_BAR;
            PG8_LDB(B0, 1, 0); PG8_SCHED; PG8_LDA(At, 1, 0); PG8_STAGE(PG8_SA(0, 1), a2 + hstepA, voffA);
            PG8_WAIT_L(8); PG8_BAR; PG8_WAIT_L(0); PG8_MMA(0, 0, At, B0); PG8_BAR; PG8_SCHED;
            PG8_LDB(B1, 1, 1); PG8_STAGE(PG8_SB(1, 0), b3, voffB);
            PG8_BAR; PG8_WAIT_L(0); PG8_MMA(0, 1, At, B1); PG8_BAR;
            PG8_LDA(At, 1, 1); PG8_STAGE(PG8_SA(1, 0), a3, voffA);
            PG8_BAR; PG8_WAIT_L(0); PG8_MMA(1, 0, At, B0); PG8_BAR; PG8_SCHED;
            PG8_STAGE(PG8_SB(1, 1), b3 + hstepB, voffB);
            PG8_WAIT_V(6); PG8_BAR; PG8_MMA(1, 1, At, B1); PG8_BAR;
            }
        }
        if constexpr (ALIGN_EPI) { if (wr == 0) PG8_BAR; }
        const bool keep_acc = E(acc, cur, wr, wc, fr, fq);
        if (!has_next) break;
        if (!keep_acc) {
#pragma unroll
        for (int a = 0; a < 2; ++a)
#pragma unroll
            for (int b = 0; b < 2; ++b)
#pragma unroll
                for (int m = 0; m < 4; ++m)
#pragma unroll
                    for (int n = 0; n < 2; ++n) acc[a][b][m][n] = (f32x4){0.f, 0.f, 0.f, 0.f};
        }
        cur = nxt; cA = nA; cB = nB; ++ui;
        if constexpr (ALIGN_EPI) { if (wr == 1) PG8_BAR; }
    }
    PG8_WAIT_V(0);
    if constexpr (!ALIGN_EPI) { if (wr == 0) PG8_BAR; }
    PG8_BAR;
#undef PG8_SA
#undef PG8_SB
#undef PG8_STAGE
#undef PG8_LDA
#undef PG8_LDB
#undef PG8_MMA
#undef PG8_WAIT_V
#undef PG8_WAIT_L
#undef PG8_BAR
#undef PG8_SCHED
}
}

__device__ __forceinline__ bf16_t* gate_ptr(unsigned char* ws, int br, size_t row, int d) {
    if (br == 0) return (bf16_t*)(ws + WS_P) + row * LDP + d;
    if (br == 1) return (bf16_t*)(ws + WS_P) + row * LDP + 2048 + d;
    return (bf16_t*)(ws + WS_AF) + row * 1024 + d;
}
typedef f32x4 acc_t[2][2][4][2];
struct EpiInproj {
    static constexpr bool PERM = true;
    unsigned char* ws; const float* lb_param; int l;
    __device__ __forceinline__ bool operator()(acc_t& acc, const pg8::Unit& u, int wr, int wc, int fr, int fq) const {
        bf16_t* P = (bf16_t*)(ws + WS_P); float* AF = (float*)(ws + WS_AF);
        const int row0 = u.pm * 256 + wr * 64 + fr, col0 = u.pn * 256 + wc * 32 + 8 * fq;
        const int pn = u.pn;
        if (pn == 2 || pn == 3) {
            float lb[2][8];
#pragma unroll
            for (int bj = 0; bj < 2; ++bj)
#pragma unroll
                for (int e = 0; e < 8; ++e) { float v = 0.f; if (l == 1) { const int k = col0 + bj * 128 - 512 + e; v = 1.0f / (1.0f + __expf(lb_param[k] - lb_param[512 + k])); } lb[bj][e] = v; }
#pragma unroll
            for (int ai = 0; ai < 2; ++ai)
#pragma unroll
                for (int m = 0; m < 4; ++m) { float* rowp = AF + (size_t)(row0 + ai * 128 + m * 16) * 512 + (col0 - 512);
#pragma unroll
                    for (int bj = 0; bj < 2; ++bj) { const f32x4 v0 = acc[ai][bj][m][0], v1 = acc[ai][bj][m][1]; f32x4 o0, o1;
#pragma unroll
                        for (int e = 0; e < 4; ++e) { o0[e] = lb[bj][e] + (1.0f - lb[bj][e]) * sigmoidf_(v0[e]); o1[e] = lb[bj][4 + e] + (1.0f - lb[bj][4 + e]) * sigmoidf_(v1[e]); }
                        *(f32x4*)(rowp + bj * 128) = o0; *(f32x4*)(rowp + bj * 128 + 4) = o1; } }
        } else {
            const int act = pn < 2 ? 1 : ((pn == 16 || pn == 17) ? 2 : 0);
#pragma unroll
            for (int ai = 0; ai < 2; ++ai)
#pragma unroll
                for (int m = 0; m < 4; ++m) { bf16_t* rowp = P + (size_t)(row0 + ai * 128 + m * 16) * LDP + col0;
#pragma unroll
                    for (int bj = 0; bj < 2; ++bj) { f32x4 v0 = acc[ai][bj][m][0], v1 = acc[ai][bj][m][1];
                        if (act == 1) {
#pragma unroll
                            for (int e = 0; e < 4; ++e) { v0[e] = siluf_(v0[e]); v1[e] = siluf_(v1[e]); } }
                        else if (act == 2) { v0 = v0 * 0.125f; v1 = v1 * 0.125f; }
                        u32x4 w; w.x = pk2(v0[0], v0[1]); w.y = pk2(v0[2], v0[3]); w.z = pk2(v1[0], v1[1]); w.w = pk2(v1[2], v1[3]);
                        *(u32x4*)(rowp + bj * 128) = w;
                        if (pn >= 8 && pn < 14) { const int row = row0 + ai * 128 + m * 16, tc = row & 63;
                            if (tc >= 61) *(u32x4*)((bf16_t*)(ws + WS_HALO) + ((size_t)(row >> 6) * 3 + (tc - 61)) * 1536 + (col0 + bj * 128 - PC_BQKV)) = w; } } }
        }
        return false;
    }
};
struct EpiGates {
    static constexpr bool PERM = true;
    unsigned char* ws;
    __device__ __forceinline__ bool operator()(acc_t& acc, const pg8::Unit& u, int wr, int wc, int fr, int fq) const {
        const int row0 = u.pm * 256 + wr * 64 + fr, br = u.pn >> 2, d0 = (u.pn & 3) * 256 + wc * 32 + 8 * fq;
#pragma unroll
        for (int ai = 0; ai < 2; ++ai)
#pragma unroll
            for (int m = 0; m < 4; ++m) { bf16_t* rowp = gate_ptr(ws, br, (size_t)(row0 + ai * 128 + m * 16), d0);
#pragma unroll
                for (int bj = 0; bj < 2; ++bj) { const f32x4 v0 = acc[ai][bj][m][0], v1 = acc[ai][bj][m][1];
                    u32x4 w; w.x = pk2(sigmoidf_(v0[0]), sigmoidf_(v0[1])); w.y = pk2(sigmoidf_(v0[2]), sigmoidf_(v0[3])); w.z = pk2(sigmoidf_(v1[0]), sigmoidf_(v1[1])); w.w = pk2(sigmoidf_(v1[2]), sigmoidf_(v1[3]));
                    *(u32x4*)(rowp + bj * 128) = w; } }
        return false;
    }
};
struct EpiLift {
    static constexpr bool PERM = true;
    unsigned char* ws;
    __device__ __forceinline__ bool operator()(acc_t& acc, const pg8::Unit& u, int wr, int wc, int fr, int fq) const {
        bf16_t* MG = (bf16_t*)(ws + WS_HB);
        const int row0 = u.pm * 256 + wr * 64 + fr, d0 = u.pn * 256 + wc * 32 + 8 * fq, s = u.kb;
        u32x4 ga[2][2], gb[2][2];
        auto gload = [&](int g, int slot) { const size_t row = (size_t)(row0 + (g >> 2) * 128 + (g & 3) * 16);
#pragma unroll
            for (int bj = 0; bj < 2; ++bj) { ga[slot][bj] = *(const u32x4*)gate_ptr(ws, s, row, d0 + bj * 128); if (s < 2) gb[slot][bj] = *(const u32x4*)gate_ptr(ws, s + 1, row, d0 + bj * 128); } };
        gload(0, 0);
#pragma unroll
        for (int g = 0; g < 8; ++g) { const int ai = g >> 2, m = g & 3, slot = g & 1; const size_t row = (size_t)(row0 + ai * 128 + m * 16);
            if (g + 1 < 8) gload(g + 1, slot ^ 1);
#pragma unroll
            for (int bj = 0; bj < 2; ++bj) { const u32x4 a4 = ga[slot][bj];
                f32x4 fa = (f32x4){bf_lo(a4.x), bf_hi(a4.x), bf_lo(a4.y), bf_hi(a4.y)}, fb = (f32x4){bf_lo(a4.z), bf_hi(a4.z), bf_lo(a4.w), bf_hi(a4.w)};
                if (s < 2) { const u32x4 b4 = gb[slot][bj];
                    fa[0] *= __builtin_amdgcn_rcpf(fmaxf(bf_lo(b4.x), 1e-30f)); fa[1] *= __builtin_amdgcn_rcpf(fmaxf(bf_hi(b4.x), 1e-30f));
                    fa[2] *= __builtin_amdgcn_rcpf(fmaxf(bf_lo(b4.y), 1e-30f)); fa[3] *= __builtin_amdgcn_rcpf(fmaxf(bf_hi(b4.y), 1e-30f));
                    fb[0] *= __builtin_amdgcn_rcpf(fmaxf(bf_lo(b4.z), 1e-30f)); fb[1] *= __builtin_amdgcn_rcpf(fmaxf(bf_hi(b4.z), 1e-30f));
                    fb[2] *= __builtin_amdgcn_rcpf(fmaxf(bf_lo(b4.w), 1e-30f)); fb[3] *= __builtin_amdgcn_rcpf(fmaxf(bf_hi(b4.w), 1e-30f)); }
                const f32x4 v0 = acc[ai][bj][m][0] * fa, v1 = acc[ai][bj][m][1] * fb;
                acc[ai][bj][m][0] = v0; acc[ai][bj][m][1] = v1;
                if (s == 2) { u32x4 w; w.x = pk2(v0[0], v0[1]); w.y = pk2(v0[2], v0[3]); w.z = pk2(v1[0], v1[1]); w.w = pk2(v1[2], v1[3]);
                    *(u32x4*)(MG + row * D + d0 + bj * 128) = w; }
            }
        }
        return s < 2;
    }
};
struct EpiOut {
    static constexpr bool PERM = false;
    const float* xin; float* out;
    __device__ __forceinline__ bool operator()(acc_t& acc, const pg8::Unit& u, int wr, int wc, int fr, int fq) const {
        const int row0 = u.pm * 256 + wr * 64 + fr, col0 = u.pn * 256 + wc * 32 + 4 * fq;
        f32x4 xv[2][4];
        auto gload = [&](int g, int slot) { const size_t off = (size_t)(row0 + (g >> 2) * 128 + (g & 3) * 16) * D + col0;
#pragma unroll
            for (int q = 0; q < 4; ++q) xv[slot][q] = *(const f32x4*)(xin + off + (q >> 1) * 128 + (q & 1) * 16); };
        gload(0, 0);
#pragma unroll
        for (int g = 0; g < 8; ++g) { const int ai = g >> 2, m = g & 3, slot = g & 1; const size_t off = (size_t)(row0 + ai * 128 + m * 16) * D + col0;
            if (g + 1 < 8) gload(g + 1, slot ^ 1);
#pragma unroll
            for (int q = 0; q < 4; ++q) *(f32x4*)(out + off + (q >> 1) * 128 + (q & 1) * 16) = xv[slot][q] + acc[ai][q >> 1][m][q & 1]; }
        return false;
    }
};
constexpr int INPROJ_LATE_TILE = 7;
struct SegLift { static __device__ __forceinline__ int a(int s) { return PC_AG + (s >= 1 ? PC_BZ - PC_AG : 0) + (s >= 2 ? PC_CG - PC_BZ : 0); } static __device__ __forceinline__ int b(int s) { return s * 512; } };
__device__ __forceinline__ void phase_inproj(const Params& p, int l, unsigned char* lds) {
    pg8::Gemm g{(const bf16_t*)(p.ws + WS_HB), (const bf16_t*)(p.ws + WS_WIN), D, D, D};
    pg8::StaticOrder S; S.init(M, NMIX, (int)gridDim.x, bid_(), 1, INPROJ_LATE_TILE);
    EpiInproj E{p.ws, p.lb_param, l};
    pg8::gemm_phase<EpiInproj, pg8::StaticOrder, pg8::SegNone, true, true>((PG8_LAS unsigned char*)lds, g, S, E);
}
__device__ __forceinline__ void inproj_late_tile(const Params& p, int l, int pm, unsigned char* lds) {
    pg8::Gemm g{(const bf16_t*)(p.ws + WS_HB), (const bf16_t*)(p.ws + WS_WIN), D, D, D};
    pg8::OneTile S{pm, INPROJ_LATE_TILE, true};
    EpiInproj E{p.ws, p.lb_param, l};
    pg8::gemm_phase<EpiInproj, pg8::OneTile, pg8::SegNone, false, true>((PG8_LAS unsigned char*)lds, g, S, E);
}
__device__ __forceinline__ void phase_gates(const Params& p, unsigned char* lds) {
    pg8::Gemm g{(const bf16_t*)(p.ws + WS_HB), (const bf16_t*)(p.ws + WS_WIN) + (size_t)NMIX * D, D, D, D};
    pg8::StaticOrder S; S.init(M, NGATE, (int)gridDim.x, bid_(), 1);
    EpiGates E{p.ws};
    pg8::gemm_phase<EpiGates, pg8::StaticOrder, pg8::SegNone, true, true>((PG8_LAS unsigned char*)lds, g, S, E);
}
__device__ __forceinline__ void phase_lift(const Params& p, unsigned char* lds) {
    pg8::Gemm g{(const bf16_t*)(p.ws + WS_P), (const bf16_t*)(p.ws + WS_WB), LDP, 1536, 512};
    pg8::StaticOrder S; S.init(M, D, (int)gridDim.x, bid_(), 3);
    EpiLift E{p.ws};
    pg8::gemm_phase<EpiLift, pg8::StaticOrder, SegLift, false, true>((PG8_LAS unsigned char*)lds, g, S, E);
}
__device__ __forceinline__ void phase_outproj(const Params& p, const float* xin, unsigned char* lds) {
    pg8::Gemm g{(const bf16_t*)(p.ws + WS_HB), (const bf16_t*)(p.ws + WS_WO), D, D, D};
    pg8::StaticOrder S; S.init(M, D, (int)gridDim.x, bid_(), 1);
    EpiOut E{xin, p.out};
    pg8::gemm_phase<EpiOut, pg8::StaticOrder, pg8::SegNone, false, true>((PG8_LAS unsigned char*)lds, g, S, E);
}

#define LDS_BARRIER() do { asm volatile("s_waitcnt lgkmcnt(0)" ::: "memory"); __builtin_amdgcn_s_barrier(); asm volatile("" ::: "memory"); } while (0)
template <int KS> __device__ __forceinline__ f32x4 mma_tile(const bf16_t* a, int lda, const bf16_t* b, int ldb, f32x4 acc, int fr, int fq) {
#pragma unroll
    for (int ks = 0; ks < KS; ++ks) {
        const bf16x8 af = *(const bf16x8*)(a + fr * lda + ks * 32 + fq * 8);
        const bf16x8 bv = *(const bf16x8*)(b + fr * ldb + ks * 32 + fq * 8);
        acc = __builtin_amdgcn_mfma_f32_16x16x32_bf16(bv, af, acc, 0, 0, 0);
    }
    return acc;
}
__device__ __forceinline__ u32x2 pack4(f32x4 v) { u32x2 o; o.x = pk2(v[0], v[1]); o.y = pk2(v[2], v[3]); return o; }
__device__ __forceinline__ f32x4 unpack4(u32x2 u) { return (f32x4){bf_lo(u.x), bf_hi(u.x), bf_lo(u.y), bf_hi(u.y)}; }

struct BpreRegs { u32x4 raw[6]; u32x4 halo; float bl, al; };
__device__ __forceinline__ void bpre_load(const Params& p, int unit, BpreRegs& R) {
    const int tid = tid_(); const int h = unit & 3, c = (unit >> 2) & 63, b = unit >> 8;
    const bf16_t* P = (const bf16_t*)(p.ws + WS_P); const float* sm8 = (const float*)(p.ws + WS_SM); const bf16_t* HALO = (const bf16_t*)(p.ws + WS_HALO);
    const size_t row0 = (size_t)b * SEQ + (size_t)c * 64;
#pragma unroll
    for (int i2 = 0; i2 < 6; ++i2) { const int ck = tid + 512 * i2, row = ck / 48, c8 = ck % 48;
        const int chg = c8 < 16 ? h * 128 + c8 * 8 : (c8 < 32 ? 512 + h * 128 + (c8 - 16) * 8 : 1024 + h * 128 + (c8 - 32) * 8);
        R.raw[i2] = *(const u32x4*)(P + (row0 + row) * LDP + PC_BQKV + chg); }
    R.halo = (u32x4){0u, 0u, 0u, 0u};
    if (tid < 144 && c > 0) { const int row = tid / 48, c8 = tid % 48;
        const int chg = c8 < 16 ? h * 128 + c8 * 8 : (c8 < 32 ? 512 + h * 128 + (c8 - 16) * 8 : 1024 + h * 128 + (c8 - 32) * 8);
        R.halo = *(const u32x4*)(HALO + ((size_t)(b * 64 + c - 1) * 3 + row) * 1536 + chg); }
    R.bl = 0.f; R.al = 0.f;
    if (tid < 64) { R.bl = sm8[(row0 + tid) * 8 + h]; R.al = sm8[(row0 + tid) * 8 + 4 + h]; }
}
__device__ __forceinline__ void bpre_unit(const Params& p, int l, int unit, int next_unit, BpreRegs& R, unsigned char* lds, int dry) {
    const int tid = tid_(), lane = tid & 63, wave = tid >> 6, fr = lane & 15, fq = lane >> 4;
    const int h = unit & 3, c = (unit >> 2) & 63, b = unit >> 8;
    bf16_t* P = (bf16_t*)(p.ws + WS_P); const float* sm8 = (const float*)(p.ws + WS_SM); float* GC = (float*)(p.ws + WS_GC);
    const bf16_t* HALO = (const bf16_t*)(p.ws + WS_HALO);
    const float* cw = p.conv_w + (size_t)l * 4 * 1536;
    constexpr int RP = 392;
    bf16_t* RAW = (bf16_t*)lds;
    bf16_t* KT2 = (bf16_t*)lds;
    float* TF = (float*)(lds + 18432);
    float* MS = (float*)(lds + 26880);
    bf16_t* KN = (bf16_t*)(lds + 52528);
    bf16_t* KB = (bf16_t*)(lds + 69936);
    bf16_t* XT = (bf16_t*)(lds + 87344);
    float* AM = (float*)(lds + 124208);
    bf16_t* QNS = (bf16_t*)(lds + 124208);
    bf16_t* TM = (bf16_t*)(lds + 140592);
    float* sgc = (float*)(lds + 149808); float* sbeta = sgc + 64; float* sg = sgc + 128;
    bf16_t* QKG = (bf16_t*)(p.ws + WS_QK) + (size_t)unit * 2560;
    const size_t row0 = (size_t)b * SEQ + (size_t)c * 64;
    const float a_coef = -__expf(p.a_log[l * 4 + h]); const float dtb = p.dt_bias[l * 4 + h];
    LDS_BARRIER();
#pragma unroll
    for (int i2 = 0; i2 < 6; ++i2) { const int ck = tid + 512 * i2, row = ck / 48, c8 = ck % 48; *(u32x4*)(RAW + (3 + row) * RP + c8 * 8) = R.raw[i2]; }
    if (tid < 144) { const int row = tid / 48, c8 = tid % 48; *(u32x4*)(RAW + row * RP + c8 * 8) = R.halo; }
    if (tid < 64) { const float xx = R.al + dtb; const float sp = xx > 20.f ? xx : log1pf(__expf(xx));
        sg[tid] = a_coef * sp; sbeta[tid] = sigmoidf_(R.bl); }
    LDS_BARRIER();
    if (tid < 64) { float s0 = 0.f, s1 = 0.f;
#pragma unroll
        for (int j = 0; j < 64; j += 2) { s0 += (j <= tid) ? sg[j] : 0.f; s1 += (j + 1 <= tid) ? sg[j + 1] : 0.f; }
        const float s = s0 + s1; sgc[tid] = s; if (!dry) GC[(row0 + tid) * 4 + h] = s; }
    LDS_BARRIER();
    if (!(dry & 4)) {
    { const int sub = tid & 15, which = (tid >> 4) & 1, tb = tid >> 5; const int ch0 = which * 128 + sub * 8;
      float wq[4][8];
#pragma unroll
      for (int j = 0; j < 4; ++j)
#pragma unroll
          for (int e = 0; e < 8; ++e) wq[j][e] = cw[j * 1536 + which * 512 + h * 128 + sub * 8 + e];
#pragma unroll 1
      for (int jt = 0; jt < 4; ++jt) { const int t = tb + 16 * jt;
          float x[8] = {0.f, 0.f, 0.f, 0.f, 0.f, 0.f, 0.f, 0.f};
#pragma unroll
          for (int j = 0; j < 4; ++j) { const u32x4 r = *(const u32x4*)(RAW + (t + j) * RP + ch0);
              x[0] += bf_lo(r.x) * wq[j][0]; x[1] += bf_hi(r.x) * wq[j][1]; x[2] += bf_lo(r.y) * wq[j][2]; x[3] += bf_hi(r.y) * wq[j][3];
              x[4] += bf_lo(r.z) * wq[j][4]; x[5] += bf_hi(r.z) * wq[j][5]; x[6] += bf_lo(r.w) * wq[j][6]; x[7] += bf_hi(r.w) * wq[j][7]; }
          float ss = 0.f;
#pragma unroll
          for (int e = 0; e < 8; ++e) { x[e] = siluf_(x[e]); ss += x[e] * x[e]; }
          ss = row16_sum(ss);
          float sc_ = __builtin_amdgcn_rsqf(ss + EPS); if (which == 0) sc_ *= 0.08838834764831845f;
#pragma unroll
          for (int e = 0; e < 8; ++e) x[e] *= sc_;
          const u32x4 pk = (u32x4){pk2(x[0], x[1]), pk2(x[2], x[3]), pk2(x[4], x[5]), pk2(x[6], x[7])};
          if (which == 0) { *(u32x4*)(QNS + t * 128 + ((sub ^ (t & 15)) * 8)) = pk;
              const float eg = __expf(sgc[t]);
              const u32x4 pq = (u32x4){pk2(x[0] * eg, x[1] * eg), pk2(x[2] * eg, x[3] * eg), pk2(x[4] * eg, x[5] * eg), pk2(x[6] * eg, x[7] * eg)};
              if (!dry) *(u32x4*)(P + (row0 + t) * LDP + PC_BQKV + h * 128 + sub * 8) = pq; }
          else { *(u32x4*)(KN + t * 136 + sub * 8) = pk; const float bt = sbeta[t];
              *(u32x4*)(KB + t * 136 + sub * 8) = (u32x4){pk2(x[0] * bt, x[1] * bt), pk2(x[2] * bt, x[3] * bt), pk2(x[4] * bt, x[5] * bt), pk2(x[6] * bt, x[7] * bt)}; } } }
    { const int t = tid & 63, cg = tid >> 6; const float bt = sbeta[t];
#pragma unroll
      for (int hf = 0; hf < 2; ++hf) { const int cv = cg * 16 + hf * 8; float x[8] = {0.f, 0.f, 0.f, 0.f, 0.f, 0.f, 0.f, 0.f};
#pragma unroll
          for (int j = 0; j < 4; ++j) { const u32x4 r = *(const u32x4*)(RAW + (t + j) * RP + 256 + cv); const float* wj = cw + j * 1536 + 1024 + h * 128 + cv;
              x[0] += bf_lo(r.x) * wj[0]; x[1] += bf_hi(r.x) * wj[1]; x[2] += bf_lo(r.y) * wj[2]; x[3] += bf_hi(r.y) * wj[3];
              x[4] += bf_lo(r.z) * wj[4]; x[5] += bf_hi(r.z) * wj[5]; x[6] += bf_lo(r.w) * wj[6]; x[7] += bf_hi(r.w) * wj[7]; }
          bf16_t* xt = XT + cv * 72 + t;
#pragma unroll
          for (int e = 0; e < 8; e += 2) { const unsigned w2 = pk2(siluf_(x[e]) * bt, siluf_(x[e + 1]) * bt); xt[e * 72] = (bf16_t)(w2 & 0xffffu); xt[(e + 1) * 72] = (bf16_t)(w2 >> 16); } } }
    }
    LDS_BARRIER();
    {
      const int t = tid & 63, d0 = (tid >> 6) * 16; const float eg = __expf(sgc[t]), rg = __expf(sgc[63] - sgc[t]);
#pragma unroll
      for (int hlf = 0; hlf < 2; ++hlf) { const u32x4 kv = *(const u32x4*)(KB + t * 136 + d0 + hlf * 8); bf16_t* xt = XT + (128 + d0 + hlf * 8) * 72 + t;
          const unsigned k0 = pk2(bf_lo(kv.x) * eg, bf_hi(kv.x) * eg), k1 = pk2(bf_lo(kv.y) * eg, bf_hi(kv.y) * eg), k2 = pk2(bf_lo(kv.z) * eg, bf_hi(kv.z) * eg), k3 = pk2(bf_lo(kv.w) * eg, bf_hi(kv.w) * eg);
          xt[0 * 72] = (bf16_t)(k0 & 0xffffu); xt[1 * 72] = (bf16_t)(k0 >> 16); xt[2 * 72] = (bf16_t)(k1 & 0xffffu); xt[3 * 72] = (bf16_t)(k1 >> 16);
          xt[4 * 72] = (bf16_t)(k2 & 0xffffu); xt[5 * 72] = (bf16_t)(k2 >> 16); xt[6 * 72] = (bf16_t)(k3 & 0xffffu); xt[7 * 72] = (bf16_t)(k3 >> 16); }
#pragma unroll
      for (int hlf = 0; hlf < 2; ++hlf) { const u32x4 kv = *(const u32x4*)(KN + t * 136 + d0 + hlf * 8); bf16_t* xt = KT2 + (d0 + hlf * 8) * 72 + t;
          const unsigned k0 = pk2(bf_lo(kv.x) * rg, bf_hi(kv.x) * rg), k1 = pk2(bf_lo(kv.y) * rg, bf_hi(kv.y) * rg), k2 = pk2(bf_lo(kv.z) * rg, bf_hi(kv.z) * rg), k3 = pk2(bf_lo(kv.w) * rg, bf_hi(kv.w) * rg);
          xt[0 * 72] = (bf16_t)(k0 & 0xffffu); xt[1 * 72] = (bf16_t)(k0 >> 16); xt[2 * 72] = (bf16_t)(k1 & 0xffffu); xt[3 * 72] = (bf16_t)(k1 >> 16);
          xt[4 * 72] = (bf16_t)(k2 & 0xffffu); xt[5 * 72] = (bf16_t)(k2 >> 16); xt[6 * 72] = (bf16_t)(k3 & 0xffffu); xt[7 * 72] = (bf16_t)(k3 >> 16); } }
#pragma unroll
    for (int i2 = 0; i2 < 2; ++i2) { const int ti = 2 * wave + i2, tm = ti >> 2, tn = ti & 3;
        if (tn <= tm) { const int qrow = tm * 16 + fr; f32x4 acc = (f32x4){0.f, 0.f, 0.f, 0.f};
#pragma unroll
            for (int ks = 0; ks < 4; ++ks) acc = __builtin_amdgcn_mfma_f32_16x16x32_bf16(*(const bf16x8*)(KN + (tn * 16 + fr) * 136 + ks * 32 + fq * 8), *(const bf16x8*)(QNS + qrow * 128 + (((ks * 4 + fq) ^ (qrow & 15)) * 8)), acc, 0, 0, 0);
            const int s0 = tn * 16 + 4 * fq; const float gt = sgc[qrow]; f32x4 o;
#pragma unroll
            for (int e = 0; e < 4; ++e) o[e] = (s0 + e <= qrow) ? acc[e] * __expf(gt - sgc[s0 + e]) : 0.f;
            if (!dry) *(u32x2*)(QKG + (tm * (tm + 1) / 2 + tn) * 256 + fr * 16 + 4 * fq) = pack4(o); } }
    LDS_BARRIER();
#pragma unroll
    for (int i2 = 0; i2 < 2; ++i2) { const int ti = 2 * wave + i2, tm = ti >> 2, tn = ti & 3;
        if (tn <= tm) { f32x4 acc = mma_tile<4>(KB + tm * 16 * 136, 136, KN + tn * 16 * 136, 136, (f32x4){0.f, 0.f, 0.f, 0.f}, fr, fq);
            const int t = tm * 16 + fr, s0 = tn * 16 + 4 * fq; const float gt = sgc[t]; f32x4 o;
#pragma unroll
            for (int e = 0; e < 4; ++e) o[e] = (s0 + e < t) ? acc[e] * __expf(gt - sgc[s0 + e]) : 0.f;
            *(f32x4*)(AM + t * 64 + s0) = o; } }
    if (next_unit >= 0) bpre_load(p, next_unit, R);
    LDS_BARRIER();
    if (wave == 0 && !(dry & 2)) {
        const int off = (lane >> 5) * 32, cc = lane & 31;
        float Tc[32];
        const float* ab = AM + off * 64 + off;
        float* tf = TF + (lane >> 5) * (32 * 33) + cc;
#pragma unroll
        for (int t = 0; t < 32; ++t) { float ac4[4] = {0.f, 0.f, 0.f, 0.f};
#pragma unroll
            for (int s4 = 0; s4 < (t + 3) / 4; ++s4) { const f32x4 a = *(const f32x4*)(ab + t * 64 + 4 * s4);
#pragma unroll
                for (int e = 0; e < 4; ++e) if (4 * s4 + e < t) ac4[e] += a[e] * Tc[4 * s4 + e]; }
            int ln = cc; asm volatile("" : "+v"(ln));
            Tc[t] = ((t == ln) ? 1.f : 0.f) - ((ac4[0] + ac4[1]) + (ac4[2] + ac4[3]));
            tf[t * 33] = Tc[t];
            TM[(off + t) * 72 + off + ln] = (bf16_t)f2bf(Tc[t]);
            if (off == 0) TM[t * 72 + 32 + ln] = (bf16_t)0; }
    }
    LDS_BARRIER();
    {
      const int i = tid >> 4, j = (tid & 15) * 2; float m0 = 0.f, m1 = 0.f;
#pragma unroll
      for (int k4 = 0; k4 < 8; ++k4) { const f32x4 a = *(const f32x4*)(AM + (32 + i) * 64 + 4 * k4);
#pragma unroll
          for (int e = 0; e < 4; ++e) { const int k = 4 * k4 + e; m0 += a[e] * TF[k * 33 + j]; m1 += a[e] * TF[k * 33 + j + 1]; } }
      MS[i * 33 + j] = m0; MS[i * 33 + j + 1] = m1; }
    LDS_BARRIER();
    {
      const int i = tid >> 4, j = (tid & 15) * 2; float m0 = 0.f, m1 = 0.f;
#pragma unroll
      for (int k = 0; k < 32; ++k) { const float tk = TF[32 * 33 + i * 33 + k]; m0 += tk * MS[k * 33 + j]; m1 += tk * MS[k * 33 + j + 1]; }
      *(unsigned*)(TM + (32 + i) * 72 + j) = pk2(-m0, -m1); }
    LDS_BARRIER();
    if (!(dry & 8))
#pragma unroll
    for (int i2 = 0; i2 < 2; ++i2) { const int nt = 2 * wave + i2;
#pragma unroll
        for (int mt = 0; mt < 4; ++mt) {
            if (nt >= 8) { const f32x4 acc = mma_tile<2>(TM + mt * 16 * 72, 72, XT + nt * 16 * 72, 72, (f32x4){0.f, 0.f, 0.f, 0.f}, fr, fq);
                const int t = mt * 16 + fr, d = (nt - 8) * 16 + 4 * fq;
                if (!dry) *(u32x2*)(P + (row0 + t) * LDP + 512 + h * 128 + d) = pack4(acc); }
            else { const f32x4 acc = mma_tile<2>(XT + nt * 16 * 72, 72, TM + mt * 16 * 72, 72, (f32x4){0.f, 0.f, 0.f, 0.f}, fr, fq);
                const int v = nt * 16 + fr, t = mt * 16 + 4 * fq;
                if (!dry) *(u32x2*)(P + (row0 + (v >> 1)) * LDP + PC_BQKV + 1024 + h * 128 + (v & 1) * 64 + t) = pack4(acc); } } }
#pragma unroll
    for (int i2 = 0; i2 < 2; ++i2) { const int ck = tid + 512 * i2, k = ck >> 3, c8 = (ck & 7) * 8;
        const u32x4 v = *(const u32x4*)(KT2 + k * 72 + c8);
        if (!dry) *(u32x4*)(P + (row0 + (k >> 1)) * LDP + PC_BQKV + 512 + h * 128 + (k & 1) * 64 + c8) = v; }
}

constexpr int BS_NV = 32;
__device__ __forceinline__ void bscan_block(const Params& p, int blk, unsigned char* lds, int dry) {
    const int tid = tid_(), lane = tid & 63, wave = tid >> 6, fr = lane & 15, fq = lane >> 4;
    const int bh = blk >> 2, v0 = (blk & 3) * BS_NV, b = bh >> 2, h = bh & 3;
    const int wv = wave & 1, wt = wave >> 1;
    bf16_t* P = (bf16_t*)(p.ws + WS_P); const float* GC = (const float*)(p.ws + WS_GC); const bf16_t* QKG = (const bf16_t*)(p.ws + WS_QK);
    bf16_t* ST = (bf16_t*)lds;
    bf16_t* Wt = (bf16_t*)(lds + 8704);
    bf16_t* QD = (bf16_t*)(lds + 26112);
    bf16_t* KDT = (bf16_t*)(lds + 43520);
    bf16_t* QK = (bf16_t*)(lds + 61952);
    bf16_t* VNT = (bf16_t*)(lds + 71168);
    bf16_t* UT = (bf16_t*)(lds + 75776);
    const size_t row0 = (size_t)b * SEQ;
    f32x4 Sacc[2];
    Sacc[0] = (f32x4){0.f, 0.f, 0.f, 0.f}; Sacc[1] = (f32x4){0.f, 0.f, 0.f, 0.f};
    LDS_BARRIER();
    for (int e = tid; e < BS_NV * 136 / 2; e += NTHREADS) ((unsigned*)ST)[e] = 0u;
    for (int e = tid; e < 64 * 72 / 2; e += NTHREADS) ((unsigned*)QK)[e] = 0u;
    u32x4 rw[2], ru, rq[2], rk[2], rqk; float rge = 0.f;
    const int qk_tile = tid >> 5, qk_tm = qk_tile < 1 ? 0 : (qk_tile < 3 ? 1 : (qk_tile < 6 ? 2 : 3)), qk_tn = qk_tile - qk_tm * (qk_tm + 1) / 2;
    bf16_t* qk_dst = QK + (qk_tm * 16 + ((tid >> 1) & 15)) * 72 + qk_tn * 16 + (tid & 1) * 8;
    auto load_g1 = [&](int c) {
#pragma unroll
        for (int i2 = 0; i2 < 2; ++i2) { const int ck = tid + 512 * i2; rw[i2] = *(const u32x4*)(P + (row0 + c * 64 + (ck >> 4)) * LDP + 512 + h * 128 + (ck & 15) * 8); }
        if (tid < 256) { const int v = v0 + (tid >> 3); ru = *(const u32x4*)(P + (row0 + c * 64 + (v >> 1)) * LDP + PC_BQKV + 1024 + h * 128 + (v & 1) * 64 + (tid & 7) * 8); } };
    auto load_g2 = [&](int c) {
#pragma unroll
        for (int i2 = 0; i2 < 2; ++i2) { const int ck = tid + 512 * i2;
            rq[i2] = *(const u32x4*)(P + (row0 + c * 64 + (ck >> 4)) * LDP + PC_BQKV + h * 128 + (ck & 15) * 8);
            const int k = ck >> 3; rk[i2] = *(const u32x4*)(P + (row0 + c * 64 + (k >> 1)) * LDP + PC_BQKV + 512 + h * 128 + (k & 1) * 64 + (ck & 7) * 8); }
        if (tid < 320) rqk = *(const u32x4*)(QKG + (size_t)((b * 64 + c) * 4 + h) * 2560 + tid * 8);
        rge = GC[(row0 + c * 64 + 63) * 4 + h]; };
    auto store_g1 = [&]() {
#pragma unroll
        for (int i2 = 0; i2 < 2; ++i2) { const int ck = tid + 512 * i2; *(u32x4*)(Wt + (ck >> 4) * 136 + (ck & 15) * 8) = rw[i2]; }
        if (tid < 256) *(u32x4*)(UT + (tid >> 3) * 72 + (tid & 7) * 8) = ru; };
    float ge = 1.f;
    auto store_g2 = [&]() {
#pragma unroll
        for (int i2 = 0; i2 < 2; ++i2) { const int ck = tid + 512 * i2;
            *(u32x4*)(QD + (ck >> 4) * 136 + (ck & 15) * 8) = rq[i2]; *(u32x4*)(KDT + (ck >> 3) * 72 + (ck & 7) * 8) = rk[i2]; }
        if (tid < 320) *(u32x4*)qk_dst = rqk;
        ge = __expf(rge); };
#define LDFRAG(base, row, pitch, ks) (*(const bf16x8*)((base) + (row) * (pitch) + (ks) * 32 + fq * 8))
#define MFMA16(bfrag, afrag, acc) __builtin_amdgcn_mfma_f32_16x16x32_bf16(bfrag, afrag, acc, 0, 0, 0)
    load_g1(0); load_g2(0);
    LDS_BARRIER();
    store_g1(); load_g1(1);
    const int vrow = 16 * wv + fr;
#pragma unroll 1
    for (int c = 0; c < 64; ++c) {
        LDS_BARRIER();
        store_g2(); if (c + 1 < 64) load_g2(c + 1);
        bf16x8 sfr[4];
#pragma unroll
        for (int ks = 0; ks < 4; ++ks) sfr[ks] = LDFRAG(ST, vrow, 136, ks);
        { f32x4 acc = (f32x4){0.f, 0.f, 0.f, 0.f};
#pragma unroll
          for (int ks = 0; ks < 4; ++ks) acc = MFMA16(LDFRAG(Wt, wt * 16 + fr, 136, ks), sfr[ks], acc);
          const f32x4 u4 = unpack4(*(const u32x2*)(UT + vrow * 72 + wt * 16 + 4 * fq));
          *(u32x2*)(VNT + vrow * 72 + wt * 16 + 4 * fq) = pack4(u4 - acc); }
        LDS_BARRIER();
        if (c + 1 < 64) { store_g1(); if (c + 2 < 64) load_g1(c + 2); }
        bf16x8 vfr[2];
#pragma unroll
        for (int ks = 0; ks < 2; ++ks) vfr[ks] = LDFRAG(VNT, vrow, 72, ks);
        { f32x4 acc = (f32x4){0.f, 0.f, 0.f, 0.f};
#pragma unroll
          for (int ks = 0; ks < 4; ++ks) acc = MFMA16(sfr[ks], LDFRAG(QD, wt * 16 + fr, 136, ks), acc);
#pragma unroll
          for (int ks = 0; ks < 2; ++ks) acc = MFMA16(vfr[ks], LDFRAG(QK, wt * 16 + fr, 72, ks), acc);
          { const int t = wt * 16 + fr;
            if (!dry) *(u32x2*)(P + (row0 + c * 64 + (v0 >> 1) + (t >> 2)) * LDP + PC_BQKV + 1024 + h * 128 + (t & 3) * 32 + 16 * wv + 4 * fq) = pack4(acc); } }
#pragma unroll
        for (int i2 = 0; i2 < 2; ++i2) { const int kt = 2 * wt + i2; f32x4 acc = Sacc[i2] * ge;
#pragma unroll
            for (int ks = 0; ks < 2; ++ks) acc = MFMA16(LDFRAG(KDT, kt * 16 + fr, 72, ks), vfr[ks], acc);
            Sacc[i2] = acc;
            *(u32x2*)(ST + vrow * 136 + kt * 16 + 4 * fq) = pack4(acc); }
    }
#undef LDFRAG
#undef MFMA16
}

__device__ __forceinline__ unsigned char* a_state_row(unsigned char* ws, size_t row0, int h, int v) {
    return ws + WS_AF + (row0 + (size_t)(v >> 1)) * 2048 + (size_t)h * 512 + (size_t)(v & 1) * 256;
}
struct Ax1Regs { f32x4 fA[4], fB[4]; u32x4 vB[2], qA[2]; };
__device__ __forceinline__ void ax1_load(const Params& p, int unit, Ax1Regs& R) {
    const int tid = tid_(); const int h = unit & 3, c = (unit >> 2) & 63, b = unit >> 8;
    const bf16_t* P = (const bf16_t*)(p.ws + WS_P); const float* AF = (const float*)(p.ws + WS_AF);
    const size_t row0 = (size_t)b * SEQ + (size_t)c * 64;
    const int rA = tid >> 3, cA = (tid & 7) * 16, tB = tid & 63, cB = (tid >> 6) * 16;
#pragma unroll
    for (int i = 0; i < 4; ++i) { R.fA[i] = *(const f32x4*)(AF + (row0 + rA) * 512 + h * 128 + cA + 4 * i); R.fB[i] = *(const f32x4*)(AF + (row0 + tB) * 512 + h * 128 + cB + 4 * i); }
#pragma unroll
    for (int i = 0; i < 2; ++i) { R.vB[i] = *(const u32x4*)(P + (row0 + tB) * LDP + PC_AI + h * 128 + cB + 8 * i); R.qA[i] = *(const u32x4*)(P + (row0 + rA) * LDP + PC_AQ + h * 128 + cA + 8 * i); }
}
__device__ __forceinline__ void ax1_unit(const Params& p, int unit, int next_unit, Ax1Regs& R, unsigned char* lds, int dry) {
    const int tid = tid_(), lane = tid & 63, wave = tid >> 6, fr = lane & 15, fq = lane >> 4;
    const int h = unit & 3, c = (unit >> 2) & 63, b = unit >> 8;
    bf16_t* P = (bf16_t*)(p.ws + WS_P); const float* AF = (const float*)(p.ws + WS_AF); float* DEC = (float*)(p.ws + WS_DEC);
    constexpr int BP = 132;
    float* BF = (float*)lds;
    bf16_t* QM = (bf16_t*)(lds + 33792);
    bf16_t* KM = (bf16_t*)(lds + 51200);
    bf16_t* KET = (bf16_t*)(lds + 68608);
    bf16_t* VT = (bf16_t*)(lds + 87040);
    bf16_t* SC = (bf16_t*)(lds + 105472);
    const size_t row0 = (size_t)b * SEQ + (size_t)c * 64;
    const int rA = tid >> 3, cA = (tid & 7) * 16;
    const int tB = tid & 63, cB = (tid >> 6) * 16;
    LDS_BARRIER();
    f32x4 fA[4], fB[4]; u32x4 vB[2], qA[2];
#pragma unroll
    for (int i = 0; i < 4; ++i) { fA[i] = R.fA[i]; fB[i] = R.fB[i];
        *(f32x4*)(BF + rA * BP + cA + 4 * i) = (f32x4){__logf(fA[i][0]), __logf(fA[i][1]), __logf(fA[i][2]), __logf(fA[i][3])}; }
#pragma unroll
    for (int i = 0; i < 2; ++i) { vB[i] = R.vB[i]; qA[i] = R.qA[i]; }
    LDS_BARRIER();
    if (tid < 128) { float s = 0.f;
#pragma unroll
        for (int t = 0; t < 64; ++t) { s += BF[t * BP + tid]; BF[t * BP + tid] = s; } }
    LDS_BARRIER();
    {
      float qv[16] = {bf_lo(qA[0].x), bf_hi(qA[0].x), bf_lo(qA[0].y), bf_hi(qA[0].y), bf_lo(qA[0].z), bf_hi(qA[0].z), bf_lo(qA[0].w), bf_hi(qA[0].w),
                      bf_lo(qA[1].x), bf_hi(qA[1].x), bf_lo(qA[1].y), bf_hi(qA[1].y), bf_lo(qA[1].z), bf_hi(qA[1].z), bf_lo(qA[1].w), bf_hi(qA[1].w)};
      unsigned wm[8], wk[8], wh[8];
#pragma unroll
      for (int i = 0; i < 4; ++i) { const f32x4 bt = *(const f32x4*)(BF + rA * BP + cA + 4 * i), bm = *(const f32x4*)(BF + 31 * BP + cA + 4 * i);
          float qm[4], km[4], qh[4];
#pragma unroll
          for (int e = 0; e < 4; ++e) { const float q = qv[4 * i + e], kk = 1.0f - fA[i][e]; qm[e] = q * __expf(bt[e] - bm[e]); km[e] = kk * __expf(bm[e] - bt[e]); qh[e] = q * __expf(bt[e]); }
          wm[2 * i] = pk2(qm[0], qm[1]); wm[2 * i + 1] = pk2(qm[2], qm[3]); wk[2 * i] = pk2(km[0], km[1]); wk[2 * i + 1] = pk2(km[2], km[3]); wh[2 * i] = pk2(qh[0], qh[1]); wh[2 * i + 1] = pk2(qh[2], qh[3]); }
      *(u32x4*)(QM + rA * 136 + cA) = (u32x4){wm[0], wm[1], wm[2], wm[3]}; *(u32x4*)(QM + rA * 136 + cA + 8) = (u32x4){wm[4], wm[5], wm[6], wm[7]};
      *(u32x4*)(KM + rA * 136 + cA) = (u32x4){wk[0], wk[1], wk[2], wk[3]}; *(u32x4*)(KM + rA * 136 + cA + 8) = (u32x4){wk[4], wk[5], wk[6], wk[7]};
      bf16_t* qg = P + (row0 + rA) * LDP + PC_AQ + h * 128 + cA;
      if (!dry) { *(u32x4*)qg = (u32x4){wh[0], wh[1], wh[2], wh[3]}; *(u32x4*)(qg + 8) = (u32x4){wh[4], wh[5], wh[6], wh[7]}; } }
    {
#pragma unroll
      for (int i = 0; i < 4; ++i) { const f32x4 bt = *(const f32x4*)(BF + tB * BP + cB + 4 * i), be = *(const f32x4*)(BF + 63 * BP + cB + 4 * i);
          const unsigned w0 = pk2((1.0f - fB[i][0]) * __expf(be[0] - bt[0]), (1.0f - fB[i][1]) * __expf(be[1] - bt[1])), w1 = pk2((1.0f - fB[i][2]) * __expf(be[2] - bt[2]), (1.0f - fB[i][3]) * __expf(be[3] - bt[3]));
          bf16_t* kt = KET + (cB + 4 * i) * 72 + tB;
          kt[0] = (bf16_t)(w0 & 0xffffu); kt[72] = (bf16_t)(w0 >> 16); kt[144] = (bf16_t)(w1 & 0xffffu); kt[216] = (bf16_t)(w1 >> 16); }
#pragma unroll
      for (int i = 0; i < 2; ++i) { bf16_t* vt = VT + (cB + 8 * i) * 72 + tB;
          vt[0 * 72] = (bf16_t)(vB[i].x & 0xffffu); vt[1 * 72] = (bf16_t)(vB[i].x >> 16); vt[2 * 72] = (bf16_t)(vB[i].y & 0xffffu); vt[3 * 72] = (bf16_t)(vB[i].y >> 16);
          vt[4 * 72] = (bf16_t)(vB[i].z & 0xffffu); vt[5 * 72] = (bf16_t)(vB[i].z >> 16); vt[6 * 72] = (bf16_t)(vB[i].w & 0xffffu); vt[7 * 72] = (bf16_t)(vB[i].w >> 16); } }
    if (tid < 128 && !dry) DEC[(size_t)unit * 128 + tid] = __expf(BF[63 * BP + tid]);
    if (next_unit >= 0) ax1_load(p, next_unit, R);
    LDS_BARRIER();
#pragma unroll
    for (int i2 = 0; i2 < 2; ++i2) { const int ti = 2 * wave + i2, tm = ti >> 2, tn = ti & 3; const int t = tm * 16 + fr, s0 = tn * 16 + 4 * fq; f32x4 o = (f32x4){0.f, 0.f, 0.f, 0.f};
        if (tn <= tm) { const f32x4 acc = mma_tile<4>(QM + tm * 16 * 136, 136, KM + tn * 16 * 136, 136, (f32x4){0.f, 0.f, 0.f, 0.f}, fr, fq);
#pragma unroll
            for (int e = 0; e < 4; ++e) o[e] = (s0 + e <= t) ? acc[e] : 0.f; }
        *(u32x2*)(SC + t * 72 + s0) = pack4(o); }
    LDS_BARRIER();
    { const int vrow = 16 * wave + fr;
      bf16x8 vfr[2];
#pragma unroll
      for (int ks = 0; ks < 2; ++ks) vfr[ks] = *(const bf16x8*)(VT + vrow * 72 + ks * 32 + fq * 8);
#pragma unroll
      for (int tt = 0; tt < 4; ++tt) { f32x4 acc = (f32x4){0.f, 0.f, 0.f, 0.f};
#pragma unroll
          for (int ks = 0; ks < 2; ++ks) acc = __builtin_amdgcn_mfma_f32_16x16x32_bf16(vfr[ks], *(const bf16x8*)(SC + (tt * 16 + fr) * 72 + ks * 32 + fq * 8), acc, 0, 0, 0);
          if (!dry) *(u32x2*)(P + (row0 + tt * 16 + fr) * LDP + PC_AI + h * 128 + 16 * wave + 4 * fq) = pack4(acc); }
      unsigned char* srow = a_state_row(p.ws, row0, h, vrow);
#pragma unroll
      for (int kt = 0; kt < 8; ++kt) { f32x4 acc = (f32x4){0.f, 0.f, 0.f, 0.f};
#pragma unroll
          for (int ks = 0; ks < 2; ++ks) acc = __builtin_amdgcn_mfma_f32_16x16x32_bf16(*(const bf16x8*)(KET + (kt * 16 + fr) * 72 + ks * 32 + fq * 8), vfr[ks], acc, 0, 0, 0);
          if (!dry) *(u32x2*)(srow + (kt * 16 + 4 * fq) * 2) = pack4(acc); } }
}
__device__ __forceinline__ void a2_block(const Params& p, int blk, unsigned char* lds) {
    const int tid = tid_(), lane = tid & 63, wave = tid >> 6, fr = lane & 15, fq = lane >> 4;
    const int bh = blk >> 3, v0 = (blk & 7) * 16, b = bh >> 2, h = bh & 3;
    bf16_t* P = (bf16_t*)(p.ws + WS_P); const float* DEC = (const float*)(p.ws + WS_DEC);
    const int sv = tid >> 5, sk = (tid & 31) * 4;
    f32x4 S = (f32x4){0.f, 0.f, 0.f, 0.f};
    u32x4 rq[2]; u32x2 rds; f32x4 rd;
    auto gload = [&](int c) { const size_t row0 = (size_t)b * SEQ + (size_t)c * 64;
#pragma unroll
        for (int i2 = 0; i2 < 2; ++i2) { const int ck = tid + 512 * i2; rq[i2] = *(const u32x4*)(P + (row0 + (ck >> 4)) * LDP + PC_AQ + h * 128 + (ck & 15) * 8); }
        rds = *(const u32x2*)(a_state_row(p.ws, row0, h, v0 + sv) + sk * 2);
        rd = *(const f32x4*)(DEC + (size_t)((b * 64 + c) * 4 + h) * 128 + sk); };
    gload(0);
    LDS_BARRIER();
#pragma unroll 1
    for (int c = 0; c < 64; ++c) {
        bf16_t* QH = (bf16_t*)(lds + (c & 1) * 21760); bf16_t* SI = QH + 64 * 136;
#pragma unroll
        for (int i2 = 0; i2 < 2; ++i2) { const int ck = tid + 512 * i2; *(u32x4*)(QH + (ck >> 4) * 136 + (ck & 15) * 8) = rq[i2]; }
        *(u32x2*)(SI + sv * 136 + sk) = pack4(S);
        S = S * rd + unpack4(rds);
        if (c + 1 < 64) gload(c + 1);
        LDS_BARRIER();
        if (wave < 4) { const size_t row0 = (size_t)b * SEQ + (size_t)c * 64; const int t = wave * 16 + fr;
            bf16_t* op = P + (row0 + t) * LDP + PC_AI + h * 128 + v0 + 4 * fq;
            f32x4 acc = unpack4(*(const u32x2*)op);
#pragma unroll
            for (int ks = 0; ks < 4; ++ks) acc = __builtin_amdgcn_mfma_f32_16x16x32_bf16(*(const bf16x8*)(SI + fr * 136 + ks * 32 + fq * 8), *(const bf16x8*)(QH + t * 136 + ks * 32 + fq * 8), acc, 0, 0, 0);
            *(u32x2*)op = pack4(acc); }
    }
}
__device__ __forceinline__ void cmma_unit(const Params& p, int l, int unit, unsigned char* lds, int dry) {
    const int tid = tid_(), lane = tid & 63, wave = tid >> 6, fr = lane & 15, fq = lane >> 4;
    const int kvh = unit & 1, nb = (unit >> 1) & 31, b = unit >> 6;
    bf16_t* P = (bf16_t*)(p.ws + WS_P);
    bf16_t* sK = (bf16_t*)lds;
    bf16_t* sVT = (bf16_t*)(lds + 36864);
    float* sBias = (float*)(lds + 70656);
    bf16_t* sP = (bf16_t*)(lds + 72704) + wave * (16 * 168);
    const size_t rowq0 = (size_t)b * SEQ + (size_t)nb * 128;
    const bool first = (nb == 0);
    LDS_BARRIER();
#pragma unroll
    for (int i2 = 0; i2 < 4; ++i2) { const int ck = tid + 512 * i2, j = ck >> 3, d8 = (ck & 7) * 8; u32x4 kv = (u32x4){0u, 0u, 0u, 0u};
        if (!first || j >= 128) kv = *(const u32x4*)(P + (rowq0 - 128 + j) * LDP + PC_CK + kvh * 64 + d8);
        *(u32x4*)(sK + j * 72 + d8) = kv; }
    { const int j = tid & 255, dh = (tid >> 8) * 32;
#pragma unroll
      for (int i = 0; i < 4; ++i) { u32x4 vv = (u32x4){0u, 0u, 0u, 0u};
          if (!first || j >= 128) vv = *(const u32x4*)(P + (rowq0 - 128 + j) * LDP + PC_CV + kvh * 64 + dh + 8 * i);
          bf16_t* vt = sVT + (dh + 8 * i) * 264 + j;
          vt[0 * 264] = (bf16_t)(vv.x & 0xffffu); vt[1 * 264] = (bf16_t)(vv.x >> 16); vt[2 * 264] = (bf16_t)(vv.y & 0xffffu); vt[3 * 264] = (bf16_t)(vv.y >> 16);
          vt[4 * 264] = (bf16_t)(vv.z & 0xffffu); vt[5 * 264] = (bf16_t)(vv.z >> 16); vt[6 * 264] = (bf16_t)(vv.w & 0xffffu); vt[7 * 264] = (bf16_t)(vv.w >> 16); } }
    { const int g = tid >> 7, dist = tid & 127; sBias[g * 128 + dist] = p.rel_bias[(int)kBucket[dist] * 8 + kvh * 4 + g]; }
    LDS_BARRIER();
    const int a = wave, kb0 = 32 * (a >> 1), qi = 16 * a + fr;
#pragma unroll 1
    for (int g = 0; g < 4; ++g) {
        const int hq = kvh * 4 + g; const size_t rowq = rowq0 + qi;
        bf16x8 qf[2];
#pragma unroll
        for (int ks = 0; ks < 2; ++ks) qf[ks] = *(const bf16x8*)(P + rowq * LDP + PC_CQ + hq * 64 + ks * 32 + fq * 8);
        f32x4 s[10];
#pragma unroll
        for (int kt = 0; kt < 10; ++kt) { f32x4 acc = (f32x4){0.f, 0.f, 0.f, 0.f};
#pragma unroll
            for (int ks = 0; ks < 2; ++ks) acc = __builtin_amdgcn_mfma_f32_16x16x32_bf16(*(const bf16x8*)(sK + (kb0 + kt * 16 + fr) * 72 + ks * 32 + fq * 8), qf[ks], acc, 0, 0, 0);
            s[kt] = acc; }
        const float sink = p.sinks[l * 8 + hq];
        float mx = sink;
#pragma unroll
        for (int kt = 0; kt < 10; ++kt)
#pragma unroll
            for (int e = 0; e < 4; ++e) { const int j = kb0 + kt * 16 + 4 * fq + e; const int dist = qi + 128 - j; const bool ok = (dist >= 0) && (dist < 128) && !(first && j < 128);
                const float v = ok ? s[kt][e] + sBias[g * 128 + (dist & 127)] : -1e30f; s[kt][e] = v; mx = fmaxf(mx, v); }
        { auto r16 = __builtin_amdgcn_permlane16_swap(__float_as_uint(mx), __float_as_uint(mx), false, false); mx = fmaxf(__uint_as_float(r16[0]), __uint_as_float(r16[1]));
          auto r32 = __builtin_amdgcn_permlane32_swap(__float_as_uint(mx), __float_as_uint(mx), false, false); mx = fmaxf(__uint_as_float(r32[0]), __uint_as_float(r32[1])); }
        float ls = 0.f;
#pragma unroll
        for (int kt = 0; kt < 10; ++kt) { f32x4 pe;
#pragma unroll
            for (int e = 0; e < 4; ++e) pe[e] = __expf(s[kt][e] - mx);
            const u32x2 pk = pack4(pe); ls += (bf_lo(pk.x) + bf_hi(pk.x)) + (bf_lo(pk.y) + bf_hi(pk.y));
            *(u32x2*)(sP + fr * 168 + kt * 16 + 4 * fq) = pk; }
        ls = xor32_sum(xor16_sum(ls)) + __expf(sink - mx);
        const float inv = __builtin_amdgcn_rcpf(ls);
        asm volatile("s_waitcnt lgkmcnt(0)" ::: "memory");
        bf16x8 pf[5];
#pragma unroll
        for (int ks = 0; ks < 5; ++ks) pf[ks] = *(const bf16x8*)(sP + fr * 168 + ks * 32 + fq * 8);
        bf16_t* gp = P + rowq * LDP + PC_CG + hq * 64;
#pragma unroll
        for (int dt = 0; dt < 4; ++dt) { f32x4 acc = (f32x4){0.f, 0.f, 0.f, 0.f};
#pragma unroll
            for (int ks = 0; ks < 5; ++ks) acc = __builtin_amdgcn_mfma_f32_16x16x32_bf16(*(const bf16x8*)(sVT + (dt * 16 + fr) * 264 + kb0 + ks * 32 + fq * 8), pf[ks], acc, 0, 0, 0);
            const f32x4 gt = unpack4(*(const u32x2*)(gp + dt * 16 + 4 * fq));
            f32x4 y;
#pragma unroll
            for (int e = 0; e < 4; ++e) y[e] = acc[e] * inv * siluf_(gt[e]);
            if (!dry) *(u32x2*)(gp + dt * 16 + 4 * fq) = pack4(y); }
        asm volatile("s_waitcnt lgkmcnt(0)" ::: "memory");
    }
}
__device__ __forceinline__ void phase_mixers(const Params& p, int l, unsigned char* lds, int dry, int mask) {
    const int vb = bid_(), G = gridDim.x;
    if (mask & 2) { BpreRegs R; if (vb < 1024) bpre_load(p, vb, R);
#pragma unroll 1
        for (int u = vb; u < 1024; u += G) bpre_unit(p, l, u, (u + G < 1024) ? u + G : -1, R, lds, dry); }
    if (mask & 1) { Ax1Regs R; if (vb < 1024) ax1_load(p, vb, R);
#pragma unroll 1
        for (int u = vb; u < 1024; u += G) ax1_unit(p, u, (u + G < 1024) ? u + G : -1, R, lds, dry); }
}
__device__ __forceinline__ void phase_scan(const Params& p, int l, unsigned char* lds, int dry, int mask) {
    const int vb = bid_();
    if (vb < 64) { if (mask & 2) bscan_block(p, vb, lds, dry); }
    else if (vb < 192) { if ((mask & 1) && !dry) { a2_block(p, vb - 64, lds); if (vb < 128) { LDS_BARRIER(); inproj_late_tile(p, l, vb - 64, lds); } } }
    else if (vb < 256) { if ((mask & 1) && !dry) {
#pragma unroll 1
        for (int u = vb - 192; u < 256; u += 64) cmma_unit(p, l, u, lds, 0); } }
}
__device__ __forceinline__ void phase_finalize(const Params& p, int l, int dry) {
    const int tid = tid_(), lane = tid & 63, wave = tid >> 6;
    bf16_t* P = (bf16_t*)(p.ws + WS_P);
    const int hh = lane >> 4, v8 = (lane & 15) * 8;
    float wa[8], wb[8];
#pragma unroll
    for (int e = 0; e < 8; ++e) { wa[e] = p.norm_a[l * 128 + v8 + e]; wb[e] = p.norm_b[l * 128 + v8 + e]; }
    const int gw = bid_() * 8 + wave, NGW = gridDim.x * 8;
    for (int m = gw; m < M; m += NGW) {
        bf16_t* pr = P + (size_t)m * LDP;
#pragma unroll
        for (int br = 0; br < 2; ++br) {
            const int ocol = br == 0 ? PC_AI + hh * 128 + v8 : PC_BQKV + 1024 + hh * 128 + (m & 3) * 32 + (v8 & 31);
            const int gcol = br == 0 ? PC_AG + hh * 128 + v8 : PC_BZ + hh * 128 + v8;
            const bf16_t* po = br == 0 ? pr : P + (size_t)((m & ~63) + 16 * (v8 >> 5) + ((m & 63) >> 2)) * LDP;
            const u32x4 ov = *(const u32x4*)(po + ocol); const u32x4 gv = *(const u32x4*)(pr + gcol);
            float o[8] = {bf_lo(ov.x), bf_hi(ov.x), bf_lo(ov.y), bf_hi(ov.y), bf_lo(ov.z), bf_hi(ov.z), bf_lo(ov.w), bf_hi(ov.w)};
            float gt[8] = {bf_lo(gv.x), bf_hi(gv.x), bf_lo(gv.y), bf_hi(gv.y), bf_lo(gv.z), bf_hi(gv.z), bf_lo(gv.w), bf_hi(gv.w)};
            float ss = 0.f;
#pragma unroll
            for (int e = 0; e < 8; ++e) ss += o[e] * o[e];
            ss = row16_sum(ss);
            const float rs = 1.0f / sqrtf(ss * (1.0f / 128.0f) + EPS);
            float y[8];
#pragma unroll
            for (int e = 0; e < 8; ++e) y[e] = o[e] * rs * (br == 0 ? wa[e] : wb[e]) * siluf_(gt[e]);
            u32x4 yo; yo.x = pk2(y[0], y[1]); yo.y = pk2(y[2], y[3]); yo.z = pk2(y[4], y[5]); yo.w = pk2(y[6], y[7]);
            if (!dry) *(u32x4*)(pr + gcol) = yo;
        }
    }
}

__device__ __forceinline__ int launder_i(int v) { asm volatile("" : "+s"(v)); return v; }
__device__ __forceinline__ Params launder(Params p) {
    asm volatile("" : "+s"(p.x), "+s"(p.norm_w), "+s"(p.w_in), "+s"(p.conv_w), "+s"(p.a_log), "+s"(p.dt_bias), "+s"(p.lb_param), "+s"(p.norm_a));
    asm volatile("" : "+s"(p.norm_b), "+s"(p.sinks), "+s"(p.rel_bias), "+s"(p.w_branch), "+s"(p.w_out), "+s"(p.final_norm), "+s"(p.out), "+s"(p.ws));
    return p;
}
#define XB_TMO      128
#define XB_XCNT(j)  (256  + 64 * (j))
#define XB_XSUB(j)  (1280 + 64 * (j))
#define XB_XGEN(j)  (2304 + 64 * (j))
#define XB_TOP      3328
#define XB_TOPGEN   3392
#define XCD_BAR_WORDS 3456
#define XB_SPIN_CAP (1u << 18)

__device__ __forceinline__ unsigned xb_ld(unsigned* p)              { return __hip_atomic_load(p, __ATOMIC_RELAXED, __HIP_MEMORY_SCOPE_AGENT); }
__device__ __forceinline__ unsigned xb_add(unsigned* p, unsigned v) { return __hip_atomic_fetch_add(p, v, __ATOMIC_RELAXED, __HIP_MEMORY_SCOPE_AGENT); }
__device__ __forceinline__ unsigned xb_xcc_id() { return (unsigned)__builtin_amdgcn_s_getreg((3 << 11) | 20) & 0xFu; }
#define XB_SPIN(cond, bar) do { unsigned _sp = 0; while (cond) { __builtin_amdgcn_s_sleep(1); \
    if ((++_sp & 255u) == 0u) { if (xb_ld(&(bar)[XB_TMO])) break; if (_sp > XB_SPIN_CAP) { atomicAdd(&(bar)[XB_TMO], 1u); break; } } } } while (0)

struct XcdBarrier {
    unsigned* bar; unsigned x;
    volatile __attribute__((address_space(3))) unsigned* st;
};

__device__ __forceinline__ XcdBarrier xcd_barrier_post(unsigned* bar, volatile __attribute__((address_space(3))) unsigned* st) {
    XcdBarrier b; b.bar = bar; b.x = xb_xcc_id(); b.st = st;
    if (threadIdx.x == 0) (void)xb_add(&bar[XB_XCNT(b.x)], 1u);
    return b;
}
__device__ __forceinline__ void xcd_barrier_complete(unsigned* bar, unsigned x, unsigned& nloc, unsigned& nx) {
    const unsigned G = gridDim.x * gridDim.y * gridDim.z;
    unsigned sum, cnt, mine, sp = 0u;
    for (;;) {
        sum = 0u; cnt = 0u; mine = 0u;
#pragma unroll
        for (unsigned j = 0; j < 16; ++j) { const unsigned c = xb_ld(&bar[XB_XCNT(j)]); sum += c; cnt += (c > 0u) ? 1u : 0u; mine = (j == x) ? c : mine; }
        if (sum == G) break;
        __builtin_amdgcn_s_sleep(1);
        if ((++sp & 255u) == 0u) { if (xb_ld(&bar[XB_TMO])) break; if (sp > XB_SPIN_CAP) { atomicAdd(&bar[XB_TMO], 1u); break; } }
    }
    nloc = mine > 0u ? mine : 1u; nx = cnt > 0u ? cnt : 1u;
}

__device__ __forceinline__ void xcd_barrier(const XcdBarrier& b) {
    asm volatile("s_waitcnt vmcnt(0)" ::: "memory");
    __syncthreads();
    if (threadIdx.x == 0) {
        unsigned* bar = b.bar;
        __builtin_amdgcn_s_waitcnt(0);
        unsigned nloc = b.st[0], nx = b.st[1];
        if (nloc == 0u) { xcd_barrier_complete(bar, b.x, nloc, nx); b.st[0] = nloc; b.st[1] = nx; }
        const unsigned old = xb_add(&bar[XB_XSUB(b.x)], 1u);
        const unsigned gen = old / nloc;
        if (old + 1u == (gen + 1u) * nloc) {
            __builtin_amdgcn_fence(__ATOMIC_RELEASE, "agent");
            asm volatile("s_waitcnt vmcnt(0)" ::: "memory");
            const unsigned og = xb_add(&bar[XB_TOP], 1u);
            const unsigned tg = og / nx;
            if (og + 1u == (tg + 1u) * nx) xb_add(&bar[XB_TOPGEN], 1u);
            else XB_SPIN(xb_ld(&bar[XB_TOPGEN]) == tg, bar);
            __builtin_amdgcn_fence(__ATOMIC_ACQUIRE, "agent");
            xb_add(&bar[XB_XGEN(b.x)], 1u);
            asm volatile("s_waitcnt vmcnt(0)" ::: "memory");
        } else {
            XB_SPIN(xb_ld(&bar[XB_XGEN(b.x)]) == gen, bar);
            __builtin_amdgcn_fence(__ATOMIC_ACQUIRE, "agent");
            asm volatile("s_waitcnt vmcnt(0)" ::: "memory");
        }
    }
    __syncthreads();
}


__global__ void __launch_bounds__(NTHREADS, 2) fwd_megakernel(Params p) {
    extern __shared__ __attribute__((aligned(16))) unsigned char lds[];
    cg::grid_group grid = cg::this_grid();
    volatile __attribute__((address_space(3))) unsigned* bst = (volatile __attribute__((address_space(3))) unsigned*)((__attribute__((address_space(3))) unsigned char*)lds + (LDS_BYTES - 16));
    if (threadIdx.x < 4) bst[threadIdx.x] = 0u;
    __syncthreads();
    XcdBarrier xbar = xcd_barrier_post((unsigned*)(p.ws + WS_BAR), bst);
#define GRID_BAR() xcd_barrier(xbar)
#pragma unroll 1
    for (int l0 = 0; l0 < DEPTH; ++l0) {
        { const Params q = launder(p); const int l = launder_i(l0); phase_convert_weights(q, l, lds); }
        __syncthreads();
        { const Params q = launder(p); const int l = launder_i(l0); phase_rowpass<0>(q, (l == 0) ? q.x : q.out, q.norm_w + (size_t)l * D, l, lds); }
        if (l0 == 0) grid.sync(); else GRID_BAR();
        { const Params q = launder(p); const int l = launder_i(l0); phase_inproj(q, l, lds); }
        GRID_BAR();
        { const Params q = launder(p); const int l = launder_i(l0); phase_mixers(q, l, lds, 0, 3); }
        GRID_BAR();
        { const Params q = launder(p); const int l = launder_i(l0); phase_scan(q, l, lds, 0, 3); }
        GRID_BAR();
        { const Params q = launder(p); const int l = launder_i(l0); phase_finalize(q, l, 0); }
        { const Params q = launder(p); phase_gates(q, lds); }
        GRID_BAR();
        { const Params q = launder(p); phase_lift(q, lds); }
        GRID_BAR();
        { const Params q = launder(p); const int l = launder_i(l0); phase_outproj(q, (l == 0) ? q.x : q.out, lds); }
        GRID_BAR();
    }
    { const Params q = launder(p); phase_rowpass<1>(q, q.out, q.final_norm, 0, lds); }
}

extern "C" void kernel_launch(void* const* d_in, const int* in_sizes, int n_in, void* d_out, int out_size, void* d_ws, size_t ws_size, hipStream_t stream) {
    static int grid_blocks = 0;
    if (grid_blocks == 0) {
        if (n_in != 14 || in_sizes[0] != M * D || out_size != M * D || ws_size < WS_END) {
            fprintf(stderr, "kernel_launch: unexpected shapes n_in=%d in0=%d out=%d ws=%zu (need %zu)\n", n_in, n_in > 0 ? in_sizes[0] : -1, out_size, ws_size, (size_t)WS_END); grid_blocks = -1; return; }
        int dev = 0, cus = 0, per_cu = 0;
        hipGetDevice(&dev);
        hipDeviceGetAttribute(&cus, hipDeviceAttributeMultiprocessorCount, dev);
        hipFuncSetAttribute((const void*)fwd_megakernel, hipFuncAttributeMaxDynamicSharedMemorySize, LDS_BYTES);
        hipOccupancyMaxActiveBlocksPerMultiprocessor(&per_cu, (const void*)fwd_megakernel, NTHREADS, LDS_BYTES);
        if (per_cu < 1) { fprintf(stderr, "kernel_launch: occupancy query says %d blocks/CU\n", per_cu); per_cu = 1; }
        if (per_cu > 1) per_cu = 1;
        grid_blocks = cus * per_cu;
        if (grid_blocks < 256) { fprintf(stderr, "kernel_launch: needs >= 256 resident blocks, got %d\n", grid_blocks); grid_blocks = -1; return; }
    }
    if (grid_blocks < 0) return;
    Params p{};
    p.x = (const float*)d_in[0]; p.norm_w = (const float*)d_in[1]; p.w_in = (const float*)d_in[2]; p.conv_w = (const float*)d_in[3];
    p.a_log = (const float*)d_in[4]; p.dt_bias = (const float*)d_in[5]; p.lb_param = (const float*)d_in[6]; p.norm_a = (const float*)d_in[7];
    p.norm_b = (const float*)d_in[8]; p.sinks = (const float*)d_in[9]; p.rel_bias = (const float*)d_in[10]; p.w_branch = (const float*)d_in[11];
    p.w_out = (const float*)d_in[12]; p.final_norm = (const float*)d_in[13];
    p.out = (float*)d_out; p.ws = (unsigned char*)d_ws;
    (void)hipMemsetAsync((char*)d_ws + WS_BAR, 0, 16384, stream);
    void* args[] = {&p};
    hipError_t e = hipLaunchCooperativeKernel((const void*)fwd_megakernel, dim3(grid_blocks), dim3(NTHREADS), args, LDS_BYTES, stream);
    if (e != hipSuccess) fprintf(stderr, "cooperative launch failed: %s (grid %d)\n", hipGetErrorString(e), grid_blocks);
}
```
